# Optimizing an MI355X kernel written in HIP

```python
import math
import jax, jax.numpy as jnp
from jax import lax
import numpy as np

D_MODEL = 2048
BATCH = 2
SEQ = 4096
DEPTH = 1
DEC_BATCH = 128
DEC_SEQ = 8
PAST_LEN = 8192
PAGE_SIZE = 128

N_META = 16
MIX_WIDTH = D_MODEL
ATT_WIDTH = MIX_WIDTH // 2
HEAD_DIM = 64
N_HEADS = ATT_WIDTH // HEAD_DIM
N_KV_HEADS = 4
GQA_GROUP = N_HEADS // N_KV_HEADS
KV_WIDTH = N_KV_HEADS * HEAD_DIM
WINDOW = 128
ATT_BLOCK = WINDOW
N_BUCKETS = 32
MAX_DISTANCE = 128
GLA_WIDTH = MIX_WIDTH - ATT_WIDTH
GLA_HEADS = 4
GLA_DV = GLA_WIDTH // GLA_HEADS
GLA_DK = GLA_DV // 2
GLA_KEY_WIDTH = GLA_HEADS * GLA_DK
GLA_RANK = 16
GLA_NORMALIZER = 16.0
GLA_CHUNK = 64
FRONT_PAD = ATT_BLOCK - N_META
EPS = 1e-6

IN_SIZES = (ATT_WIDTH, KV_WIDTH, KV_WIDTH, ATT_WIDTH,
            GLA_KEY_WIDTH, GLA_KEY_WIDTH, GLA_WIDTH, GLA_WIDTH, GLA_RANK)
IN_WIDTH = sum(IN_SIZES)
SPLIT_POINTS = tuple(int(c) for c in np.cumsum(IN_SIZES)[:-1])

kernel_name = 'hymba_swa_sink_gla_decode_step'


def rmsnorm(x, w):
    xf = x.astype(jnp.float32)
    var = jnp.mean(xf * xf, axis=-1, keepdims=True)
    return (xf * lax.rsqrt(var + EPS) * w.astype(jnp.float32)).astype(x.dtype)


def t5_bucket(dist):
    max_exact = N_BUCKETS // 2
    d = jnp.maximum(dist, 0)
    ratio = jnp.maximum(d, max_exact).astype(jnp.float32) / max_exact
    large = max_exact + (jnp.log(ratio) / math.log(MAX_DISTANCE / max_exact)
                         * (N_BUCKETS - max_exact)).astype(jnp.int32)
    large = jnp.minimum(large, N_BUCKETS - 1)
    return jnp.where(d < max_exact, d, large)


def sink_softmax(s, mask, sink):
    s = jnp.where(mask, s, -jnp.inf)
    m = jnp.maximum(jnp.max(s, axis=-1, keepdims=True), sink)
    e = jnp.exp(s - m)
    return e / (jnp.sum(e, axis=-1, keepdims=True) + jnp.exp(sink - m))


def project(h, w_in, w_a2, b_a):
    q_a, k_a, v_a, gate_a, q_g, k_g, v_g, gate_g, z_g = jnp.split(h @ w_in, SPLIT_POINTS, axis=-1)
    lead = h.shape[:-1]
    q_a = q_a.reshape(*lead, N_KV_HEADS, GQA_GROUP, HEAD_DIM)
    k_a = k_a.reshape(*lead, N_KV_HEADS, HEAD_DIM)
    v_a = v_a.reshape(*lead, N_KV_HEADS, HEAD_DIM)
    q_g = q_g.reshape(*lead, GLA_HEADS, GLA_DK) * (GLA_DK ** -0.5)
    k_g = k_g.reshape(*lead, GLA_HEADS, GLA_DK)
    v_g = v_g.reshape(*lead, GLA_HEADS, GLA_DV)
    log_f = jax.nn.log_sigmoid((z_g @ w_a2 + b_a).astype(jnp.float32)) / GLA_NORMALIZER
    log_f = log_f.reshape(*lead, GLA_HEADS, GLA_DK)
    return q_a, k_a, v_a, gate_a, q_g, k_g, v_g, gate_g, log_f


def merge(att_o, gate_a, gla_o, gate_g, gla_norm, w_out):
    lead = att_o.shape[:-1]
    gla_o = rmsnorm(gla_o, gla_norm).reshape(*lead, GLA_WIDTH).astype(gate_g.dtype)
    mixed = jnp.concatenate([att_o * jax.nn.silu(gate_a), gla_o * jax.nn.silu(gate_g)], axis=-1)
    return mixed @ w_out


def swa_prompt(q, k, v, sinks, rel_bias):
    B, Lp = q.shape[:2]
    nb = Lp // ATT_BLOCK
    qb = q.reshape(B, nb, ATT_BLOCK, N_KV_HEADS, GQA_GROUP, HEAD_DIM)
    kb = k.reshape(B, nb, ATT_BLOCK, N_KV_HEADS, HEAD_DIM)
    vb = v.reshape(B, nb, ATT_BLOCK, N_KV_HEADS, HEAD_DIM)

    def with_prev(t):
        prev = jnp.concatenate([jnp.zeros_like(t[:, :1]), t[:, :-1]], axis=1)
        return jnp.concatenate([prev, t], axis=2)

    kk, vv = with_prev(kb), with_prev(vb)
    qpos = (jnp.arange(Lp) - FRONT_PAD).reshape(nb, ATT_BLOCK)
    kpos = (jnp.arange(nb)[:, None] - 1) * ATT_BLOCK + jnp.arange(2 * ATT_BLOCK)[None, :] - FRONT_PAD
    dist = qpos[:, :, None] - kpos[:, None, :]
    mask = (dist >= 0) & (dist < WINDOW) & (kpos[:, None, :] >= 0)
    bias = rel_bias[t5_bucket(dist)].astype(jnp.float32)
    bias = bias.reshape(nb, ATT_BLOCK, 2 * ATT_BLOCK, N_KV_HEADS, GQA_GROUP).transpose(0, 3, 4, 1, 2)
    s = jnp.einsum('bnqhgd,bnshd->bnhgqs', qb, kk).astype(jnp.float32) * (HEAD_DIM ** -0.5) + bias
    p = sink_softmax(s, mask[:, None, None], sinks.astype(jnp.float32).reshape(N_KV_HEADS, GQA_GROUP, 1, 1))
    o = jnp.einsum('bnhgqs,bnshd->bnqhgd', p.astype(v.dtype), vv)
    return o.reshape(B, Lp, ATT_WIDTH)


def swa_sample(q, k, v, k_buf, v_buf, sinks, rel_bias):
    DB, T = q.shape[:2]
    W = k_buf.shape[1]
    kk = jnp.concatenate([k_buf, k], axis=1)
    vv = jnp.concatenate([v_buf, v], axis=1)
    qpos = PAST_LEN + jnp.arange(T)
    kpos = PAST_LEN - W + jnp.arange(W + T)
    dist = qpos[:, None] - kpos[None, :]
    mask = (dist >= 0) & (dist < WINDOW)
    bias = rel_bias[t5_bucket(dist)].astype(jnp.float32)
    bias = bias.reshape(T, W + T, N_KV_HEADS, GQA_GROUP).transpose(2, 3, 0, 1)
    s = jnp.einsum('bqhgd,bshd->bhgqs', q, kk).astype(jnp.float32) * (HEAD_DIM ** -0.5) + bias
    p = sink_softmax(s, mask, sinks.astype(jnp.float32).reshape(N_KV_HEADS, GQA_GROUP, 1, 1))
    o = jnp.einsum('bhgqs,bshd->bqhgd', p.astype(v.dtype), vv)
    return o.reshape(DB, T, ATT_WIDTH), kk[:, -W:], vv[:, -W:]


def gla_chunk(q, k, v, g, s0):
    C = q.shape[2]
    b = jnp.cumsum(g, axis=2)
    causal = jnp.tril(jnp.ones((C, C), dtype=bool))
    diff = b[:, :, :, None, :] - b[:, :, None, :, :]
    decay = jnp.exp(jnp.where(causal[:, :, None], diff, -jnp.inf))
    scores = jnp.einsum('bhtk,bhtsk,bhsk->bhts', q, decay, k)
    o = (jnp.einsum('bhts,bhsv->bhtv', scores, v)
         + jnp.einsum('bhtk,bhkv->bhtv', q * jnp.exp(b), s0))
    b_last = b[:, :, -1:, :]
    s_new = (jnp.exp(b_last[:, :, 0, :, None]) * s0
             + jnp.einsum('bhsk,bhsv->bhkv', k * jnp.exp(b_last - b), v))
    return o, s_new


def gla_prompt(q, k, v, log_f):
    B, Lp = q.shape[:2]
    nc = Lp // GLA_CHUNK
    valid = (jnp.arange(Lp) >= FRONT_PAD)[None, :, None, None]
    k = jnp.where(valid, k, 0)
    log_f = jnp.where(valid, log_f, 0.0)

    def to_chunks(t):
        return t.astype(jnp.float32).reshape(B, nc, GLA_CHUNK, GLA_HEADS, -1).transpose(1, 0, 3, 2, 4)

    def step(s, inp):
        qc, kc, vc, gc = inp
        o, s = gla_chunk(qc, kc, vc, gc, s)
        return s, o

    s0 = jnp.zeros((B, GLA_HEADS, GLA_DK, GLA_DV), jnp.float32)
    s_fin, o = lax.scan(step, s0, (to_chunks(q), to_chunks(k), to_chunks(v), to_chunks(log_f)))
    o = o.transpose(1, 0, 3, 2, 4).reshape(B, Lp, GLA_HEADS, GLA_DV)
    return o, s_fin


def setup_inputs(seed: int = 0) -> dict:
    key = jax.random.key(seed)
    ks = jax.random.split(key, 16)
    w_cache = min(WINDOW, PAST_LEN)
    nrm = jax.random.normal
    return {
        'x_prompt': nrm(ks[0], (BATCH, SEQ, D_MODEL), jnp.float32),
        'x_sample': nrm(ks[1], (DEC_BATCH, DEC_SEQ, D_MODEL), jnp.float32),
        'cache_k_win': nrm(ks[2], (DEPTH, DEC_BATCH, w_cache, N_KV_HEADS, HEAD_DIM), jnp.float32),
        'cache_v_win': nrm(ks[3], (DEPTH, DEC_BATCH, w_cache, N_KV_HEADS, HEAD_DIM), jnp.float32),
        'state_gla': 0.1 * nrm(ks[4], (DEPTH, DEC_BATCH, GLA_HEADS, GLA_DK, GLA_DV), jnp.float32),
        'meta_tokens': nrm(ks[5], (N_META, D_MODEL), jnp.float32),
        'rel_bias': 0.5 * nrm(ks[6], (N_BUCKETS, N_HEADS), jnp.float32),
        'norm_pre': 1.0 + 0.1 * nrm(ks[7], (DEPTH, D_MODEL), jnp.float32),
        'norm_post': 1.0 + 0.1 * nrm(ks[8], (DEPTH, D_MODEL), jnp.float32),
        'w_in': nrm(ks[9], (DEPTH, D_MODEL, IN_WIDTH), jnp.float32) * D_MODEL ** -0.5,
        'w_a2': nrm(ks[10], (DEPTH, GLA_RANK, GLA_KEY_WIDTH), jnp.float32) * GLA_RANK ** -0.5,
        'b_a': 0.1 * nrm(ks[11], (DEPTH, GLA_KEY_WIDTH), jnp.float32),
        'attn_sinks': nrm(ks[12], (DEPTH, N_HEADS), jnp.float32),
        'gla_norm': 1.0 + 0.1 * nrm(ks[13], (DEPTH, GLA_DV), jnp.float32),
        'w_out': nrm(ks[14], (DEPTH, MIX_WIDTH, D_MODEL), jnp.float32) * MIX_WIDTH ** -0.5,
    }


def reference(x_prompt, x_sample, cache_k_win, cache_v_win, state_gla, meta_tokens, rel_bias,
              norm_pre, norm_post, w_in, w_a2, b_a, attn_sinks, gla_norm, w_out):
    B = x_prompt.shape[0]
    meta = jnp.broadcast_to(meta_tokens[None].astype(x_prompt.dtype), (B, N_META, D_MODEL))
    xp = jnp.concatenate([meta, x_prompt], axis=1)
    xs = x_sample
    kwp, vwp, sgp, kws, vws, sgs = [], [], [], [], [], []
    for l in range(DEPTH):
        h = rmsnorm(xp, norm_pre[l])
        h = jnp.pad(h, ((0, 0), (FRONT_PAD, 0), (0, 0)))
        q_a, k_a, v_a, gate_a, q_g, k_g, v_g, gate_g, log_f = project(h, w_in[l], w_a2[l], b_a[l])
        att_o = swa_prompt(q_a, k_a, v_a, attn_sinks[l], rel_bias)
        gla_o, s_fin = gla_prompt(q_g, k_g, v_g, log_f)
        o = merge(att_o, gate_a, gla_o, gate_g, gla_norm[l], w_out[l])[:, FRONT_PAD:]
        xp = xp + rmsnorm(o, norm_post[l])
        kwp.append(k_a[:, -WINDOW:])
        vwp.append(v_a[:, -WINDOW:])
        sgp.append(s_fin)
        h = rmsnorm(xs, norm_pre[l])
        q_a, k_a, v_a, gate_a, q_g, k_g, v_g, gate_g, log_f = project(h, w_in[l], w_a2[l], b_a[l])
        att_o, k_new, v_new = swa_sample(q_a, k_a, v_a, cache_k_win[l], cache_v_win[l], attn_sinks[l], rel_bias)
        to_bhtd = lambda t: t.astype(jnp.float32).transpose(0, 2, 1, 3)
        gla_o, s_new = gla_chunk(to_bhtd(q_g), to_bhtd(k_g), to_bhtd(v_g), to_bhtd(log_f),
                                 state_gla[l].astype(jnp.float32))
        gla_o = gla_o.transpose(0, 2, 1, 3)
        o = merge(att_o, gate_a, gla_o, gate_g, gla_norm[l], w_out[l])
        xs = xs + rmsnorm(o, norm_post[l])
        kws.append(k_new)
        vws.append(v_new)
        sgs.append(s_new)
    y_prompt = xp[:, N_META:]
    y_sample = xs
    return (y_prompt, y_sample, jnp.stack(kwp), jnp.stack(vwp), jnp.stack(sgp),
            jnp.stack(kws), jnp.stack(vws), jnp.stack(sgs))
```

```cpp
#include <hip/hip_runtime.h>
#include <cstdio>
#include <cstdint>
#include <cmath>
namespace pg8 {
#define PG8_LAS __attribute__((address_space(3)))
typedef unsigned short bf16_t;
typedef short bf16x8 __attribute__((ext_vector_type(8)));
typedef float f32x4 __attribute__((ext_vector_type(4)));
typedef unsigned u32x4 __attribute__((ext_vector_type(4)));
constexpr int BM = 256, BK = 64, HALF = 128, HTB = HALF * BK * 2  , STAGE_BYTES = 8 * HTB, NXCD = 8, WGM = 8;

__host__ __device__ __forceinline__ int lds_byte(int r, int c) { const int st = (r >> 4) * 2 + (c >> 5), rr = r & 15, cc = c & 31, ob = rr * 64 + cc * 2; return st * 1024 + (ob ^ (((ob >> 9) & 1) << 5)); }
__host__ __device__ __forceinline__ void stage_rc(int b, int& R, int& C) { const int st = b / 1024, sb = b % 1024, swz = sb ^ (((sb >> 9) & 1) << 5); R = (st >> 1) * 16 + swz / 64; C = (st & 1) * 32 + (swz % 64) / 2; }
__host__ __device__ __forceinline__ int perm32(int rho) { const int n = rho >> 4, i = rho & 15; return 8 * (i >> 2) + 4 * n + (i & 3); }

struct Unit { int pm, pn; };
struct Gemm { const bf16_t* A; const bf16_t* Bt; int M, N, K; };

struct StaticOrder {
    int nM, nN, nwg, G, c;
    __host__ __device__ void init(int M, int N, int G_, int c_) { nM = M / BM; nN = N / BM; nwg = nM * nN; G = G_; c = c_; }
    __host__ __device__ bool next(int i, Unit& u) const {
        const long L = (long)i * G + c; if (L >= nwg) return false;
        int wgid = (int)L; { const int q = nwg / NXCD, r = nwg % NXCD, xcd = wgid % NXCD, off = wgid / NXCD; wgid = (xcd < r ? xcd * (q + 1) : r * (q + 1) + (xcd - r) * q) + off; }
        const int nig = WGM * nN, gid = wgid / nig, fm = gid * WGM, gsz = (nM - fm) < WGM ? (nM - fm) : WGM;
        u.pm = fm + ((wgid % nig) % gsz); u.pn = (wgid % nig) / gsz; return true;
    }
    __device__ __forceinline__ void a_ready(const Unit&) const {}
    __device__ __forceinline__ void done(const Unit&) const {}
};

__device__ __forceinline__ unsigned cvt_pk_bf16(float lo, float hi) { unsigned r; asm volatile("v_cvt_pk_bf16_f32 %0, %1, %2" : "=v"(r) : "v"(lo), "v"(hi)); return r; }
typedef float f32x2 __attribute__((ext_vector_type(2)));
__device__ __forceinline__ f32x2 gelu_pk(f32x2 v) {
    const f32x2 av = __builtin_elementwise_abs(v), d = av * 0.2316418882f + 1.0f;
    f32x2 t; t.x = __builtin_amdgcn_rcpf(d.x); t.y = __builtin_amdgcn_rcpf(d.y);
    f32x2 q = t * 0.5307027145f + (-0.7265760135f); q = q * t + 0.7107068705f; q = q * t + (-0.142248368f); q = q * t + 0.127414796f; q = q * t;
    const f32x2 s = (v * v) * (-0.72134752044f);
    f32x2 e; e.x = __builtin_amdgcn_exp2f(s.x); e.y = __builtin_amdgcn_exp2f(s.y);
    const f32x2 m = v * (q * e), r = v - m;
    f32x2 o; o.x = v.x < 0.f ? m.x : r.x; o.y = v.y < 0.f ? m.y : r.y; return o;
}

template <int ACT  > struct EpiBf16 {
    static constexpr bool PERM = true, AFTER_DRAIN = false; static_assert(ACT == 0 || ACT == 1, "EpiBf16: ACT is 0 (none) or 1 (gelu_pk)");
    bf16_t* O; int ldc; const float* bias; int split_cols; size_t split_stride; float scale0;
    __device__ __forceinline__ void operator()(const f32x4 (&acc)[2][2][4][2], const Unit& u, int wr, int wc, int fr, int fq) const {
        const int row0 = u.pm * BM + wr * 64 + fr; int colt = u.pn * BM; bf16_t* base = O;
        float sc = 1.f; if (split_cols) { const int t = colt / split_cols; base += (size_t)t * split_stride; colt -= t * split_cols; if (t == 0) sc = scale0; }
        const int col0 = colt + wc * 32 + 8 * fq, bcol0 = u.pn * BM + wc * 32 + 8 * fq;
        f32x4 bv[2][2];
#pragma unroll
        for (int bj = 0; bj < 2; ++bj)
#pragma unroll
            for (int n = 0; n < 2; ++n) bv[bj][n] = bias ? *(const f32x4*)(bias + bcol0 + bj * HALF + 4 * n) : (f32x4){0.f, 0.f, 0.f, 0.f};
#pragma unroll
        for (int ai = 0; ai < 2; ++ai)
#pragma unroll
            for (int m = 0; m < 4; ++m) { bf16_t* rowp = base + (size_t)(row0 + ai * HALF + m * 16) * ldc + col0;
#pragma unroll
                for (int bj = 0; bj < 2; ++bj) { f32x4 v0 = acc[ai][bj][m][0] + bv[bj][0], v1 = acc[ai][bj][m][1] + bv[bj][1];
                    if (ACT == 1) { f32x2 a = gelu_pk((f32x2){v0[0], v0[1]}), b = gelu_pk((f32x2){v0[2], v0[3]}), c = gelu_pk((f32x2){v1[0], v1[1]}), d = gelu_pk((f32x2){v1[2], v1[3]});
                        v0 = (f32x4){a.x, a.y, b.x, b.y}; v1 = (f32x4){c.x, c.y, d.x, d.y}; }
                    v0 = v0 * sc; v1 = v1 * sc; u32x4 w; w.x = cvt_pk_bf16(v0[0], v0[1]); w.y = cvt_pk_bf16(v0[2], v0[3]); w.z = cvt_pk_bf16(v1[0], v1[1]); w.w = cvt_pk_bf16(v1[2], v1[3]);
                    *(u32x4*)(rowp + bj * HALF) = w; } }
    }
};

struct EpiF32 {
    static constexpr bool PERM = false, AFTER_DRAIN = false;
    float* O; int ldc;
    __device__ __forceinline__ void operator()(const f32x4 (&acc)[2][2][4][2], const Unit& u, int wr, int wc, int fr, int fq) const {
        const int row0 = u.pm * BM + wr * 64 + fr, col0 = u.pn * BM + wc * 32 + 4 * fq;
#pragma unroll
        for (int ai = 0; ai < 2; ++ai)
#pragma unroll
            for (int m = 0; m < 4; ++m) { float* rowp = O + (size_t)(row0 + ai * HALF + m * 16) * ldc + col0;
#pragma unroll
                for (int bj = 0; bj < 2; ++bj)
#pragma unroll
                    for (int n = 0; n < 2; ++n) *(f32x4*)(rowp + bj * HALF + n * 16) = acc[ai][bj][m][n]; }
    }
};
template <class Epi, class Sched, bool ALIGN_EPI = false, bool SP2 = false>
__device__ __forceinline__ void gemm_phase(PG8_LAS unsigned char* lds, const Gemm g, const Sched& S, const Epi& E) {
    const int tid = threadIdx.x, wid = __builtin_amdgcn_readfirstlane(tid >> 6), lane = tid & 63, wr = wid >> 2, wc = wid & 3, fr = lane & 15, fq = lane >> 4;
    const int K = g.K, nt = K / BK;
    unsigned voffA[2], voffB[2];
#pragma unroll
    for (int i = 0; i < 2; ++i) { int R, C; stage_rc(tid * 16 + i * 8192, R, C); const int Rb = Epi::PERM ? ((R & ~31) + perm32(R & 31)) : R;
        voffA[i] = (unsigned)(R * K + C) * 2u; voffB[i] = (unsigned)(Rb * K + C) * 2u; }
    const size_t kstep = (size_t)(BK * 2);
    const size_t hstep = (size_t)HALF * K * 2;
    const size_t tstep = 2 * hstep;
    const unsigned ldsw = (unsigned)wid * 1024u;
    const int aoff = lds_byte(wr * 64 + fr, fq * 8), boff = lds_byte(wc * 32 + fr, fq * 8);
#define PG8_SA(b, h) (((b) * 2 + (h)) * HTB)
#define PG8_SB(b, h) ((4 + (b) * 2 + (h)) * HTB)
#define PG8_STAGE(bufoff, gbase, voff) do { _Pragma("unroll") for (int _i = 0; _i < 2; ++_i) \
        __builtin_amdgcn_global_load_lds((const unsigned*)((const char*)(gbase) + (voff)[_i]), (PG8_LAS unsigned*)(lds + (bufoff) + ldsw + _i * 8192), 16, 0, 0); } while (0)
#define PG8_LDA(dst, b, h) do { _Pragma("unroll") for (int m = 0; m < 4; ++m) _Pragma("unroll") for (int k = 0; k < 2; ++k) dst[m][k] = *(const PG8_LAS bf16x8*)(lds + PG8_SA(b, h) + aoff + m * 2048 + k * 1024); } while (0)
#define PG8_LDB(dst, b, h) do { _Pragma("unroll") for (int n = 0; n < 2; ++n) _Pragma("unroll") for (int k = 0; k < 2; ++k) dst[n][k] = *(const PG8_LAS bf16x8*)(lds + PG8_SB(b, h) + boff + n * 2048 + k * 1024); } while (0)
#define PG8_MMA(ai, bj, At, Bt) do { __builtin_amdgcn_s_setprio(1); _Pragma("unroll") for (int m = 0; m < 4; ++m) _Pragma("unroll") for (int n = 0; n < 2; ++n) _Pragma("unroll") for (int k = 0; k < 2; ++k) \
        acc[ai][bj][m][n] = __builtin_amdgcn_mfma_f32_16x16x32_bf16(Bt[n][k], At[m][k], acc[ai][bj][m][n], 0, 0, 0); __builtin_amdgcn_s_setprio(0); } while (0)
#define PG8_WAIT_V(n) asm volatile("s_waitcnt vmcnt(" #n ")" ::: "memory")
#define PG8_WAIT_L(n) asm volatile("s_waitcnt lgkmcnt(" #n ")" ::: "memory")
#define PG8_BAR __builtin_amdgcn_s_barrier()
#define PG8_SCHED __builtin_amdgcn_sched_barrier(0)
    Unit cur, nxt; int ui = 0;
    if (!S.next(0, cur)) return;
    f32x4 acc[2][2][4][2];
#pragma unroll
    for (int a = 0; a < 2; ++a)
#pragma unroll
        for (int b = 0; b < 2; ++b)
#pragma unroll
            for (int m = 0; m < 4; ++m)
#pragma unroll
                for (int n = 0; n < 2; ++n) acc[a][b][m][n] = (f32x4){0.f, 0.f, 0.f, 0.f};
    bf16x8 At[4][2], B0[2][2], B1[2][2];
    const char* cA = (const char*)g.A + (size_t)cur.pm * tstep; const char* cB = (const char*)g.Bt + (size_t)cur.pn * tstep;
    S.a_ready(cur);
    if constexpr (SP2) {
        PG8_STAGE(PG8_SB(0, 0), cB, voffB); PG8_STAGE(PG8_SB(0, 1), cB + hstep, voffB); PG8_STAGE(PG8_SA(0, 0), cA, voffA); PG8_STAGE(PG8_SA(0, 1), cA + hstep, voffA);
        if (wr == 1) PG8_BAR;
        PG8_WAIT_V(2); PG8_BAR;
        PG8_STAGE(PG8_SB(1, 0), cB + kstep, voffB); PG8_STAGE(PG8_SA(1, 0), cA + kstep, voffA); PG8_STAGE(PG8_SB(1, 1), cB + hstep + kstep, voffB);
        PG8_WAIT_V(6); PG8_BAR;
    } else {
        PG8_STAGE(PG8_SB(0, 0), cB, voffB); PG8_STAGE(PG8_SA(0, 0), cA, voffA); PG8_STAGE(PG8_SB(0, 1), cB + hstep, voffB); PG8_STAGE(PG8_SA(0, 1), cA + hstep, voffA);
        if (wr == 1) PG8_BAR;
        PG8_WAIT_V(4); PG8_BAR;
        PG8_STAGE(PG8_SB(1, 0), cB + kstep, voffB); PG8_STAGE(PG8_SA(1, 0), cA + kstep, voffA); PG8_STAGE(PG8_SB(1, 1), cB + hstep + kstep, voffB);
        PG8_WAIT_V(6); PG8_BAR;
    }
    for (;;) {
        const bool has_next = S.next(ui + 1, nxt);
        const char* nA = has_next ? (const char*)g.A + (size_t)nxt.pm * tstep : cA; const char* nB = has_next ? (const char*)g.Bt + (size_t)nxt.pn * tstep : cB;
        for (int t = 0; t < nt; t += 2) {
            const bool last = (t == nt - 2);
            const char* a1 = cA + (size_t)(t + 1) * kstep;
            const char* a2 = last ? nA : cA + (size_t)(t + 2) * kstep; const char* b2 = last ? nB : cB + (size_t)(t + 2) * kstep;
            const char* a3 = a2 + kstep; const char* b3 = b2 + kstep;
            if (last && has_next) S.a_ready(nxt);
            if constexpr (SP2) {
            PG8_LDB(B0, 0, 0); PG8_LDB(B1, 0, 1); PG8_SCHED; PG8_LDA(At, 0, 0); PG8_STAGE(PG8_SA(1, 1), a1 + hstep, voffA);
            PG8_WAIT_V(8); PG8_WAIT_L(0); PG8_BAR; PG8_MMA(0, 0, At, B0); PG8_MMA(0, 1, At, B1); PG8_BAR; PG8_SCHED;
            PG8_LDA(At, 0, 1); PG8_STAGE(PG8_SB(0, 0), b2, voffB); PG8_STAGE(PG8_SB(0, 1), b2 + hstep, voffB); PG8_STAGE(PG8_SA(0, 0), a2, voffA);
            PG8_WAIT_V(8); PG8_WAIT_L(0); PG8_BAR; PG8_MMA(1, 0, At, B0); PG8_MMA(1, 1, At, B1); PG8_BAR; PG8_SCHED;
            PG8_LDB(B0, 1, 0); PG8_LDB(B1, 1, 1); PG8_SCHED; PG8_LDA(At, 1, 0); PG8_STAGE(PG8_SA(0, 1), a2 + hstep, voffA);
            PG8_WAIT_V(8); PG8_WAIT_L(0); PG8_BAR; PG8_MMA(0, 0, At, B0); PG8_MMA(0, 1, At, B1); PG8_BAR; PG8_SCHED;
            PG8_LDA(At, 1, 1); PG8_STAGE(PG8_SB(1, 0), b3, voffB); PG8_STAGE(PG8_SB(1, 1), b3 + hstep, voffB); PG8_STAGE(PG8_SA(1, 0), a3, voffA);
            PG8_WAIT_V(8); PG8_WAIT_L(0); PG8_BAR; PG8_MMA(1, 0, At, B0); PG8_MMA(1, 1, At, B1); PG8_BAR; PG8_SCHED;
            } else {
            PG8_LDB(B0, 0, 0); PG8_SCHED; PG8_LDA(At, 0, 0); PG8_STAGE(PG8_SA(1, 1), a1 + hstep, voffA);
            PG8_WAIT_L(8); PG8_BAR; PG8_WAIT_L(0); PG8_MMA(0, 0, At, B0); PG8_BAR; PG8_SCHED;
            PG8_LDB(B1, 0, 1); PG8_STAGE(PG8_SB(0, 0), b2, voffB);
            PG8_BAR; PG8_WAIT_L(0); PG8_MMA(0, 1, At, B1); PG8_BAR;
            PG8_LDA(At, 0, 1); PG8_STAGE(PG8_SA(0, 0), a2, voffA);
            PG8_BAR; PG8_WAIT_L(0); PG8_MMA(1, 0, At, B0); PG8_BAR; PG8_SCHED;
            PG8_STAGE(PG8_SB(0, 1), b2 + hstep, voffB);
            PG8_WAIT_V(6); PG8_BAR; PG8_MMA(1, 1, At, B1); PG8_BAR;
            PG8_LDB(B0, 1, 0); PG8_SCHED; PG8_LDA(At, 1, 0); PG8_STAGE(PG8_SA(0, 1), a2 + hstep, voffA);
            PG8_WAIT_L(8); PG8_BAR; PG8_WAIT_L(0); PG8_MMA(0, 0, At, B0); PG8_BAR; PG8_SCHED;
            PG8_LDB(B1, 1, 1); PG8_STAGE(PG8_SB(1, 0), b3, voffB);
            PG8_BAR; PG8_WAIT_L(0); PG8_MMA(0, 1, At, B1); PG8_BAR;
            PG8_LDA(At, 1, 1); PG8_STAGE(PG8_SA(1, 0), a3, voffA);
            PG8_BAR; PG8_WAIT_L(0); PG8_MMA(1, 0, At, B0); PG8_BAR; PG8_SCHED;
            PG8_STAGE(PG8_SB(1, 1), b3 + hstep, voffB);
            PG8_WAIT_V(6); PG8_BAR; PG8_MMA(1, 1, At, B1); PG8_BAR;
            }
        }
        if constexpr (ALIGN_EPI) { if (wr == 0) PG8_BAR; }
        if constexpr (!Epi::AFTER_DRAIN) { E(acc, cur, wr, wc, fr, fq); S.done(cur); }
        if (!has_next) break;
#pragma unroll
        for (int a = 0; a < 2; ++a)
#pragma unroll
            for (int b = 0; b < 2; ++b)
#pragma unroll
                for (int m = 0; m < 4; ++m)
#pragma unroll
                    for (int n = 0; n < 2; ++n) acc[a][b][m][n] = (f32x4){0.f, 0.f, 0.f, 0.f};
        cur = nxt; cA = nA; cB = nB; ++ui;
        if constexpr (ALIGN_EPI) { if (wr == 1) PG8_BAR; }
    }
    PG8_WAIT_V(0);
    if constexpr (!ALIGN_EPI) { if (wr == 0) PG8_BAR; }
    PG8_BAR;
    if constexpr (Epi::AFTER_DRAIN) { E.fused(acc, cur, wr, wc, fr, fq, lds, wid, lane); S.done(cur); }
#undef PG8_SA
#undef PG8_SB
#undef PG8_STAGE
#undef PG8_LDA
#undef PG8_LDB
#undef PG8_MMA
#undef PG8_WAIT_V
#undef PG8_WAIT_L
#undef PG8_BAR
#undef PG8_SCHED
}
}

#define GAS __attribute__((address_space(1)))
#define LAS __attribute__((address_space(3)))
typedef unsigned short bf16;
typedef unsigned v4u __attribute__((ext_vector_type(4)));
typedef float f32x4 __attribute__((ext_vector_type(4)));
typedef short bf16x8 __attribute__((ext_vector_type(8)));
typedef GAS unsigned gu32;
typedef GAS unsigned long long gu64;
#define RLX_AGENT __ATOMIC_RELAXED, __HIP_MEMORY_SCOPE_AGENT
#define LDS_WAIT() asm volatile("s_waitcnt lgkmcnt(0)" ::: "memory")
#define VM_WAIT() asm volatile("s_waitcnt vmcnt(0)" ::: "memory")
__device__ __forceinline__ unsigned long long rt() { return __builtin_amdgcn_s_memrealtime(); }
__device__ __forceinline__ unsigned f2bf(float f) { unsigned u = __builtin_bit_cast(unsigned, f); return (u + 0x7fffu + ((u >> 16) & 1u)) >> 16; }
__device__ __forceinline__ unsigned pk2(float lo, float hi) { return f2bf(lo) | (f2bf(hi) << 16); }
#define XB_TMO      128
#define XB_XCNT(j)  (256  + 64 * (j))
#define XB_XSUB(j)  (1280 + 64 * (j))
#define XB_XGEN(j)  (2304 + 64 * (j))
#define XB_TOP      3328
#define XB_TOPGEN   3392
#define XCD_BAR_WORDS 3456
#define XB_SPIN_CAP (1u << 18)

__device__ __forceinline__ unsigned xb_ld(unsigned* p)              { return __hip_atomic_load(p, __ATOMIC_RELAXED, __HIP_MEMORY_SCOPE_AGENT); }
__device__ __forceinline__ unsigned xb_add(unsigned* p, unsigned v) { return __hip_atomic_fetch_add(p, v, __ATOMIC_RELAXED, __HIP_MEMORY_SCOPE_AGENT); }
__device__ __forceinline__ unsigned xb_xcc_id() { return (unsigned)__builtin_amdgcn_s_getreg((3 << 11) | 20) & 0xFu; }
#define XB_SPIN(cond, bar) do { unsigned _sp = 0; while (cond) { __builtin_amdgcn_s_sleep(1); \
    if ((++_sp & 255u) == 0u) { if (xb_ld(&(bar)[XB_TMO])) break; if (_sp > XB_SPIN_CAP) { atomicAdd(&(bar)[XB_TMO], 1u); break; } } } } while (0)

struct XcdBarrier {
    unsigned* bar; unsigned x;
    volatile LAS unsigned* st;
};

__device__ __forceinline__ XcdBarrier xcd_barrier_post(unsigned* bar, volatile LAS unsigned* st) {
    XcdBarrier b; b.bar = bar; b.x = xb_xcc_id(); b.st = st;
    if (threadIdx.x == 0) (void)xb_add(&bar[XB_XCNT(b.x)], 1u);
    return b;
}
__device__ __forceinline__ void xcd_barrier_complete(unsigned* bar, unsigned x, unsigned& nloc, unsigned& nx) {
    const unsigned G = gridDim.x * gridDim.y * gridDim.z;
    unsigned sum, cnt, mine, sp = 0u;
    for (;;) {
        sum = 0u; cnt = 0u; mine = 0u;
#pragma unroll
        for (unsigned j = 0; j < 16; ++j) { const unsigned c = xb_ld(&bar[XB_XCNT(j)]); sum += c; cnt += (c > 0u) ? 1u : 0u; mine = (j == x) ? c : mine; }
        if (sum == G) break;
        __builtin_amdgcn_s_sleep(1);
        if ((++sp & 255u) == 0u) { if (xb_ld(&bar[XB_TMO])) break; if (sp > XB_SPIN_CAP) { atomicAdd(&bar[XB_TMO], 1u); break; } }
    }
    nloc = mine > 0u ? mine : 1u; nx = cnt > 0u ? cnt : 1u;
}

__device__ __forceinline__ void xcd_barrier(const XcdBarrier& b) {
    asm volatile("s_waitcnt vmcnt(0)" ::: "memory");
    __syncthreads();
    if (threadIdx.x == 0) {
        unsigned* bar = b.bar;
        __builtin_amdgcn_s_waitcnt(0);
        unsigned nloc = b.st[0], nx = b.st[1];
        if (nloc == 0u) { xcd_barrier_complete(bar, b.x, nloc, nx); b.st[0] = nloc; b.st[1] = nx; }
        const unsigned old = xb_add(&bar[XB_XSUB(b.x)], 1u);
        const unsigned gen = old / nloc;
        if (old + 1u == (gen + 1u) * nloc) {
            __builtin_amdgcn_fence(__ATOMIC_RELEASE, "agent");
            asm volatile("s_waitcnt vmcnt(0)" ::: "memory");
            const unsigned og = xb_add(&bar[XB_TOP], 1u);
            const unsigned tg = og / nx;
            if (og + 1u == (tg + 1u) * nx) xb_add(&bar[XB_TOPGEN], 1u);
            else XB_SPIN(xb_ld(&bar[XB_TOPGEN]) == tg, bar);
            __builtin_amdgcn_fence(__ATOMIC_ACQUIRE, "agent");
            xb_add(&bar[XB_XGEN(b.x)], 1u);
            asm volatile("s_waitcnt vmcnt(0)" ::: "memory");
        } else {
            XB_SPIN(xb_ld(&bar[XB_XGEN(b.x)]) == gen, bar);
            __builtin_amdgcn_fence(__ATOMIC_ACQUIRE, "agent");
            asm volatile("s_waitcnt vmcnt(0)" ::: "memory");
        }
    }
    __syncthreads();
}


constexpr int NWAVES = 8, NTHREADS = 512;
constexpr int DM = 2048, NBATCH = 2, SEQ = 4096, NMETA = 16, FPAD = 112, LP = 4224, NBLK = 33;
constexpr int DBATCH = 128, DSEQ = 8, WIN = 128;
constexpr int ROWS_P = NBATCH * LP, ROWS_S = DBATCH * DSEQ, MROWS = ROWS_P + ROWS_S;
constexpr int NIN = 5648, NPAD = 5888;
constexpr int C_QA = 0, C_KA = 1024, C_VA = 1280, C_GA = 1536, C_QG = 2560, C_KG = 3072, C_VG = 3584, C_GG = 4608, C_ZG = 5632;
constexpr float EPSN = 1e-6f;
static_assert(MROWS % 256 == 0 && NPAD % 256 == 0, "tiles");

constexpr size_t O_YP = 0, O_YS = 16777216, O_KWP = 18874368, O_VWP = 18939904, O_GP = 19005440, O_KWS = 19267584, O_VWS = 23461888, O_GS = 27656192, O_END = 44433408;

constexpr size_t MiB = 1u << 20;
constexpr size_t WS_CTL = 0, CTL_ZERO_BYTES = 64 * 1024;
constexpr size_t WS_WIN = 1 * MiB;
constexpr size_t WS_WOUT = 24 * MiB;
constexpr size_t WS_XN = 32 * MiB;
constexpr size_t WS_P = 69 * MiB;
constexpr size_t WS_DST = 176 * MiB;
constexpr size_t WS_ST = 209 * MiB;
constexpr size_t WS_DEC = 226 * MiB;
constexpr size_t WS_END = 227 * MiB;
constexpr int CW_BAR = 1024;

constexpr int LDS_CTL_BYTES = 1024;
constexpr int SCR_OFF = 1024;
constexpr int LDS_BYTES = 156 * 1024;

typedef short bf16x4 __attribute__((ext_vector_type(4)));
typedef short v4i16_t __attribute__((ext_vector_type(4)));
typedef float f32x2 __attribute__((ext_vector_type(2)));

__device__ __forceinline__ float bf2f(unsigned short b) { return __uint_as_float(((unsigned)b) << 16); }
__device__ __forceinline__ unsigned short f2bf16(float f) { return (unsigned short)f2bf(f); }
__device__ __forceinline__ float wave_sum(float v) {
#pragma unroll
    for (int o = 1; o < 64; o <<= 1) v += __shfl_xor(v, o);
    return v;
}
__device__ __forceinline__ float silu_f(float x) { return x / (1.f + __expf(-x)); }
__device__ __forceinline__ float logsig_f(float x) { return fminf(x, 0.f) - __logf(1.f + __expf(-fabsf(x))); }

#ifndef USE_TR
#define USE_TR 1
#endif
__device__ __forceinline__ bf16x8 tr_frag(const LAS unsigned short* M, int row0, int col0, int pitch, int lane) {
#if USE_TR
    const int q = (lane & 15) >> 2, p = lane & 3;
    const LAS unsigned short* a0 = M + (row0 + q) * pitch + col0 + 4 * p;
    const v4i16_t lo = __builtin_amdgcn_ds_read_tr16_b64_v4i16((LAS v4i16_t*)a0);
    const v4i16_t hi = __builtin_amdgcn_ds_read_tr16_b64_v4i16((LAS v4i16_t*)(a0 + 4 * pitch));
    return (bf16x8){lo[0], lo[1], lo[2], lo[3], hi[0], hi[1], hi[2], hi[3]};
#else
    bf16x8 r; const LAS unsigned short* a0 = M + row0 * pitch + col0 + (lane & 15);
#pragma unroll
    for (int j = 0; j < 8; ++j) r[j] = (short)a0[j * pitch];
    return r;
#endif
}
#define MFMA16(a, b, c) __builtin_amdgcn_mfma_f32_16x16x32_bf16((a), (b), (c), 0, 0, 0)

struct Frame {
    LAS unsigned char* lds;
    int tid, lane, wave, G;
    unsigned char* ws; float* out;
    __device__ __forceinline__ bf16* WinT() const { return (bf16*)(ws + WS_WIN); }
    __device__ __forceinline__ bf16* WoutT() const { return (bf16*)(ws + WS_WOUT); }
    __device__ __forceinline__ bf16* XN() const { return (bf16*)(ws + WS_XN); }
    __device__ __forceinline__ bf16* MIX() const { return (bf16*)(ws + WS_XN); }
    __device__ __forceinline__ bf16* P() const { return (bf16*)(ws + WS_P); }
    __device__ __forceinline__ float* O2() const { return (float*)(ws + WS_P); }
    __device__ __forceinline__ float* dST() const { return (float*)(ws + WS_DST); }
    __device__ __forceinline__ bf16* St() const { return (bf16*)(ws + WS_ST); }
    __device__ __forceinline__ float* dec() const { return (float*)(ws + WS_DEC); }
};
enum { A_XP = 0, A_XS, A_CK, A_CV, A_STATE, A_META, A_RELB, A_NPRE, A_NPOST, A_WIN, A_WA2, A_BA, A_SINK, A_GNORM, A_WOUT, A_OUT, A_WS };
template <int IDX> __device__ __forceinline__ const float* ldarg() {
    const unsigned long long ka = (unsigned long long)__builtin_amdgcn_kernarg_segment_ptr();
    unsigned long long v;
    asm volatile("s_load_dwordx2 %0, %1, %2\n\ts_waitcnt lgkmcnt(0)" : "=s"(v) : "s"(ka), "i"(IDX * 8) : "memory");
    return (const float*)v;
}

__device__ __forceinline__ void p0_transpose_item(const float* W, int K, int N, bf16* WT, LAS float* scr, int kb, int nb, int lane) {
    const int k0 = 64 * kb, n0 = 32 * nb; const int n = n0 + (lane & 31);
#pragma unroll 8
    for (int i = 0; i < 32; ++i) { const int kk = 2 * i + (lane >> 5); scr[kk * 33 + (lane & 31)] = (n < N) ? W[(size_t)(k0 + kk) * N + n] : 0.f; }
    LDS_WAIT(); asm volatile("" ::: "memory");
    const int c = lane & 7;
#pragma unroll
    for (int j = 0; j < 4; ++j) { const int nn = (lane >> 3) + 8 * j; const LAS float* s = scr + (8 * c) * 33 + nn;
        v4u o; o.x = pk2(s[0 * 33], s[1 * 33]); o.y = pk2(s[2 * 33], s[3 * 33]); o.z = pk2(s[4 * 33], s[5 * 33]); o.w = pk2(s[6 * 33], s[7 * 33]);
        *(GAS v4u*)(WT + (size_t)(n0 + nn) * K + k0 + 8 * c) = o; }
    LDS_WAIT(); asm volatile("" ::: "memory");
}
__device__ __forceinline__ void p0_row(Frame& F, int m) { const float* const meta = ldarg<A_META>(); const float* const x_prompt = ldarg<A_XP>(); const float* const x_sample = ldarg<A_XS>(); const float* const norm_pre = ldarg<A_NPRE>();
    GAS unsigned long long* o8 = (GAS unsigned long long*)(F.XN() + (size_t)m * DM) + F.lane;
    const float* src = nullptr;
    if (m < ROWS_P) { const int b = m / LP, i = m - b * LP;
        if (i >= FPAD) src = (i < 128) ? meta + (size_t)(i - FPAD) * DM : x_prompt + ((size_t)b * SEQ + (i - 128)) * DM;
    } else src = x_sample + (size_t)(m - ROWS_P) * DM;
    if (src == nullptr) {
#pragma unroll
        for (int j = 0; j < 8; ++j) o8[64 * j] = 0ull;
        return;
    }
    const GAS f32x4* xr = (const GAS f32x4*)src + F.lane; const GAS f32x4* wr = (const GAS f32x4*)norm_pre + F.lane;
    f32x4 v[8]; float s = 0.f;
#pragma unroll
    for (int j = 0; j < 8; ++j) { v[j] = xr[64 * j]; s += (v[j].x * v[j].x + v[j].y * v[j].y) + (v[j].z * v[j].z + v[j].w * v[j].w); }
    const float rstd = rsqrtf(wave_sum(s) * (1.f / DM) + EPSN);
#pragma unroll
    for (int j = 0; j < 8; ++j) { const f32x4 w = wr[64 * j];
        o8[64 * j] = (unsigned long long)pk2(v[j].x * rstd * w.x, v[j].y * rstd * w.y) | ((unsigned long long)pk2(v[j].z * rstd * w.z, v[j].w * rstd * w.w) << 32); }
}
__device__ __forceinline__ void p0_prologue(Frame& F) { const float* const w_in = ldarg<A_WIN>(); const float* const w_out = ldarg<A_WOUT>();
    LAS float* scr = (LAS float*)(F.lds + SCR_OFF + F.wave * 8704);
    const int gw = blockIdx.x * NWAVES + F.wave, NGW = F.G * NWAVES;
    constexpr int I_IN = (DM / 64) * (NPAD / 32), I_OUT = (DM / 64) * (DM / 32);
    for (int it = gw; it < I_IN + I_OUT; it += NGW) {
        if (it < I_IN) p0_transpose_item(w_in, DM, NIN, F.WinT(), scr, it / (NPAD / 32), it % (NPAD / 32), F.lane);
        else { const int r = it - I_IN; p0_transpose_item(w_out, DM, DM, F.WoutT(), scr, r / (DM / 32), r % (DM / 32), F.lane); }
    }
    for (int m = gw; m < MROWS; m += NGW) p0_row(F, m);
}

constexpr int AKP = 72, APP = 168;
constexpr int A_K = 0, A_V = 272 * AKP * 2, A_BIAS = 2 * A_V, A_P = A_BIAS + 2048, A_END = A_P + NWAVES * 16 * APP * 2;
static_assert(A_END <= LDS_BYTES - SCR_OFF, "attention LDS");

template <bool SAMPLE>
__device__ __forceinline__ void attn_tile(Frame& F, LAS unsigned char* scr, const bf16* qptr, int s0, int kmin  ,
                                          const int (&trow)[4], const int (&grow)[4], const float (&sinkr)[4], const size_t (&orow)[4]  , int headcol0  ) {
    int lane = F.lane; asm volatile("" : "+v"(lane));
    const int gq = lane >> 4, i = lane & 15;
    const LAS unsigned short* AK = (const LAS unsigned short*)(scr + A_K);
    const LAS unsigned short* AV = (const LAS unsigned short*)(scr + A_V);
    const LAS float* AB = (const LAS float*)(scr + A_BIAS);
    LAS unsigned short* AP = (LAS unsigned short*)(scr + A_P) + F.wave * 16 * APP;
    bf16x8 qa[2];
    qa[0] = *(const bf16x8*)(qptr + 8 * gq); qa[1] = *(const bf16x8*)(qptr + 32 + 8 * gq);
    f32x4 acc[10];
#pragma unroll
    for (int cb = 0; cb < 10; ++cb) { acc[cb] = (f32x4){0.f, 0.f, 0.f, 0.f};
#pragma unroll
        for (int ks = 0; ks < 2; ++ks) { const bf16x8 kb = *(const LAS bf16x8*)(AK + (s0 + 16 * cb + i) * AKP + 32 * ks + 8 * gq); acc[cb] = MFMA16(qa[ks], kb, acc[cb]); } }
    float mx[4] = {-INFINITY, -INFINITY, -INFINITY, -INFINITY};
#pragma unroll
    for (int cb = 0; cb < 10; ++cb) { const int s = s0 + 16 * cb + i;
#pragma unroll
        for (int r = 0; r < 4; ++r) { const int dist = 128 + trow[r] - s; const bool valid = (dist >= 0) && (dist < 128) && (s >= kmin);
            const int dc = dist < 0 ? 0 : (dist > 127 ? 127 : dist);
            const float v = valid ? acc[cb][r] * 0.125f + AB[grow[r] * 128 + dc] : -INFINITY; acc[cb][r] = v; mx[r] = fmaxf(mx[r], v); } }
    float inv[4];
#pragma unroll
    for (int r = 0; r < 4; ++r) { float m = mx[r];
        m = fmaxf(m, __shfl_xor(m, 1)); m = fmaxf(m, __shfl_xor(m, 2)); m = fmaxf(m, __shfl_xor(m, 4)); m = fmaxf(m, __shfl_xor(m, 8));
        m = fmaxf(m, sinkr[r]); float sum = 0.f;
#pragma unroll
        for (int cb = 0; cb < 10; ++cb) { const float e = __expf(acc[cb][r] - m); acc[cb][r] = e; sum += e; }
        sum += __shfl_xor(sum, 1); sum += __shfl_xor(sum, 2); sum += __shfl_xor(sum, 4); sum += __shfl_xor(sum, 8);
        inv[r] = 1.f / (sum + __expf(sinkr[r] - m)); }
#pragma unroll
    for (int cb = 0; cb < 10; ++cb)
#pragma unroll
        for (int r = 0; r < 4; ++r) AP[(4 * gq + r) * APP + 16 * cb + i] = f2bf16(acc[cb][r]);
    LDS_WAIT(); asm volatile("" ::: "memory");
    f32x4 o[4];
#pragma unroll
    for (int db = 0; db < 4; ++db) o[db] = (f32x4){0.f, 0.f, 0.f, 0.f};
#pragma unroll
    for (int kk = 0; kk < 5; ++kk) { const bf16x8 pa = *(const LAS bf16x8*)(AP + i * APP + 32 * kk + 8 * gq);
#pragma unroll
        for (int db = 0; db < 4; ++db) { const bf16x8 vb = tr_frag(AV, s0 + 32 * kk + 8 * gq, 16 * db, AKP, lane); o[db] = MFMA16(pa, vb, o[db]); } }
    LDS_WAIT(); asm volatile("" ::: "memory");
#pragma unroll
    for (int r = 0; r < 4; ++r) { const int col = headcol0 + grow[r] * 64 + i; const bf16* gp = F.P() + orow[r] * NPAD + C_GA + col; bf16* mp = F.MIX() + orow[r] * DM + col;
#pragma unroll
        for (int db = 0; db < 4; ++db) { const float gate = bf2f(gp[16 * db]); mp[16 * db] = f2bf16(o[db][r] * inv[r] * silu_f(gate)); } }
}

__device__ __forceinline__ void attn_bias_table(Frame& F, LAS unsigned char* scr, int kvh) { const float* const rel_bias = ldarg<A_RELB>();
    const int g = F.tid >> 7, d = F.tid & 127;
    int bk = d;
    if (d >= 16) { bk = 16 + (int)(__logf((float)d * (1.f / 16.f)) * (16.f / 2.0794415416798357f)); bk = bk > 31 ? 31 : bk; }
    ((LAS float*)(scr + A_BIAS))[g * 128 + d] = rel_bias[bk * 16 + kvh * 4 + g];
}

__device__ __forceinline__ void attn_prompt_unit(Frame& F0, LAS unsigned char* scr, int u) { Frame F = F0; asm volatile("" : "+v"(F.tid), "+v"(F.lane));     const float* const sinks = ldarg<A_SINK>();
    const int kvh = u & 3, bn = u >> 2, b = bn / NBLK, n = bn - b * NBLK;
    LAS unsigned short* AK = (LAS unsigned short*)(scr + A_K); LAS unsigned short* AV = (LAS unsigned short*)(scr + A_V);
    __syncthreads();
    const long wrow0 = (long)b * LP + 128 * (n - 1);
#pragma unroll
    for (int j = 0; j < 4; ++j) { const int c = F.tid + 512 * j, row = c >> 3, ch = c & 7; const long gr = wrow0 + row;
        v4u kv = (v4u){0u, 0u, 0u, 0u}, vv = kv;
        if (gr >= 0) { const bf16* p = F.P() + (size_t)gr * NPAD + kvh * 64 + 8 * ch; kv = *(const GAS v4u*)(p + C_KA); vv = *(const GAS v4u*)(p + C_VA); }
        *(LAS v4u*)(AK + row * AKP + 8 * ch) = kv; *(LAS v4u*)(AV + row * AKP + 8 * ch) = vv; }
    if (F.tid < 128) { const int row = 256 + (F.tid >> 3), ch = F.tid & 7; *(LAS v4u*)(AK + row * AKP + 8 * ch) = (v4u){0u, 0u, 0u, 0u}; *(LAS v4u*)(AV + row * AKP + 8 * ch) = (v4u){0u, 0u, 0u, 0u}; }
    attn_bias_table(F, scr, kvh);
    __syncthreads();
    const int gq = F.lane >> 4, i = F.lane & 15, t0 = 16 * F.wave;
    const int kmin = FPAD - 128 * (n - 1);
    const size_t rbase = (size_t)b * LP + 128 * n;
#pragma unroll 1
    for (int g = 0; g < 4; ++g) {
        int trow[4], grow[4]; float sinkr[4]; size_t orow[4];
#pragma unroll
        for (int r = 0; r < 4; ++r) { trow[r] = t0 + 4 * gq + r; grow[r] = g; sinkr[r] = sinks[kvh * 4 + g]; orow[r] = rbase + t0 + 4 * gq + r; }
        const bf16* qptr = F.P() + (rbase + t0 + i) * NPAD + C_QA + (kvh * 4 + g) * 64;
        attn_tile<false>(F, scr, qptr, t0, kmin, trow, grow, sinkr, orow, kvh * 256);
    }
    if (n == NBLK - 1) {
#pragma unroll
        for (int j = 0; j < 16; ++j) { const int e = F.tid + 512 * j, row = e >> 6, d = e & 63;
            const size_t oidx = (((size_t)b * WIN + row) * 4 + kvh) * 64 + d;
            F.out[O_KWP + oidx] = bf2f(AK[(128 + row) * AKP + d]); F.out[O_VWP + oidx] = bf2f(AV[(128 + row) * AKP + d]); }
    }
}

__device__ __forceinline__ void attn_sample_unit(Frame& F0, LAS unsigned char* scr, int u) { Frame F = F0; asm volatile("" : "+v"(F.tid), "+v"(F.lane));     const float* const cache_k = ldarg<A_CK>(); const float* const cache_v = ldarg<A_CV>(); const float* const sinks = ldarg<A_SINK>();
    const int kvh = u & 3, db = u >> 2;
    LAS unsigned short* AK = (LAS unsigned short*)(scr + A_K); LAS unsigned short* AV = (LAS unsigned short*)(scr + A_V);
    __syncthreads();
#pragma unroll
    for (int j = 0; j < 4; ++j) { const int c = F.tid + 512 * j, row = c >> 4, ch = c & 15;
        const size_t src = (((size_t)db * WIN + row) * 4 + kvh) * 64 + 4 * ch;
        const f32x4 kv = *(const GAS f32x4*)(cache_k + src), vv = *(const GAS f32x4*)(cache_v + src);
        *(LAS unsigned long long*)(AK + row * AKP + 4 * ch) = (unsigned long long)pk2(kv.x, kv.y) | ((unsigned long long)pk2(kv.z, kv.w) << 32);
        *(LAS unsigned long long*)(AV + row * AKP + 4 * ch) = (unsigned long long)pk2(vv.x, vv.y) | ((unsigned long long)pk2(vv.z, vv.w) << 32);
        if (row >= DSEQ) { const size_t dst = (((size_t)db * WIN + row - DSEQ) * 4 + kvh) * 64 + 4 * ch; *(GAS f32x4*)(F.out + O_KWS + dst) = kv; *(GAS f32x4*)(F.out + O_VWS + dst) = vv; } }
    const size_t srow0 = (size_t)ROWS_P + (size_t)db * DSEQ;
    if (F.tid < 64) { const int t = F.tid >> 3, ch = F.tid & 7; const bf16* p = F.P() + (srow0 + t) * NPAD + kvh * 64 + 8 * ch;
        const v4u kv = *(const GAS v4u*)(p + C_KA), vv = *(const GAS v4u*)(p + C_VA);
        *(LAS v4u*)(AK + (128 + t) * AKP + 8 * ch) = kv; *(LAS v4u*)(AV + (128 + t) * AKP + 8 * ch) = vv;
        const size_t dst = (((size_t)db * WIN + (WIN - DSEQ) + t) * 4 + kvh) * 64 + 8 * ch;
        f32x4 a, c2; a.x = bf2f(kv.x & 0xffff); a.y = bf2f(kv.x >> 16); a.z = bf2f(kv.y & 0xffff); a.w = bf2f(kv.y >> 16); c2.x = bf2f(kv.z & 0xffff); c2.y = bf2f(kv.z >> 16); c2.z = bf2f(kv.w & 0xffff); c2.w = bf2f(kv.w >> 16);
        *(GAS f32x4*)(F.out + O_KWS + dst) = a; *(GAS f32x4*)(F.out + O_KWS + dst + 4) = c2;
        a.x = bf2f(vv.x & 0xffff); a.y = bf2f(vv.x >> 16); a.z = bf2f(vv.y & 0xffff); a.w = bf2f(vv.y >> 16); c2.x = bf2f(vv.z & 0xffff); c2.y = bf2f(vv.z >> 16); c2.z = bf2f(vv.w & 0xffff); c2.w = bf2f(vv.w >> 16);
        *(GAS f32x4*)(F.out + O_VWS + dst) = a; *(GAS f32x4*)(F.out + O_VWS + dst + 4) = c2; }
    if (F.tid >= 64 && F.tid < 64 + 192) { const int c = F.tid - 64, row = 136 + (c >> 3), ch = c & 7; *(LAS v4u*)(AK + row * AKP + 8 * ch) = (v4u){0u, 0u, 0u, 0u}; *(LAS v4u*)(AV + row * AKP + 8 * ch) = (v4u){0u, 0u, 0u, 0u}; }
    attn_bias_table(F, scr, kvh);
    __syncthreads();
    if (F.wave < 2) {
        const int gq = F.lane >> 4, i = F.lane & 15;
        int trow[4], grow[4]; float sinkr[4]; size_t orow[4];
#pragma unroll
        for (int r = 0; r < 4; ++r) { const int rr = 4 * gq + r; trow[r] = rr & 7; grow[r] = 2 * F.wave + (rr >> 3); sinkr[r] = sinks[kvh * 4 + grow[r]]; orow[r] = srow0 + (rr & 7); }
        const bf16* qptr = F.P() + (srow0 + (i & 7)) * NPAD + C_QA + (kvh * 4 + 2 * F.wave + (i >> 3)) * 64;
        attn_tile<true>(F, scr, qptr, 0, 0, trow, grow, sinkr, orow, kvh * 256);
    }
}

constexpr int GQP = 136, GVP = 264;
constexpr int G_Q = 0, G_K = 128 * GQP * 2, G_V = 2 * G_K, G_Z = G_V + 128 * GVP * 2, G_TOT = G_Z + 8192, G_D = G_TOT + 2048, G_END = G_D + 512;
static_assert(G_END <= LDS_BYTES - SCR_OFF, "GLA LDS");

template <bool NEED_Q>
__device__ __forceinline__ void gla_gate(Frame& F, LAS unsigned char* scr, int b, int c, int h) { const float* const w_a2 = ldarg<A_WA2>(); const float* const b_a = ldarg<A_BA>();
    LAS unsigned short* GQ = (LAS unsigned short*)(scr + G_Q); LAS unsigned short* GK = (LAS unsigned short*)(scr + G_K); LAS unsigned short* GV = (LAS unsigned short*)(scr + G_V);
    LAS float* GZ = (LAS float*)(scr + G_Z); LAS float* GT = (LAS float*)(scr + G_TOT); LAS float* GD = (LAS float*)(scr + G_D);
    const size_t R0 = (size_t)b * LP + 128 * c;
    __syncthreads();
    { const int t = F.tid >> 2, r4 = (F.tid & 3) * 4; const unsigned long long z = *(const GAS unsigned long long*)(F.P() + (R0 + t) * NPAD + C_ZG + r4);
      *(LAS f32x4*)(GZ + t * 16 + r4) = (f32x4){bf2f((unsigned short)z), bf2f((unsigned short)(z >> 16)), bf2f((unsigned short)(z >> 32)), bf2f((unsigned short)(z >> 48))}; }
#pragma unroll
    for (int j = 0; j < 8; ++j) { const int cc = F.tid + 512 * j, row = cc >> 5, ch = cc & 31;
        *(LAS v4u*)(GV + row * GVP + 8 * ch) = *(const GAS v4u*)(F.P() + (R0 + row) * NPAD + C_VG + h * 256 + 8 * ch); }
    __syncthreads();
    const int k = F.tid & 127, seg = F.tid >> 7;
    float w[16];
#pragma unroll
    for (int r = 0; r < 16; ++r) w[r] = w_a2[r * 512 + h * 128 + k];
    const float ba = b_a[h * 128 + k];
    float loc[32]; float run = 0.f;
#pragma unroll
    for (int j = 0; j < 32; ++j) { const int t = seg * 32 + j; float x = ba;
#pragma unroll
        for (int r4 = 0; r4 < 4; ++r4) { const f32x4 z = *(const LAS f32x4*)(GZ + t * 16 + 4 * r4); x += z.x * w[4 * r4] + z.y * w[4 * r4 + 1] + z.z * w[4 * r4 + 2] + z.w * w[4 * r4 + 3]; }
        float lg = logsig_f(x) * (1.f / 16.f);
        if (c == 0 && t < FPAD) lg = 0.f;
        run += lg; loc[j] = run; }
    GT[seg * 128 + k] = run;
    __syncthreads();
    float off = 0.f, blast = 0.f;
#pragma unroll
    for (int s2 = 0; s2 < 4; ++s2) { const float tv = GT[s2 * 128 + k]; blast += tv; if (s2 < seg) off += tv; }
#pragma unroll
    for (int j = 0; j < 32; ++j) { const int t = seg * 32 + j; const float bt = off + loc[j]; const bf16* p = F.P() + (R0 + t) * NPAD + h * 128 + k;
        GK[t * GQP + k] = f2bf16(bf2f(p[C_KG]) * __expf(-bt));
        if (NEED_Q) GQ[t * GQP + k] = f2bf16(bf2f(p[C_QG]) * __expf(bt) * 0.08838834764831845f); }
    if (seg == 0) GD[k] = __expf(blast);
    __syncthreads();
}

__device__ __forceinline__ void gla_ds_unit(Frame& F0, LAS unsigned char* scr, int u) { Frame F = F0; asm volatile("" : "+v"(F.tid), "+v"(F.lane));
    const int h = u & 3, bc = u >> 2, b = bc / NBLK, c = bc - b * NBLK;
    gla_gate<false>(F, scr, b, c, h);
    const LAS unsigned short* GK = (const LAS unsigned short*)(scr + G_K); const LAS unsigned short* GV = (const LAS unsigned short*)(scr + G_V); const LAS float* GD = (const LAS float*)(scr + G_D);
    int lane = F.lane; asm volatile("" : "+v"(lane));
    const int gq = lane >> 4, i = lane & 15, w = F.wave;
    f32x4 acc[8][2];
#pragma unroll
    for (int rb = 0; rb < 8; ++rb) { acc[rb][0] = (f32x4){0.f, 0.f, 0.f, 0.f}; acc[rb][1] = (f32x4){0.f, 0.f, 0.f, 0.f}; }
#pragma unroll
    for (int ks = 0; ks < 4; ++ks) {
        const bf16x8 vb0 = tr_frag(GV, 32 * ks + 8 * gq, 32 * w, GVP, lane), vb1 = tr_frag(GV, 32 * ks + 8 * gq, 32 * w + 16, GVP, lane);
#pragma unroll
        for (int rb = 0; rb < 8; ++rb) { const bf16x8 ka = tr_frag(GK, 32 * ks + 8 * gq, 16 * rb, GQP, lane); acc[rb][0] = MFMA16(ka, vb0, acc[rb][0]); acc[rb][1] = MFMA16(ka, vb1, acc[rb][1]); } }
    float* dst = F.dST() + (size_t)u * 32768;
#pragma unroll
    for (int rb = 0; rb < 8; ++rb) { const f32x4 d4 = *(const LAS f32x4*)(GD + 16 * rb + 4 * gq);
#pragma unroll
        for (int cb = 0; cb < 2; ++cb) *(GAS f32x4*)(dst + (size_t)(32 * w + 16 * cb + i) * 128 + 16 * rb + 4 * gq) = acc[rb][cb] * d4; }
    if (F.tid < 128) F.dec()[(size_t)u * 128 + F.tid] = GD[F.tid];
}

__device__ __forceinline__ void gla_scan(Frame& F) {
    for (int e = blockIdx.x * NTHREADS + F.tid; e < NBATCH * 4 * 256 * 64; e += F.G * NTHREADS) {
        const int k2 = e & 63, v = (e >> 6) & 255, bh = e >> 14, b = bh >> 2, h = bh & 3;
        float s0 = 0.f, s1 = 0.f;
#pragma unroll 3
        for (int c = 0; c < NBLK; ++c) { const size_t u = ((size_t)b * NBLK + c) * 4 + h;
            const f32x2 d = *(const GAS f32x2*)(F.dec() + u * 128 + 2 * k2); const f32x2 ds = *(const GAS f32x2*)(F.dST() + u * 32768 + (size_t)v * 128 + 2 * k2);
            *(GAS unsigned*)(F.St() + u * 32768 + (size_t)v * 128 + 2 * k2) = pk2(s0, s1);
            s0 = d.x * s0 + ds.x; s1 = d.y * s1 + ds.y; }
        float* gp = F.out + O_GP + ((size_t)bh * 128 + 2 * k2) * 256 + v; gp[0] = s0; gp[256] = s1;
    }
}

__device__ __forceinline__ void gla_out_unit(Frame& F0, LAS unsigned char* scr, int u) { Frame F = F0; asm volatile("" : "+v"(F.tid), "+v"(F.lane));     const float* const gla_norm = ldarg<A_GNORM>();
    const int h = u & 3, bc = u >> 2, b = bc / NBLK, c = bc - b * NBLK;
    gla_gate<true>(F, scr, b, c, h);
    const LAS unsigned short* GQ = (const LAS unsigned short*)(scr + G_Q); LAS unsigned short* GK = (LAS unsigned short*)(scr + G_K); const LAS unsigned short* GV = (const LAS unsigned short*)(scr + G_V);
    int lane = F.lane; asm volatile("" : "+v"(lane));
    const int gq = lane >> 4, i = lane & 15, w = F.wave;
    bf16x8 qa[4];
#pragma unroll
    for (int ks = 0; ks < 4; ++ks) qa[ks] = *(const LAS bf16x8*)(GQ + (16 * w + i) * GQP + 32 * ks + 8 * gq);
    f32x4 aa[8];
#pragma unroll
    for (int sb = 0; sb < 8; ++sb) { aa[sb] = (f32x4){0.f, 0.f, 0.f, 0.f};
        if (sb <= w) {
#pragma unroll
            for (int ks = 0; ks < 4; ++ks) { const bf16x8 kb = *(const LAS bf16x8*)(GK + (16 * sb + i) * GQP + 32 * ks + 8 * gq); aa[sb] = MFMA16(qa[ks], kb, aa[sb]); } } }
    __syncthreads();
#pragma unroll
    for (int sb = 0; sb < 8; ++sb)
#pragma unroll
        for (int r = 0; r < 4; ++r) { const int t = 16 * w + 4 * gq + r, s = 16 * sb + i; GK[t * GQP + s] = f2bf16(s <= t ? aa[sb][r] : 0.f); }
    LDS_WAIT(); asm volatile("" ::: "memory");
    f32x4 acc[16];
#pragma unroll
    for (int cb = 0; cb < 16; ++cb) acc[cb] = (f32x4){0.f, 0.f, 0.f, 0.f};
#pragma unroll
    for (int ks = 0; ks < 4; ++ks) {
        if (2 * ks <= w) {
            const bf16x8 af = *(const LAS bf16x8*)(GK + (16 * w + i) * GQP + 32 * ks + 8 * gq);
#pragma unroll
            for (int cb = 0; cb < 16; ++cb) { const bf16x8 vb = tr_frag(GV, 32 * ks + 8 * gq, 16 * cb, GVP, lane); acc[cb] = MFMA16(af, vb, acc[cb]); } } }
    const bf16* St = F.St() + (size_t)u * 32768;
#pragma unroll
    for (int ks = 0; ks < 4; ++ks)
#pragma unroll
        for (int cb = 0; cb < 16; ++cb) { const bf16x8 sb = *(const bf16x8*)(St + (size_t)(16 * cb + i) * 128 + 32 * ks + 8 * gq); acc[cb] = MFMA16(qa[ks], sb, acc[cb]); }
    const size_t R0 = (size_t)b * LP + 128 * c;
#pragma unroll
    for (int r = 0; r < 4; ++r) { float ss = 0.f;
#pragma unroll
        for (int cb = 0; cb < 16; ++cb) ss += acc[cb][r] * acc[cb][r];
        ss += __shfl_xor(ss, 1); ss += __shfl_xor(ss, 2); ss += __shfl_xor(ss, 4); ss += __shfl_xor(ss, 8);
        const float rstd = rsqrtf(ss * (1.f / 256.f) + EPSN); const size_t row = R0 + 16 * w + 4 * gq + r;
        const bf16* gp = F.P() + row * NPAD + C_GG + h * 256 + i; bf16* mp = F.MIX() + row * DM + 1024 + h * 256 + i;
#pragma unroll
        for (int cb = 0; cb < 16; ++cb) { const float gate = bf2f(gp[16 * cb]); mp[16 * cb] = f2bf16(acc[cb][r] * rstd * gla_norm[16 * cb + i] * silu_f(gate)); } }
}

constexpr int S_Q = 0, S_KH = 4096, S_KT = 8192, S_D = 12288, S_A = 12800, S_Z = 13056, S_OP = 13568, S_END = S_OP + 16384;
__device__ __forceinline__ void gla_sample_unit(Frame& F0, LAS unsigned char* scr, int u) { Frame F = F0; asm volatile("" : "+v"(F.tid), "+v"(F.lane));     const float* const w_a2 = ldarg<A_WA2>(); const float* const b_a = ldarg<A_BA>(); const float* const state = ldarg<A_STATE>(); const float* const gla_norm = ldarg<A_GNORM>();
    const int h = u & 3, db = u >> 2;
    LAS float* SQ = (LAS float*)(scr + S_Q); LAS float* SKH = (LAS float*)(scr + S_KH); LAS float* SKT = (LAS float*)(scr + S_KT); LAS float* SD = (LAS float*)(scr + S_D);
    LAS float* SA = (LAS float*)(scr + S_A); LAS float* SZ = (LAS float*)(scr + S_Z); LAS float* SOP = (LAS float*)(scr + S_OP);
    const size_t R0 = (size_t)ROWS_P + (size_t)db * DSEQ;
    __syncthreads();
    if (F.tid < 128) SZ[F.tid] = bf2f(F.P()[(R0 + (F.tid >> 4)) * NPAD + C_ZG + (F.tid & 15)]);
    __syncthreads();
    if (F.tid < 128) { const int k = F.tid; float w[16];
#pragma unroll
        for (int r = 0; r < 16; ++r) w[r] = w_a2[r * 512 + h * 128 + k];
        const float ba = b_a[h * 128 + k]; float bt[8]; float run = 0.f;
#pragma unroll
        for (int t = 0; t < 8; ++t) { float x = ba;
#pragma unroll
            for (int r = 0; r < 16; ++r) x += SZ[t * 16 + r] * w[r];
            run += logsig_f(x) * (1.f / 16.f); bt[t] = run; }
#pragma unroll
        for (int t = 0; t < 8; ++t) { const bf16* p = F.P() + (R0 + t) * NPAD + h * 128 + k; const float qv = bf2f(p[C_QG]), kv = bf2f(p[C_KG]);
            SQ[k * 8 + t] = qv * __expf(bt[t]) * 0.08838834764831845f; SKT[k * 8 + t] = kv * __expf(-bt[t]); SKH[k * 8 + t] = kv * __expf(run - bt[t]); }
        SD[k] = __expf(run); }
    __syncthreads();
    if (F.tid < 64) { const int t = F.tid >> 3, s = F.tid & 7; float a = 0.f;
        if (s <= t) { for (int k = 0; k < 128; ++k) a += SQ[k * 8 + t] * SKT[k * 8 + s]; }
        SA[t * 8 + s] = a; }
    {   const int v = F.tid & 255, half = F.tid >> 8;
        float vv[8], op[8];
#pragma unroll
        for (int t = 0; t < 8; ++t) { vv[t] = bf2f(F.P()[(R0 + t) * NPAD + C_VG + h * 256 + v]); op[t] = 0.f; }
        const float* sp = state + ((size_t)u * 128 + half * 64) * 256 + v; float* np = F.out + O_GS + ((size_t)u * 128 + half * 64) * 256 + v;
#pragma unroll 8
        for (int kk = 0; kk < 64; ++kk) { const int k = half * 64 + kk; const float s0 = sp[(size_t)kk * 256];
            const f32x4 q0 = *(const LAS f32x4*)(SQ + k * 8), q1 = *(const LAS f32x4*)(SQ + k * 8 + 4), h0 = *(const LAS f32x4*)(SKH + k * 8), h1 = *(const LAS f32x4*)(SKH + k * 8 + 4);
            float sn = SD[k] * s0;
            sn += h0.x * vv[0] + h0.y * vv[1] + h0.z * vv[2] + h0.w * vv[3] + h1.x * vv[4] + h1.y * vv[5] + h1.z * vv[6] + h1.w * vv[7];
            np[(size_t)kk * 256] = sn;
            op[0] += q0.x * s0; op[1] += q0.y * s0; op[2] += q0.z * s0; op[3] += q0.w * s0; op[4] += q1.x * s0; op[5] += q1.y * s0; op[6] += q1.z * s0; op[7] += q1.w * s0; }
#pragma unroll
        for (int t = 0; t < 8; ++t) SOP[(half * 8 + t) * 256 + v] = op[t];
    }
    __syncthreads();
    {   const int t = F.wave; float o[4]; float ss = 0.f;
#pragma unroll
        for (int j = 0; j < 4; ++j) { const int v = F.lane + 64 * j; float a = SOP[t * 256 + v] + SOP[(8 + t) * 256 + v];
            for (int s = 0; s <= t; ++s) a += SA[t * 8 + s] * bf2f(F.P()[(R0 + s) * NPAD + C_VG + h * 256 + v]);
            o[j] = a; ss += a * a; }
        const float rstd = rsqrtf(wave_sum(ss) * (1.f / 256.f) + EPSN);
#pragma unroll
        for (int j = 0; j < 4; ++j) { const int v = F.lane + 64 * j; const float gate = bf2f(F.P()[(R0 + t) * NPAD + C_GG + h * 256 + v]);
            F.MIX()[(R0 + t) * DM + 1024 + h * 256 + v] = f2bf16(o[j] * rstd * gla_norm[v] * silu_f(gate)); }
    }
}

__device__ __forceinline__ void final_rows(Frame& F) { const float* const x_prompt = ldarg<A_XP>(); const float* const x_sample = ldarg<A_XS>(); const float* const norm_post = ldarg<A_NPOST>();
    const int gw = blockIdx.x * NWAVES + F.wave, NGW = F.G * NWAVES;
    for (int idx = gw; idx < NBATCH * SEQ + ROWS_S; idx += NGW) {
        size_t grow; const float* x; float* y;
        if (idx < NBATCH * SEQ) { const int b = idx / SEQ, s = idx - b * SEQ; grow = (size_t)b * LP + 128 + s; x = x_prompt + (size_t)idx * DM; y = F.out + O_YP + (size_t)idx * DM; }
        else { const int j = idx - NBATCH * SEQ; grow = (size_t)ROWS_P + j; x = x_sample + (size_t)j * DM; y = F.out + O_YS + (size_t)j * DM; }
        const GAS f32x4* o4 = (const GAS f32x4*)(F.O2() + grow * DM) + F.lane; const GAS f32x4* x4 = (const GAS f32x4*)x + F.lane; const GAS f32x4* w4 = (const GAS f32x4*)norm_post + F.lane;
        GAS f32x4* y4 = (GAS f32x4*)y + F.lane;
        f32x4 v[8]; float s = 0.f;
#pragma unroll
        for (int j = 0; j < 8; ++j) { v[j] = o4[64 * j]; s += (v[j].x * v[j].x + v[j].y * v[j].y) + (v[j].z * v[j].z + v[j].w * v[j].w); }
        const float rstd = rsqrtf(wave_sum(s) * (1.f / DM) + EPSN);
#pragma unroll
        for (int j = 0; j < 8; ++j) { const f32x4 w = w4[64 * j], xx = x4[64 * j]; y4[64 * j] = xx + v[j] * rstd * w; }
    }
}

#ifndef MK_PER_PHASE
#define MK_PER_PHASE 0
#endif
constexpr int N_PHASES = 7;
struct Args { const float* in[15]; float* out; unsigned char* ws; int ph_lo, ph_hi; };
__global__ void __launch_bounds__(NTHREADS, 2) hymba_fwd(Args args) {
    extern __shared__ __attribute__((aligned(16))) unsigned char lds_raw[];
    Frame F;
    F.lds = (LAS unsigned char*)lds_raw;
    F.tid = threadIdx.x; F.lane = F.tid & 63; F.wave = __builtin_amdgcn_readfirstlane(F.tid >> 6); F.G = gridDim.x;
    F.out = args.out; F.ws = args.ws;
    unsigned char* ws = args.ws;
    for (int u = F.tid; u < LDS_CTL_BYTES / 4; u += NTHREADS) ((LAS unsigned*)F.lds)[u] = 0u;
    __syncthreads();
    volatile LAS unsigned* MISC = (volatile LAS unsigned*)(F.lds + 512);
    XcdBarrier bar; bar.bar = (unsigned*)(ws + WS_CTL) + CW_BAR; bar.x = 0; bar.st = nullptr;
    if (!MK_PER_PHASE) bar = xcd_barrier_post((unsigned*)(ws + WS_CTL) + CW_BAR, MISC + 8);
    LAS unsigned char* scr = F.lds + SCR_OFF;
    const int lo = args.ph_lo, hi = args.ph_hi;
#define IN(k) (lo <= (k) && (k) < hi)
#define SEAM(k) do { if (IN(k) && IN((k) + 1)) xcd_barrier(bar); } while (0)

    if (IN(0)) { p0_prologue(F); }
    SEAM(0);
    if (IN(1)) {
        pg8::Gemm g{F.XN(), F.WinT(), MROWS, NPAD, DM}; pg8::StaticOrder S; S.init(MROWS, NPAD, F.G, (int)blockIdx.x);
        pg8::EpiBf16<0> E{F.P(), NPAD, nullptr, 0, 0, 1.f};
        pg8::gemm_phase<pg8::EpiBf16<0>, pg8::StaticOrder, true, true>(scr, g, S, E);
    }
    SEAM(1);
    if (IN(2)) {
        for (int u = blockIdx.x; u < NBATCH * NBLK * 4; u += F.G) attn_prompt_unit(F, scr, u);
        for (int u = blockIdx.x; u < NBATCH * NBLK * 4; u += F.G) gla_ds_unit(F, scr, u);
        for (int u = blockIdx.x; u < DBATCH * 4; u += F.G) attn_sample_unit(F, scr, u);
        for (int u = blockIdx.x; u < DBATCH * 4; u += F.G) gla_sample_unit(F, scr, u);
    }
    SEAM(2);
    if (IN(3)) { gla_scan(F); }
    SEAM(3);
    if (IN(4)) {
        for (int u = blockIdx.x; u < NBATCH * NBLK * 4; u += F.G) gla_out_unit(F, scr, u);
        __syncthreads();
    }
    SEAM(4);
    if (IN(5)) {
        pg8::Gemm g{F.MIX(), F.WoutT(), MROWS, DM, DM}; pg8::StaticOrder S; S.init(MROWS, DM, F.G, (int)blockIdx.x);
        pg8::EpiF32 E{F.O2(), DM};
        pg8::gemm_phase<pg8::EpiF32, pg8::StaticOrder, true, true>(scr, g, S, E);
    }
    SEAM(5);
    if (IN(6)) { final_rows(F); }
#undef IN
#undef SEAM
}

extern "C" void kernel_launch(void* const* d_in, const int* in_sizes, int n_in, void* d_out, int out_size, void* d_ws, size_t ws_size, hipStream_t stream) {
    static int grid = 0;
    if (grid == 0) {
        if (n_in != 15 || out_size != (int)O_END || ws_size < WS_END) { fprintf(stderr, "kernel_launch: unexpected problem: n_in %d out %d ws %zu\n", n_in, out_size, ws_size); grid = -1; return; }
        int dev = 0, cus = 0, per_cu = 0;
        if (hipGetDevice(&dev) != hipSuccess || hipDeviceGetAttribute(&cus, hipDeviceAttributeMultiprocessorCount, dev) != hipSuccess) { grid = -1; return; }
        if (hipFuncSetAttribute((const void*)hymba_fwd, hipFuncAttributeMaxDynamicSharedMemorySize, LDS_BYTES) != hipSuccess) { fprintf(stderr, "kernel_launch: hipFuncSetAttribute failed\n"); grid = -1; return; }
        if (hipOccupancyMaxActiveBlocksPerMultiprocessor(&per_cu, (const void*)hymba_fwd, NTHREADS, LDS_BYTES) != hipSuccess || per_cu < 1) fprintf(stderr, "kernel_launch: note: occupancy query reports %d\n", per_cu);
        (void)hipGetLastError();
        grid = cus;
    }
    if (grid < 0) return;
    (void)hipMemsetAsync((char*)d_ws + WS_CTL, 0, CTL_ZERO_BYTES, stream);
    Args a{};
    for (int i = 0; i < 15; ++i) a.in[i] = (const float*)d_in[i];
    a.out = (float*)d_out; a.ws = (unsigned char*)d_ws;
#if MK_PER_PHASE
    for (int p = 0; p < N_PHASES; ++p) { a.ph_lo = p; a.ph_hi = p + 1; hipLaunchKernelGGL(hymba_fwd, dim3(grid), dim3(NTHREADS), LDS_BYTES, stream, a); }
#else
    a.ph_lo = 0; a.ph_hi = N_PHASES;
    hipLaunchKernelGGL(hymba_fwd, dim3(grid), dim3(NTHREADS), LDS_BYTES, stream, a);
#endif
}
```

```cpp
#include <hip/hip_runtime.h>
#include <cstdio>
#include <cstdint>
#include <cmath>
namespace pg8 {
#define PG8_LAS __attribute__((address_space(3)))
typedef unsigned short bf16_t;
typedef short bf16x8 __attribute__((ext_vector_type(8)));
typedef float f32x4 __attribute__((ext_vector_type(4)));
typedef unsigned u32x4 __attribute__((ext_vector_type(4)));
constexpr int BM = 256, BK = 64, HALF = 128, HTB = HALF * BK * 2  , STAGE_BYTES = 8 * HTB, NXCD = 8, WGM = 8;

__host__ __device__ __forceinline__ int lds_byte(int r, int c) { const int st = (r >> 4) * 2 + (c >> 5), rr = r & 15, cc = c & 31, ob = rr * 64 + cc * 2; return st * 1024 + (ob ^ (((ob >> 9) & 1) << 5)); }
__host__ __device__ __forceinline__ void stage_rc(int b, int& R, int& C) { const int st = b / 1024, sb = b % 1024, swz = sb ^ (((sb >> 9) & 1) << 5); R = (st >> 1) * 16 + swz / 64; C = (st & 1) * 32 + (swz % 64) / 2; }
__host__ __device__ __forceinline__ int perm32(int rho) { const int n = rho >> 4, i = rho & 15; return 8 * (i >> 2) + 4 * n + (i & 3); }

struct Unit { int pm, pn; };
struct Gemm { const bf16_t* A; const bf16_t* Bt; int M, N, K; };

struct StaticOrder {
    int nM, nN, nwg, G, c;
    __host__ __device__ void init(int M, int N, int G_, int c_) { nM = M / BM; nN = N / BM; nwg = nM * nN; G = G_; c = c_; }
    __host__ __device__ bool next(int i, Unit& u) const {
        const long L = (long)i * G + c; if (L >= nwg) return false;
        int wgid = (int)L; { const int q = nwg / NXCD, r = nwg % NXCD, xcd = wgid % NXCD, off = wgid / NXCD; wgid = (xcd < r ? xcd * (q + 1) : r * (q + 1) + (xcd - r) * q) + off; }
        const int nig = WGM * nN, gid = wgid / nig, fm = gid * WGM, gsz = (nM - fm) < WGM ? (nM - fm) : WGM;
        u.pm = fm + ((wgid % nig) % gsz); u.pn = (wgid % nig) / gsz; return true;
    }
    __device__ __forceinline__ void a_ready(const Unit&) const {}
    __device__ __forceinline__ void done(const Unit&) const {}
};

__device__ __forceinline__ unsigned cvt_pk_bf16(float lo, float hi) { unsigned r; asm volatile("v_cvt_pk_bf16_f32 %0, %1, %2" : "=v"(r) : "v"(lo), "v"(hi)); return r; }
typedef float f32x2 __attribute__((ext_vector_type(2)));
__device__ __forceinline__ f32x2 gelu_pk(f32x2 v) {
    const f32x2 av = __builtin_elementwise_abs(v), d = av * 0.2316418882f + 1.0f;
    f32x2 t; t.x = __builtin_amdgcn_rcpf(d.x); t.y = __builtin_amdgcn_rcpf(d.y);
    f32x2 q = t * 0.5307027145f + (-0.7265760135f); q = q * t + 0.7107068705f; q = q * t + (-0.142248368f); q = q * t + 0.127414796f; q = q * t;
    const f32x2 s = (v * v) * (-0.72134752044f);
    f32x2 e; e.x = __builtin_amdgcn_exp2f(s.x); e.y = __builtin_amdgcn_exp2f(s.y);
    const f32x2 m = v * (q * e), r = v - m;
    f32x2 o; o.x = v.x < 0.f ? m.x : r.x; o.y = v.y < 0.f ? m.y : r.y; return o;
}

template <int ACT  > struct EpiBf16 {
    static constexpr bool PERM = true, AFTER_DRAIN = false; static_assert(ACT == 0 || ACT == 1, "EpiBf16: ACT is 0 (none) or 1 (gelu_pk)");
    bf16_t* O; int ldc; const float* bias; int split_cols; size_t split_stride; float scale0;
    __device__ __forceinline__ void operator()(const f32x4 (&acc)[2][2][4][2], const Unit& u, int wr, int wc, int fr, int fq) const {
        const int row0 = u.pm * BM + wr * 64 + fr; int colt = u.pn * BM; bf16_t* base = O;
        float sc = 1.f; if (split_cols) { const int t = colt / split_cols; base += (size_t)t * split_stride; colt -= t * split_cols; if (t == 0) sc = scale0; }
        const int col0 = colt + wc * 32 + 8 * fq, bcol0 = u.pn * BM + wc * 32 + 8 * fq;
        f32x4 bv[2][2];
#pragma unroll
        for (int bj = 0; bj < 2; ++bj)
#pragma unroll
            for (int n = 0; n < 2; ++n) bv[bj][n] = bias ? *(const f32x4*)(bias + bcol0 + bj * HALF + 4 * n) : (f32x4){0.f, 0.f, 0.f, 0.f};
#pragma unroll
        for (int ai = 0; ai < 2; ++ai)
#pragma unroll
            for (int m = 0; m < 4; ++m) { bf16_t* rowp = base + (size_t)(row0 + ai * HALF + m * 16) * ldc + col0;
#pragma unroll
                for (int bj = 0; bj < 2; ++bj) { f32x4 v0 = acc[ai][bj][m][0] + bv[bj][0], v1 = acc[ai][bj][m][1] + bv[bj][1];
                    if (ACT == 1) { f32x2 a = gelu_pk((f32x2){v0[0], v0[1]}), b = gelu_pk((f32x2){v0[2], v0[3]}), c = gelu_pk((f32x2){v1[0], v1[1]}), d = gelu_pk((f32x2){v1[2], v1[3]});
                        v0 = (f32x4){a.x, a.y, b.x, b.y}; v1 = (f32x4){c.x, c.y, d.x, d.y}; }
                    v0 = v0 * sc; v1 = v1 * sc; u32x4 w; w.x = cvt_pk_bf16(v0[0], v0[1]); w.y = cvt_pk_bf16(v0[2], v0[3]); w.z = cvt_pk_bf16(v1[0], v1[1]); w.w = cvt_pk_bf16(v1[2], v1[3]);
                    *(u32x4*)(rowp + bj * HALF) = w; } }
    }
};

struct EpiF32 {
    static constexpr bool PERM = false, AFTER_DRAIN = false;
    float* O; int ldc;
    __device__ __forceinline__ void operator()(const f32x4 (&acc)[2][2][4][2], const Unit& u, int wr, int wc, int fr, int fq) const {
        const int row0 = u.pm * BM + wr * 64 + fr, col0 = u.pn * BM + wc * 32 + 4 * fq;
#pragma unroll
        for (int ai = 0; ai < 2; ++ai)
#pragma unroll
            for (int m = 0; m < 4; ++m) { float* rowp = O + (size_t)(row0 + ai * HALF + m * 16) * ldc + col0;
#pragma unroll
                for (int bj = 0; bj < 2; ++bj)
#pragma unroll
                    for (int n = 0; n < 2; ++n) *(f32x4*)(rowp + bj * HALF + n * 16) = acc[ai][bj][m][n]; }
    }
};
struct EpiY {
    static constexpr bool PERM = false, AFTER_DRAIN = false;
    float* yp; float* ys; int lp, seq, rows_p;
    __device__ __forceinline__ void operator()(const f32x4 (&acc)[2][2][4][2], const Unit& u, int wr, int wc, int fr, int fq) const {
        const int row0 = u.pm * BM + wr * 64 + fr, col0 = u.pn * BM + wc * 32 + 4 * fq;
#pragma unroll
        for (int ai = 0; ai < 2; ++ai)
#pragma unroll
            for (int m = 0; m < 4; ++m) { const int row = row0 + ai * HALF + m * 16; float* rowp;
                if (row < rows_p) { const int b = row / lp, i = row - b * lp; if (i < 128) continue; rowp = yp + ((size_t)b * seq + (i - 128)) * 2048 + col0; }
                else rowp = ys + (size_t)(row - rows_p) * 2048 + col0;
#pragma unroll
                for (int bj = 0; bj < 2; ++bj)
#pragma unroll
                    for (int n = 0; n < 2; ++n) *(f32x4*)(rowp + bj * HALF + n * 16) = acc[ai][bj][m][n]; }
    }
};
template <class Epi, class Sched, bool ALIGN_EPI = false, bool SP2 = false>
__device__ __forceinline__ void gemm_phase(PG8_LAS unsigned char* lds, const Gemm g, const Sched& S, const Epi& E) {
    const int tid = threadIdx.x, wid = __builtin_amdgcn_readfirstlane(tid >> 6), lane = tid & 63, wr = wid >> 2, wc = wid & 3, fr = lane & 15, fq = lane >> 4;
    const int K = g.K, nt = K / BK;
    unsigned voffA[2], voffB[2];
#pragma unroll
    for (int i = 0; i < 2; ++i) { int R, C; stage_rc(tid * 16 + i * 8192, R, C); const int Rb = Epi::PERM ? ((R & ~31) + perm32(R & 31)) : R;
        voffA[i] = (unsigned)(R * K + C) * 2u; voffB[i] = (unsigned)(Rb * K + C) * 2u; }
    const size_t kstep = (size_t)(BK * 2);
    const size_t hstep = (size_t)HALF * K * 2;
    const size_t tstep = 2 * hstep;
    const unsigned ldsw = (unsigned)wid * 1024u;
    const int aoff = lds_byte(wr * 64 + fr, fq * 8), boff = lds_byte(wc * 32 + fr, fq * 8);
#define PG8_SA(b, h) (((b) * 2 + (h)) * HTB)
#define PG8_SB(b, h) ((4 + (b) * 2 + (h)) * HTB)
#define PG8_STAGE(bufoff, gbase, voff) do { _Pragma("unroll") for (int _i = 0; _i < 2; ++_i) \
        __builtin_amdgcn_global_load_lds((const unsigned*)((const char*)(gbase) + (voff)[_i]), (PG8_LAS unsigned*)(lds + (bufoff) + ldsw + _i * 8192), 16, 0, 0); } while (0)
#define PG8_LDA(dst, b, h) do { _Pragma("unroll") for (int m = 0; m < 4; ++m) _Pragma("unroll") for (int k = 0; k < 2; ++k) dst[m][k] = *(const PG8_LAS bf16x8*)(lds + PG8_SA(b, h) + aoff + m * 2048 + k * 1024); } while (0)
#define PG8_LDB(dst, b, h) do { _Pragma("unroll") for (int n = 0; n < 2; ++n) _Pragma("unroll") for (int k = 0; k < 2; ++k) dst[n][k] = *(const PG8_LAS bf16x8*)(lds + PG8_SB(b, h) + boff + n * 2048 + k * 1024); } while (0)
#define PG8_MMA(ai, bj, At, Bt) do { __builtin_amdgcn_s_setprio(1); _Pragma("unroll") for (int m = 0; m < 4; ++m) _Pragma("unroll") for (int n = 0; n < 2; ++n) _Pragma("unroll") for (int k = 0; k < 2; ++k) \
        acc[ai][bj][m][n] = __builtin_amdgcn_mfma_f32_16x16x32_bf16(Bt[n][k], At[m][k], acc[ai][bj][m][n], 0, 0, 0); __builtin_amdgcn_s_setprio(0); } while (0)
#define PG8_WAIT_V(n) asm volatile("s_waitcnt vmcnt(" #n ")" ::: "memory")
#define PG8_WAIT_L(n) asm volatile("s_waitcnt lgkmcnt(" #n ")" ::: "memory")
#define PG8_BAR __builtin_amdgcn_s_barrier()
#define PG8_SCHED __builtin_amdgcn_sched_barrier(0)
    Unit cur, nxt; int ui = 0;
    if (!S.next(0, cur)) return;
    f32x4 acc[2][2][4][2];
#pragma unroll
    for (int a = 0; a < 2; ++a)
#pragma unroll
        for (int b = 0; b < 2; ++b)
#pragma unroll
            for (int m = 0; m < 4; ++m)
#pragma unroll
                for (int n = 0; n < 2; ++n) acc[a][b][m][n] = (f32x4){0.f, 0.f, 0.f, 0.f};
    bf16x8 At[4][2], B0[2][2], B1[2][2];
    const char* cA = (const char*)g.A + (size_t)cur.pm * tstep; const char* cB = (const char*)g.Bt + (size_t)cur.pn * tstep;
    S.a_ready(cur);
    if constexpr (SP2) {
        PG8_STAGE(PG8_SB(0, 0), cB, voffB); PG8_STAGE(PG8_SB(0, 1), cB + hstep, voffB); PG8_STAGE(PG8_SA(0, 0), cA, voffA); PG8_STAGE(PG8_SA(0, 1), cA + hstep, voffA);
        if (wr == 1) PG8_BAR;
        PG8_WAIT_V(2); PG8_BAR;
        PG8_STAGE(PG8_SB(1, 0), cB + kstep, voffB); PG8_STAGE(PG8_SA(1, 0), cA + kstep, voffA); PG8_STAGE(PG8_SB(1, 1), cB + hstep + kstep, voffB);
        PG8_WAIT_V(6); PG8_BAR;
    } else {
        PG8_STAGE(PG8_SB(0, 0), cB, voffB); PG8_STAGE(PG8_SA(0, 0), cA, voffA); PG8_STAGE(PG8_SB(0, 1), cB + hstep, voffB); PG8_STAGE(PG8_SA(0, 1), cA + hstep, voffA);
        if (wr == 1) PG8_BAR;
        PG8_WAIT_V(4); PG8_BAR;
        PG8_STAGE(PG8_SB(1, 0), cB + kstep, voffB); PG8_STAGE(PG8_SA(1, 0), cA + kstep, voffA); PG8_STAGE(PG8_SB(1, 1), cB + hstep + kstep, voffB);
        PG8_WAIT_V(6); PG8_BAR;
    }
    for (;;) {
        const bool has_next = S.next(ui + 1, nxt);
        const char* nA = has_next ? (const char*)g.A + (size_t)nxt.pm * tstep : cA; const char* nB = has_next ? (const char*)g.Bt + (size_t)nxt.pn * tstep : cB;
        for (int t = 0; t < nt; t += 2) {
            const bool last = (t == nt - 2);
            const char* a1 = cA + (size_t)(t + 1) * kstep;
            const char* a2 = last ? nA : cA + (size_t)(t + 2) * kstep; const char* b2 = last ? nB : cB + (size_t)(t + 2) * kstep;
            const char* a3 = a2 + kstep; const char* b3 = b2 + kstep;
            if (last && has_next) S.a_ready(nxt);
            if constexpr (SP2) {
            PG8_LDB(B0, 0, 0); PG8_LDB(B1, 0, 1); PG8_SCHED; PG8_LDA(At, 0, 0); PG8_STAGE(PG8_SA(1, 1), a1 + hstep, voffA);
            PG8_WAIT_V(8); PG8_WAIT_L(0); PG8_BAR; PG8_MMA(0, 0, At, B0); PG8_MMA(0, 1, At, B1); PG8_BAR; PG8_SCHED;
            PG8_LDA(At, 0, 1); PG8_STAGE(PG8_SB(0, 0), b2, voffB); PG8_STAGE(PG8_SB(0, 1), b2 + hstep, voffB); PG8_STAGE(PG8_SA(0, 0), a2, voffA);
            PG8_WAIT_V(8); PG8_WAIT_L(0); PG8_BAR; PG8_MMA(1, 0, At, B0); PG8_MMA(1, 1, At, B1); PG8_BAR; PG8_SCHED;
            PG8_LDB(B0, 1, 0); PG8_LDB(B1, 1, 1); PG8_SCHED; PG8_LDA(At, 1, 0); PG8_STAGE(PG8_SA(0, 1), a2 + hstep, voffA);
            PG8_WAIT_V(8); PG8_WAIT_L(0); PG8_BAR; PG8_MMA(0, 0, At, B0); PG8_MMA(0, 1, At, B1); PG8_BAR; PG8_SCHED;
            PG8_LDA(At, 1, 1); PG8_STAGE(PG8_SB(1, 0), b3, voffB); PG8_STAGE(PG8_SB(1, 1), b3 + hstep, voffB); PG8_STAGE(PG8_SA(1, 0), a3, voffA);
            PG8_WAIT_V(8); PG8_WAIT_L(0); PG8_BAR; PG8_MMA(1, 0, At, B0); PG8_MMA(1, 1, At, B1); PG8_BAR; PG8_SCHED;
            } else {
            PG8_LDB(B0, 0, 0); PG8_SCHED; PG8_LDA(At, 0, 0); PG8_STAGE(PG8_SA(1, 1), a1 + hstep, voffA);
            PG8_WAIT_L(8); PG8_BAR; PG8_WAIT_L(0); PG8_MMA(0, 0, At, B0); PG8_BAR; PG8_SCHED;
            PG8_LDB(B1, 0, 1); PG8_STAGE(PG8_SB(0, 0), b2, voffB);
            PG8_BAR; PG8_WAIT_L(0); PG8_MMA(0, 1, At, B1); PG8_BAR;
            PG8_LDA(At, 0, 1); PG8_STAGE(PG8_SA(0, 0), a2, voffA);
            PG8_BAR; PG8_WAIT_L(0); PG8_MMA(1, 0, At, B0); PG8_BAR; PG8_SCHED;
            PG8_STAGE(PG8_SB(0, 1), b2 + hstep, voffB);
            PG8_WAIT_V(6); PG8_BAR; PG8_MMA(1, 1, At, B1); PG8_BAR;
            PG8_LDB(B0, 1, 0); PG8_SCHED; PG8_LDA(At, 1, 0); PG8_STAGE(PG8_SA(0, 1), a2 + hstep, voffA);
            PG8_WAIT_L(8); PG8_BAR; PG8_WAIT_L(0); PG8_MMA(0, 0, At, B0); PG8_BAR; PG8_SCHED;
            PG8_LDB(B1, 1, 1); PG8_STAGE(PG8_SB(1, 0), b3, voffB);
            PG8_BAR; PG8_WAIT_L(0); PG8_MMA(0, 1, At, B1); PG8_BAR;
            PG8_LDA(At, 1, 1); PG8_STAGE(PG8_SA(1, 0), a3, voffA);
            PG8_BAR; PG8_WAIT_L(0); PG8_MMA(1, 0, At, B0); PG8_BAR; PG8_SCHED;
            PG8_STAGE(PG8_SB(1, 1), b3 + hstep, voffB);
            PG8_WAIT_V(6); PG8_BAR; PG8_MMA(1, 1, At, B1); PG8_BAR;
            }
        }
        if constexpr (ALIGN_EPI) { if (wr == 0) PG8_BAR; }
        if constexpr (!Epi::AFTER_DRAIN) { E(acc, cur, wr, wc, fr, fq); S.done(cur); }
        if (!has_next) break;
#pragma unroll
        for (int a = 0; a < 2; ++a)
#pragma unroll
            for (int b = 0; b < 2; ++b)
#pragma unroll
                for (int m = 0; m < 4; ++m)
#pragma unroll
                    for (int n = 0; n < 2; ++n) acc[a][b][m][n] = (f32x4){0.f, 0.f, 0.f, 0.f};
        cur = nxt; cA = nA; cB = nB; ++ui;
        if constexpr (ALIGN_EPI) { if (wr == 1) PG8_BAR; }
    }
    PG8_WAIT_V(0);
    if constexpr (!ALIGN_EPI) { if (wr == 0) PG8_BAR; }
    PG8_BAR;
    if constexpr (Epi::AFTER_DRAIN) { E.fused(acc, cur, wr, wc, fr, fq, lds, wid, lane); S.done(cur); }
#undef PG8_SA
#undef PG8_SB
#undef PG8_STAGE
#undef PG8_LDA
#undef PG8_LDB
#undef PG8_MMA
#undef PG8_WAIT_V
#undef PG8_WAIT_L
#undef PG8_BAR
#undef PG8_SCHED
}
}

#define GAS __attribute__((address_space(1)))
#define LAS __attribute__((address_space(3)))
typedef unsigned short bf16;
typedef unsigned v4u __attribute__((ext_vector_type(4)));
typedef float f32x4 __attribute__((ext_vector_type(4)));
typedef short bf16x8 __attribute__((ext_vector_type(8)));
typedef GAS unsigned gu32;
typedef GAS unsigned long long gu64;
#define RLX_AGENT __ATOMIC_RELAXED, __HIP_MEMORY_SCOPE_AGENT
#define LDS_WAIT() asm volatile("s_waitcnt lgkmcnt(0)" ::: "memory")
#define VM_WAIT() asm volatile("s_waitcnt vmcnt(0)" ::: "memory")
__device__ __forceinline__ unsigned long long rt() { return __builtin_amdgcn_s_memrealtime(); }
__device__ __forceinline__ unsigned f2bf(float f) { unsigned u = __builtin_bit_cast(unsigned, f); return (u + 0x7fffu + ((u >> 16) & 1u)) >> 16; }
__device__ __forceinline__ unsigned pk2(float lo, float hi) { return f2bf(lo) | (f2bf(hi) << 16); }
#define XB_TMO      128
#define XB_XCNT(j)  (256  + 64 * (j))
#define XB_XSUB(j)  (1280 + 64 * (j))
#define XB_XGEN(j)  (2304 + 64 * (j))
#define XB_TOP      3328
#define XB_TOPGEN   3392
#define XCD_BAR_WORDS 3456
#define XB_SPIN_CAP (1u << 18)

__device__ __forceinline__ unsigned xb_ld(unsigned* p)              { return __hip_atomic_load(p, __ATOMIC_RELAXED, __HIP_MEMORY_SCOPE_AGENT); }
__device__ __forceinline__ unsigned xb_add(unsigned* p, unsigned v) { return __hip_atomic_fetch_add(p, v, __ATOMIC_RELAXED, __HIP_MEMORY_SCOPE_AGENT); }
__device__ __forceinline__ unsigned xb_xcc_id() { return (unsigned)__builtin_amdgcn_s_getreg((3 << 11) | 20) & 0xFu; }
#define XB_SPIN(cond, bar) do { unsigned _sp = 0; while (cond) { __builtin_amdgcn_s_sleep(1); \
    if ((++_sp & 255u) == 0u) { if (xb_ld(&(bar)[XB_TMO])) break; if (_sp > XB_SPIN_CAP) { atomicAdd(&(bar)[XB_TMO], 1u); break; } } } } while (0)

struct XcdBarrier {
    unsigned* bar; unsigned x;
    volatile LAS unsigned* st;
};

__device__ __forceinline__ XcdBarrier xcd_barrier_post(unsigned* bar, volatile LAS unsigned* st) {
    XcdBarrier b; b.bar = bar; b.x = xb_xcc_id(); b.st = st;
    if (threadIdx.x == 0) (void)xb_add(&bar[XB_XCNT(b.x)], 1u);
    return b;
}
__device__ __forceinline__ void xcd_barrier_complete(unsigned* bar, unsigned x, unsigned& nloc, unsigned& nx) {
    const unsigned G = gridDim.x * gridDim.y * gridDim.z;
    unsigned sum, cnt, mine, sp = 0u;
    for (;;) {
        sum = 0u; cnt = 0u; mine = 0u;
#pragma unroll
        for (unsigned j = 0; j < 16; ++j) { const unsigned c = xb_ld(&bar[XB_XCNT(j)]); sum += c; cnt += (c > 0u) ? 1u : 0u; mine = (j == x) ? c : mine; }
        if (sum == G) break;
        __builtin_amdgcn_s_sleep(1);
        if ((++sp & 255u) == 0u) { if (xb_ld(&bar[XB_TMO])) break; if (sp > XB_SPIN_CAP) { atomicAdd(&bar[XB_TMO], 1u); break; } }
    }
    nloc = mine > 0u ? mine : 1u; nx = cnt > 0u ? cnt : 1u;
}

__device__ __forceinline__ void xcd_barrier(const XcdBarrier& b) {
    asm volatile("s_waitcnt vmcnt(0)" ::: "memory");
    __syncthreads();
    if (threadIdx.x == 0) {
        unsigned* bar = b.bar;
        __builtin_amdgcn_s_waitcnt(0);
        unsigned nloc = b.st[0], nx = b.st[1];
        if (nloc == 0u) { xcd_barrier_complete(bar, b.x, nloc, nx); b.st[0] = nloc; b.st[1] = nx; }
        const unsigned old = xb_add(&bar[XB_XSUB(b.x)], 1u);
        const unsigned gen = old / nloc;
        if (old + 1u == (gen + 1u) * nloc) {
            __builtin_amdgcn_fence(__ATOMIC_RELEASE, "agent");
            asm volatile("s_waitcnt vmcnt(0)" ::: "memory");
            const unsigned og = xb_add(&bar[XB_TOP], 1u);
            const unsigned tg = og / nx;
            if (og + 1u == (tg + 1u) * nx) xb_add(&bar[XB_TOPGEN], 1u);
            else XB_SPIN(xb_ld(&bar[XB_TOPGEN]) == tg, bar);
            __builtin_amdgcn_fence(__ATOMIC_ACQUIRE, "agent");
            xb_add(&bar[XB_XGEN(b.x)], 1u);
            asm volatile("s_waitcnt vmcnt(0)" ::: "memory");
        } else {
            XB_SPIN(xb_ld(&bar[XB_XGEN(b.x)]) == gen, bar);
            __builtin_amdgcn_fence(__ATOMIC_ACQUIRE, "agent");
            asm volatile("s_waitcnt vmcnt(0)" ::: "memory");
        }
    }
    __syncthreads();
}


constexpr int NWAVES = 8, NTHREADS = 512;
constexpr int DM = 2048, NBATCH = 2, SEQ = 4096, NMETA = 16, FPAD = 112, LP = 4224, NBLK = 33;
constexpr int DBATCH = 128, DSEQ = 8, WIN = 128;
constexpr int ROWS_P = NBATCH * LP, ROWS_S = DBATCH * DSEQ, MROWS = ROWS_P + ROWS_S;
constexpr int NIN = 5648, NPAD = 5888;
constexpr int C_QA = 0, C_KA = 1024, C_VA = 1280, C_GA = 1536, C_QG = 2560, C_KG = 3072, C_VG = 3584, C_GG = 4608, C_ZG = 5632;
constexpr float EPSN = 1e-6f;
static_assert(MROWS % 256 == 0 && NPAD % 256 == 0, "tiles");

constexpr size_t O_YP = 0, O_YS = 16777216, O_KWP = 18874368, O_VWP = 18939904, O_GP = 19005440, O_KWS = 19267584, O_VWS = 23461888, O_GS = 27656192, O_END = 44433408;

constexpr size_t MiB = 1u << 20;
constexpr size_t WS_CTL = 0, CTL_ZERO_BYTES = 64 * 1024;
constexpr size_t WS_WIN = 1 * MiB;
constexpr size_t WS_WOUT = 24 * MiB;
constexpr size_t WS_XN = 32 * MiB;
constexpr size_t WS_P = 69 * MiB;
constexpr size_t WS_DST = 176 * MiB;
constexpr size_t WS_ST = 209 * MiB;
constexpr size_t WS_DEC = 226 * MiB;
constexpr size_t WS_END = 227 * MiB;
constexpr int CW_BAR = 1024;

constexpr int LDS_CTL_BYTES = 1024;
constexpr int SCR_OFF = 1024;
constexpr int LDS_BYTES = 156 * 1024;

typedef short bf16x4 __attribute__((ext_vector_type(4)));
typedef short v4i16_t __attribute__((ext_vector_type(4)));
typedef float f32x2 __attribute__((ext_vector_type(2)));

__device__ __forceinline__ float bf2f(unsigned short b) { return __uint_as_float(((unsigned)b) << 16); }
__device__ __forceinline__ unsigned short f2bf16(float f) { return (unsigned short)f2bf(f); }
__device__ __forceinline__ float wave_sum(float v) {
#pragma unroll
    for (int o = 1; o < 64; o <<= 1) v += __shfl_xor(v, o);
    return v;
}
__device__ __forceinline__ float silu_f(float x) { return x / (1.f + __expf(-x)); }
__device__ __forceinline__ float logsig_f(float x) { return fminf(x, 0.f) - __logf(1.f + __expf(-fabsf(x))); }

#ifndef USE_TR
#define USE_TR 1
#endif
__device__ __forceinline__ bf16x8 tr_frag(const LAS unsigned short* M, int row0, int col0, int pitch, int lane) {
#if USE_TR
    const int q = (lane & 15) >> 2, p = lane & 3;
    const LAS unsigned short* a0 = M + (row0 + q) * pitch + col0 + 4 * p;
    const v4i16_t lo = __builtin_amdgcn_ds_read_tr16_b64_v4i16((LAS v4i16_t*)a0);
    const v4i16_t hi = __builtin_amdgcn_ds_read_tr16_b64_v4i16((LAS v4i16_t*)(a0 + 4 * pitch));
    return (bf16x8){lo[0], lo[1], lo[2], lo[3], hi[0], hi[1], hi[2], hi[3]};
#else
    bf16x8 r; const LAS unsigned short* a0 = M + row0 * pitch + col0 + (lane & 15);
#pragma unroll
    for (int j = 0; j < 8; ++j) r[j] = (short)a0[j * pitch];
    return r;
#endif
}
#define MFMA16(a, b, c) __builtin_amdgcn_mfma_f32_16x16x32_bf16((a), (b), (c), 0, 0, 0)

struct Frame {
    LAS unsigned char* lds;
    int tid, lane, wave, G;
    unsigned char* ws; float* out;
    __device__ __forceinline__ bf16* WinT() const { return (bf16*)(ws + WS_WIN); }
    __device__ __forceinline__ bf16* WoutT() const { return (bf16*)(ws + WS_WOUT); }
    __device__ __forceinline__ bf16* XN() const { return (bf16*)(out + O_GS); }
    __device__ __forceinline__ bf16* MIX() const { return (bf16*)(ws + WS_XN); }
    __device__ __forceinline__ bf16* P() const { return (bf16*)(ws + WS_P); }
    __device__ __forceinline__ float* O2() const { return (float*)(ws + WS_P); }
    __device__ __forceinline__ float* dST() const { return (float*)(ws + WS_DST); }
    __device__ __forceinline__ bf16* St() const { return (bf16*)(ws + WS_ST); }
    __device__ __forceinline__ float* dec() const { return (float*)(ws + WS_DEC); }
};
enum { A_XP = 0, A_XS, A_CK, A_CV, A_STATE, A_META, A_RELB, A_NPRE, A_NPOST, A_WIN, A_WA2, A_BA, A_SINK, A_GNORM, A_WOUT, A_OUT, A_WS };
typedef const GAS float* gcf;
template <int IDX> __device__ __forceinline__ gcf ldarg() {
    const unsigned long long ka = (unsigned long long)__builtin_amdgcn_kernarg_segment_ptr();
    unsigned long long v;
    asm volatile("s_load_dwordx2 %0, %1, %2\n\ts_waitcnt lgkmcnt(0)" : "=s"(v) : "s"(ka), "i"(IDX * 8) : "memory");
    return (gcf)v;
}

struct P0Item { gcf W; bf16* WT; int N, kb, nb; bool on; };
__device__ __forceinline__ void p0_item_load(const P0Item& it, int K, int lane, f32x4 (&v)[16]) {
    const int k0 = 64 * it.kb, n0 = 64 * it.nb; const int nq = 4 * (lane & 15), kr = lane >> 4; const bool ok = it.on && (n0 + nq) < it.N;
#pragma unroll
    for (int i = 0; i < 16; ++i) v[i] = ok ? *(const GAS f32x4*)(it.W + (size_t)(k0 + 4 * i + kr) * it.N + n0 + nq) : (f32x4){0.f, 0.f, 0.f, 0.f};
}
__device__ __forceinline__ void p0_item_store(const P0Item& it, int K, int lane, const f32x4 (&v)[16], LAS float* scr) {
    if (!it.on) return;
    const int k0 = 64 * it.kb, n0 = 64 * it.nb; const int nq = 4 * (lane & 15), kr = lane >> 4;
#pragma unroll
    for (int i = 0; i < 16; ++i) { LAS float* d = scr + (4 * i + kr) * 65 + nq; d[0] = v[i].x; d[1] = v[i].y; d[2] = v[i].z; d[3] = v[i].w; }
    LDS_WAIT(); asm volatile("" ::: "memory");
    const int c = lane & 7;
#pragma unroll
    for (int j = 0; j < 8; ++j) { const int nn = (lane >> 3) + 8 * j; const LAS float* s = scr + (8 * c) * 65 + nn;
        v4u o; o.x = pk2(s[0 * 65], s[1 * 65]); o.y = pk2(s[2 * 65], s[3 * 65]); o.z = pk2(s[4 * 65], s[5 * 65]); o.w = pk2(s[6 * 65], s[7 * 65]);
        *(GAS v4u*)(it.WT + (size_t)(n0 + nn) * K + k0 + 8 * c) = o; }
    LDS_WAIT(); asm volatile("" ::: "memory");
}
__device__ __forceinline__ gcf p0_row_src(int m, gcf meta, gcf x_prompt, gcf x_sample) {
    if (m < ROWS_P) { const int b = m / LP, i = m - b * LP;
        if (i < FPAD) return nullptr;
        return (i < 128) ? meta + (size_t)(i - FPAD) * DM : x_prompt + ((size_t)b * SEQ + (i - 128)) * DM; }
    return x_sample + (size_t)(m - ROWS_P) * DM;
}
constexpr int P0R = 4;
__device__ __forceinline__ void p0_rows2(Frame& F, int m0, int mstep, gcf meta, gcf x_prompt, gcf x_sample, gcf norm_pre) {
    gcf src[P0R]; int mm[P0R];
#pragma unroll
    for (int q = 0; q < P0R; ++q) { mm[q] = m0 + q * mstep; src[q] = (mm[q] < MROWS) ? p0_row_src(mm[q], meta, x_prompt, x_sample) : nullptr; }
    f32x4 v[P0R][8];
#pragma unroll
    for (int q = 0; q < P0R; ++q)
#pragma unroll
        for (int j = 0; j < 8; ++j) v[q][j] = src[q] ? ((const GAS f32x4*)src[q])[F.lane + 64 * j] : (f32x4){0.f, 0.f, 0.f, 0.f};
#pragma unroll
    for (int q = 0; q < P0R; ++q) { if (mm[q] >= MROWS) continue;
        float s = 0.f;
#pragma unroll
        for (int j = 0; j < 8; ++j) s += (v[q][j].x * v[q][j].x + v[q][j].y * v[q][j].y) + (v[q][j].z * v[q][j].z + v[q][j].w * v[q][j].w);
        const float rstd = rsqrtf(wave_sum(s) * (1.f / DM) + EPSN);
        GAS unsigned long long* o8 = (GAS unsigned long long*)(F.XN() + (size_t)mm[q] * DM) + F.lane;
        if (src[q] == nullptr) { GAS unsigned long long* z8 = (GAS unsigned long long*)(F.MIX() + (size_t)mm[q] * DM) + F.lane;
#pragma unroll
            for (int j = 0; j < 8; ++j) z8[64 * j] = 0ull; }
#pragma unroll
        for (int j = 0; j < 8; ++j) { const f32x4 w = ((const GAS f32x4*)norm_pre)[F.lane + 64 * j];
            o8[64 * j] = (unsigned long long)pk2(v[q][j].x * rstd * w.x, v[q][j].y * rstd * w.y) | ((unsigned long long)pk2(v[q][j].z * rstd * w.z, v[q][j].w * rstd * w.w) << 32); } }
}
__device__ __forceinline__ void p0_prologue(Frame& F) { gcf const w_in = ldarg<A_WIN>(); gcf const w_out = ldarg<A_WOUT>();
    LAS float* scr = (LAS float*)(F.lds + SCR_OFF + F.wave * 16640);
    const int gw = blockIdx.x * NWAVES + F.wave, NGW = F.G * NWAVES;
    constexpr int I_IN = (DM / 64) * (NPAD / 64), I_OUT = (DM / 64) * (DM / 64);
    auto mk = [&](int it) { P0Item r; r.on = it < I_IN + I_OUT;
        if (it < I_IN) { r.W = w_in; r.WT = F.WinT(); r.N = NIN; r.kb = it / (NPAD / 64); r.nb = it % (NPAD / 64); }
        else { const int q = r.on ? it - I_IN : 0; r.W = w_out; r.WT = F.WoutT(); r.N = DM; r.kb = q / (DM / 64); r.nb = q % (DM / 64); }
        return r; };
    for (int it = gw; it < I_IN + I_OUT; it += 2 * NGW) {
        const P0Item a = mk(it), b = mk(it + NGW);
        f32x4 va[16], vb[16];
        p0_item_load(a, DM, F.lane, va); p0_item_load(b, DM, F.lane, vb);
        p0_item_store(a, DM, F.lane, va, scr); p0_item_store(b, DM, F.lane, vb, scr);
    }
    gcf const meta = ldarg<A_META>(); gcf const x_prompt = ldarg<A_XP>(); gcf const x_sample = ldarg<A_XS>(); gcf const norm_pre = ldarg<A_NPRE>();
    for (int m = gw; m < MROWS; m += P0R * NGW) p0_rows2(F, m, NGW, meta, x_prompt, x_sample, norm_pre);
}

constexpr int AKP = 72, APP = 168;
constexpr int A_K = 0, A_V = 272 * AKP * 2, A_BIAS = 2 * A_V, A_P = A_BIAS + 2048, A_END = A_P + NWAVES * 16 * APP * 2;
static_assert(A_END <= LDS_BYTES - SCR_OFF, "attention LDS");

struct AttnLds { const LAS unsigned short* AK; const LAS unsigned short* AV; const LAS float* AB; LAS unsigned short* AP; };
template <bool SAMPLE>
__device__ __forceinline__ void attn_tile(Frame& F, const AttnLds& L, const bf16x8 (&qa)[2], int s0, int kmin  ,
                                          int tb, int gb, size_t rowb, gcf sinks, int kvh) {
    int lane = F.lane; asm volatile("" : "+v"(lane));
    const int gq = lane >> 4, i = lane & 15;
    const LAS unsigned short* AK = L.AK; const LAS unsigned short* AV = L.AV; const LAS float* AB = L.AB; LAS unsigned short* AP = L.AP;
    size_t prow[2]; int pcol[2]; v4u gpre[2];
#pragma unroll
    for (int jj = 0; jj < 2; ++jj) { const int q = lane + 64 * jj, rr = q >> 3, ch = q & 7;
        prow[jj] = SAMPLE ? rowb + (rr & 7) : rowb + rr; pcol[jj] = kvh * 256 + (SAMPLE ? gb + (rr >> 3) : gb) * 64 + 8 * ch;
        gpre[jj] = *(const GAS v4u*)(F.P() + prow[jj] * NPAD + C_GA + pcol[jj]); }
    int trow[4], grow[4]; float sinkr[4];
#pragma unroll
    for (int r = 0; r < 4; ++r) { const int rr = 4 * gq + r; trow[r] = SAMPLE ? (rr & 7) : tb + rr; grow[r] = SAMPLE ? gb + (rr >> 3) : gb; sinkr[r] = sinks[kvh * 4 + grow[r]]; }
    f32x4 acc[10];
#pragma unroll
    for (int cb = 0; cb < 10; ++cb) { acc[cb] = (f32x4){0.f, 0.f, 0.f, 0.f};
#pragma unroll
        for (int ks = 0; ks < 2; ++ks) { const bf16x8 kb = *(const LAS bf16x8*)(AK + (s0 + 16 * cb + i) * AKP + 32 * ks + 8 * gq); acc[cb] = MFMA16(qa[ks], kb, acc[cb]); } }
    float mx[4] = {-INFINITY, -INFINITY, -INFINITY, -INFINITY};
#pragma unroll
    for (int cb = 0; cb < 10; ++cb) { const int s = s0 + 16 * cb + i;
#pragma unroll
        for (int r = 0; r < 4; ++r) { const int dist = 128 + trow[r] - s; const bool valid = (dist >= 0) && (dist < 128) && (s >= kmin);
            const int dc = dist < 0 ? 0 : (dist > 127 ? 127 : dist);
            const float v = valid ? acc[cb][r] * 0.125f + AB[grow[r] * 128 + dc] : -INFINITY; acc[cb][r] = v; mx[r] = fmaxf(mx[r], v); } }
    float inv[4];
#pragma unroll
    for (int r = 0; r < 4; ++r) { float m = mx[r];
        m = fmaxf(m, __shfl_xor(m, 1)); m = fmaxf(m, __shfl_xor(m, 2)); m = fmaxf(m, __shfl_xor(m, 4)); m = fmaxf(m, __shfl_xor(m, 8));
        m = fmaxf(m, sinkr[r]); float sum = 0.f;
#pragma unroll
        for (int cb = 0; cb < 10; ++cb) { const float e = __expf(acc[cb][r] - m); acc[cb][r] = e; sum += e; }
        sum += __shfl_xor(sum, 1); sum += __shfl_xor(sum, 2); sum += __shfl_xor(sum, 4); sum += __shfl_xor(sum, 8);
        inv[r] = 1.f / (sum + __expf(sinkr[r] - m)); }
#pragma unroll
    for (int cb = 0; cb < 10; ++cb)
#pragma unroll
        for (int r = 0; r < 4; ++r) AP[(4 * gq + r) * APP + 16 * cb + i] = f2bf16(acc[cb][r]);
    LDS_WAIT(); asm volatile("" ::: "memory");
    f32x4 o[4];
#pragma unroll
    for (int db = 0; db < 4; ++db) o[db] = (f32x4){0.f, 0.f, 0.f, 0.f};
#pragma unroll
    for (int kk = 0; kk < 5; ++kk) { const bf16x8 pa = *(const LAS bf16x8*)(AP + i * APP + 32 * kk + 8 * gq);
#pragma unroll
        for (int db = 0; db < 4; ++db) { const bf16x8 vb = tr_frag(AV, s0 + 32 * kk + 8 * gq, 16 * db, AKP, lane); o[db] = MFMA16(pa, vb, o[db]); } }
    LDS_WAIT(); asm volatile("" ::: "memory");
#pragma unroll
    for (int r = 0; r < 4; ++r)
#pragma unroll
        for (int db = 0; db < 4; ++db) AP[(4 * gq + r) * APP + 16 * db + i] = f2bf16(o[db][r] * inv[r]);
    LDS_WAIT(); asm volatile("" ::: "memory");
#pragma unroll
    for (int jj = 0; jj < 2; ++jj) { const int q = lane + 64 * jj, rr = q >> 3, ch = q & 7;
        const v4u ov = *(const LAS v4u*)(AP + rr * APP + 8 * ch); const v4u gv = gpre[jj];
        v4u res;
        res.x = pk2(bf2f(ov.x & 0xffff) * silu_f(bf2f(gv.x & 0xffff)), bf2f(ov.x >> 16) * silu_f(bf2f(gv.x >> 16)));
        res.y = pk2(bf2f(ov.y & 0xffff) * silu_f(bf2f(gv.y & 0xffff)), bf2f(ov.y >> 16) * silu_f(bf2f(gv.y >> 16)));
        res.z = pk2(bf2f(ov.z & 0xffff) * silu_f(bf2f(gv.z & 0xffff)), bf2f(ov.z >> 16) * silu_f(bf2f(gv.z >> 16)));
        res.w = pk2(bf2f(ov.w & 0xffff) * silu_f(bf2f(gv.w & 0xffff)), bf2f(ov.w >> 16) * silu_f(bf2f(gv.w >> 16)));
        *(GAS v4u*)(F.MIX() + prow[jj] * DM + pcol[jj]) = res; }
    LDS_WAIT(); asm volatile("" ::: "memory");
}

__device__ __forceinline__ void attn_bias_table(Frame& F, LAS float* AB, int kvh) { gcf const rel_bias = ldarg<A_RELB>();
    const int g = F.tid >> 7, d = F.tid & 127;
    int bk = d;
    if (d >= 16) { bk = 16 + (int)(__logf((float)d * (1.f / 16.f)) * (16.f / 2.0794415416798357f)); bk = bk > 31 ? 31 : bk; }
    AB[g * 128 + d] = rel_bias[bk * 16 + kvh * 4 + g];
}

__device__ __forceinline__ void attn_prompt_unit(Frame& F0, LAS unsigned char* scr, int b, int n, int kvh) { Frame F = F0; asm volatile("" : "+v"(F.tid), "+v"(F.lane));     gcf const sinks = ldarg<A_SINK>();
    LAS unsigned short* AK = (LAS unsigned short*)(scr + A_K); LAS unsigned short* AV = (LAS unsigned short*)(scr + A_V);
    __syncthreads();
    const long wrow0 = (long)b * LP + 128 * (n - 1);
#pragma unroll
    for (int j = 0; j < 4; ++j) { const int c = F.tid + 512 * j, row = c >> 3, ch = c & 7; const long gr = wrow0 + row;
        v4u kv = (v4u){0u, 0u, 0u, 0u}, vv = kv;
        if (gr >= 0) { const bf16* p = F.P() + (size_t)gr * NPAD + kvh * 64 + 8 * ch; kv = *(const GAS v4u*)(p + C_KA); vv = *(const GAS v4u*)(p + C_VA); }
        *(LAS v4u*)(AK + row * AKP + 8 * ch) = kv; *(LAS v4u*)(AV + row * AKP + 8 * ch) = vv; }
    if (F.tid < 128) { const int row = 256 + (F.tid >> 3), ch = F.tid & 7; *(LAS v4u*)(AK + row * AKP + 8 * ch) = (v4u){0u, 0u, 0u, 0u}; *(LAS v4u*)(AV + row * AKP + 8 * ch) = (v4u){0u, 0u, 0u, 0u}; }
    attn_bias_table(F, (LAS float*)(scr + A_BIAS), kvh);
    __syncthreads();
    const AttnLds L{AK, AV, (const LAS float*)(scr + A_BIAS), (LAS unsigned short*)(scr + A_P) + F.wave * 16 * APP};
    const int gq = F.lane >> 4, i = F.lane & 15, t0 = (n == 0) ? 112 : 16 * F.wave;
    const int kmin = FPAD - 128 * (n - 1);
    const size_t rbase = (size_t)b * LP + 128 * n;
    const int g_lo = (n == 0) ? F.wave : 0, g_hi = (n == 0) ? (F.wave < 4 ? F.wave + 1 : 0) : 4;
    bf16x8 qn[2] = {(bf16x8){0, 0, 0, 0, 0, 0, 0, 0}, (bf16x8){0, 0, 0, 0, 0, 0, 0, 0}};
    if (g_lo < g_hi) { const bf16* qp = F.P() + (rbase + t0 + i) * NPAD + C_QA + (kvh * 4 + g_lo) * 64; qn[0] = *(const GAS bf16x8*)(qp + 8 * gq); qn[1] = *(const GAS bf16x8*)(qp + 32 + 8 * gq); }
#pragma unroll 1
    for (int g = g_lo; g < g_hi; ++g) {
        const bf16x8 qa[2] = {qn[0], qn[1]};
        if (g + 1 < g_hi) { const bf16* qp = F.P() + (rbase + t0 + i) * NPAD + C_QA + (kvh * 4 + g + 1) * 64; qn[0] = *(const GAS bf16x8*)(qp + 8 * gq); qn[1] = *(const GAS bf16x8*)(qp + 32 + 8 * gq); }
        attn_tile<false>(F, L, qa, t0, kmin, t0, g, rbase + t0, sinks, kvh);
    }
    if (n == NBLK - 1) {
#pragma unroll
        for (int j = 0; j < 16; ++j) { const int e = F.tid + 512 * j, row = e >> 6, d = e & 63;
            const size_t oidx = (((size_t)b * WIN + row) * 4 + kvh) * 64 + d;
            F.out[O_KWP + oidx] = bf2f(AK[(128 + row) * AKP + d]); F.out[O_VWP + oidx] = bf2f(AV[(128 + row) * AKP + d]); }
    }
}

__device__ __forceinline__ void attn_sample_stage(Frame& F, LAS unsigned short* AK, LAS unsigned short* AV, int db, int kvh, gcf cache_k, gcf cache_v) {
#pragma unroll
    for (int j = 0; j < 4; ++j) { const int c = F.tid + 512 * j, row = c >> 4, ch = c & 15;
        const size_t src = (((size_t)db * WIN + row) * 4 + kvh) * 64 + 4 * ch;
        const f32x4 kv = *(const GAS f32x4*)(cache_k + src), vv = *(const GAS f32x4*)(cache_v + src);
        *(LAS unsigned long long*)(AK + row * AKP + 4 * ch) = (unsigned long long)pk2(kv.x, kv.y) | ((unsigned long long)pk2(kv.z, kv.w) << 32);
        *(LAS unsigned long long*)(AV + row * AKP + 4 * ch) = (unsigned long long)pk2(vv.x, vv.y) | ((unsigned long long)pk2(vv.z, vv.w) << 32);
        if (row >= DSEQ) { const size_t dst = (((size_t)db * WIN + row - DSEQ) * 4 + kvh) * 64 + 4 * ch; *(GAS f32x4*)(F.out + O_KWS + dst) = kv; *(GAS f32x4*)(F.out + O_VWS + dst) = vv; } }
    const size_t srow0 = (size_t)ROWS_P + (size_t)db * DSEQ;
    if (F.tid < 64) { const int t = F.tid >> 3, ch = F.tid & 7; const bf16* p = F.P() + (srow0 + t) * NPAD + kvh * 64 + 8 * ch;
        const v4u kv = *(const GAS v4u*)(p + C_KA), vv = *(const GAS v4u*)(p + C_VA);
        *(LAS v4u*)(AK + (128 + t) * AKP + 8 * ch) = kv; *(LAS v4u*)(AV + (128 + t) * AKP + 8 * ch) = vv;
        const size_t dst = (((size_t)db * WIN + (WIN - DSEQ) + t) * 4 + kvh) * 64 + 8 * ch;
        f32x4 a, c2; a.x = bf2f(kv.x & 0xffff); a.y = bf2f(kv.x >> 16); a.z = bf2f(kv.y & 0xffff); a.w = bf2f(kv.y >> 16); c2.x = bf2f(kv.z & 0xffff); c2.y = bf2f(kv.z >> 16); c2.z = bf2f(kv.w & 0xffff); c2.w = bf2f(kv.w >> 16);
        *(GAS f32x4*)(F.out + O_KWS + dst) = a; *(GAS f32x4*)(F.out + O_KWS + dst + 4) = c2;
        a.x = bf2f(vv.x & 0xffff); a.y = bf2f(vv.x >> 16); a.z = bf2f(vv.y & 0xffff); a.w = bf2f(vv.y >> 16); c2.x = bf2f(vv.z & 0xffff); c2.y = bf2f(vv.z >> 16); c2.z = bf2f(vv.w & 0xffff); c2.w = bf2f(vv.w >> 16);
        *(GAS f32x4*)(F.out + O_VWS + dst) = a; *(GAS f32x4*)(F.out + O_VWS + dst + 4) = c2; }
    if (F.tid >= 64 && F.tid < 64 + 192) { const int c = F.tid - 64, row = 136 + (c >> 3), ch = c & 7; *(LAS v4u*)(AK + row * AKP + 8 * ch) = (v4u){0u, 0u, 0u, 0u}; *(LAS v4u*)(AV + row * AKP + 8 * ch) = (v4u){0u, 0u, 0u, 0u}; }
}
__device__ __forceinline__ void attn_sample_tiles(Frame& F, const AttnLds& L, int db, int kvh, int wl, gcf sinks) {
    const int gq = F.lane >> 4, i = F.lane & 15; const size_t srow0 = (size_t)ROWS_P + (size_t)db * DSEQ;
    const bf16* qptr = F.P() + (srow0 + (i & 7)) * NPAD + C_QA + (kvh * 4 + 2 * wl + (i >> 3)) * 64;
    const bf16x8 qa[2] = {*(const GAS bf16x8*)(qptr + 8 * gq), *(const GAS bf16x8*)(qptr + 32 + 8 * gq)};
    attn_tile<true>(F, L, qa, 0, 0, 0, 2 * wl, srow0, sinks, kvh);
}
__device__ __forceinline__ void attn_sample_unit(Frame& F0, LAS unsigned char* scr, int u) { Frame F = F0; asm volatile("" : "+v"(F.tid), "+v"(F.lane));
    gcf const cache_k = ldarg<A_CK>(); gcf const cache_v = ldarg<A_CV>(); gcf const sinks = ldarg<A_SINK>();
    const int kvh = u & 3, db = u >> 2;
    LAS unsigned short* AK = (LAS unsigned short*)(scr + A_K); LAS unsigned short* AV = (LAS unsigned short*)(scr + A_V);
    __syncthreads();
    attn_sample_stage(F, AK, AV, db, kvh, cache_k, cache_v);
    attn_bias_table(F, (LAS float*)(scr + A_BIAS), kvh);
    __syncthreads();
    if (F.wave < 2) { const AttnLds L{AK, AV, (const LAS float*)(scr + A_BIAS), (LAS unsigned short*)(scr + A_P) + F.wave * 16 * APP}; attn_sample_tiles(F, L, db, kvh, F.wave, sinks); }
}
constexpr int SP_SLOT = 160 * AKP * 2, SP_BIAS = 4 * SP_SLOT, SP_P = SP_BIAS + 2048, SP_END = SP_P + 4 * 16 * APP * 2;
static_assert(SP_END <= LDS_BYTES - SCR_OFF, "sample pair LDS");
__device__ __forceinline__ void attn_sample_pair(Frame& F0, LAS unsigned char* scr, int u0, int u1) { Frame F = F0; asm volatile("" : "+v"(F.tid), "+v"(F.lane));
    gcf const cache_k = ldarg<A_CK>(); gcf const cache_v = ldarg<A_CV>(); gcf const sinks = ldarg<A_SINK>();
    const int kvh = u0 & 3;
    LAS unsigned short* K0 = (LAS unsigned short*)(scr); LAS unsigned short* V0 = (LAS unsigned short*)(scr + SP_SLOT);
    LAS unsigned short* K1 = (LAS unsigned short*)(scr + 2 * SP_SLOT); LAS unsigned short* V1 = (LAS unsigned short*)(scr + 3 * SP_SLOT);
    __syncthreads();
    attn_sample_stage(F, K0, V0, u0 >> 2, kvh, cache_k, cache_v);
    attn_sample_stage(F, K1, V1, u1 >> 2, kvh, cache_k, cache_v);
    attn_bias_table(F, (LAS float*)(scr + SP_BIAS), kvh);
    __syncthreads();
    if (F.wave < 4) { const int sl = F.wave >> 1;
        const AttnLds L{sl ? K1 : K0, sl ? V1 : V0, (const LAS float*)(scr + SP_BIAS), (LAS unsigned short*)(scr + SP_P) + F.wave * 16 * APP};
        attn_sample_tiles(F, L, (sl ? u1 : u0) >> 2, kvh, F.wave & 1, sinks); }
}

constexpr int GQP = 136, GVP = 264;
constexpr int G_Q = 0, G_K = 128 * GQP * 2, G_V = 2 * G_K, G_Z = G_V + 128 * GVP * 2, G_TOT = G_Z + 8192, G_D = G_TOT + 2048, G_END = G_D + 512;
static_assert(G_END <= LDS_BYTES - SCR_OFF, "GLA LDS");

template <bool NEED_Q>
__device__ __forceinline__ void gla_gate(Frame& F, LAS unsigned char* scr, int b, int c, int h) { gcf const w_a2 = ldarg<A_WA2>(); gcf const b_a = ldarg<A_BA>();
    LAS unsigned short* GQ = (LAS unsigned short*)(scr + G_Q); LAS unsigned short* GK = (LAS unsigned short*)(scr + G_K); LAS unsigned short* GV = (LAS unsigned short*)(scr + G_V);
    LAS float* GD = (LAS float*)(scr + G_D);
    const size_t R0 = (size_t)b * LP + 128 * c;
    const int lane = F.lane, gq = lane >> 4, i = lane & 15, w = F.wave;
    __syncthreads();
    bf16x8 za[8]; bf16x8 wh, wl; float ba;
    {
        v4u vv[8], kk[4], qq[4];
#pragma unroll
        for (int j = 0; j < 8; ++j) { const int cc = F.tid + 512 * j, row = cc >> 5, ch = cc & 31; vv[j] = *(const GAS v4u*)(F.P() + (R0 + row) * NPAD + C_VG + h * 256 + 8 * ch); }
#pragma unroll
        for (int j = 0; j < 4; ++j) { const int cc = F.tid + 512 * j, row = cc >> 4, ch = cc & 15; const bf16* p = F.P() + (R0 + row) * NPAD + h * 128 + 8 * ch;
            kk[j] = *(const GAS v4u*)(p + C_KG); if (NEED_Q) qq[j] = *(const GAS v4u*)(p + C_QG); }
#pragma unroll
        for (int tb = 0; tb < 8; ++tb) za[tb] = (gq < 2) ? *(const GAS bf16x8*)(F.P() + (R0 + 16 * tb + i) * NPAD + C_ZG + 8 * gq) : (bf16x8){0, 0, 0, 0, 0, 0, 0, 0};
#pragma unroll
        for (int j = 0; j < 8; ++j) { const float wv = (gq < 2) ? w_a2[(8 * gq + j) * 512 + h * 128 + 16 * w + i] : 0.f; const unsigned short hi = f2bf16(wv); wh[j] = (short)hi; wl[j] = (short)f2bf16(wv - bf2f(hi)); }
        ba = b_a[h * 128 + 16 * w + i];
#pragma unroll
        for (int j = 0; j < 8; ++j) { const int cc = F.tid + 512 * j, row = cc >> 5, ch = cc & 31; *(LAS v4u*)(GV + row * GVP + 8 * ch) = vv[j]; }
#pragma unroll
        for (int j = 0; j < 4; ++j) { const int cc = F.tid + 512 * j, row = cc >> 4, ch = cc & 15; *(LAS v4u*)(GK + row * GQP + 8 * ch) = kk[j]; if (NEED_Q) *(LAS v4u*)(GQ + row * GQP + 8 * ch) = qq[j]; }
    }
    f32x4 bc[8]; float run = 0.f;
#pragma unroll
    for (int tb = 0; tb < 8; ++tb) { f32x4 x = (f32x4){ba, ba, ba, ba}; x = MFMA16(za[tb], wh, x); x = MFMA16(za[tb], wl, x);
        float l0 = logsig_f(x[0]) * (1.f / 16.f), l1 = logsig_f(x[1]) * (1.f / 16.f), l2 = logsig_f(x[2]) * (1.f / 16.f), l3 = logsig_f(x[3]) * (1.f / 16.f);
        if (c == 0) { const int t0 = 16 * tb + 4 * gq; if (t0 + 0 < FPAD) l0 = 0.f; if (t0 + 1 < FPAD) l1 = 0.f; if (t0 + 2 < FPAD) l2 = 0.f; if (t0 + 3 < FPAD) l3 = 0.f; }
        const float p0 = l0, p1 = p0 + l1, p2 = p1 + l2, p3 = p2 + l3;
        float a = p3; const float u1 = __shfl_up(a, 16); if (gq >= 1) a += u1; const float u2 = __shfl_up(a, 32); if (gq >= 2) a += u2;
        const float excl = a - p3, tot = __shfl(a, 48 + i);
        bc[tb] = (f32x4){run + excl + p0, run + excl + p1, run + excl + p2, run + excl + p3}; run += tot; }
    __syncthreads();
#pragma unroll
    for (int tb = 0; tb < 8; ++tb)
#pragma unroll
        for (int r = 0; r < 4; ++r) { const int t = 16 * tb + 4 * gq + r, k = 16 * w + i; const float bt = bc[tb][r];
            GK[t * GQP + k] = f2bf16(bf2f(GK[t * GQP + k]) * __expf(-bt));
            if (NEED_Q) GQ[t * GQP + k] = f2bf16(bf2f(GQ[t * GQP + k]) * __expf(bt) * 0.08838834764831845f); }
    if (gq == 0) GD[16 * w + i] = __expf(run);
    __syncthreads();
}

__device__ __forceinline__ void gla_ds_unit(Frame& F0, LAS unsigned char* scr, int b, int c, int h) { Frame F = F0; asm volatile("" : "+v"(F.tid), "+v"(F.lane));
    const int u = (b * NBLK + c) * 4 + h;
    gla_gate<false>(F, scr, b, c, h);
    const LAS unsigned short* GK = (const LAS unsigned short*)(scr + G_K); const LAS unsigned short* GV = (const LAS unsigned short*)(scr + G_V); const LAS float* GD = (const LAS float*)(scr + G_D);
    int lane = F.lane; asm volatile("" : "+v"(lane));
    const int gq = lane >> 4, i = lane & 15, w = F.wave;
    f32x4 acc[8][2];
#pragma unroll
    for (int rb = 0; rb < 8; ++rb) { acc[rb][0] = (f32x4){0.f, 0.f, 0.f, 0.f}; acc[rb][1] = (f32x4){0.f, 0.f, 0.f, 0.f}; }
#pragma unroll
    for (int ks = 0; ks < 4; ++ks) {
        if (c == 0 && ks < 3) continue;
        const bf16x8 vb0 = tr_frag(GV, 32 * ks + 8 * gq, 32 * w, GVP, lane), vb1 = tr_frag(GV, 32 * ks + 8 * gq, 32 * w + 16, GVP, lane);
#pragma unroll
        for (int rb = 0; rb < 8; ++rb) { const bf16x8 ka = tr_frag(GK, 32 * ks + 8 * gq, 16 * rb, GQP, lane); acc[rb][0] = MFMA16(ka, vb0, acc[rb][0]); acc[rb][1] = MFMA16(ka, vb1, acc[rb][1]); } }
    float* dst = F.dST() + (size_t)u * 32768;
#pragma unroll
    for (int rb = 0; rb < 8; ++rb) { const f32x4 d4 = *(const LAS f32x4*)(GD + 16 * rb + 4 * gq);
#pragma unroll
        for (int cb = 0; cb < 2; ++cb) *(GAS f32x4*)(dst + (size_t)(32 * w + 16 * cb + i) * 128 + 16 * rb + 4 * gq) = acc[rb][cb] * d4; }
    if (F.tid < 128) F.dec()[(size_t)u * 128 + F.tid] = GD[F.tid];
}

__device__ __forceinline__ void gla_scan(Frame& F) {
    for (int e = blockIdx.x * NTHREADS + F.tid; e < NBATCH * 4 * 256 * 64; e += F.G * NTHREADS) {
        const int k2 = e & 63, v = (e >> 6) & 255, bh = e >> 14, b = bh >> 2, h = bh & 3;
        float s0 = 0.f, s1 = 0.f;
#pragma unroll 1
        for (int c0 = 0; c0 < NBLK; c0 += 11) {
            f32x2 d[11], ds[11];
#pragma unroll
            for (int q = 0; q < 11; ++q) { const size_t u = ((size_t)b * NBLK + c0 + q) * 4 + h;
                d[q] = *(const GAS f32x2*)(F.dec() + u * 128 + 2 * k2); ds[q] = *(const GAS f32x2*)(F.dST() + u * 32768 + (size_t)v * 128 + 2 * k2); }
#pragma unroll
            for (int q = 0; q < 11; ++q) { const size_t u = ((size_t)b * NBLK + c0 + q) * 4 + h;
                *(GAS unsigned*)(F.St() + u * 32768 + (size_t)v * 128 + 2 * k2) = pk2(s0, s1);
                s0 = d[q].x * s0 + ds[q].x; s1 = d[q].y * s1 + ds[q].y; }
        }
        float* gp = F.out + O_GP + ((size_t)bh * 128 + 2 * k2) * 256 + v; gp[0] = s0; gp[256] = s1;
    }
}

__device__ __forceinline__ void gla_out_unit(Frame& F0, LAS unsigned char* scr, int b, int c, int h) { Frame F = F0; asm volatile("" : "+v"(F.tid), "+v"(F.lane)); gcf const gla_norm = ldarg<A_GNORM>();
    const int u = (b * NBLK + c) * 4 + h;
    const bf16* St = F.St() + (size_t)u * 32768; const size_t R0 = (size_t)b * LP + 128 * c;
    v4u stp[8], gvp[8];
#pragma unroll
    for (int j = 0; j < 8; ++j) { const int cc = F.tid + 512 * j; stp[j] = (c != 0) ? *(const GAS v4u*)(St + (size_t)(cc >> 4) * 128 + 8 * (cc & 15)) : (v4u){0u, 0u, 0u, 0u}; }
#pragma unroll
    for (int j = 0; j < 8; ++j) { const int q = F.lane + 64 * j, row = 16 * F.wave + (q >> 5), ch = q & 31; gvp[j] = *(const GAS v4u*)(F.P() + (R0 + row) * NPAD + C_GG + h * 256 + 8 * ch); }
    gla_gate<true>(F, scr, b, c, h);
    const LAS unsigned short* GQ = (const LAS unsigned short*)(scr + G_Q); LAS unsigned short* GK = (LAS unsigned short*)(scr + G_K); const LAS unsigned short* GV = (const LAS unsigned short*)(scr + G_V);
    int lane = F.lane; asm volatile("" : "+v"(lane));
    const int gq = lane >> 4, i = lane & 15, w = F.wave;
    const bool active = true;
    bf16x8 qa[4];
#pragma unroll
    for (int ks = 0; ks < 4; ++ks) qa[ks] = *(const LAS bf16x8*)(GQ + (16 * w + i) * GQP + 32 * ks + 8 * gq);
    f32x4 aa[8];
#pragma unroll
    for (int sb = 0; sb < 8; ++sb) { aa[sb] = (f32x4){0.f, 0.f, 0.f, 0.f};
        if (active && sb <= w) {
#pragma unroll
            for (int ks = 0; ks < 4; ++ks) { const bf16x8 kb = *(const LAS bf16x8*)(GK + (16 * sb + i) * GQP + 32 * ks + 8 * gq); aa[sb] = MFMA16(qa[ks], kb, aa[sb]); } } }
    __syncthreads();
    f32x4 acc[16];
#pragma unroll
    for (int cb = 0; cb < 16; ++cb) acc[cb] = (f32x4){0.f, 0.f, 0.f, 0.f};
    if (active) {
#pragma unroll
    for (int sb = 0; sb < 8; ++sb)
#pragma unroll
        for (int r = 0; r < 4; ++r) { const int t = 16 * w + 4 * gq + r, s = 16 * sb + i; GK[t * GQP + s] = f2bf16(s <= t ? aa[sb][r] : 0.f); }
    LDS_WAIT(); asm volatile("" ::: "memory");
#pragma unroll
    for (int ks = 0; ks < 4; ++ks) {
        if (2 * ks <= w) {
            const bf16x8 af = *(const LAS bf16x8*)(GK + (16 * w + i) * GQP + 32 * ks + 8 * gq);
#pragma unroll
            for (int cb = 0; cb < 16; ++cb) { const bf16x8 vb = tr_frag(GV, 32 * ks + 8 * gq, 16 * cb, GVP, lane); acc[cb] = MFMA16(af, vb, acc[cb]); } } }
    }
    __syncthreads();
    { LAS unsigned char* GS = scr + G_V;
#pragma unroll
      for (int j = 0; j < 8; ++j) { const int cc = F.tid + 512 * j, v = cc >> 4, ch = cc & 15; *(LAS v4u*)(GS + v * 256 + ((ch ^ (v & 15)) << 4)) = stp[j]; } }
    __syncthreads();
    if (active) {
    if (c != 0) {
        const LAS unsigned char* GS = scr + G_V;
#pragma unroll
    for (int ks = 0; ks < 4; ++ks)
#pragma unroll
        for (int cb = 0; cb < 16; ++cb) { const bf16x8 sb = *(const LAS bf16x8*)(GS + (16 * cb + i) * 256 + (((4 * ks + gq) ^ i) << 4)); acc[cb] = MFMA16(qa[ks], sb, acc[cb]); }
    }
    LDS_WAIT(); asm volatile("" ::: "memory");
    { LAS unsigned short* GQw = (LAS unsigned short*)(scr + G_Q);
#pragma unroll
    for (int r = 0; r < 4; ++r) { float ss = 0.f;
#pragma unroll
        for (int cb = 0; cb < 16; ++cb) ss += acc[cb][r] * acc[cb][r];
        ss += __shfl_xor(ss, 1); ss += __shfl_xor(ss, 2); ss += __shfl_xor(ss, 4); ss += __shfl_xor(ss, 8);
        const float rstd = rsqrtf(ss * (1.f / 256.f) + EPSN); const int row = 16 * w + 4 * gq + r;
#pragma unroll
        for (int cb = 0; cb < 8; ++cb) { GQw[row * GQP + 16 * cb + i] = f2bf16(acc[cb][r] * rstd); GK[row * GQP + 16 * cb + i] = f2bf16(acc[cb + 8][r] * rstd); } }
    LDS_WAIT(); asm volatile("" ::: "memory");
#pragma unroll
    for (int j = 0; j < 8; ++j) { const int q = lane + 64 * j, row = 16 * w + (q >> 5), ch = q & 31;
        const v4u ov = *(const LAS v4u*)((ch < 16 ? GQw : GK) + row * GQP + 8 * (ch & 15));
        const v4u gv = gvp[j];
        const f32x4 n0 = *(const GAS f32x4*)(gla_norm + 8 * ch), n1 = *(const GAS f32x4*)(gla_norm + 8 * ch + 4);
        v4u res;
        res.x = pk2(bf2f(ov.x & 0xffff) * n0.x * silu_f(bf2f(gv.x & 0xffff)), bf2f(ov.x >> 16) * n0.y * silu_f(bf2f(gv.x >> 16)));
        res.y = pk2(bf2f(ov.y & 0xffff) * n0.z * silu_f(bf2f(gv.y & 0xffff)), bf2f(ov.y >> 16) * n0.w * silu_f(bf2f(gv.y >> 16)));
        res.z = pk2(bf2f(ov.z & 0xffff) * n1.x * silu_f(bf2f(gv.z & 0xffff)), bf2f(ov.z >> 16) * n1.y * silu_f(bf2f(gv.z >> 16)));
        res.w = pk2(bf2f(ov.w & 0xffff) * n1.z * silu_f(bf2f(gv.w & 0xffff)), bf2f(ov.w >> 16) * n1.w * silu_f(bf2f(gv.w >> 16)));
        *(GAS v4u*)(F.MIX() + (R0 + row) * DM + 1024 + h * 256 + 8 * ch) = res; } }
    }
}

constexpr int S_Q = 0, S_KH = 4096, S_KT = 8192, S_LG = 12288, S_D = 16384, S_A = 16896, S_Z = 17152, S_OP = 17664, S_END = S_OP + 65536;
static_assert(S_END <= LDS_BYTES - SCR_OFF, "sample GLA LDS");
__device__ __forceinline__ void gla_sample_unit(Frame& F0, LAS unsigned char* scr, int u) { Frame F = F0; asm volatile("" : "+v"(F.tid), "+v"(F.lane));
    gcf const w_a2 = ldarg<A_WA2>(); gcf const b_a = ldarg<A_BA>(); gcf const state = ldarg<A_STATE>(); gcf const gla_norm = ldarg<A_GNORM>();
    const int h = u & 3, db = u >> 2;
    LAS float* SQ = (LAS float*)(scr + S_Q); LAS float* SKH = (LAS float*)(scr + S_KH); LAS float* SKT = (LAS float*)(scr + S_KT); LAS float* SLG = (LAS float*)(scr + S_LG); LAS float* SD = (LAS float*)(scr + S_D);
    LAS float* SA = (LAS float*)(scr + S_A); LAS float* SZ = (LAS float*)(scr + S_Z); LAS float* SOP = (LAS float*)(scr + S_OP);
    const size_t R0 = (size_t)ROWS_P + (size_t)db * DSEQ;
    const int w = F.wave, lane = F.lane;
    f32x4 st[16];
    { const GAS f32x4* sp = (const GAS f32x4*)(state + ((size_t)u * 128 + 16 * w) * 256) + lane;
#pragma unroll
      for (int kk = 0; kk < 16; ++kk) st[kk] = sp[64 * kk]; }
    __syncthreads();
    if (F.tid < 128) SZ[F.tid] = bf2f(F.P()[(R0 + (F.tid >> 4)) * NPAD + C_ZG + (F.tid & 15)]);
    const int k = F.tid & 127, tp = F.tid >> 7;
    float qv[2], kv[2], wv[16];
#pragma unroll
    for (int q = 0; q < 2; ++q) { const bf16* p = F.P() + (R0 + 2 * tp + q) * NPAD + h * 128 + k; qv[q] = bf2f(p[C_QG]); kv[q] = bf2f(p[C_KG]); }
#pragma unroll
    for (int r = 0; r < 16; ++r) wv[r] = w_a2[r * 512 + h * 128 + k];
    const float ba = b_a[h * 128 + k];
    __syncthreads();
#pragma unroll
    for (int q = 0; q < 2; ++q) { const int t = 2 * tp + q; float x = ba;
#pragma unroll
        for (int r = 0; r < 16; ++r) x += SZ[t * 16 + r] * wv[r];
        SLG[t * 128 + k] = logsig_f(x) * (1.f / 16.f); }
    __syncthreads();
    { float run = 0.f, bt[2] = {0.f, 0.f};
#pragma unroll
      for (int t = 0; t < 8; ++t) { run += SLG[t * 128 + k]; if (t == 2 * tp) bt[0] = run; if (t == 2 * tp + 1) bt[1] = run; }
#pragma unroll
      for (int q = 0; q < 2; ++q) { const int t = 2 * tp + q;
          SQ[k * 8 + t] = qv[q] * __expf(bt[q]) * 0.08838834764831845f; SKT[k * 8 + t] = kv[q] * __expf(-bt[q]); SKH[k * 8 + t] = kv[q] * __expf(run - bt[q]); }
      if (tp == 0) SD[k] = __expf(run); }
    __syncthreads();
    if (F.tid < 64) { const int t = F.tid >> 3, s2 = F.tid & 7; float a = 0.f;
        if (s2 <= t) { for (int kk = 0; kk < 128; ++kk) a += SQ[kk * 8 + t] * SKT[kk * 8 + s2]; }
        SA[t * 8 + s2] = a; }
    {   f32x4 vv[8], op[8];
#pragma unroll
        for (int t = 0; t < 8; ++t) { const unsigned long long pv = *(const GAS unsigned long long*)(F.P() + (R0 + t) * NPAD + C_VG + h * 256 + 4 * lane);
            vv[t] = (f32x4){bf2f((unsigned short)pv), bf2f((unsigned short)(pv >> 16)), bf2f((unsigned short)(pv >> 32)), bf2f((unsigned short)(pv >> 48))}; op[t] = (f32x4){0.f, 0.f, 0.f, 0.f}; }
        GAS f32x4* np = (GAS f32x4*)(F.out + O_GS + ((size_t)u * 128 + 16 * w) * 256) + lane;
#pragma unroll
        for (int kk = 0; kk < 16; ++kk) { const int kc = 16 * w + kk; const f32x4 s0 = st[kk];
            const f32x4 q0 = *(const LAS f32x4*)(SQ + kc * 8), q1 = *(const LAS f32x4*)(SQ + kc * 8 + 4), h0 = *(const LAS f32x4*)(SKH + kc * 8), h1 = *(const LAS f32x4*)(SKH + kc * 8 + 4);
            f32x4 sn = s0 * SD[kc];
            sn += vv[0] * h0.x + vv[1] * h0.y + vv[2] * h0.z + vv[3] * h0.w + vv[4] * h1.x + vv[5] * h1.y + vv[6] * h1.z + vv[7] * h1.w;
            np[64 * kk] = sn;
            op[0] += s0 * q0.x; op[1] += s0 * q0.y; op[2] += s0 * q0.z; op[3] += s0 * q0.w; op[4] += s0 * q1.x; op[5] += s0 * q1.y; op[6] += s0 * q1.z; op[7] += s0 * q1.w; }
#pragma unroll
        for (int t = 0; t < 8; ++t) *(LAS f32x4*)(SOP + (w * 8 + t) * 256 + 4 * lane) = op[t];
    }
    __syncthreads();
    {   const int t = w; f32x4 a = (f32x4){0.f, 0.f, 0.f, 0.f};
#pragma unroll
        for (int w2 = 0; w2 < 8; ++w2) a += *(const LAS f32x4*)(SOP + (w2 * 8 + t) * 256 + 4 * lane);
        for (int s2 = 0; s2 <= t; ++s2) { const unsigned long long pv = *(const GAS unsigned long long*)(F.P() + (R0 + s2) * NPAD + C_VG + h * 256 + 4 * lane); const float c = SA[t * 8 + s2];
            a += (f32x4){bf2f((unsigned short)pv), bf2f((unsigned short)(pv >> 16)), bf2f((unsigned short)(pv >> 32)), bf2f((unsigned short)(pv >> 48))} * c; }
        const float ss = (a.x * a.x + a.y * a.y) + (a.z * a.z + a.w * a.w);
        const float rstd = rsqrtf(wave_sum(ss) * (1.f / 256.f) + EPSN);
        const unsigned long long gv = *(const GAS unsigned long long*)(F.P() + (R0 + t) * NPAD + C_GG + h * 256 + 4 * lane); const f32x4 gn = *(const GAS f32x4*)(gla_norm + 4 * lane);
        const float g0 = bf2f((unsigned short)gv), g1 = bf2f((unsigned short)(gv >> 16)), g2 = bf2f((unsigned short)(gv >> 32)), g3 = bf2f((unsigned short)(gv >> 48));
        *(GAS unsigned long long*)(F.MIX() + (R0 + t) * DM + 1024 + h * 256 + 4 * lane) =
            (unsigned long long)pk2(a.x * rstd * gn.x * silu_f(g0), a.y * rstd * gn.y * silu_f(g1)) | ((unsigned long long)pk2(a.z * rstd * gn.z * silu_f(g2), a.w * rstd * gn.w * silu_f(g3)) << 32);
    }
}

__device__ __forceinline__ void final_rows(Frame& F) { gcf const x_prompt = ldarg<A_XP>(); gcf const x_sample = ldarg<A_XS>(); gcf const norm_post = ldarg<A_NPOST>();
    const int gw = blockIdx.x * NWAVES + F.wave, NGW = F.G * NWAVES; constexpr int NR = NBATCH * SEQ + ROWS_S;
    for (int idx0 = gw; idx0 < NR; idx0 += 2 * NGW) {
        f32x4 v[2][8], xx[2][8]; float* yp[2]; bool on[2];
#pragma unroll
        for (int q = 0; q < 2; ++q) { const int idx = idx0 + q * NGW; on[q] = idx < NR; const int id2 = on[q] ? idx : idx0;
            size_t grow; gcf x;
            if (id2 < NBATCH * SEQ) { const int b = id2 / SEQ, s2 = id2 - b * SEQ; grow = (size_t)b * LP + 128 + s2; x = x_prompt + (size_t)id2 * DM; yp[q] = F.out + O_YP + (size_t)id2 * DM; }
            else { const int j = id2 - NBATCH * SEQ; grow = (size_t)ROWS_P + j; x = x_sample + (size_t)j * DM; yp[q] = F.out + O_YS + (size_t)j * DM; }
            const GAS f32x4* o4 = (const GAS f32x4*)yp[q] + F.lane;   const GAS f32x4* x4 = (const GAS f32x4*)x + F.lane;
#pragma unroll
            for (int j = 0; j < 8; ++j) { v[q][j] = o4[64 * j]; xx[q][j] = x4[64 * j]; } }
#pragma unroll
        for (int q = 0; q < 2; ++q) { float s2 = 0.f;
#pragma unroll
            for (int j = 0; j < 8; ++j) s2 += (v[q][j].x * v[q][j].x + v[q][j].y * v[q][j].y) + (v[q][j].z * v[q][j].z + v[q][j].w * v[q][j].w);
            const float rstd = rsqrtf(wave_sum(s2) * (1.f / DM) + EPSN);
            if (on[q]) { GAS f32x4* y4 = (GAS f32x4*)yp[q] + F.lane;
#pragma unroll
                for (int j = 0; j < 8; ++j) { const f32x4 w = ((const GAS f32x4*)norm_post)[F.lane + 64 * j]; y4[64 * j] = xx[q][j] + v[q][j] * rstd * w; } } }
    }
}

#ifndef MK_PER_PHASE
#define MK_PER_PHASE 0
#endif
constexpr int N_PHASES = 7;
struct Args { const float* in[15]; float* out; unsigned char* ws; int ph_lo, ph_hi; };
__global__ void __launch_bounds__(NTHREADS, 2) hymba_fwd(Args args) {
    extern __shared__ __attribute__((aligned(16))) unsigned char lds_raw[];
    Frame F;
    F.lds = (LAS unsigned char*)lds_raw;
    F.tid = threadIdx.x; F.lane = F.tid & 63; F.wave = __builtin_amdgcn_readfirstlane(F.tid >> 6); F.G = gridDim.x;
    F.out = args.out; F.ws = args.ws;
    unsigned char* ws = args.ws;
    for (int u = F.tid; u < LDS_CTL_BYTES / 4; u += NTHREADS) ((LAS unsigned*)F.lds)[u] = 0u;
    __syncthreads();
    volatile LAS unsigned* MISC = (volatile LAS unsigned*)(F.lds + 512);
    XcdBarrier bar; bar.bar = (unsigned*)(ws + WS_CTL) + CW_BAR; bar.x = 0; bar.st = nullptr;
    if (!MK_PER_PHASE) bar = xcd_barrier_post((unsigned*)(ws + WS_CTL) + CW_BAR, MISC + 8);
    LAS unsigned char* scr = F.lds + SCR_OFF;
    const int lo = args.ph_lo, hi = args.ph_hi;
#define IN(k) (lo <= (k) && (k) < hi)
#define SEAM(k) do { if (IN(k) && IN((k) + 1)) xcd_barrier(bar); } while (0)

#ifndef PROBE_PHASE
#define PROBE_PHASE -1
#endif
#ifndef PROBE_REP
#define PROBE_REP 1
#endif
#define REPS(k) for (int rep_ = 0; rep_ < ((k) == PROBE_PHASE ? PROBE_REP : 1); ++rep_)
    REPS(0) if (IN(0)) { p0_prologue(F); if (PROBE_PHASE == 0) xcd_barrier(bar); }
    SEAM(0);
    REPS(1) if (IN(1)) {
        pg8::Gemm g{F.XN(), F.WinT(), MROWS, NPAD, DM}; pg8::StaticOrder S; S.init(MROWS, NPAD, F.G, (int)blockIdx.x);
        pg8::EpiBf16<0> E{F.P(), NPAD, nullptr, 0, 0, 1.f};
        pg8::gemm_phase<pg8::EpiBf16<0>, pg8::StaticOrder, true, true>(scr, g, S, E);
        if (PROBE_PHASE == 1) xcd_barrier(bar);
    }
    SEAM(1);
    REPS(2) if (IN(2)) {
#define UNIT_BCH(idx, b_, c_, h_) const int b_ = (idx) < 256 ? (idx) >> 7 : ((idx) - 256) >> 2, c_ = (idx) < 256 ? 1 + (((idx) >> 2) & 31) : 0, h_ = (idx) & 3
        REPS(20) for (int u = blockIdx.x; u < NBATCH * NBLK * 4; u += F.G) { UNIT_BCH(u, b_, c_, h_); attn_prompt_unit(F, scr, b_, c_, h_); }
        REPS(21) for (int u = blockIdx.x; u < NBATCH * NBLK * 4; u += F.G) { UNIT_BCH(u, b_, c_, h_); gla_ds_unit(F, scr, b_, c_, h_); }
        if (F.G == 256) {
            if (blockIdx.x < 8) { UNIT_BCH(256 + (int)blockIdx.x, b_, c_, h_); gla_out_unit(F, scr, b_, c_, h_); }
            else { const int v = (int)blockIdx.x - 8;
                attn_sample_pair(F, scr, v, 248 + v); if (v < 16) attn_sample_unit(F, scr, 496 + v);
                gla_sample_unit(F, scr, v); gla_sample_unit(F, scr, 248 + v); if (v >= 16 && v < 32) gla_sample_unit(F, scr, 496 + v - 16); }
        } else {
            for (int u = 256 + blockIdx.x; u < NBATCH * NBLK * 4; u += F.G) { UNIT_BCH(u, b_, c_, h_); gla_out_unit(F, scr, b_, c_, h_); }
            REPS(22) for (int u = blockIdx.x; u < DBATCH * 4; u += F.G) attn_sample_unit(F, scr, u);
            REPS(23) for (int u = blockIdx.x; u < DBATCH * 4; u += F.G) gla_sample_unit(F, scr, u);
        }
        if (PROBE_PHASE == 2) xcd_barrier(bar);
    }
    SEAM(2);
    REPS(3) if (IN(3)) { gla_scan(F); if (PROBE_PHASE == 3) xcd_barrier(bar); }
    SEAM(3);
    REPS(4) if (IN(4)) {
        for (int u = blockIdx.x; u < 256; u += F.G) { UNIT_BCH(u, b_, c_, h_); gla_out_unit(F, scr, b_, c_, h_); }
        __syncthreads();
        if (PROBE_PHASE == 4) xcd_barrier(bar);
    }
    SEAM(4);
    REPS(5) if (IN(5)) {
        pg8::Gemm g{F.MIX(), F.WoutT(), MROWS, DM, DM}; pg8::StaticOrder S; S.init(MROWS, DM, F.G, (int)blockIdx.x);
        pg8::EpiY E{F.out + O_YP, F.out + O_YS, LP, SEQ, ROWS_P};
        pg8::gemm_phase<pg8::EpiY, pg8::StaticOrder, true, true>(scr, g, S, E);
        if (PROBE_PHASE == 5) xcd_barrier(bar);
    }
    SEAM(5);
    REPS(6) if (IN(6)) { final_rows(F); if (PROBE_PHASE == 6) xcd_barrier(bar); }
#undef IN
#undef SEAM
}

extern "C" void kernel_launch(void* const* d_in, const int* in_sizes, int n_in, void* d_out, int out_size, void* d_ws, size_t ws_size, hipStream_t stream) {
    static int grid = 0;
    if (grid == 0) {
        if (n_in != 15 || out_size != (int)O_END || ws_size < WS_END) { fprintf(stderr, "kernel_launch: unexpected problem: n_in %d out %d ws %zu\n", n_in, out_size, ws_size); grid = -1; return; }
        int dev = 0, cus = 0, per_cu = 0;
        if (hipGetDevice(&dev) != hipSuccess || hipDeviceGetAttribute(&cus, hipDeviceAttributeMultiprocessorCount, dev) != hipSuccess) { grid = -1; return; }
        if (hipFuncSetAttribute((const void*)hymba_fwd, hipFuncAttributeMaxDynamicSharedMemorySize, LDS_BYTES) != hipSuccess) { fprintf(stderr, "kernel_launch: hipFuncSetAttribute failed\n"); grid = -1; return; }
        if (hipOccupancyMaxActiveBlocksPerMultiprocessor(&per_cu, (const void*)hymba_fwd, NTHREADS, LDS_BYTES) != hipSuccess || per_cu < 1) fprintf(stderr, "kernel_launch: note: occupancy query reports %d\n", per_cu);
        (void)hipGetLastError();
        grid = cus;
    }
    if (grid < 0) return;
    (void)hipMemsetAsync((char*)d_ws + WS_CTL, 0, CTL_ZERO_BYTES, stream);
    Args a{};
    for (int i = 0; i < 15; ++i) a.in[i] = (const float*)d_in[i];
    a.out = (float*)d_out; a.ws = (unsigned char*)d_ws;
#if MK_PER_PHASE
    for (int p = 0; p < N_PHASES; ++p) { a.ph_lo = p; a.ph_hi = p + 1; hipLaunchKernelGGL(hymba_fwd, dim3(grid), dim3(NTHREADS), LDS_BYTES, stream, a); }
#else
    a.ph_lo = 0; a.ph_hi = N_PHASES;
    hipLaunchKernelGGL(hymba_fwd, dim3(grid), dim3(NTHREADS), LDS_BYTES, stream, a);
#endif
}
```

```cpp
#include <hip/hip_runtime.h>
#include <cstdio>
#include <cstdint>
#include <cmath>
namespace pg8 {
#define PG8_LAS __attribute__((address_space(3)))
typedef unsigned short bf16_t;
typedef short bf16x8 __attribute__((ext_vector_type(8)));
typedef float f32x4 __attribute__((ext_vector_type(4)));
typedef unsigned u32x4 __attribute__((ext_vector_type(4)));
constexpr int BM = 256, BK = 64, HALF = 128, HTB = HALF * BK * 2  , STAGE_BYTES = 8 * HTB, NXCD = 8, WGM = 8;

__host__ __device__ __forceinline__ int lds_byte(int r, int c) { const int st = (r >> 4) * 2 + (c >> 5), rr = r & 15, cc = c & 31, ob = rr * 64 + cc * 2; return st * 1024 + (ob ^ (((ob >> 9) & 1) << 5)); }
__host__ __device__ __forceinline__ void stage_rc(int b, int& R, int& C) { const int st = b / 1024, sb = b % 1024, swz = sb ^ (((sb >> 9) & 1) << 5); R = (st >> 1) * 16 + swz / 64; C = (st & 1) * 32 + (swz % 64) / 2; }
__host__ __device__ __forceinline__ int perm32(int rho) { const int n = rho >> 4, i = rho & 15; return 8 * (i >> 2) + 4 * n + (i & 3); }

struct Unit { int pm, pn; };
struct Gemm { const bf16_t* A; const bf16_t* Bt; int M, N, K; };

struct StaticOrder {
    int nM, nN, nwg, G, c;
    __host__ __device__ void init(int M, int N, int G_, int c_) { nM = M / BM; nN = N / BM; nwg = nM * nN; G = G_; c = c_; }
    __host__ __device__ bool next(int i, Unit& u) const {
        const long L = (long)i * G + c; if (L >= nwg) return false;
        int wgid = (int)L; { const int q = nwg / NXCD, r = nwg % NXCD, xcd = wgid % NXCD, off = wgid / NXCD; wgid = (xcd < r ? xcd * (q + 1) : r * (q + 1) + (xcd - r) * q) + off; }
        const int nig = WGM * nN, gid = wgid / nig, fm = gid * WGM, gsz = (nM - fm) < WGM ? (nM - fm) : WGM;
        u.pm = fm + ((wgid % nig) % gsz); u.pn = (wgid % nig) / gsz; return true;
    }
    __device__ __forceinline__ void a_ready(const Unit&) const {}
    __device__ __forceinline__ void done(const Unit&) const {}
};

struct OrderPF {
    int nMp, nMs, nN, G, c, r0, r1;
    __device__ bool next(int i, Unit& u) const {
        const int ii = r0 + i; if (ii >= r1) return false;
        const int nP = nMp * nN, nT = (nMp + nMs) * nN; const int e = ii * G + c; if (e >= nT) return false;
        if (e < nP) { int wgid = e; { const int q = nP / NXCD, r = nP % NXCD, xcd = wgid % NXCD, off = wgid / NXCD; wgid = (xcd < r ? xcd * (q + 1) : r * (q + 1) + (xcd - r) * q) + off; }
            const int nig = WGM * nN, gid = wgid / nig, fm = gid * WGM, gsz = (nMp - fm) < WGM ? (nMp - fm) : WGM; u.pm = fm + ((wgid % nig) % gsz); u.pn = (wgid % nig) / gsz; }
        else { const int q = e - nP; u.pm = nMp + q % nMs; u.pn = q / nMs; }
        return true;
    }
    __device__ __forceinline__ void a_ready(const Unit&) const {}
    __device__ __forceinline__ void done(const Unit&) const {}
};

__device__ __forceinline__ unsigned cvt_pk_bf16(float lo, float hi) { unsigned r; asm volatile("v_cvt_pk_bf16_f32 %0, %1, %2" : "=v"(r) : "v"(lo), "v"(hi)); return r; }
typedef float f32x2 __attribute__((ext_vector_type(2)));
__device__ __forceinline__ f32x2 gelu_pk(f32x2 v) {
    const f32x2 av = __builtin_elementwise_abs(v), d = av * 0.2316418882f + 1.0f;
    f32x2 t; t.x = __builtin_amdgcn_rcpf(d.x); t.y = __builtin_amdgcn_rcpf(d.y);
    f32x2 q = t * 0.5307027145f + (-0.7265760135f); q = q * t + 0.7107068705f; q = q * t + (-0.142248368f); q = q * t + 0.127414796f; q = q * t;
    const f32x2 s = (v * v) * (-0.72134752044f);
    f32x2 e; e.x = __builtin_amdgcn_exp2f(s.x); e.y = __builtin_amdgcn_exp2f(s.y);
    const f32x2 m = v * (q * e), r = v - m;
    f32x2 o; o.x = v.x < 0.f ? m.x : r.x; o.y = v.y < 0.f ? m.y : r.y; return o;
}

template <int ACT  > struct EpiBf16 {
    static constexpr bool PERM = true, AFTER_DRAIN = false; static_assert(ACT == 0 || ACT == 1, "EpiBf16: ACT is 0 (none) or 1 (gelu_pk)");
    bf16_t* O; int ldc; const float* bias; int split_cols; size_t split_stride; float scale0;
    __device__ __forceinline__ void operator()(const f32x4 (&acc)[2][2][4][2], const Unit& u, int wr, int wc, int fr, int fq) const {
        const int row0 = u.pm * BM + wr * 64 + fr; int colt = u.pn * BM; bf16_t* base = O;
        float sc = 1.f; if (split_cols) { const int t = colt / split_cols; base += (size_t)t * split_stride; colt -= t * split_cols; if (t == 0) sc = scale0; }
        const int col0 = colt + wc * 32 + 8 * fq, bcol0 = u.pn * BM + wc * 32 + 8 * fq;
        f32x4 bv[2][2];
#pragma unroll
        for (int bj = 0; bj < 2; ++bj)
#pragma unroll
            for (int n = 0; n < 2; ++n) bv[bj][n] = bias ? *(const f32x4*)(bias + bcol0 + bj * HALF + 4 * n) : (f32x4){0.f, 0.f, 0.f, 0.f};
#pragma unroll
        for (int ai = 0; ai < 2; ++ai)
#pragma unroll
            for (int m = 0; m < 4; ++m) { bf16_t* rowp = base + (size_t)(row0 + ai * HALF + m * 16) * ldc + col0;
#pragma unroll
                for (int bj = 0; bj < 2; ++bj) { f32x4 v0 = acc[ai][bj][m][0] + bv[bj][0], v1 = acc[ai][bj][m][1] + bv[bj][1];
                    if (ACT == 1) { f32x2 a = gelu_pk((f32x2){v0[0], v0[1]}), b = gelu_pk((f32x2){v0[2], v0[3]}), c = gelu_pk((f32x2){v1[0], v1[1]}), d = gelu_pk((f32x2){v1[2], v1[3]});
                        v0 = (f32x4){a.x, a.y, b.x, b.y}; v1 = (f32x4){c.x, c.y, d.x, d.y}; }
                    v0 = v0 * sc; v1 = v1 * sc; u32x4 w; w.x = cvt_pk_bf16(v0[0], v0[1]); w.y = cvt_pk_bf16(v0[2], v0[3]); w.z = cvt_pk_bf16(v1[0], v1[1]); w.w = cvt_pk_bf16(v1[2], v1[3]);
                    *(u32x4*)(rowp + bj * HALF) = w; } }
    }
};

struct EpiF32 {
    static constexpr bool PERM = false, AFTER_DRAIN = false;
    float* O; int ldc;
    __device__ __forceinline__ void operator()(const f32x4 (&acc)[2][2][4][2], const Unit& u, int wr, int wc, int fr, int fq) const {
        const int row0 = u.pm * BM + wr * 64 + fr, col0 = u.pn * BM + wc * 32 + 4 * fq;
#pragma unroll
        for (int ai = 0; ai < 2; ++ai)
#pragma unroll
            for (int m = 0; m < 4; ++m) { float* rowp = O + (size_t)(row0 + ai * HALF + m * 16) * ldc + col0;
#pragma unroll
                for (int bj = 0; bj < 2; ++bj)
#pragma unroll
                    for (int n = 0; n < 2; ++n) *(f32x4*)(rowp + bj * HALF + n * 16) = acc[ai][bj][m][n]; }
    }
};
struct EpiY {
    static constexpr bool PERM = false, AFTER_DRAIN = false;
    float* yp; float* ys; int lp, seq, rows_p;
    __device__ __forceinline__ void operator()(const f32x4 (&acc)[2][2][4][2], const Unit& u, int wr, int wc, int fr, int fq) const {
        const int row0 = u.pm * BM + wr * 64 + fr, col0 = u.pn * BM + wc * 32 + 4 * fq;
#pragma unroll
        for (int ai = 0; ai < 2; ++ai)
#pragma unroll
            for (int m = 0; m < 4; ++m) { const int row = row0 + ai * HALF + m * 16; float* rowp;
                if (row < rows_p) { const int b = row / lp, i = row - b * lp; if (i < 128) continue; rowp = yp + ((size_t)b * seq + (i - 128)) * 2048 + col0; }
                else rowp = ys + (size_t)(row - rows_p) * 2048 + col0;
#pragma unroll
                for (int bj = 0; bj < 2; ++bj)
#pragma unroll
                    for (int n = 0; n < 2; ++n) *(f32x4*)(rowp + bj * HALF + n * 16) = acc[ai][bj][m][n]; }
    }
};
template <class Epi, class Sched, bool ALIGN_EPI = false, bool SP2 = false>
__device__ __forceinline__ void gemm_phase(PG8_LAS unsigned char* lds, const Gemm g, const Sched& S, const Epi& E) {
    const int tid = threadIdx.x, wid = __builtin_amdgcn_readfirstlane(tid >> 6), lane = tid & 63, wr = wid >> 2, wc = wid & 3, fr = lane & 15, fq = lane >> 4;
    const int K = g.K, nt = K / BK;
    unsigned voffA[2], voffB[2];
#pragma unroll
    for (int i = 0; i < 2; ++i) { int R, C; stage_rc(tid * 16 + i * 8192, R, C); const int Rb = Epi::PERM ? ((R & ~31) + perm32(R & 31)) : R;
        voffA[i] = (unsigned)(R * K + C) * 2u; voffB[i] = (unsigned)(Rb * K + C) * 2u; }
    const size_t kstep = (size_t)(BK * 2);
    const size_t hstep = (size_t)HALF * K * 2;
    const size_t tstep = 2 * hstep;
    const unsigned ldsw = (unsigned)wid * 1024u;
    const int aoff = lds_byte(wr * 64 + fr, fq * 8), boff = lds_byte(wc * 32 + fr, fq * 8);
#define PG8_SA(b, h) (((b) * 2 + (h)) * HTB)
#define PG8_SB(b, h) ((4 + (b) * 2 + (h)) * HTB)
#define PG8_STAGE(bufoff, gbase, voff) do { _Pragma("unroll") for (int _i = 0; _i < 2; ++_i) \
        __builtin_amdgcn_global_load_lds((const unsigned*)((const char*)(gbase) + (voff)[_i]), (PG8_LAS unsigned*)(lds + (bufoff) + ldsw + _i * 8192), 16, 0, 0); } while (0)
#define PG8_LDA(dst, b, h) do { _Pragma("unroll") for (int m = 0; m < 4; ++m) _Pragma("unroll") for (int k = 0; k < 2; ++k) dst[m][k] = *(const PG8_LAS bf16x8*)(lds + PG8_SA(b, h) + aoff + m * 2048 + k * 1024); } while (0)
#define PG8_LDB(dst, b, h) do { _Pragma("unroll") for (int n = 0; n < 2; ++n) _Pragma("unroll") for (int k = 0; k < 2; ++k) dst[n][k] = *(const PG8_LAS bf16x8*)(lds + PG8_SB(b, h) + boff + n * 2048 + k * 1024); } while (0)
#define PG8_MMA(ai, bj, At, Bt) do { __builtin_amdgcn_s_setprio(1); _Pragma("unroll") for (int m = 0; m < 4; ++m) _Pragma("unroll") for (int n = 0; n < 2; ++n) _Pragma("unroll") for (int k = 0; k < 2; ++k) \
        acc[ai][bj][m][n] = __builtin_amdgcn_mfma_f32_16x16x32_bf16(Bt[n][k], At[m][k], acc[ai][bj][m][n], 0, 0, 0); __builtin_amdgcn_s_setprio(0); } while (0)
#define PG8_WAIT_V(n) asm volatile("s_waitcnt vmcnt(" #n ")" ::: "memory")
#define PG8_WAIT_L(n) asm volatile("s_waitcnt lgkmcnt(" #n ")" ::: "memory")
#define PG8_BAR __builtin_amdgcn_s_barrier()
#define PG8_SCHED __builtin_amdgcn_sched_barrier(0)
    Unit cur, nxt; int ui = 0;
    if (!S.next(0, cur)) return;
    f32x4 acc[2][2][4][2];
#pragma unroll
    for (int a = 0; a < 2; ++a)
#pragma unroll
        for (int b = 0; b < 2; ++b)
#pragma unroll
            for (int m = 0; m < 4; ++m)
#pragma unroll
                for (int n = 0; n < 2; ++n) acc[a][b][m][n] = (f32x4){0.f, 0.f, 0.f, 0.f};
    bf16x8 At[4][2], B0[2][2], B1[2][2];
    const char* cA = (const char*)g.A + (size_t)cur.pm * tstep; const char* cB = (const char*)g.Bt + (size_t)cur.pn * tstep;
    S.a_ready(cur);
    if constexpr (SP2) {
        PG8_STAGE(PG8_SB(0, 0), cB, voffB); PG8_STAGE(PG8_SB(0, 1), cB + hstep, voffB); PG8_STAGE(PG8_SA(0, 0), cA, voffA); PG8_STAGE(PG8_SA(0, 1), cA + hstep, voffA);
        if (wr == 1) PG8_BAR;
        PG8_WAIT_V(2); PG8_BAR;
        PG8_STAGE(PG8_SB(1, 0), cB + kstep, voffB); PG8_STAGE(PG8_SA(1, 0), cA + kstep, voffA); PG8_STAGE(PG8_SB(1, 1), cB + hstep + kstep, voffB);
        PG8_WAIT_V(6); PG8_BAR;
    } else {
        PG8_STAGE(PG8_SB(0, 0), cB, voffB); PG8_STAGE(PG8_SA(0, 0), cA, voffA); PG8_STAGE(PG8_SB(0, 1), cB + hstep, voffB); PG8_STAGE(PG8_SA(0, 1), cA + hstep, voffA);
        if (wr == 1) PG8_BAR;
        PG8_WAIT_V(4); PG8_BAR;
        PG8_STAGE(PG8_SB(1, 0), cB + kstep, voffB); PG8_STAGE(PG8_SA(1, 0), cA + kstep, voffA); PG8_STAGE(PG8_SB(1, 1), cB + hstep + kstep, voffB);
        PG8_WAIT_V(6); PG8_BAR;
    }
    for (;;) {
        const bool has_next = S.next(ui + 1, nxt);
        const char* nA = has_next ? (const char*)g.A + (size_t)nxt.pm * tstep : cA; const char* nB = has_next ? (const char*)g.Bt + (size_t)nxt.pn * tstep : cB;
        for (int t = 0; t < nt; t += 2) {
            const bool last = (t == nt - 2);
            const char* a1 = cA + (size_t)(t + 1) * kstep;
            const char* a2 = last ? nA : cA + (size_t)(t + 2) * kstep; const char* b2 = last ? nB : cB + (size_t)(t + 2) * kstep;
            const char* a3 = a2 + kstep; const char* b3 = b2 + kstep;
            if (last && has_next) S.a_ready(nxt);
            if constexpr (SP2) {
            PG8_LDB(B0, 0, 0); PG8_LDB(B1, 0, 1); PG8_SCHED; PG8_LDA(At, 0, 0); PG8_STAGE(PG8_SA(1, 1), a1 + hstep, voffA);
            PG8_WAIT_V(8); PG8_WAIT_L(0); PG8_BAR; PG8_MMA(0, 0, At, B0); PG8_MMA(0, 1, At, B1); PG8_BAR; PG8_SCHED;
            PG8_LDA(At, 0, 1); PG8_STAGE(PG8_SB(0, 0), b2, voffB); PG8_STAGE(PG8_SB(0, 1), b2 + hstep, voffB); PG8_STAGE(PG8_SA(0, 0), a2, voffA);
            PG8_WAIT_V(8); PG8_WAIT_L(0); PG8_BAR; PG8_MMA(1, 0, At, B0); PG8_MMA(1, 1, At, B1); PG8_BAR; PG8_SCHED;
            PG8_LDB(B0, 1, 0); PG8_LDB(B1, 1, 1); PG8_SCHED; PG8_LDA(At, 1, 0); PG8_STAGE(PG8_SA(0, 1), a2 + hstep, voffA);
            PG8_WAIT_V(8); PG8_WAIT_L(0); PG8_BAR; PG8_MMA(0, 0, At, B0); PG8_MMA(0, 1, At, B1); PG8_BAR; PG8_SCHED;
            PG8_LDA(At, 1, 1); PG8_STAGE(PG8_SB(1, 0), b3, voffB); PG8_STAGE(PG8_SB(1, 1), b3 + hstep, voffB); PG8_STAGE(PG8_SA(1, 0), a3, voffA);
            PG8_WAIT_V(8); PG8_WAIT_L(0); PG8_BAR; PG8_MMA(1, 0, At, B0); PG8_MMA(1, 1, At, B1); PG8_BAR; PG8_SCHED;
            } else {
            PG8_LDB(B0, 0, 0); PG8_SCHED; PG8_LDA(At, 0, 0); PG8_STAGE(PG8_SA(1, 1), a1 + hstep, voffA);
            PG8_WAIT_L(8); PG8_BAR; PG8_WAIT_L(0); PG8_MMA(0, 0, At, B0); PG8_BAR; PG8_SCHED;
            PG8_LDB(B1, 0, 1); PG8_STAGE(PG8_SB(0, 0), b2, voffB);
            PG8_BAR; PG8_WAIT_L(0); PG8_MMA(0, 1, At, B1); PG8_BAR;
            PG8_LDA(At, 0, 1); PG8_STAGE(PG8_SA(0, 0), a2, voffA);
            PG8_BAR; PG8_WAIT_L(0); PG8_MMA(1, 0, At, B0); PG8_BAR; PG8_SCHED;
            PG8_STAGE(PG8_SB(0, 1), b2 + hstep, voffB);
            PG8_WAIT_V(6); PG8_BAR; PG8_MMA(1, 1, At, B1); PG8_BAR;
            PG8_LDB(B0, 1, 0); PG8_SCHED; PG8_LDA(At, 1, 0); PG8_STAGE(PG8_SA(0, 1), a2 + hstep, voffA);
            PG8_WAIT_L(8); PG8_BAR; PG8_WAIT_L(0); PG8_MMA(0, 0, At, B0); PG8_BAR; PG8_SCHED;
            PG8_LDB(B1, 1, 1); PG8_STAGE(PG8_SB(1, 0), b3, voffB);
            PG8_BAR; PG8_WAIT_L(0); PG8_MMA(0, 1, At, B1); PG8_BAR;
            PG8_LDA(At, 1, 1); PG8_STAGE(PG8_SA(1, 0), a3, voffA);
            PG8_BAR; PG8_WAIT_L(0); PG8_MMA(1, 0, At, B0); PG8_BAR; PG8_SCHED;
            PG8_STAGE(PG8_SB(1, 1), b3 + hstep, voffB);
            PG8_WAIT_V(6); PG8_BAR; PG8_MMA(1, 1, At, B1); PG8_BAR;
            }
        }
        if constexpr (ALIGN_EPI) { if (wr == 0) PG8_BAR; }
        if constexpr (!Epi::AFTER_DRAIN) { E(acc, cur, wr, wc, fr, fq); S.done(cur); }
        if (!has_next) break;
#pragma unroll
        for (int a = 0; a < 2; ++a)
#pragma unroll
            for (int b = 0; b < 2; ++b)
#pragma unroll
                for (int m = 0; m < 4; ++m)
#pragma unroll
                    for (int n = 0; n < 2; ++n) acc[a][b][m][n] = (f32x4){0.f, 0.f, 0.f, 0.f};
        cur = nxt; cA = nA; cB = nB; ++ui;
        if constexpr (ALIGN_EPI) { if (wr == 1) PG8_BAR; }
    }
    PG8_WAIT_V(0);
    if constexpr (!ALIGN_EPI) { if (wr == 0) PG8_BAR; }
    PG8_BAR;
    if constexpr (Epi::AFTER_DRAIN) { E.fused(acc, cur, wr, wc, fr, fq, lds, wid, lane); S.done(cur); }
#undef PG8_SA
#undef PG8_SB
#undef PG8_STAGE
#undef PG8_LDA
#undef PG8_LDB
#undef PG8_MMA
#undef PG8_WAIT_V
#undef PG8_WAIT_L
#undef PG8_BAR
#undef PG8_SCHED
}
}

#define GAS __attribute__((address_space(1)))
#define LAS __attribute__((address_space(3)))
typedef unsigned short bf16;
typedef unsigned v4u __attribute__((ext_vector_type(4)));
typedef float f32x4 __attribute__((ext_vector_type(4)));
typedef short bf16x8 __attribute__((ext_vector_type(8)));
typedef GAS unsigned gu32;
typedef GAS unsigned long long gu64;
#define RLX_AGENT __ATOMIC_RELAXED, __HIP_MEMORY_SCOPE_AGENT
#define LDS_WAIT() asm volatile("s_waitcnt lgkmcnt(0)" ::: "memory")
#define VM_WAIT() asm volatile("s_waitcnt vmcnt(0)" ::: "memory")
__device__ __forceinline__ unsigned long long rt() { return __builtin_amdgcn_s_memrealtime(); }
__device__ __forceinline__ unsigned f2bf(float f) { unsigned u = __builtin_bit_cast(unsigned, f); return (u + 0x7fffu + ((u >> 16) & 1u)) >> 16; }
__device__ __forceinline__ unsigned pk2(float lo, float hi) { return f2bf(lo) | (f2bf(hi) << 16); }
#define XB_TMO      128
#define XB_XCNT(j)  (256  + 64 * (j))
#define XB_XSUB(j)  (1280 + 64 * (j))
#define XB_XGEN(j)  (2304 + 64 * (j))
#define XB_TOP      3328
#define XB_TOPGEN   3392
#define XCD_BAR_WORDS 3456
#define XB_SPIN_CAP (1u << 18)

__device__ __forceinline__ unsigned xb_ld(unsigned* p)              { return __hip_atomic_load(p, __ATOMIC_RELAXED, __HIP_MEMORY_SCOPE_AGENT); }
__device__ __forceinline__ unsigned xb_add(unsigned* p, unsigned v) { return __hip_atomic_fetch_add(p, v, __ATOMIC_RELAXED, __HIP_MEMORY_SCOPE_AGENT); }
__device__ __forceinline__ unsigned xb_xcc_id() { return (unsigned)__builtin_amdgcn_s_getreg((3 << 11) | 20) & 0xFu; }
#define XB_SPIN(cond, bar) do { unsigned _sp = 0; while (cond) { __builtin_amdgcn_s_sleep(1); \
    if ((++_sp & 255u) == 0u) { if (xb_ld(&(bar)[XB_TMO])) break; if (_sp > XB_SPIN_CAP) { atomicAdd(&(bar)[XB_TMO], 1u); break; } } } } while (0)

struct XcdBarrier {
    unsigned* bar; unsigned x;
    volatile LAS unsigned* st;
};

__device__ __forceinline__ XcdBarrier xcd_barrier_post(unsigned* bar, volatile LAS unsigned* st) {
    XcdBarrier b; b.bar = bar; b.x = xb_xcc_id(); b.st = st;
    if (threadIdx.x == 0) (void)xb_add(&bar[XB_XCNT(b.x)], 1u);
    return b;
}
__device__ __forceinline__ void xcd_barrier_complete(unsigned* bar, unsigned x, unsigned& nloc, unsigned& nx) {
    const unsigned G = gridDim.x * gridDim.y * gridDim.z;
    unsigned sum, cnt, mine, sp = 0u;
    for (;;) {
        sum = 0u; cnt = 0u; mine = 0u;
#pragma unroll
        for (unsigned j = 0; j < 16; ++j) { const unsigned c = xb_ld(&bar[XB_XCNT(j)]); sum += c; cnt += (c > 0u) ? 1u : 0u; mine = (j == x) ? c : mine; }
        if (sum == G) break;
        __builtin_amdgcn_s_sleep(1);
        if ((++sp & 255u) == 0u) { if (xb_ld(&bar[XB_TMO])) break; if (sp > XB_SPIN_CAP) { atomicAdd(&bar[XB_TMO], 1u); break; } }
    }
    nloc = mine > 0u ? mine : 1u; nx = cnt > 0u ? cnt : 1u;
}

__device__ __forceinline__ void xcd_barrier(const XcdBarrier& b) {
    asm volatile("s_waitcnt vmcnt(0)" ::: "memory");
    __syncthreads();
    if (threadIdx.x == 0) {
        unsigned* bar = b.bar;
        __builtin_amdgcn_s_waitcnt(0);
        unsigned nloc = b.st[0], nx = b.st[1];
        if (nloc == 0u) { xcd_barrier_complete(bar, b.x, nloc, nx); b.st[0] = nloc; b.st[1] = nx; }
        const unsigned old = xb_add(&bar[XB_XSUB(b.x)], 1u);
        const unsigned gen = old / nloc;
        if (old + 1u == (gen + 1u) * nloc) {
            __builtin_amdgcn_fence(__ATOMIC_RELEASE, "agent");
            asm volatile("s_waitcnt vmcnt(0)" ::: "memory");
            const unsigned og = xb_add(&bar[XB_TOP], 1u);
            const unsigned tg = og / nx;
            if (og + 1u == (tg + 1u) * nx) xb_add(&bar[XB_TOPGEN], 1u);
            else XB_SPIN(xb_ld(&bar[XB_TOPGEN]) == tg, bar);
            __builtin_amdgcn_fence(__ATOMIC_ACQUIRE, "agent");
            xb_add(&bar[XB_XGEN(b.x)], 1u);
            asm volatile("s_waitcnt vmcnt(0)" ::: "memory");
        } else {
            XB_SPIN(xb_ld(&bar[XB_XGEN(b.x)]) == gen, bar);
            __builtin_amdgcn_fence(__ATOMIC_ACQUIRE, "agent");
            asm volatile("s_waitcnt vmcnt(0)" ::: "memory");
        }
    }
    __syncthreads();
}


constexpr int NWAVES = 8, NTHREADS = 512;
constexpr int DM = 2048, NBATCH = 2, SEQ = 4096, NMETA = 16, FPAD = 112, LP = 4224, NBLK = 33;
constexpr int DBATCH = 128, DSEQ = 8, WIN = 128;
constexpr int ROWS_P = NBATCH * LP, ROWS_S = DBATCH * DSEQ, MROWS = ROWS_P + ROWS_S;
constexpr int NIN = 5648, NPAD = 5888;
constexpr int C_QA = 0, C_KA = 1024, C_VA = 1280, C_GA = 1536, C_QG = 2560, C_KG = 3072, C_VG = 3584, C_GG = 4608, C_ZG = 5632;
constexpr float EPSN = 1e-6f;
static_assert(MROWS % 256 == 0 && NPAD % 256 == 0, "tiles");

constexpr size_t O_YP = 0, O_YS = 16777216, O_KWP = 18874368, O_VWP = 18939904, O_GP = 19005440, O_KWS = 19267584, O_VWS = 23461888, O_GS = 27656192, O_END = 44433408;

constexpr size_t MiB = 1u << 20;
constexpr size_t WS_CTL = 0, CTL_ZERO_BYTES = 64 * 1024;
constexpr size_t WS_WIN = 1 * MiB;
constexpr size_t WS_WOUT = 24 * MiB;
constexpr size_t WS_XN = 32 * MiB;
constexpr size_t WS_P = 69 * MiB;
constexpr size_t WS_DST = 176 * MiB;
constexpr size_t WS_ST = 209 * MiB;
constexpr size_t WS_DEC = 226 * MiB;
constexpr size_t WS_END = 227 * MiB;
constexpr int CW_BAR = 1024;

constexpr int LDS_CTL_BYTES = 1024;
constexpr int SCR_OFF = 1024;
constexpr int LDS_BYTES = 156 * 1024;

typedef short bf16x4 __attribute__((ext_vector_type(4)));
typedef short v4i16_t __attribute__((ext_vector_type(4)));
typedef float f32x2 __attribute__((ext_vector_type(2)));

__device__ __forceinline__ float bf2f(unsigned short b) { return __uint_as_float(((unsigned)b) << 16); }
__device__ __forceinline__ unsigned short f2bf16(float f) { return (unsigned short)f2bf(f); }
__device__ __forceinline__ float wave_sum(float v) {
#pragma unroll
    for (int o = 1; o < 64; o <<= 1) v += __shfl_xor(v, o);
    return v;
}
__device__ __forceinline__ float silu_f(float x) { return x / (1.f + __expf(-x)); }
__device__ __forceinline__ float logsig_f(float x) { return fminf(x, 0.f) - __logf(1.f + __expf(-fabsf(x))); }

#ifndef USE_TR
#define USE_TR 1
#endif
__device__ __forceinline__ bf16x8 tr_frag(const LAS unsigned short* M, int row0, int col0, int pitch, int lane) {
#if USE_TR
    const int q = (lane & 15) >> 2, p = lane & 3;
    const LAS unsigned short* a0 = M + (row0 + q) * pitch + col0 + 4 * p;
    const v4i16_t lo = __builtin_amdgcn_ds_read_tr16_b64_v4i16((LAS v4i16_t*)a0);
    const v4i16_t hi = __builtin_amdgcn_ds_read_tr16_b64_v4i16((LAS v4i16_t*)(a0 + 4 * pitch));
    return (bf16x8){lo[0], lo[1], lo[2], lo[3], hi[0], hi[1], hi[2], hi[3]};
#else
    bf16x8 r; const LAS unsigned short* a0 = M + row0 * pitch + col0 + (lane & 15);
#pragma unroll
    for (int j = 0; j < 8; ++j) r[j] = (short)a0[j * pitch];
    return r;
#endif
}
#define MFMA16(a, b, c) __builtin_amdgcn_mfma_f32_16x16x32_bf16((a), (b), (c), 0, 0, 0)

struct Frame {
    LAS unsigned char* lds;
    int tid, lane, wave, G;
    unsigned char* ws; float* out;
    __device__ __forceinline__ bf16* WinT() const { return (bf16*)(ws + WS_WIN); }
    __device__ __forceinline__ bf16* WoutT() const { return (bf16*)(ws + WS_WOUT); }
    __device__ __forceinline__ bf16* XN() const { return (bf16*)(out + O_GS); }
    __device__ __forceinline__ bf16* MIX() const { return (bf16*)(ws + WS_XN); }
    __device__ __forceinline__ bf16* P() const { return (bf16*)(ws + WS_P); }
    __device__ __forceinline__ float* O2() const { return (float*)(ws + WS_P); }
    __device__ __forceinline__ float* dST() const { return (float*)(ws + WS_DST); }
    __device__ __forceinline__ bf16* St() const { return (bf16*)(ws + WS_ST); }
    __device__ __forceinline__ float* dec() const { return (float*)(ws + WS_DEC); }
};
enum { A_XP = 0, A_XS, A_CK, A_CV, A_STATE, A_META, A_RELB, A_NPRE, A_NPOST, A_WIN, A_WA2, A_BA, A_SINK, A_GNORM, A_WOUT, A_OUT, A_WS };
typedef const GAS float* gcf;
template <int IDX> __device__ __forceinline__ gcf ldarg() {
    const unsigned long long ka = (unsigned long long)__builtin_amdgcn_kernarg_segment_ptr();
    unsigned long long v;
    asm volatile("s_load_dwordx2 %0, %1, %2\n\ts_waitcnt lgkmcnt(0)" : "=s"(v) : "s"(ka), "i"(IDX * 8) : "memory");
    return (gcf)v;
}

struct P0Item { gcf W; bf16* WT; int N, kb, nb; bool on; };
__device__ __forceinline__ void p0_item_load(const P0Item& it, int K, int lane, f32x4 (&v)[16]) {
    const int k0 = 64 * it.kb, n0 = 64 * it.nb; const int nq = 4 * (lane & 15), kr = lane >> 4; const bool ok = it.on && (n0 + nq) < it.N;
#pragma unroll
    for (int i = 0; i < 16; ++i) v[i] = ok ? *(const GAS f32x4*)(it.W + (size_t)(k0 + 4 * i + kr) * it.N + n0 + nq) : (f32x4){0.f, 0.f, 0.f, 0.f};
}
__device__ __forceinline__ void p0_item_store(const P0Item& it, int K, int lane, const f32x4 (&v)[16], LAS float* scr) {
    if (!it.on) return;
    const int k0 = 64 * it.kb, n0 = 64 * it.nb; const int nq = 4 * (lane & 15), kr = lane >> 4;
#pragma unroll
    for (int i = 0; i < 16; ++i) { LAS float* d = scr + (4 * i + kr) * 65 + nq; d[0] = v[i].x; d[1] = v[i].y; d[2] = v[i].z; d[3] = v[i].w; }
    LDS_WAIT(); asm volatile("" ::: "memory");
    const int c = lane & 7;
#pragma unroll
    for (int j = 0; j < 8; ++j) { const int nn = (lane >> 3) + 8 * j; const LAS float* s = scr + (8 * c) * 65 + nn;
        v4u o; o.x = pk2(s[0 * 65], s[1 * 65]); o.y = pk2(s[2 * 65], s[3 * 65]); o.z = pk2(s[4 * 65], s[5 * 65]); o.w = pk2(s[6 * 65], s[7 * 65]);
        *(GAS v4u*)(it.WT + (size_t)(n0 + nn) * K + k0 + 8 * c) = o; }
    LDS_WAIT(); asm volatile("" ::: "memory");
}
__device__ __forceinline__ gcf p0_row_src(int m, gcf meta, gcf x_prompt, gcf x_sample) {
    if (m < ROWS_P) { const int b = m / LP, i = m - b * LP;
        if (i < FPAD) return nullptr;
        return (i < 128) ? meta + (size_t)(i - FPAD) * DM : x_prompt + ((size_t)b * SEQ + (i - 128)) * DM; }
    return x_sample + (size_t)(m - ROWS_P) * DM;
}
constexpr int P0R = 4;
__device__ __forceinline__ void p0_rows2(Frame& F, int m0, int mstep, gcf meta, gcf x_prompt, gcf x_sample, gcf norm_pre) {
    gcf src[P0R]; int mm[P0R];
#pragma unroll
    for (int q = 0; q < P0R; ++q) { mm[q] = m0 + q * mstep; src[q] = (mm[q] < MROWS) ? p0_row_src(mm[q], meta, x_prompt, x_sample) : nullptr; }
    f32x4 v[P0R][8];
#pragma unroll
    for (int q = 0; q < P0R; ++q)
#pragma unroll
        for (int j = 0; j < 8; ++j) v[q][j] = src[q] ? ((const GAS f32x4*)src[q])[F.lane + 64 * j] : (f32x4){0.f, 0.f, 0.f, 0.f};
#pragma unroll
    for (int q = 0; q < P0R; ++q) { if (mm[q] >= MROWS) continue;
        float s = 0.f;
#pragma unroll
        for (int j = 0; j < 8; ++j) s += (v[q][j].x * v[q][j].x + v[q][j].y * v[q][j].y) + (v[q][j].z * v[q][j].z + v[q][j].w * v[q][j].w);
        const float rstd = rsqrtf(wave_sum(s) * (1.f / DM) + EPSN);
        GAS unsigned long long* o8 = (GAS unsigned long long*)(F.XN() + (size_t)mm[q] * DM) + F.lane;
        if (src[q] == nullptr) { GAS unsigned long long* z8 = (GAS unsigned long long*)(F.MIX() + (size_t)mm[q] * DM) + F.lane;
#pragma unroll
            for (int j = 0; j < 8; ++j) z8[64 * j] = 0ull; }
#pragma unroll
        for (int j = 0; j < 8; ++j) { const f32x4 w = ((const GAS f32x4*)norm_pre)[F.lane + 64 * j];
            o8[64 * j] = (unsigned long long)pk2(v[q][j].x * rstd * w.x, v[q][j].y * rstd * w.y) | ((unsigned long long)pk2(v[q][j].z * rstd * w.z, v[q][j].w * rstd * w.w) << 32); } }
}
__device__ __forceinline__ void p0_prologue(Frame& F, int it_lo, int it_hi, int b_lo, int nb, bool with_rows) { gcf const w_in = ldarg<A_WIN>(); gcf const w_out = ldarg<A_WOUT>();
    LAS float* scr = (LAS float*)(F.lds + SCR_OFF + F.wave * 16640);
    const int gw = ((int)blockIdx.x - b_lo) * NWAVES + F.wave, NGW = nb * NWAVES;
    constexpr int I_IN = (DM / 64) * (NPAD / 64), I_OUT = (DM / 64) * (DM / 64);
    auto mk = [&](int it) { P0Item r; r.on = it < it_hi;
        if (it < I_IN) { r.W = w_in; r.WT = F.WinT(); r.N = NIN; r.kb = it / (NPAD / 64); r.nb = it % (NPAD / 64); }
        else { const int q = r.on ? it - I_IN : 0; r.W = w_out; r.WT = F.WoutT(); r.N = DM; r.kb = q / (DM / 64); r.nb = q % (DM / 64); }
        return r; };
    for (int it = it_lo + gw; it < it_hi; it += 2 * NGW) {
        const P0Item a = mk(it), b = mk(it + NGW);
        f32x4 va[16], vb[16];
        p0_item_load(a, DM, F.lane, va); p0_item_load(b, DM, F.lane, vb);
        p0_item_store(a, DM, F.lane, va, scr); p0_item_store(b, DM, F.lane, vb, scr);
    }
    if (with_rows) {
        gcf const meta = ldarg<A_META>(); gcf const x_prompt = ldarg<A_XP>(); gcf const x_sample = ldarg<A_XS>(); gcf const norm_pre = ldarg<A_NPRE>();
        for (int m = gw; m < MROWS; m += P0R * NGW) p0_rows2(F, m, NGW, meta, x_prompt, x_sample, norm_pre);
    }
}

constexpr int AKP = 72, APP = 168;
constexpr int A_K = 0, A_V = 272 * AKP * 2, A_BIAS = 2 * A_V, A_P = A_BIAS + 2048, A_END = A_P + NWAVES * 16 * APP * 2;
static_assert(A_END <= LDS_BYTES - SCR_OFF, "attention LDS");

struct AttnLds { const LAS unsigned short* AK; const LAS unsigned short* AV; const LAS float* AB; LAS unsigned short* AP; };
template <bool SAMPLE>
__device__ __forceinline__ void attn_tile(Frame& F, const AttnLds& L, const bf16x8 (&qa)[2], int s0, int kmin  ,
                                          int tb, int gb, size_t rowb, gcf sinks, int kvh) {
    int lane = F.lane; asm volatile("" : "+v"(lane));
    const int gq = lane >> 4, i = lane & 15;
    const LAS unsigned short* AK = L.AK; const LAS unsigned short* AV = L.AV; const LAS float* AB = L.AB; LAS unsigned short* AP = L.AP;
    size_t prow[2]; int pcol[2]; v4u gpre[2];
#pragma unroll
    for (int jj = 0; jj < 2; ++jj) { const int q = lane + 64 * jj, rr = q >> 3, ch = q & 7;
        prow[jj] = SAMPLE ? rowb + (rr & 7) : rowb + rr; pcol[jj] = kvh * 256 + (SAMPLE ? gb + (rr >> 3) : gb) * 64 + 8 * ch;
        gpre[jj] = *(const GAS v4u*)(F.P() + prow[jj] * NPAD + C_GA + pcol[jj]); }
    int trow[4], grow[4]; float sinkr[4];
#pragma unroll
    for (int r = 0; r < 4; ++r) { const int rr = 4 * gq + r; trow[r] = SAMPLE ? (rr & 7) : tb + rr; grow[r] = SAMPLE ? gb + (rr >> 3) : gb; sinkr[r] = sinks[kvh * 4 + grow[r]]; }
    f32x4 acc[10];
#pragma unroll
    for (int cb = 0; cb < 10; ++cb) { acc[cb] = (f32x4){0.f, 0.f, 0.f, 0.f};
#pragma unroll
        for (int ks = 0; ks < 2; ++ks) { const bf16x8 kb = *(const LAS bf16x8*)(AK + (s0 + 16 * cb + i) * AKP + 32 * ks + 8 * gq); acc[cb] = MFMA16(qa[ks], kb, acc[cb]); } }
    float mx[4] = {-INFINITY, -INFINITY, -INFINITY, -INFINITY};
#pragma unroll
    for (int cb = 0; cb < 10; ++cb) { const int s = s0 + 16 * cb + i;
#pragma unroll
        for (int r = 0; r < 4; ++r) { const int dist = 128 + trow[r] - s; const bool valid = (dist >= 0) && (dist < 128) && (s >= kmin);
            const int dc = dist < 0 ? 0 : (dist > 127 ? 127 : dist);
            const float v = valid ? acc[cb][r] * 0.125f + AB[grow[r] * 128 + dc] : -INFINITY; acc[cb][r] = v; mx[r] = fmaxf(mx[r], v); } }
    float inv[4];
#pragma unroll
    for (int r = 0; r < 4; ++r) { float m = mx[r];
        m = fmaxf(m, __shfl_xor(m, 1)); m = fmaxf(m, __shfl_xor(m, 2)); m = fmaxf(m, __shfl_xor(m, 4)); m = fmaxf(m, __shfl_xor(m, 8));
        m = fmaxf(m, sinkr[r]); float sum = 0.f;
#pragma unroll
        for (int cb = 0; cb < 10; ++cb) { const float e = __expf(acc[cb][r] - m); acc[cb][r] = e; sum += e; }
        sum += __shfl_xor(sum, 1); sum += __shfl_xor(sum, 2); sum += __shfl_xor(sum, 4); sum += __shfl_xor(sum, 8);
        inv[r] = 1.f / (sum + __expf(sinkr[r] - m)); }
#pragma unroll
    for (int cb = 0; cb < 10; ++cb)
#pragma unroll
        for (int r = 0; r < 4; ++r) AP[(4 * gq + r) * APP + 16 * cb + i] = f2bf16(acc[cb][r]);
    LDS_WAIT(); asm volatile("" ::: "memory");
    f32x4 o[4];
#pragma unroll
    for (int db = 0; db < 4; ++db) o[db] = (f32x4){0.f, 0.f, 0.f, 0.f};
#pragma unroll
    for (int kk = 0; kk < 5; ++kk) { const bf16x8 pa = *(const LAS bf16x8*)(AP + i * APP + 32 * kk + 8 * gq);
#pragma unroll
        for (int db = 0; db < 4; ++db) { const bf16x8 vb = tr_frag(AV, s0 + 32 * kk + 8 * gq, 16 * db, AKP, lane); o[db] = MFMA16(pa, vb, o[db]); } }
    LDS_WAIT(); asm volatile("" ::: "memory");
#pragma unroll
    for (int r = 0; r < 4; ++r)
#pragma unroll
        for (int db = 0; db < 4; ++db) AP[(4 * gq + r) * APP + 16 * db + i] = f2bf16(o[db][r] * inv[r]);
    LDS_WAIT(); asm volatile("" ::: "memory");
#pragma unroll
    for (int jj = 0; jj < 2; ++jj) { const int q = lane + 64 * jj, rr = q >> 3, ch = q & 7;
        const v4u ov = *(const LAS v4u*)(AP + rr * APP + 8 * ch); const v4u gv = gpre[jj];
        v4u res;
        res.x = pk2(bf2f(ov.x & 0xffff) * silu_f(bf2f(gv.x & 0xffff)), bf2f(ov.x >> 16) * silu_f(bf2f(gv.x >> 16)));
        res.y = pk2(bf2f(ov.y & 0xffff) * silu_f(bf2f(gv.y & 0xffff)), bf2f(ov.y >> 16) * silu_f(bf2f(gv.y >> 16)));
        res.z = pk2(bf2f(ov.z & 0xffff) * silu_f(bf2f(gv.z & 0xffff)), bf2f(ov.z >> 16) * silu_f(bf2f(gv.z >> 16)));
        res.w = pk2(bf2f(ov.w & 0xffff) * silu_f(bf2f(gv.w & 0xffff)), bf2f(ov.w >> 16) * silu_f(bf2f(gv.w >> 16)));
        *(GAS v4u*)(F.MIX() + prow[jj] * DM + pcol[jj]) = res; }
    LDS_WAIT(); asm volatile("" ::: "memory");
}

__device__ __forceinline__ void attn_bias_table(Frame& F, LAS float* AB, int kvh) { gcf const rel_bias = ldarg<A_RELB>();
    const int g = F.tid >> 7, d = F.tid & 127;
    int bk = d;
    if (d >= 16) { bk = 16 + (int)(__logf((float)d * (1.f / 16.f)) * (16.f / 2.0794415416798357f)); bk = bk > 31 ? 31 : bk; }
    AB[g * 128 + d] = rel_bias[bk * 16 + kvh * 4 + g];
}

__device__ __forceinline__ void attn_prompt_unit(Frame& F0, LAS unsigned char* scr, int b, int n, int kvh) { Frame F = F0; asm volatile("" : "+v"(F.tid), "+v"(F.lane));     gcf const sinks = ldarg<A_SINK>();
    LAS unsigned short* AK = (LAS unsigned short*)(scr + A_K); LAS unsigned short* AV = (LAS unsigned short*)(scr + A_V);
    __syncthreads();
    const long wrow0 = (long)b * LP + 128 * (n - 1);
#pragma unroll
    for (int j = 0; j < 4; ++j) { const int c = F.tid + 512 * j, row = c >> 3, ch = c & 7; const long gr = wrow0 + row;
        v4u kv = (v4u){0u, 0u, 0u, 0u}, vv = kv;
        if (gr >= 0) { const bf16* p = F.P() + (size_t)gr * NPAD + kvh * 64 + 8 * ch; kv = *(const GAS v4u*)(p + C_KA); vv = *(const GAS v4u*)(p + C_VA); }
        *(LAS v4u*)(AK + row * AKP + 8 * ch) = kv; *(LAS v4u*)(AV + row * AKP + 8 * ch) = vv; }
    if (F.tid < 128) { const int row = 256 + (F.tid >> 3), ch = F.tid & 7; *(LAS v4u*)(AK + row * AKP + 8 * ch) = (v4u){0u, 0u, 0u, 0u}; *(LAS v4u*)(AV + row * AKP + 8 * ch) = (v4u){0u, 0u, 0u, 0u}; }
    attn_bias_table(F, (LAS float*)(scr + A_BIAS), kvh);
    __syncthreads();
    const AttnLds L{AK, AV, (const LAS float*)(scr + A_BIAS), (LAS unsigned short*)(scr + A_P) + F.wave * 16 * APP};
    const int gq = F.lane >> 4, i = F.lane & 15, t0 = (n == 0) ? 112 : 16 * F.wave;
    const int kmin = FPAD - 128 * (n - 1);
    const size_t rbase = (size_t)b * LP + 128 * n;
    const int g_lo = (n == 0) ? F.wave : 0, g_hi = (n == 0) ? (F.wave < 4 ? F.wave + 1 : 0) : 4;
    bf16x8 qn[2] = {(bf16x8){0, 0, 0, 0, 0, 0, 0, 0}, (bf16x8){0, 0, 0, 0, 0, 0, 0, 0}};
    if (g_lo < g_hi) { const bf16* qp = F.P() + (rbase + t0 + i) * NPAD + C_QA + (kvh * 4 + g_lo) * 64; qn[0] = *(const GAS bf16x8*)(qp + 8 * gq); qn[1] = *(const GAS bf16x8*)(qp + 32 + 8 * gq); }
#pragma unroll 1
    for (int g = g_lo; g < g_hi; ++g) {
        const bf16x8 qa[2] = {qn[0], qn[1]};
        if (g + 1 < g_hi) { const bf16* qp = F.P() + (rbase + t0 + i) * NPAD + C_QA + (kvh * 4 + g + 1) * 64; qn[0] = *(const GAS bf16x8*)(qp + 8 * gq); qn[1] = *(const GAS bf16x8*)(qp + 32 + 8 * gq); }
        attn_tile<false>(F, L, qa, t0, kmin, t0, g, rbase + t0, sinks, kvh);
    }
    if (n == NBLK - 1) {
#pragma unroll
        for (int j = 0; j < 16; ++j) { const int e = F.tid + 512 * j, row = e >> 6, d = e & 63;
            const size_t oidx = (((size_t)b * WIN + row) * 4 + kvh) * 64 + d;
            F.out[O_KWP + oidx] = bf2f(AK[(128 + row) * AKP + d]); F.out[O_VWP + oidx] = bf2f(AV[(128 + row) * AKP + d]); }
    }
}

__device__ __forceinline__ void attn_sample_stage(Frame& F, LAS unsigned short* AK, LAS unsigned short* AV, int db, int kvh, gcf cache_k, gcf cache_v) {
#pragma unroll
    for (int j = 0; j < 4; ++j) { const int c = F.tid + 512 * j, row = c >> 4, ch = c & 15;
        const size_t src = (((size_t)db * WIN + row) * 4 + kvh) * 64 + 4 * ch;
        const f32x4 kv = *(const GAS f32x4*)(cache_k + src), vv = *(const GAS f32x4*)(cache_v + src);
        *(LAS unsigned long long*)(AK + row * AKP + 4 * ch) = (unsigned long long)pk2(kv.x, kv.y) | ((unsigned long long)pk2(kv.z, kv.w) << 32);
        *(LAS unsigned long long*)(AV + row * AKP + 4 * ch) = (unsigned long long)pk2(vv.x, vv.y) | ((unsigned long long)pk2(vv.z, vv.w) << 32);
        if (row >= DSEQ) { const size_t dst = (((size_t)db * WIN + row - DSEQ) * 4 + kvh) * 64 + 4 * ch; *(GAS f32x4*)(F.out + O_KWS + dst) = kv; *(GAS f32x4*)(F.out + O_VWS + dst) = vv; } }
    const size_t srow0 = (size_t)ROWS_P + (size_t)db * DSEQ;
    if (F.tid < 64) { const int t = F.tid >> 3, ch = F.tid & 7; const bf16* p = F.P() + (srow0 + t) * NPAD + kvh * 64 + 8 * ch;
        const v4u kv = *(const GAS v4u*)(p + C_KA), vv = *(const GAS v4u*)(p + C_VA);
        *(LAS v4u*)(AK + (128 + t) * AKP + 8 * ch) = kv; *(LAS v4u*)(AV + (128 + t) * AKP + 8 * ch) = vv;
        const size_t dst = (((size_t)db * WIN + (WIN - DSEQ) + t) * 4 + kvh) * 64 + 8 * ch;
        f32x4 a, c2; a.x = bf2f(kv.x & 0xffff); a.y = bf2f(kv.x >> 16); a.z = bf2f(kv.y & 0xffff); a.w = bf2f(kv.y >> 16); c2.x = bf2f(kv.z & 0xffff); c2.y = bf2f(kv.z >> 16); c2.z = bf2f(kv.w & 0xffff); c2.w = bf2f(kv.w >> 16);
        *(GAS f32x4*)(F.out + O_KWS + dst) = a; *(GAS f32x4*)(F.out + O_KWS + dst + 4) = c2;
        a.x = bf2f(vv.x & 0xffff); a.y = bf2f(vv.x >> 16); a.z = bf2f(vv.y & 0xffff); a.w = bf2f(vv.y >> 16); c2.x = bf2f(vv.z & 0xffff); c2.y = bf2f(vv.z >> 16); c2.z = bf2f(vv.w & 0xffff); c2.w = bf2f(vv.w >> 16);
        *(GAS f32x4*)(F.out + O_VWS + dst) = a; *(GAS f32x4*)(F.out + O_VWS + dst + 4) = c2; }
    if (F.tid >= 64 && F.tid < 64 + 192) { const int c = F.tid - 64, row = 136 + (c >> 3), ch = c & 7; *(LAS v4u*)(AK + row * AKP + 8 * ch) = (v4u){0u, 0u, 0u, 0u}; *(LAS v4u*)(AV + row * AKP + 8 * ch) = (v4u){0u, 0u, 0u, 0u}; }
}
__device__ __forceinline__ void attn_sample_tiles(Frame& F, const AttnLds& L, int db, int kvh, int wl, gcf sinks) {
    const int gq = F.lane >> 4, i = F.lane & 15; const size_t srow0 = (size_t)ROWS_P + (size_t)db * DSEQ;
    const bf16* qptr = F.P() + (srow0 + (i & 7)) * NPAD + C_QA + (kvh * 4 + 2 * wl + (i >> 3)) * 64;
    const bf16x8 qa[2] = {*(const GAS bf16x8*)(qptr + 8 * gq), *(const GAS bf16x8*)(qptr + 32 + 8 * gq)};
    attn_tile<true>(F, L, qa, 0, 0, 0, 2 * wl, srow0, sinks, kvh);
}
__device__ __forceinline__ void attn_sample_unit(Frame& F0, LAS unsigned char* scr, int u) { Frame F = F0; asm volatile("" : "+v"(F.tid), "+v"(F.lane));
    gcf const cache_k = ldarg<A_CK>(); gcf const cache_v = ldarg<A_CV>(); gcf const sinks = ldarg<A_SINK>();
    const int kvh = u & 3, db = u >> 2;
    LAS unsigned short* AK = (LAS unsigned short*)(scr + A_K); LAS unsigned short* AV = (LAS unsigned short*)(scr + A_V);
    __syncthreads();
    attn_sample_stage(F, AK, AV, db, kvh, cache_k, cache_v);
    attn_bias_table(F, (LAS float*)(scr + A_BIAS), kvh);
    __syncthreads();
    if (F.wave < 2) { const AttnLds L{AK, AV, (const LAS float*)(scr + A_BIAS), (LAS unsigned short*)(scr + A_P) + F.wave * 16 * APP}; attn_sample_tiles(F, L, db, kvh, F.wave, sinks); }
}
constexpr int SP_SLOT = 160 * AKP * 2, SP_BIAS = 4 * SP_SLOT, SP_P = SP_BIAS + 2048, SP_END = SP_P + 4 * 16 * APP * 2;
static_assert(SP_END <= LDS_BYTES - SCR_OFF, "sample pair LDS");
__device__ __forceinline__ void attn_sample_pair(Frame& F0, LAS unsigned char* scr, int u0, int u1) { Frame F = F0; asm volatile("" : "+v"(F.tid), "+v"(F.lane));
    gcf const cache_k = ldarg<A_CK>(); gcf const cache_v = ldarg<A_CV>(); gcf const sinks = ldarg<A_SINK>();
    const int kvh = u0 & 3;
    LAS unsigned short* K0 = (LAS unsigned short*)(scr); LAS unsigned short* V0 = (LAS unsigned short*)(scr + SP_SLOT);
    LAS unsigned short* K1 = (LAS unsigned short*)(scr + 2 * SP_SLOT); LAS unsigned short* V1 = (LAS unsigned short*)(scr + 3 * SP_SLOT);
    __syncthreads();
    attn_sample_stage(F, K0, V0, u0 >> 2, kvh, cache_k, cache_v);
    attn_sample_stage(F, K1, V1, u1 >> 2, kvh, cache_k, cache_v);
    attn_bias_table(F, (LAS float*)(scr + SP_BIAS), kvh);
    __syncthreads();
    if (F.wave < 4) { const int sl = F.wave >> 1;
        const AttnLds L{sl ? K1 : K0, sl ? V1 : V0, (const LAS float*)(scr + SP_BIAS), (LAS unsigned short*)(scr + SP_P) + F.wave * 16 * APP};
        attn_sample_tiles(F, L, (sl ? u1 : u0) >> 2, kvh, F.wave & 1, sinks); }
}

constexpr int GQP = 136, GVP = 264;
constexpr int G_Q = 0, G_K = 128 * GQP * 2, G_V = 2 * G_K, G_Z = G_V + 128 * GVP * 2, G_TOT = G_Z + 8192, G_D = G_TOT + 2048, G_END = G_D + 512;
static_assert(G_END <= LDS_BYTES - SCR_OFF, "GLA LDS");

template <bool NEED_Q>
__device__ __forceinline__ void gla_gate(Frame& F, LAS unsigned char* scr, int b, int c, int h) { gcf const w_a2 = ldarg<A_WA2>(); gcf const b_a = ldarg<A_BA>();
    LAS unsigned short* GQ = (LAS unsigned short*)(scr + G_Q); LAS unsigned short* GK = (LAS unsigned short*)(scr + G_K); LAS unsigned short* GV = (LAS unsigned short*)(scr + G_V);
    LAS float* GD = (LAS float*)(scr + G_D);
    const size_t R0 = (size_t)b * LP + 128 * c;
    const int lane = F.lane, gq = lane >> 4, i = lane & 15, w = F.wave;
    __syncthreads();
    bf16x8 za[8]; bf16x8 wh, wl; float ba;
    {
        v4u vv[8], kk[4], qq[4];
#pragma unroll
        for (int j = 0; j < 8; ++j) { const int cc = F.tid + 512 * j, row = cc >> 5, ch = cc & 31; vv[j] = *(const GAS v4u*)(F.P() + (R0 + row) * NPAD + C_VG + h * 256 + 8 * ch); }
#pragma unroll
        for (int j = 0; j < 4; ++j) { const int cc = F.tid + 512 * j, row = cc >> 4, ch = cc & 15; const bf16* p = F.P() + (R0 + row) * NPAD + h * 128 + 8 * ch;
            kk[j] = *(const GAS v4u*)(p + C_KG); if (NEED_Q) qq[j] = *(const GAS v4u*)(p + C_QG); }
#pragma unroll
        for (int tb = 0; tb < 8; ++tb) za[tb] = (gq < 2) ? *(const GAS bf16x8*)(F.P() + (R0 + 16 * tb + i) * NPAD + C_ZG + 8 * gq) : (bf16x8){0, 0, 0, 0, 0, 0, 0, 0};
#pragma unroll
        for (int j = 0; j < 8; ++j) { const float wv = (gq < 2) ? w_a2[(8 * gq + j) * 512 + h * 128 + 16 * w + i] : 0.f; const unsigned short hi = f2bf16(wv); wh[j] = (short)hi; wl[j] = (short)f2bf16(wv - bf2f(hi)); }
        ba = b_a[h * 128 + 16 * w + i];
#pragma unroll
        for (int j = 0; j < 8; ++j) { const int cc = F.tid + 512 * j, row = cc >> 5, ch = cc & 31; *(LAS v4u*)(GV + row * GVP + 8 * ch) = vv[j]; }
#pragma unroll
        for (int j = 0; j < 4; ++j) { const int cc = F.tid + 512 * j, row = cc >> 4, ch = cc & 15; *(LAS v4u*)(GK + row * GQP + 8 * ch) = kk[j]; if (NEED_Q) *(LAS v4u*)(GQ + row * GQP + 8 * ch) = qq[j]; }
    }
    f32x4 bc[8]; float run = 0.f;
#pragma unroll
    for (int tb = 0; tb < 8; ++tb) { f32x4 x = (f32x4){ba, ba, ba, ba}; x = MFMA16(za[tb], wh, x); x = MFMA16(za[tb], wl, x);
        float l0 = logsig_f(x[0]) * (1.f / 16.f), l1 = logsig_f(x[1]) * (1.f / 16.f), l2 = logsig_f(x[2]) * (1.f / 16.f), l3 = logsig_f(x[3]) * (1.f / 16.f);
        if (c == 0) { const int t0 = 16 * tb + 4 * gq; if (t0 + 0 < FPAD) l0 = 0.f; if (t0 + 1 < FPAD) l1 = 0.f; if (t0 + 2 < FPAD) l2 = 0.f; if (t0 + 3 < FPAD) l3 = 0.f; }
        const float p0 = l0, p1 = p0 + l1, p2 = p1 + l2, p3 = p2 + l3;
        float a = p3; const float u1 = __shfl_up(a, 16); if (gq >= 1) a += u1; const float u2 = __shfl_up(a, 32); if (gq >= 2) a += u2;
        const float excl = a - p3, tot = __shfl(a, 48 + i);
        bc[tb] = (f32x4){run + excl + p0, run + excl + p1, run + excl + p2, run + excl + p3}; run += tot; }
    __syncthreads();
#pragma unroll
    for (int tb = 0; tb < 8; ++tb)
#pragma unroll
        for (int r = 0; r < 4; ++r) { const int t = 16 * tb + 4 * gq + r, k = 16 * w + i; const float bt = bc[tb][r];
            GK[t * GQP + k] = f2bf16(bf2f(GK[t * GQP + k]) * __expf(-bt));
            if (NEED_Q) GQ[t * GQP + k] = f2bf16(bf2f(GQ[t * GQP + k]) * __expf(bt) * 0.08838834764831845f); }
    if (gq == 0) GD[16 * w + i] = __expf(run);
    __syncthreads();
}

__device__ __forceinline__ void gla_ds_unit(Frame& F0, LAS unsigned char* scr, int b, int c, int h) { Frame F = F0; asm volatile("" : "+v"(F.tid), "+v"(F.lane));
    const int u = (b * NBLK + c) * 4 + h;
    gla_gate<false>(F, scr, b, c, h);
    const LAS unsigned short* GK = (const LAS unsigned short*)(scr + G_K); const LAS unsigned short* GV = (const LAS unsigned short*)(scr + G_V); const LAS float* GD = (const LAS float*)(scr + G_D);
    int lane = F.lane; asm volatile("" : "+v"(lane));
    const int gq = lane >> 4, i = lane & 15, w = F.wave;
    f32x4 acc[8][2];
#pragma unroll
    for (int rb = 0; rb < 8; ++rb) { acc[rb][0] = (f32x4){0.f, 0.f, 0.f, 0.f}; acc[rb][1] = (f32x4){0.f, 0.f, 0.f, 0.f}; }
#pragma unroll
    for (int ks = 0; ks < 4; ++ks) {
        if (c == 0 && ks < 3) continue;
        const bf16x8 vb0 = tr_frag(GV, 32 * ks + 8 * gq, 32 * w, GVP, lane), vb1 = tr_frag(GV, 32 * ks + 8 * gq, 32 * w + 16, GVP, lane);
#pragma unroll
        for (int rb = 0; rb < 8; ++rb) { const bf16x8 ka = tr_frag(GK, 32 * ks + 8 * gq, 16 * rb, GQP, lane); acc[rb][0] = MFMA16(ka, vb0, acc[rb][0]); acc[rb][1] = MFMA16(ka, vb1, acc[rb][1]); } }
    float* dst = F.dST() + (size_t)u * 32768;
#pragma unroll
    for (int rb = 0; rb < 8; ++rb) { const f32x4 d4 = *(const LAS f32x4*)(GD + 16 * rb + 4 * gq);
#pragma unroll
        for (int cb = 0; cb < 2; ++cb) *(GAS f32x4*)(dst + (size_t)(32 * w + 16 * cb + i) * 128 + 16 * rb + 4 * gq) = acc[rb][cb] * d4; }
    if (F.tid < 128) F.dec()[(size_t)u * 128 + F.tid] = GD[F.tid];
}

__device__ __forceinline__ void gla_scan(Frame& F) {
    for (int e = blockIdx.x * NTHREADS + F.tid; e < NBATCH * 4 * 256 * 64; e += F.G * NTHREADS) {
        const int k2 = e & 63, v = (e >> 6) & 255, bh = e >> 14, b = bh >> 2, h = bh & 3;
        float s0 = 0.f, s1 = 0.f;
#pragma unroll 1
        for (int c0 = 0; c0 < NBLK; c0 += 11) {
            f32x2 d[11], ds[11];
#pragma unroll
            for (int q = 0; q < 11; ++q) { const size_t u = ((size_t)b * NBLK + c0 + q) * 4 + h;
                d[q] = *(const GAS f32x2*)(F.dec() + u * 128 + 2 * k2); ds[q] = *(const GAS f32x2*)(F.dST() + u * 32768 + (size_t)v * 128 + 2 * k2); }
#pragma unroll
            for (int q = 0; q < 11; ++q) { const size_t u = ((size_t)b * NBLK + c0 + q) * 4 + h;
                *(GAS unsigned*)(F.St() + u * 32768 + (size_t)v * 128 + 2 * k2) = pk2(s0, s1);
                s0 = d[q].x * s0 + ds[q].x; s1 = d[q].y * s1 + ds[q].y; }
        }
        float* gp = F.out + O_GP + ((size_t)bh * 128 + 2 * k2) * 256 + v; gp[0] = s0; gp[256] = s1;
    }
}

__device__ __forceinline__ void gla_out_unit(Frame& F0, LAS unsigned char* scr, int b, int c, int h) { Frame F = F0; asm volatile("" : "+v"(F.tid), "+v"(F.lane)); gcf const gla_norm = ldarg<A_GNORM>();
    const int u = (b * NBLK + c) * 4 + h;
    const bf16* St = F.St() + (size_t)u * 32768; const size_t R0 = (size_t)b * LP + 128 * c;
    v4u stp[8], gvp[8];
#pragma unroll
    for (int j = 0; j < 8; ++j) { const int cc = F.tid + 512 * j; stp[j] = (c != 0) ? *(const GAS v4u*)(St + (size_t)(cc >> 4) * 128 + 8 * (cc & 15)) : (v4u){0u, 0u, 0u, 0u}; }
#pragma unroll
    for (int j = 0; j < 8; ++j) { const int q = F.lane + 64 * j, row = 16 * F.wave + (q >> 5), ch = q & 31; gvp[j] = *(const GAS v4u*)(F.P() + (R0 + row) * NPAD + C_GG + h * 256 + 8 * ch); }
    gla_gate<true>(F, scr, b, c, h);
    const LAS unsigned short* GQ = (const LAS unsigned short*)(scr + G_Q); LAS unsigned short* GK = (LAS unsigned short*)(scr + G_K); const LAS unsigned short* GV = (const LAS unsigned short*)(scr + G_V);
    int lane = F.lane; asm volatile("" : "+v"(lane));
    const int gq = lane >> 4, i = lane & 15, w = F.wave;
    const bool active = true;
    bf16x8 qa[4];
#pragma unroll
    for (int ks = 0; ks < 4; ++ks) qa[ks] = *(const LAS bf16x8*)(GQ + (16 * w + i) * GQP + 32 * ks + 8 * gq);
    f32x4 aa[8];
#pragma unroll
    for (int sb = 0; sb < 8; ++sb) { aa[sb] = (f32x4){0.f, 0.f, 0.f, 0.f};
        if (active && sb <= w) {
#pragma unroll
            for (int ks = 0; ks < 4; ++ks) { const bf16x8 kb = *(const LAS bf16x8*)(GK + (16 * sb + i) * GQP + 32 * ks + 8 * gq); aa[sb] = MFMA16(qa[ks], kb, aa[sb]); } } }
    __syncthreads();
    f32x4 acc[16];
#pragma unroll
    for (int cb = 0; cb < 16; ++cb) acc[cb] = (f32x4){0.f, 0.f, 0.f, 0.f};
    if (active) {
#pragma unroll
    for (int sb = 0; sb < 8; ++sb)
#pragma unroll
        for (int r = 0; r < 4; ++r) { const int t = 16 * w + 4 * gq + r, s = 16 * sb + i; GK[t * GQP + s] = f2bf16(s <= t ? aa[sb][r] : 0.f); }
    LDS_WAIT(); asm volatile("" ::: "memory");
#pragma unroll
    for (int ks = 0; ks < 4; ++ks) {
        if (2 * ks <= w) {
            const bf16x8 af = *(const LAS bf16x8*)(GK + (16 * w + i) * GQP + 32 * ks + 8 * gq);
#pragma unroll
            for (int cb = 0; cb < 16; ++cb) { const bf16x8 vb = tr_frag(GV, 32 * ks + 8 * gq, 16 * cb, GVP, lane); acc[cb] = MFMA16(af, vb, acc[cb]); } } }
    }
    __syncthreads();
    { LAS unsigned char* GS = scr + G_V;
#pragma unroll
      for (int j = 0; j < 8; ++j) { const int cc = F.tid + 512 * j, v = cc >> 4, ch = cc & 15; *(LAS v4u*)(GS + v * 256 + ((ch ^ (v & 15)) << 4)) = stp[j]; } }
    __syncthreads();
    if (active) {
    if (c != 0) {
        const LAS unsigned char* GS = scr + G_V;
#pragma unroll
    for (int ks = 0; ks < 4; ++ks)
#pragma unroll
        for (int cb = 0; cb < 16; ++cb) { const bf16x8 sb = *(const LAS bf16x8*)(GS + (16 * cb + i) * 256 + (((4 * ks + gq) ^ i) << 4)); acc[cb] = MFMA16(qa[ks], sb, acc[cb]); }
    }
    LDS_WAIT(); asm volatile("" ::: "memory");
    { LAS unsigned short* GQw = (LAS unsigned short*)(scr + G_Q);
#pragma unroll
    for (int r = 0; r < 4; ++r) { float ss = 0.f;
#pragma unroll
        for (int cb = 0; cb < 16; ++cb) ss += acc[cb][r] * acc[cb][r];
        ss += __shfl_xor(ss, 1); ss += __shfl_xor(ss, 2); ss += __shfl_xor(ss, 4); ss += __shfl_xor(ss, 8);
        const float rstd = rsqrtf(ss * (1.f / 256.f) + EPSN); const int row = 16 * w + 4 * gq + r;
#pragma unroll
        for (int cb = 0; cb < 8; ++cb) { GQw[row * GQP + 16 * cb + i] = f2bf16(acc[cb][r] * rstd); GK[row * GQP + 16 * cb + i] = f2bf16(acc[cb + 8][r] * rstd); } }
    LDS_WAIT(); asm volatile("" ::: "memory");
#pragma unroll
    for (int j = 0; j < 8; ++j) { const int q = lane + 64 * j, row = 16 * w + (q >> 5), ch = q & 31;
        const v4u ov = *(const LAS v4u*)((ch < 16 ? GQw : GK) + row * GQP + 8 * (ch & 15));
        const v4u gv = gvp[j];
        const f32x4 n0 = *(const GAS f32x4*)(gla_norm + 8 * ch), n1 = *(const GAS f32x4*)(gla_norm + 8 * ch + 4);
        v4u res;
        res.x = pk2(bf2f(ov.x & 0xffff) * n0.x * silu_f(bf2f(gv.x & 0xffff)), bf2f(ov.x >> 16) * n0.y * silu_f(bf2f(gv.x >> 16)));
        res.y = pk2(bf2f(ov.y & 0xffff) * n0.z * silu_f(bf2f(gv.y & 0xffff)), bf2f(ov.y >> 16) * n0.w * silu_f(bf2f(gv.y >> 16)));
        res.z = pk2(bf2f(ov.z & 0xffff) * n1.x * silu_f(bf2f(gv.z & 0xffff)), bf2f(ov.z >> 16) * n1.y * silu_f(bf2f(gv.z >> 16)));
        res.w = pk2(bf2f(ov.w & 0xffff) * n1.z * silu_f(bf2f(gv.w & 0xffff)), bf2f(ov.w >> 16) * n1.w * silu_f(bf2f(gv.w >> 16)));
        *(GAS v4u*)(F.MIX() + (R0 + row) * DM + 1024 + h * 256 + 8 * ch) = res; } }
    }
}

constexpr int S_Q = 0, S_KH = 4096, S_KT = 8192, S_LG = 12288, S_D = 16384, S_A = 16896, S_Z = 17152, S_OP = 17664, S_END = S_OP + 65536;
static_assert(S_END <= LDS_BYTES - SCR_OFF, "sample GLA LDS");
__device__ __forceinline__ void gla_sample_unit(Frame& F0, LAS unsigned char* scr, int u) { Frame F = F0; asm volatile("" : "+v"(F.tid), "+v"(F.lane));
    gcf const w_a2 = ldarg<A_WA2>(); gcf const b_a = ldarg<A_BA>(); gcf const state = ldarg<A_STATE>(); gcf const gla_norm = ldarg<A_GNORM>();
    const int h = u & 3, db = u >> 2;
    LAS float* SQ = (LAS float*)(scr + S_Q); LAS float* SKH = (LAS float*)(scr + S_KH); LAS float* SKT = (LAS float*)(scr + S_KT); LAS float* SLG = (LAS float*)(scr + S_LG); LAS float* SD = (LAS float*)(scr + S_D);
    LAS float* SA = (LAS float*)(scr + S_A); LAS float* SZ = (LAS float*)(scr + S_Z); LAS float* SOP = (LAS float*)(scr + S_OP);
    const size_t R0 = (size_t)ROWS_P + (size_t)db * DSEQ;
    const int w = F.wave, lane = F.lane;
    f32x4 st[16];
    { const GAS f32x4* sp = (const GAS f32x4*)(state + ((size_t)u * 128 + 16 * w) * 256) + lane;
#pragma unroll
      for (int kk = 0; kk < 16; ++kk) st[kk] = sp[64 * kk]; }
    __syncthreads();
    if (F.tid < 128) SZ[F.tid] = bf2f(F.P()[(R0 + (F.tid >> 4)) * NPAD + C_ZG + (F.tid & 15)]);
    const int k = F.tid & 127, tp = F.tid >> 7;
    float qv[2], kv[2], wv[16];
#pragma unroll
    for (int q = 0; q < 2; ++q) { const bf16* p = F.P() + (R0 + 2 * tp + q) * NPAD + h * 128 + k; qv[q] = bf2f(p[C_QG]); kv[q] = bf2f(p[C_KG]); }
#pragma unroll
    for (int r = 0; r < 16; ++r) wv[r] = w_a2[r * 512 + h * 128 + k];
    const float ba = b_a[h * 128 + k];
    __syncthreads();
#pragma unroll
    for (int q = 0; q < 2; ++q) { const int t = 2 * tp + q; float x = ba;
#pragma unroll
        for (int r = 0; r < 16; ++r) x += SZ[t * 16 + r] * wv[r];
        SLG[t * 128 + k] = logsig_f(x) * (1.f / 16.f); }
    __syncthreads();
    { float run = 0.f, bt[2] = {0.f, 0.f};
#pragma unroll
      for (int t = 0; t < 8; ++t) { run += SLG[t * 128 + k]; if (t == 2 * tp) bt[0] = run; if (t == 2 * tp + 1) bt[1] = run; }
#pragma unroll
      for (int q = 0; q < 2; ++q) { const int t = 2 * tp + q;
          SQ[k * 8 + t] = qv[q] * __expf(bt[q]) * 0.08838834764831845f; SKT[k * 8 + t] = kv[q] * __expf(-bt[q]); SKH[k * 8 + t] = kv[q] * __expf(run - bt[q]); }
      if (tp == 0) SD[k] = __expf(run); }
    __syncthreads();
    if (F.tid < 64) { const int t = F.tid >> 3, s2 = F.tid & 7; float a = 0.f;
        if (s2 <= t) { for (int kk = 0; kk < 128; ++kk) a += SQ[kk * 8 + t] * SKT[kk * 8 + s2]; }
        SA[t * 8 + s2] = a; }
    {   f32x4 vv[8], op[8];
#pragma unroll
        for (int t = 0; t < 8; ++t) { const unsigned long long pv = *(const GAS unsigned long long*)(F.P() + (R0 + t) * NPAD + C_VG + h * 256 + 4 * lane);
            vv[t] = (f32x4){bf2f((unsigned short)pv), bf2f((unsigned short)(pv >> 16)), bf2f((unsigned short)(pv >> 32)), bf2f((unsigned short)(pv >> 48))}; op[t] = (f32x4){0.f, 0.f, 0.f, 0.f}; }
        GAS f32x4* np = (GAS f32x4*)(F.out + O_GS + ((size_t)u * 128 + 16 * w) * 256) + lane;
#pragma unroll
        for (int kk = 0; kk < 16; ++kk) { const int kc = 16 * w + kk; const f32x4 s0 = st[kk];
            const f32x4 q0 = *(const LAS f32x4*)(SQ + kc * 8), q1 = *(const LAS f32x4*)(SQ + kc * 8 + 4), h0 = *(const LAS f32x4*)(SKH + kc * 8), h1 = *(const LAS f32x4*)(SKH + kc * 8 + 4);
            f32x4 sn = s0 * SD[kc];
            sn += vv[0] * h0.x + vv[1] * h0.y + vv[2] * h0.z + vv[3] * h0.w + vv[4] * h1.x + vv[5] * h1.y + vv[6] * h1.z + vv[7] * h1.w;
            np[64 * kk] = sn;
            op[0] += s0 * q0.x; op[1] += s0 * q0.y; op[2] += s0 * q0.z; op[3] += s0 * q0.w; op[4] += s0 * q1.x; op[5] += s0 * q1.y; op[6] += s0 * q1.z; op[7] += s0 * q1.w; }
#pragma unroll
        for (int t = 0; t < 8; ++t) *(LAS f32x4*)(SOP + (w * 8 + t) * 256 + 4 * lane) = op[t];
    }
    __syncthreads();
    {   const int t = w; f32x4 a = (f32x4){0.f, 0.f, 0.f, 0.f};
#pragma unroll
        for (int w2 = 0; w2 < 8; ++w2) a += *(const LAS f32x4*)(SOP + (w2 * 8 + t) * 256 + 4 * lane);
        for (int s2 = 0; s2 <= t; ++s2) { const unsigned long long pv = *(const GAS unsigned long long*)(F.P() + (R0 + s2) * NPAD + C_VG + h * 256 + 4 * lane); const float c = SA[t * 8 + s2];
            a += (f32x4){bf2f((unsigned short)pv), bf2f((unsigned short)(pv >> 16)), bf2f((unsigned short)(pv >> 32)), bf2f((unsigned short)(pv >> 48))} * c; }
        const float ss = (a.x * a.x + a.y * a.y) + (a.z * a.z + a.w * a.w);
        const float rstd = rsqrtf(wave_sum(ss) * (1.f / 256.f) + EPSN);
        const unsigned long long gv = *(const GAS unsigned long long*)(F.P() + (R0 + t) * NPAD + C_GG + h * 256 + 4 * lane); const f32x4 gn = *(const GAS f32x4*)(gla_norm + 4 * lane);
        const float g0 = bf2f((unsigned short)gv), g1 = bf2f((unsigned short)(gv >> 16)), g2 = bf2f((unsigned short)(gv >> 32)), g3 = bf2f((unsigned short)(gv >> 48));
        *(GAS unsigned long long*)(F.MIX() + (R0 + t) * DM + 1024 + h * 256 + 4 * lane) =
            (unsigned long long)pk2(a.x * rstd * gn.x * silu_f(g0), a.y * rstd * gn.y * silu_f(g1)) | ((unsigned long long)pk2(a.z * rstd * gn.z * silu_f(g2), a.w * rstd * gn.w * silu_f(g3)) << 32);
    }
}

__device__ __forceinline__ void final_rows(Frame& F) { gcf const x_prompt = ldarg<A_XP>(); gcf const x_sample = ldarg<A_XS>(); gcf const norm_post = ldarg<A_NPOST>();
    const int gw = blockIdx.x * NWAVES + F.wave, NGW = F.G * NWAVES; constexpr int NR = NBATCH * SEQ + ROWS_S;
    for (int idx0 = gw; idx0 < NR; idx0 += 2 * NGW) {
        f32x4 v[2][8], xx[2][8]; float* yp[2]; bool on[2];
#pragma unroll
        for (int q = 0; q < 2; ++q) { const int idx = idx0 + q * NGW; on[q] = idx < NR; const int id2 = on[q] ? idx : idx0;
            size_t grow; gcf x;
            if (id2 < NBATCH * SEQ) { const int b = id2 / SEQ, s2 = id2 - b * SEQ; grow = (size_t)b * LP + 128 + s2; x = x_prompt + (size_t)id2 * DM; yp[q] = F.out + O_YP + (size_t)id2 * DM; }
            else { const int j = id2 - NBATCH * SEQ; grow = (size_t)ROWS_P + j; x = x_sample + (size_t)j * DM; yp[q] = F.out + O_YS + (size_t)j * DM; }
            const GAS f32x4* o4 = (const GAS f32x4*)yp[q] + F.lane;   const GAS f32x4* x4 = (const GAS f32x4*)x + F.lane;
#pragma unroll
            for (int j = 0; j < 8; ++j) { v[q][j] = o4[64 * j]; xx[q][j] = x4[64 * j]; } }
#pragma unroll
        for (int q = 0; q < 2; ++q) { float s2 = 0.f;
#pragma unroll
            for (int j = 0; j < 8; ++j) s2 += (v[q][j].x * v[q][j].x + v[q][j].y * v[q][j].y) + (v[q][j].z * v[q][j].z + v[q][j].w * v[q][j].w);
            const float rstd = rsqrtf(wave_sum(s2) * (1.f / DM) + EPSN);
            if (on[q]) { GAS f32x4* y4 = (GAS f32x4*)yp[q] + F.lane;
#pragma unroll
                for (int j = 0; j < 8; ++j) { const f32x4 w = ((const GAS f32x4*)norm_post)[F.lane + 64 * j]; y4[64 * j] = xx[q][j] + v[q][j] * rstd * w; } } }
    }
}

#ifndef MK_PER_PHASE
#define MK_PER_PHASE 0
#endif
constexpr int N_PHASES = 7;
struct Args { const float* in[15]; float* out; unsigned char* ws; int ph_lo, ph_hi; };
__global__ void __launch_bounds__(NTHREADS, 2) hymba_fwd(Args args) {
    extern __shared__ __attribute__((aligned(16))) unsigned char lds_raw[];
    Frame F;
    F.lds = (LAS unsigned char*)lds_raw;
    F.tid = threadIdx.x; F.lane = F.tid & 63; F.wave = __builtin_amdgcn_readfirstlane(F.tid >> 6); F.G = gridDim.x;
    F.out = args.out; F.ws = args.ws;
    unsigned char* ws = args.ws;
    for (int u = F.tid; u < LDS_CTL_BYTES / 4; u += NTHREADS) ((LAS unsigned*)F.lds)[u] = 0u;
    __syncthreads();
    volatile LAS unsigned* MISC = (volatile LAS unsigned*)(F.lds + 512);
    XcdBarrier bar; bar.bar = (unsigned*)(ws + WS_CTL) + CW_BAR; bar.x = 0; bar.st = nullptr;
    if (!MK_PER_PHASE) bar = xcd_barrier_post((unsigned*)(ws + WS_CTL) + CW_BAR, MISC + 8);
    LAS unsigned char* scr = F.lds + SCR_OFF;
    const int lo = args.ph_lo, hi = args.ph_hi;
#define IN(k) (lo <= (k) && (k) < hi)
#define SEAM(k) do { if (IN(k) && IN((k) + 1)) xcd_barrier(bar); } while (0)

#ifndef PROBE_PHASE
#define PROBE_PHASE -1
#endif
#ifndef PROBE_REP
#define PROBE_REP 1
#endif
#define REPS(k) for (int rep_ = 0; rep_ < ((k) == PROBE_PHASE ? PROBE_REP : 1); ++rep_)
    constexpr int P0_I_IN = (DM / 64) * (NPAD / 64), P0_I_ALL = P0_I_IN + (DM / 64) * (DM / 64);
    constexpr int G1_TAIL = (MROWS / 256) * (NPAD / 256) % 256;
    const bool wout_late = (F.G == 256) && !MK_PER_PHASE && IN(0) && IN(1) && IN(2) && PROBE_PHASE < 0;
    REPS(0) if (IN(0)) { p0_prologue(F, 0, wout_late ? P0_I_IN : P0_I_ALL, 0, F.G, true); if (PROBE_PHASE == 0) xcd_barrier(bar); }
    SEAM(0);
#define UNIT_BCH(idx, b_, c_, h_) const int b_ = (idx) < 256 ? (idx) >> 7 : ((idx) - 256) >> 2, c_ = (idx) < 256 ? 1 + (((idx) >> 2) & 31) : 0, h_ = (idx) & 3
    const bool split12 = (F.G == 256) && !MK_PER_PHASE && IN(0) && IN(1) && IN(2) && PROBE_PHASE < 0;
    if (split12) {
        constexpr int G1_MP = ROWS_P / 256, G1_MS = ROWS_S / 256, G1_N = NPAD / 256, G1_FULL = (G1_MP + G1_MS) * G1_N / 256;
        const int cb_ = (int)blockIdx.x;
        { pg8::Gemm g{F.XN(), F.WinT(), MROWS, NPAD, DM}; pg8::OrderPF S{G1_MP, G1_MS, G1_N, F.G, cb_, 0, G1_FULL};
          pg8::EpiBf16<0> E{F.P(), NPAD, nullptr, 0, 0, 1.f}; pg8::gemm_phase<pg8::EpiBf16<0>, pg8::OrderPF, true, true>(scr, g, S, E); }
        xcd_barrier(bar);
        if (cb_ < G1_TAIL) {
            { pg8::Gemm g{F.XN(), F.WinT(), MROWS, NPAD, DM}; pg8::OrderPF S{G1_MP, G1_MS, G1_N, F.G, cb_, G1_FULL, G1_FULL + 1};
              pg8::EpiBf16<0> E{F.P(), NPAD, nullptr, 0, 0, 1.f}; pg8::gemm_phase<pg8::EpiBf16<0>, pg8::OrderPF, true, true>(scr, g, S, E); }
            __syncthreads(); p0_prologue(F, P0_I_IN, P0_I_ALL, 0, G1_TAIL, false);
        } else { UNIT_BCH(cb_, b_, c_, h_); attn_prompt_unit(F, scr, b_, c_, h_); gla_ds_unit(F, scr, b_, c_, h_); }
        xcd_barrier(bar);
        if (cb_ < G1_TAIL) { { UNIT_BCH(cb_, b_, c_, h_); attn_prompt_unit(F, scr, b_, c_, h_); gla_ds_unit(F, scr, b_, c_, h_); } gla_sample_unit(F, scr, cb_); }
        else if (cb_ < G1_TAIL + 8) { UNIT_BCH(256 + (cb_ - G1_TAIL), b_, c_, h_); attn_prompt_unit(F, scr, b_, c_, h_); gla_ds_unit(F, scr, b_, c_, h_); gla_out_unit(F, scr, b_, c_, h_); }
        else { const int v = cb_ - (G1_TAIL + 8), nb = 256 - (G1_TAIL + 8);
            attn_sample_pair(F, scr, v, 256 + v); if (nb + v < 256) attn_sample_pair(F, scr, nb + v, 256 + nb + v);
            gla_sample_unit(F, scr, G1_TAIL + v); gla_sample_unit(F, scr, G1_TAIL + nb + v); { const int n3 = DBATCH * 4 - (G1_TAIL + 2 * nb), v3 = v - (nb - n3); if (v3 >= 0) gla_sample_unit(F, scr, G1_TAIL + 2 * nb + v3); } }
    } else {
    REPS(1) if (IN(1)) {
        pg8::Gemm g{F.XN(), F.WinT(), MROWS, NPAD, DM}; pg8::StaticOrder S; S.init(MROWS, NPAD, F.G, (int)blockIdx.x);
        pg8::EpiBf16<0> E{F.P(), NPAD, nullptr, 0, 0, 1.f};
        pg8::gemm_phase<pg8::EpiBf16<0>, pg8::StaticOrder, true, true>(scr, g, S, E);
        if (wout_late && (int)blockIdx.x >= G1_TAIL) { __syncthreads(); p0_prologue(F, P0_I_IN, P0_I_ALL, G1_TAIL, F.G - G1_TAIL, false); }
        if (PROBE_PHASE == 1) xcd_barrier(bar);
    }
    SEAM(1);
    REPS(2) if (IN(2)) {
        REPS(20) for (int u = blockIdx.x; u < NBATCH * NBLK * 4; u += F.G) { UNIT_BCH(u, b_, c_, h_); attn_prompt_unit(F, scr, b_, c_, h_); }
        REPS(21) for (int u = blockIdx.x; u < NBATCH * NBLK * 4; u += F.G) { UNIT_BCH(u, b_, c_, h_); gla_ds_unit(F, scr, b_, c_, h_); }
        if (F.G == 256) {
            if (blockIdx.x < 8) { UNIT_BCH(256 + (int)blockIdx.x, b_, c_, h_); gla_out_unit(F, scr, b_, c_, h_); }
            else { const int v = (int)blockIdx.x - 8;
                attn_sample_pair(F, scr, v, 248 + v); if (v < 16) attn_sample_unit(F, scr, 496 + v);
                gla_sample_unit(F, scr, v); gla_sample_unit(F, scr, 248 + v); if (v >= 16 && v < 32) gla_sample_unit(F, scr, 496 + v - 16); }
        } else {
            for (int u = 256 + blockIdx.x; u < NBATCH * NBLK * 4; u += F.G) { UNIT_BCH(u, b_, c_, h_); gla_out_unit(F, scr, b_, c_, h_); }
            REPS(22) for (int u = blockIdx.x; u < DBATCH * 4; u += F.G) attn_sample_unit(F, scr, u);
            REPS(23) for (int u = blockIdx.x; u < DBATCH * 4; u += F.G) gla_sample_unit(F, scr, u);
        }
        if (PROBE_PHASE == 2) xcd_barrier(bar);
    }
    }
    SEAM(2);
    REPS(3) if (IN(3)) { gla_scan(F); if (PROBE_PHASE == 3) xcd_barrier(bar); }
    SEAM(3);
    REPS(4) if (IN(4)) {
        for (int u = blockIdx.x; u < 256; u += F.G) { UNIT_BCH(u, b_, c_, h_); gla_out_unit(F, scr, b_, c_, h_); }
        __syncthreads();
        if (PROBE_PHASE == 4) xcd_barrier(bar);
    }
    SEAM(4);
    REPS(5) if (IN(5)) {
        pg8::Gemm g{F.MIX(), F.WoutT(), MROWS, DM, DM}; pg8::StaticOrder S; S.init(MROWS, DM, F.G, (int)blockIdx.x);
        pg8::EpiY E{F.out + O_YP, F.out + O_YS, LP, SEQ, ROWS_P};
        pg8::gemm_phase<pg8::EpiY, pg8::StaticOrder, true, true>(scr, g, S, E);
        if (PROBE_PHASE == 5) xcd_barrier(bar);
    }
    SEAM(5);
    REPS(6) if (IN(6)) { final_rows(F); if (PROBE_PHASE == 6) xcd_barrier(bar); }
#undef IN
#undef SEAM
}

extern "C" void kernel_launch(void* const* d_in, const int* in_sizes, int n_in, void* d_out, int out_size, void* d_ws, size_t ws_size, hipStream_t stream) {
    static int grid = 0;
    if (grid == 0) {
        if (n_in != 15 || out_size != (int)O_END || ws_size < WS_END) { fprintf(stderr, "kernel_launch: unexpected problem: n_in %d out %d ws %zu\n", n_in, out_size, ws_size); grid = -1; return; }
        int dev = 0, cus = 0, per_cu = 0;
        if (hipGetDevice(&dev) != hipSuccess || hipDeviceGetAttribute(&cus, hipDeviceAttributeMultiprocessorCount, dev) != hipSuccess) { grid = -1; return; }
        if (hipFuncSetAttribute((const void*)hymba_fwd, hipFuncAttributeMaxDynamicSharedMemorySize, LDS_BYTES) != hipSuccess) { fprintf(stderr, "kernel_launch: hipFuncSetAttribute failed\n"); grid = -1; return; }
        if (hipOccupancyMaxActiveBlocksPerMultiprocessor(&per_cu, (const void*)hymba_fwd, NTHREADS, LDS_BYTES) != hipSuccess || per_cu < 1) fprintf(stderr, "kernel_launch: note: occupancy query reports %d\n", per_cu);
        (void)hipGetLastError();
        grid = cus;
    }
    if (grid < 0) return;
    (void)hipMemsetAsync((char*)d_ws + WS_CTL, 0, CTL_ZERO_BYTES, stream);
    Args a{};
    for (int i = 0; i < 15; ++i) a.in[i] = (const float*)d_in[i];
    a.out = (float*)d_out; a.ws = (unsigned char*)d_ws;
#if MK_PER_PHASE
    for (int p = 0; p < N_PHASES; ++p) { a.ph_lo = p; a.ph_hi = p + 1; hipLaunchKernelGGL(hymba_fwd, dim3(grid), dim3(NTHREADS), LDS_BYTES, stream, a); }
#else
    a.ph_lo = 0; a.ph_hi = N_PHASES;
    hipLaunchKernelGGL(hymba_fwd, dim3(grid), dim3(NTHREADS), LDS_BYTES, stream, a);
#endif
}
```

```cpp
#include <hip/hip_runtime.h>
#include <cstdio>
#include <cstdint>
#include <cmath>
namespace pg8 {
#define PG8_LAS __attribute__((address_space(3)))
typedef unsigned short bf16_t;
typedef short bf16x8 __attribute__((ext_vector_type(8)));
typedef float f32x4 __attribute__((ext_vector_type(4)));
typedef unsigned u32x4 __attribute__((ext_vector_type(4)));
constexpr int BM = 256, BK = 64, HALF = 128, HTB = HALF * BK * 2  , STAGE_BYTES = 8 * HTB, NXCD = 8, WGM = 8;

__host__ __device__ __forceinline__ int lds_byte(int r, int c) { const int st = (r >> 4) * 2 + (c >> 5), rr = r & 15, cc = c & 31, ob = rr * 64 + cc * 2; return st * 1024 + (ob ^ (((ob >> 9) & 1) << 5)); }
__host__ __device__ __forceinline__ void stage_rc(int b, int& R, int& C) { const int st = b / 1024, sb = b % 1024, swz = sb ^ (((sb >> 9) & 1) << 5); R = (st >> 1) * 16 + swz / 64; C = (st & 1) * 32 + (swz % 64) / 2; }
__host__ __device__ __forceinline__ int perm32(int rho) { const int n = rho >> 4, i = rho & 15; return 8 * (i >> 2) + 4 * n + (i & 3); }

struct Unit { int pm, pn; };
struct Gemm { const bf16_t* A; const bf16_t* Bt; int M, N, K; };

struct StaticOrder {
    int nM, nN, nwg, G, c;
    __host__ __device__ void init(int M, int N, int G_, int c_) { nM = M / BM; nN = N / BM; nwg = nM * nN; G = G_; c = c_; }
    __host__ __device__ bool next(int i, Unit& u) const {
        const long L = (long)i * G + c; if (L >= nwg) return false;
        int wgid = (int)L; { const int q = nwg / NXCD, r = nwg % NXCD, xcd = wgid % NXCD, off = wgid / NXCD; wgid = (xcd < r ? xcd * (q + 1) : r * (q + 1) + (xcd - r) * q) + off; }
        const int nig = WGM * nN, gid = wgid / nig, fm = gid * WGM, gsz = (nM - fm) < WGM ? (nM - fm) : WGM;
        u.pm = fm + ((wgid % nig) % gsz); u.pn = (wgid % nig) / gsz; return true;
    }
    __device__ __forceinline__ void a_ready(const Unit&) const {}
    __device__ __forceinline__ void done(const Unit&) const {}
};

struct OrderPF {
    int nMp, nMs, nN, G, c, r0, r1;
    __device__ bool next(int i, Unit& u) const {
        const int ii = r0 + i; if (ii >= r1) return false;
        const int nP = nMp * nN, nT = (nMp + nMs) * nN; const int e = ii * G + c; if (e >= nT) return false;
        if (e < nP) { int wgid = e; { const int q = nP / NXCD, r = nP % NXCD, xcd = wgid % NXCD, off = wgid / NXCD; wgid = (xcd < r ? xcd * (q + 1) : r * (q + 1) + (xcd - r) * q) + off; }
            const int nig = WGM * nN, gid = wgid / nig, fm = gid * WGM, gsz = (nMp - fm) < WGM ? (nMp - fm) : WGM; u.pm = fm + ((wgid % nig) % gsz); u.pn = (wgid % nig) / gsz; }
        else { const int q = e - nP; u.pm = nMp + q % nMs; u.pn = q / nMs; }
        return true;
    }
    __device__ __forceinline__ void a_ready(const Unit&) const {}
    __device__ __forceinline__ void done(const Unit&) const {}
};

__device__ __forceinline__ unsigned cvt_pk_bf16(float lo, float hi) { unsigned r; asm volatile("v_cvt_pk_bf16_f32 %0, %1, %2" : "=v"(r) : "v"(lo), "v"(hi)); return r; }
typedef float f32x2 __attribute__((ext_vector_type(2)));
__device__ __forceinline__ f32x2 gelu_pk(f32x2 v) {
    const f32x2 av = __builtin_elementwise_abs(v), d = av * 0.2316418882f + 1.0f;
    f32x2 t; t.x = __builtin_amdgcn_rcpf(d.x); t.y = __builtin_amdgcn_rcpf(d.y);
    f32x2 q = t * 0.5307027145f + (-0.7265760135f); q = q * t + 0.7107068705f; q = q * t + (-0.142248368f); q = q * t + 0.127414796f; q = q * t;
    const f32x2 s = (v * v) * (-0.72134752044f);
    f32x2 e; e.x = __builtin_amdgcn_exp2f(s.x); e.y = __builtin_amdgcn_exp2f(s.y);
    const f32x2 m = v * (q * e), r = v - m;
    f32x2 o; o.x = v.x < 0.f ? m.x : r.x; o.y = v.y < 0.f ? m.y : r.y; return o;
}

template <int ACT  > struct EpiBf16 {
    static constexpr bool PERM = true, AFTER_DRAIN = false; static_assert(ACT == 0 || ACT == 1, "EpiBf16: ACT is 0 (none) or 1 (gelu_pk)");
    bf16_t* O; int ldc; const float* bias; int split_cols; size_t split_stride; float scale0;
    __device__ __forceinline__ void operator()(const f32x4 (&acc)[2][2][4][2], const Unit& u, int wr, int wc, int fr, int fq) const {
        const int row0 = u.pm * BM + wr * 64 + fr; int colt = u.pn * BM; bf16_t* base = O;
        float sc = 1.f; if (split_cols) { const int t = colt / split_cols; base += (size_t)t * split_stride; colt -= t * split_cols; if (t == 0) sc = scale0; }
        const int col0 = colt + wc * 32 + 8 * fq, bcol0 = u.pn * BM + wc * 32 + 8 * fq;
        f32x4 bv[2][2];
#pragma unroll
        for (int bj = 0; bj < 2; ++bj)
#pragma unroll
            for (int n = 0; n < 2; ++n) bv[bj][n] = bias ? *(const f32x4*)(bias + bcol0 + bj * HALF + 4 * n) : (f32x4){0.f, 0.f, 0.f, 0.f};
#pragma unroll
        for (int ai = 0; ai < 2; ++ai)
#pragma unroll
            for (int m = 0; m < 4; ++m) { bf16_t* rowp = base + (size_t)(row0 + ai * HALF + m * 16) * ldc + col0;
#pragma unroll
                for (int bj = 0; bj < 2; ++bj) { f32x4 v0 = acc[ai][bj][m][0] + bv[bj][0], v1 = acc[ai][bj][m][1] + bv[bj][1];
                    if (ACT == 1) { f32x2 a = gelu_pk((f32x2){v0[0], v0[1]}), b = gelu_pk((f32x2){v0[2], v0[3]}), c = gelu_pk((f32x2){v1[0], v1[1]}), d = gelu_pk((f32x2){v1[2], v1[3]});
                        v0 = (f32x4){a.x, a.y, b.x, b.y}; v1 = (f32x4){c.x, c.y, d.x, d.y}; }
                    v0 = v0 * sc; v1 = v1 * sc; u32x4 w; w.x = cvt_pk_bf16(v0[0], v0[1]); w.y = cvt_pk_bf16(v0[2], v0[3]); w.z = cvt_pk_bf16(v1[0], v1[1]); w.w = cvt_pk_bf16(v1[2], v1[3]);
                    *(u32x4*)(rowp + bj * HALF) = w; } }
    }
};

struct EpiF32 {
    static constexpr bool PERM = false, AFTER_DRAIN = false;
    float* O; int ldc;
    __device__ __forceinline__ void operator()(const f32x4 (&acc)[2][2][4][2], const Unit& u, int wr, int wc, int fr, int fq) const {
        const int row0 = u.pm * BM + wr * 64 + fr, col0 = u.pn * BM + wc * 32 + 4 * fq;
#pragma unroll
        for (int ai = 0; ai < 2; ++ai)
#pragma unroll
            for (int m = 0; m < 4; ++m) { float* rowp = O + (size_t)(row0 + ai * HALF + m * 16) * ldc + col0;
#pragma unroll
                for (int bj = 0; bj < 2; ++bj)
#pragma unroll
                    for (int n = 0; n < 2; ++n) *(f32x4*)(rowp + bj * HALF + n * 16) = acc[ai][bj][m][n]; }
    }
};
struct EpiY {
    static constexpr bool PERM = false, AFTER_DRAIN = false;
    float* yp; float* ys; int lp, seq, rows_p;
    __device__ __forceinline__ void operator()(const f32x4 (&acc)[2][2][4][2], const Unit& u, int wr, int wc, int fr, int fq) const {
        const int row0 = u.pm * BM + wr * 64 + fr, col0 = u.pn * BM + wc * 32 + 4 * fq;
#pragma unroll
        for (int ai = 0; ai < 2; ++ai)
#pragma unroll
            for (int m = 0; m < 4; ++m) { const int row = row0 + ai * HALF + m * 16; float* rowp;
                if (row < rows_p) { const int b = row / lp, i = row - b * lp; if (i < 128) continue; rowp = yp + ((size_t)b * seq + (i - 128)) * 2048 + col0; }
                else rowp = ys + (size_t)(row - rows_p) * 2048 + col0;
#pragma unroll
                for (int bj = 0; bj < 2; ++bj)
#pragma unroll
                    for (int n = 0; n < 2; ++n) *(f32x4*)(rowp + bj * HALF + n * 16) = acc[ai][bj][m][n]; }
    }
};
template <class Epi, class Sched, bool ALIGN_EPI = false, bool SP2 = false>
__device__ __forceinline__ void gemm_phase(PG8_LAS unsigned char* lds, const Gemm g, const Sched& S, const Epi& E) {
    const int tid = threadIdx.x, wid = __builtin_amdgcn_readfirstlane(tid >> 6), lane = tid & 63, wr = wid >> 2, wc = wid & 3, fr = lane & 15, fq = lane >> 4;
    const int K = g.K, nt = K / BK;
    unsigned voffA[2], voffB[2];
#pragma unroll
    for (int i = 0; i < 2; ++i) { int R, C; stage_rc(tid * 16 + i * 8192, R, C); const int Rb = Epi::PERM ? ((R & ~31) + perm32(R & 31)) : R;
        voffA[i] = (unsigned)(R * K + C) * 2u; voffB[i] = (unsigned)(Rb * K + C) * 2u; }
    const size_t kstep = (size_t)(BK * 2);
    const size_t hstep = (size_t)HALF * K * 2;
    const size_t tstep = 2 * hstep;
    const unsigned ldsw = (unsigned)wid * 1024u;
    const int aoff = lds_byte(wr * 64 + fr, fq * 8), boff = lds_byte(wc * 32 + fr, fq * 8);
#define PG8_SA(b, h) (((b) * 2 + (h)) * HTB)
#define PG8_SB(b, h) ((4 + (b) * 2 + (h)) * HTB)
#define PG8_STAGE(bufoff, gbase, voff) do { _Pragma("unroll") for (int _i = 0; _i < 2; ++_i) \
        __builtin_amdgcn_global_load_lds((const unsigned*)((const char*)(gbase) + (voff)[_i]), (PG8_LAS unsigned*)(lds + (bufoff) + ldsw + _i * 8192), 16, 0, 0); } while (0)
#define PG8_LDA(dst, b, h) do { _Pragma("unroll") for (int m = 0; m < 4; ++m) _Pragma("unroll") for (int k = 0; k < 2; ++k) dst[m][k] = *(const PG8_LAS bf16x8*)(lds + PG8_SA(b, h) + aoff + m * 2048 + k * 1024); } while (0)
#define PG8_LDB(dst, b, h) do { _Pragma("unroll") for (int n = 0; n < 2; ++n) _Pragma("unroll") for (int k = 0; k < 2; ++k) dst[n][k] = *(const PG8_LAS bf16x8*)(lds + PG8_SB(b, h) + boff + n * 2048 + k * 1024); } while (0)
#define PG8_MMA(ai, bj, At, Bt) do { __builtin_amdgcn_s_setprio(1); _Pragma("unroll") for (int m = 0; m < 4; ++m) _Pragma("unroll") for (int n = 0; n < 2; ++n) _Pragma("unroll") for (int k = 0; k < 2; ++k) \
        acc[ai][bj][m][n] = __builtin_amdgcn_mfma_f32_16x16x32_bf16(Bt[n][k], At[m][k], acc[ai][bj][m][n], 0, 0, 0); __builtin_amdgcn_s_setprio(0); } while (0)
#define PG8_WAIT_V(n) asm volatile("s_waitcnt vmcnt(" #n ")" ::: "memory")
#define PG8_WAIT_L(n) asm volatile("s_waitcnt lgkmcnt(" #n ")" ::: "memory")
#define PG8_BAR __builtin_amdgcn_s_barrier()
#define PG8_SCHED __builtin_amdgcn_sched_barrier(0)
    Unit cur, nxt; int ui = 0;
    if (!S.next(0, cur)) return;
    f32x4 acc[2][2][4][2];
#pragma unroll
    for (int a = 0; a < 2; ++a)
#pragma unroll
        for (int b = 0; b < 2; ++b)
#pragma unroll
            for (int m = 0; m < 4; ++m)
#pragma unroll
                for (int n = 0; n < 2; ++n) acc[a][b][m][n] = (f32x4){0.f, 0.f, 0.f, 0.f};
    bf16x8 At[4][2], B0[2][2], B1[2][2];
    const char* cA = (const char*)g.A + (size_t)cur.pm * tstep; const char* cB = (const char*)g.Bt + (size_t)cur.pn * tstep;
    S.a_ready(cur);
    if constexpr (SP2) {
        PG8_STAGE(PG8_SB(0, 0), cB, voffB); PG8_STAGE(PG8_SB(0, 1), cB + hstep, voffB); PG8_STAGE(PG8_SA(0, 0), cA, voffA); PG8_STAGE(PG8_SA(0, 1), cA + hstep, voffA);
        if (wr == 1) PG8_BAR;
        PG8_WAIT_V(2); PG8_BAR;
        PG8_STAGE(PG8_SB(1, 0), cB + kstep, voffB); PG8_STAGE(PG8_SA(1, 0), cA + kstep, voffA); PG8_STAGE(PG8_SB(1, 1), cB + hstep + kstep, voffB);
        PG8_WAIT_V(6); PG8_BAR;
    } else {
        PG8_STAGE(PG8_SB(0, 0), cB, voffB); PG8_STAGE(PG8_SA(0, 0), cA, voffA); PG8_STAGE(PG8_SB(0, 1), cB + hstep, voffB); PG8_STAGE(PG8_SA(0, 1), cA + hstep, voffA);
        if (wr == 1) PG8_BAR;
        PG8_WAIT_V(4); PG8_BAR;
        PG8_STAGE(PG8_SB(1, 0), cB + kstep, voffB); PG8_STAGE(PG8_SA(1, 0), cA + kstep, voffA); PG8_STAGE(PG8_SB(1, 1), cB + hstep + kstep, voffB);
        PG8_WAIT_V(6); PG8_BAR;
    }
    for (;;) {
        const bool has_next = S.next(ui + 1, nxt);
        const char* nA = has_next ? (const char*)g.A + (size_t)nxt.pm * tstep : cA; const char* nB = has_next ? (const char*)g.Bt + (size_t)nxt.pn * tstep : cB;
        for (int t = 0; t < nt; t += 2) {
            const bool last = (t == nt - 2);
            const char* a1 = cA + (size_t)(t + 1) * kstep;
            const char* a2 = last ? nA : cA + (size_t)(t + 2) * kstep; const char* b2 = last ? nB : cB + (size_t)(t + 2) * kstep;
            const char* a3 = a2 + kstep; const char* b3 = b2 + kstep;
            if (last && has_next) S.a_ready(nxt);
            if constexpr (SP2) {
            PG8_LDB(B0, 0, 0); PG8_LDB(B1, 0, 1); PG8_SCHED; PG8_LDA(At, 0, 0); PG8_STAGE(PG8_SA(1, 1), a1 + hstep, voffA);
            PG8_WAIT_V(8); PG8_WAIT_L(0); PG8_BAR; PG8_MMA(0, 0, At, B0); PG8_MMA(0, 1, At, B1); PG8_BAR; PG8_SCHED;
            PG8_LDA(At, 0, 1); PG8_STAGE(PG8_SB(0, 0), b2, voffB); PG8_STAGE(PG8_SB(0, 1), b2 + hstep, voffB); PG8_STAGE(PG8_SA(0, 0), a2, voffA);
            PG8_WAIT_V(8); PG8_WAIT_L(0); PG8_BAR; PG8_MMA(1, 0, At, B0); PG8_MMA(1, 1, At, B1); PG8_BAR; PG8_SCHED;
            PG8_LDB(B0, 1, 0); PG8_LDB(B1, 1, 1); PG8_SCHED; PG8_LDA(At, 1, 0); PG8_STAGE(PG8_SA(0, 1), a2 + hstep, voffA);
            PG8_WAIT_V(8); PG8_WAIT_L(0); PG8_BAR; PG8_MMA(0, 0, At, B0); PG8_MMA(0, 1, At, B1); PG8_BAR; PG8_SCHED;
            PG8_LDA(At, 1, 1); PG8_STAGE(PG8_SB(1, 0), b3, voffB); PG8_STAGE(PG8_SB(1, 1), b3 + hstep, voffB); PG8_STAGE(PG8_SA(1, 0), a3, voffA);
            PG8_WAIT_V(8); PG8_WAIT_L(0); PG8_BAR; PG8_MMA(1, 0, At, B0); PG8_MMA(1, 1, At, B1); PG8_BAR; PG8_SCHED;
            } else {
            PG8_LDB(B0, 0, 0); PG8_SCHED; PG8_LDA(At, 0, 0); PG8_STAGE(PG8_SA(1, 1), a1 + hstep, voffA);
            PG8_WAIT_L(8); PG8_BAR; PG8_WAIT_L(0); PG8_MMA(0, 0, At, B0); PG8_BAR; PG8_SCHED;
            PG8_LDB(B1, 0, 1); PG8_STAGE(PG8_SB(0, 0), b2, voffB);
            PG8_BAR; PG8_WAIT_L(0); PG8_MMA(0, 1, At, B1); PG8_BAR;
            PG8_LDA(At, 0, 1); PG8_STAGE(PG8_SA(0, 0), a2, voffA);
            PG8_BAR; PG8_WAIT_L(0); PG8_MMA(1, 0, At, B0); PG8_BAR; PG8_SCHED;
            PG8_STAGE(PG8_SB(0, 1), b2 + hstep, voffB);
            PG8_WAIT_V(6); PG8_BAR; PG8_MMA(1, 1, At, B1); PG8_BAR;
            PG8_LDB(B0, 1, 0); PG8_SCHED; PG8_LDA(At, 1, 0); PG8_STAGE(PG8_SA(0, 1), a2 + hstep, voffA);
            PG8_WAIT_L(8); PG8_BAR; PG8_WAIT_L(0); PG8_MMA(0, 0, At, B0); PG8_BAR; PG8_SCHED;
            PG8_LDB(B1, 1, 1); PG8_STAGE(PG8_SB(1, 0), b3, voffB);
            PG8_BAR; PG8_WAIT_L(0); PG8_MMA(0, 1, At, B1); PG8_BAR;
            PG8_LDA(At, 1, 1); PG8_STAGE(PG8_SA(1, 0), a3, voffA);
            PG8_BAR; PG8_WAIT_L(0); PG8_MMA(1, 0, At, B0); PG8_BAR; PG8_SCHED;
            PG8_STAGE(PG8_SB(1, 1), b3 + hstep, voffB);
            PG8_WAIT_V(6); PG8_BAR; PG8_MMA(1, 1, At, B1); PG8_BAR;
            }
        }
        if constexpr (ALIGN_EPI) { if (wr == 0) PG8_BAR; }
        if constexpr (!Epi::AFTER_DRAIN) { E(acc, cur, wr, wc, fr, fq); S.done(cur); }
        if (!has_next) break;
#pragma unroll
        for (int a = 0; a < 2; ++a)
#pragma unroll
            for (int b = 0; b < 2; ++b)
#pragma unroll
                for (int m = 0; m < 4; ++m)
#pragma unroll
                    for (int n = 0; n < 2; ++n) acc[a][b][m][n] = (f32x4){0.f, 0.f, 0.f, 0.f};
        cur = nxt; cA = nA; cB = nB; ++ui;
        if constexpr (ALIGN_EPI) { if (wr == 1) PG8_BAR; }
    }
    PG8_WAIT_V(0);
    if constexpr (!ALIGN_EPI) { if (wr == 0) PG8_BAR; }
    PG8_BAR;
    if constexpr (Epi::AFTER_DRAIN) { E.fused(acc, cur, wr, wc, fr, fq, lds, wid, lane); S.done(cur); }
#undef PG8_SA
#undef PG8_SB
#undef PG8_STAGE
#undef PG8_LDA
#undef PG8_LDB
#undef PG8_MMA
#undef PG8_WAIT_V
#undef PG8_WAIT_L
#undef PG8_BAR
#undef PG8_SCHED
}
}

#define GAS __attribute__((address_space(1)))
#define LAS __attribute__((address_space(3)))
typedef unsigned short bf16;
typedef unsigned v4u __attribute__((ext_vector_type(4)));
typedef float f32x4 __attribute__((ext_vector_type(4)));
typedef short bf16x8 __attribute__((ext_vector_type(8)));
typedef GAS unsigned gu32;
typedef GAS unsigned long long gu64;
#define RLX_AGENT __ATOMIC_RELAXED, __HIP_MEMORY_SCOPE_AGENT
#define LDS_WAIT() asm volatile("s_waitcnt lgkmcnt(0)" ::: "memory")
#define VM_WAIT() asm volatile("s_waitcnt vmcnt(0)" ::: "memory")
__device__ __forceinline__ unsigned long long rt() { return __builtin_amdgcn_s_memrealtime(); }
__device__ __forceinline__ unsigned f2bf(float f) { unsigned u = __builtin_bit_cast(unsigned, f); return (u + 0x7fffu + ((u >> 16) & 1u)) >> 16; }
__device__ __forceinline__ unsigned pk2(float lo, float hi) { return f2bf(lo) | (f2bf(hi) << 16); }
#define XB_TMO      128
#define XB_XCNT(j)  (256  + 64 * (j))
#define XB_XSUB(j)  (1280 + 64 * (j))
#define XB_XGEN(j)  (2304 + 64 * (j))
#define XB_TOP      3328
#define XB_TOPGEN   3392
#define XCD_BAR_WORDS 3456
#define XB_SPIN_CAP (1u << 18)

__device__ __forceinline__ unsigned xb_ld(unsigned* p)              { return __hip_atomic_load(p, __ATOMIC_RELAXED, __HIP_MEMORY_SCOPE_AGENT); }
__device__ __forceinline__ unsigned xb_add(unsigned* p, unsigned v) { return __hip_atomic_fetch_add(p, v, __ATOMIC_RELAXED, __HIP_MEMORY_SCOPE_AGENT); }
__device__ __forceinline__ unsigned xb_xcc_id() { return (unsigned)__builtin_amdgcn_s_getreg((3 << 11) | 20) & 0xFu; }
#define XB_SPIN(cond, bar) do { unsigned _sp = 0; while (cond) { __builtin_amdgcn_s_sleep(1); \
    if ((++_sp & 255u) == 0u) { if (xb_ld(&(bar)[XB_TMO])) break; if (_sp > XB_SPIN_CAP) { atomicAdd(&(bar)[XB_TMO], 1u); break; } } } } while (0)

struct XcdBarrier {
    unsigned* bar; unsigned x;
    volatile LAS unsigned* st;
};

__device__ __forceinline__ XcdBarrier xcd_barrier_post(unsigned* bar, volatile LAS unsigned* st) {
    XcdBarrier b; b.bar = bar; b.x = xb_xcc_id(); b.st = st;
    if (threadIdx.x == 0) (void)xb_add(&bar[XB_XCNT(b.x)], 1u);
    return b;
}
__device__ __forceinline__ void xcd_barrier_complete(unsigned* bar, unsigned x, unsigned& nloc, unsigned& nx) {
    const unsigned G = gridDim.x * gridDim.y * gridDim.z;
    unsigned sum, cnt, mine, sp = 0u;
    for (;;) {
        sum = 0u; cnt = 0u; mine = 0u;
#pragma unroll
        for (unsigned j = 0; j < 16; ++j) { const unsigned c = xb_ld(&bar[XB_XCNT(j)]); sum += c; cnt += (c > 0u) ? 1u : 0u; mine = (j == x) ? c : mine; }
        if (sum == G) break;
        __builtin_amdgcn_s_sleep(1);
        if ((++sp & 255u) == 0u) { if (xb_ld(&bar[XB_TMO])) break; if (sp > XB_SPIN_CAP) { atomicAdd(&bar[XB_TMO], 1u); break; } }
    }
    nloc = mine > 0u ? mine : 1u; nx = cnt > 0u ? cnt : 1u;
}

__device__ __forceinline__ void xcd_barrier(const XcdBarrier& b) {
    asm volatile("s_waitcnt vmcnt(0)" ::: "memory");
    __syncthreads();
    if (threadIdx.x == 0) {
        unsigned* bar = b.bar;
        __builtin_amdgcn_s_waitcnt(0);
        unsigned nloc = b.st[0], nx = b.st[1];
        if (nloc == 0u) { xcd_barrier_complete(bar, b.x, nloc, nx); b.st[0] = nloc; b.st[1] = nx; }
        const unsigned old = xb_add(&bar[XB_XSUB(b.x)], 1u);
        const unsigned gen = old / nloc;
        if (old + 1u == (gen + 1u) * nloc) {
            __builtin_amdgcn_fence(__ATOMIC_RELEASE, "agent");
            asm volatile("s_waitcnt vmcnt(0)" ::: "memory");
            const unsigned og = xb_add(&bar[XB_TOP], 1u);
            const unsigned tg = og / nx;
            if (og + 1u == (tg + 1u) * nx) xb_add(&bar[XB_TOPGEN], 1u);
            else XB_SPIN(xb_ld(&bar[XB_TOPGEN]) == tg, bar);
            __builtin_amdgcn_fence(__ATOMIC_ACQUIRE, "agent");
            xb_add(&bar[XB_XGEN(b.x)], 1u);
            asm volatile("s_waitcnt vmcnt(0)" ::: "memory");
        } else {
            XB_SPIN(xb_ld(&bar[XB_XGEN(b.x)]) == gen, bar);
            __builtin_amdgcn_fence(__ATOMIC_ACQUIRE, "agent");
            asm volatile("s_waitcnt vmcnt(0)" ::: "memory");
        }
    }
    __syncthreads();
}


constexpr int NWAVES = 8, NTHREADS = 512;
constexpr int DM = 2048, NBATCH = 2, SEQ = 4096, NMETA = 16, FPAD = 112, LP = 4224, NBLK = 33;
constexpr int DBATCH = 128, DSEQ = 8, WIN = 128;
constexpr int ROWS_P = NBATCH * LP, ROWS_S = DBATCH * DSEQ, MROWS = ROWS_P + ROWS_S;
constexpr int NIN = 5648, NPAD = 5888;
constexpr int C_QA = 0, C_KA = 1024, C_VA = 1280, C_GA = 1536, C_QG = 2560, C_KG = 3072, C_VG = 3584, C_GG = 4608, C_ZG = 5632;
constexpr float EPSN = 1e-6f;
static_assert(MROWS % 256 == 0 && NPAD % 256 == 0, "tiles");

constexpr size_t O_YP = 0, O_YS = 16777216, O_KWP = 18874368, O_VWP = 18939904, O_GP = 19005440, O_KWS = 19267584, O_VWS = 23461888, O_GS = 27656192, O_END = 44433408;

constexpr size_t MiB = 1u << 20;
constexpr size_t WS_CTL = 0, CTL_ZERO_BYTES = 64 * 1024;
constexpr size_t WS_WIN = 1 * MiB;
constexpr size_t WS_WOUT = 24 * MiB;
constexpr size_t WS_XN = 32 * MiB;
constexpr size_t WS_P = 69 * MiB;
constexpr size_t WS_DST = 176 * MiB;
constexpr size_t WS_ST = 209 * MiB;
constexpr size_t WS_DEC = 226 * MiB;
constexpr size_t WS_END = 227 * MiB;
constexpr int CW_BAR = 1024;

constexpr int LDS_CTL_BYTES = 1024;
constexpr int SCR_OFF = 1024;
constexpr int LDS_BYTES = 156 * 1024;

typedef short bf16x4 __attribute__((ext_vector_type(4)));
typedef short v4i16_t __attribute__((ext_vector_type(4)));
typedef float f32x2 __attribute__((ext_vector_type(2)));

__device__ __forceinline__ float bf2f(unsigned short b) { return __uint_as_float(((unsigned)b) << 16); }
__device__ __forceinline__ unsigned short f2bf16(float f) { return (unsigned short)f2bf(f); }
__device__ __forceinline__ float wave_sum(float v) {
#pragma unroll
    for (int o = 1; o < 64; o <<= 1) v += __shfl_xor(v, o);
    return v;
}
__device__ __forceinline__ float silu_f(float x) { return x / (1.f + __expf(-x)); }
__device__ __forceinline__ float logsig_f(float x) { return fminf(x, 0.f) - __logf(1.f + __expf(-fabsf(x))); }

#ifndef USE_TR
#define USE_TR 1
#endif
__device__ __forceinline__ bf16x8 tr_frag(const LAS unsigned short* M, int row0, int col0, int pitch, int lane) {
#if USE_TR
    const int q = (lane & 15) >> 2, p = lane & 3;
    const LAS unsigned short* a0 = M + (row0 + q) * pitch + col0 + 4 * p;
    const v4i16_t lo = __builtin_amdgcn_ds_read_tr16_b64_v4i16((LAS v4i16_t*)a0);
    const v4i16_t hi = __builtin_amdgcn_ds_read_tr16_b64_v4i16((LAS v4i16_t*)(a0 + 4 * pitch));
    return (bf16x8){lo[0], lo[1], lo[2], lo[3], hi[0], hi[1], hi[2], hi[3]};
#else
    bf16x8 r; const LAS unsigned short* a0 = M + row0 * pitch + col0 + (lane & 15);
#pragma unroll
    for (int j = 0; j < 8; ++j) r[j] = (short)a0[j * pitch];
    return r;
#endif
}
#define MFMA16(a, b, c) __builtin_amdgcn_mfma_f32_16x16x32_bf16((a), (b), (c), 0, 0, 0)

struct Frame {
    LAS unsigned char* lds;
    int tid, lane, wave, G;
    unsigned char* ws; float* out;
    __device__ __forceinline__ bf16* WinT() const { return (bf16*)(ws + WS_WIN); }
    __device__ __forceinline__ bf16* WoutT() const { return (bf16*)(ws + WS_WOUT); }
    __device__ __forceinline__ bf16* XN() const { return (bf16*)(out + O_GS); }
    __device__ __forceinline__ bf16* MIX() const { return (bf16*)(ws + WS_XN); }
    __device__ __forceinline__ bf16* P() const { return (bf16*)(ws + WS_P); }
    __device__ __forceinline__ float* O2() const { return (float*)(ws + WS_P); }
    __device__ __forceinline__ float* dST() const { return (float*)(ws + WS_DST); }
    __device__ __forceinline__ bf16* St() const { return (bf16*)(ws + WS_ST); }
    __device__ __forceinline__ float* dec() const { return (float*)(ws + WS_DEC); }
};
enum { A_XP = 0, A_XS, A_CK, A_CV, A_STATE, A_META, A_RELB, A_NPRE, A_NPOST, A_WIN, A_WA2, A_BA, A_SINK, A_GNORM, A_WOUT, A_OUT, A_WS };
typedef const GAS float* gcf;
template <int IDX> __device__ __forceinline__ gcf ldarg() {
    const unsigned long long ka = (unsigned long long)__builtin_amdgcn_kernarg_segment_ptr();
    unsigned long long v;
    asm volatile("s_load_dwordx2 %0, %1, %2\n\ts_waitcnt lgkmcnt(0)" : "=s"(v) : "s"(ka), "i"(IDX * 8) : "memory");
    return (gcf)v;
}

struct P0Item { gcf W; bf16* WT; int N, kb, nb; bool on; };
__device__ __forceinline__ void p0_item_load(const P0Item& it, int K, int lane, f32x4 (&v)[16]) {
    const int k0 = 64 * it.kb, n0 = 64 * it.nb; const int nq = 4 * (lane & 15), kr = lane >> 4; const bool ok = it.on && (n0 + nq) < it.N;
#pragma unroll
    for (int i = 0; i < 16; ++i) v[i] = ok ? *(const GAS f32x4*)(it.W + (size_t)(k0 + 4 * i + kr) * it.N + n0 + nq) : (f32x4){0.f, 0.f, 0.f, 0.f};
}
__device__ __forceinline__ void p0_item_store(const P0Item& it, int K, int lane, const f32x4 (&v)[16], LAS float* scr) {
    if (!it.on) return;
    const int k0 = 64 * it.kb, n0 = 64 * it.nb; const int nq = 4 * (lane & 15), kr = lane >> 4;
#pragma unroll
    for (int i = 0; i < 16; ++i) { LAS float* d = scr + (4 * i + kr) * 65 + nq; d[0] = v[i].x; d[1] = v[i].y; d[2] = v[i].z; d[3] = v[i].w; }
    LDS_WAIT(); asm volatile("" ::: "memory");
    const int c = lane & 7;
#pragma unroll
    for (int j = 0; j < 8; ++j) { const int nn = (lane >> 3) + 8 * j; const LAS float* s = scr + (8 * c) * 65 + nn;
        v4u o; o.x = pk2(s[0 * 65], s[1 * 65]); o.y = pk2(s[2 * 65], s[3 * 65]); o.z = pk2(s[4 * 65], s[5 * 65]); o.w = pk2(s[6 * 65], s[7 * 65]);
        *(GAS v4u*)(it.WT + (size_t)(n0 + nn) * K + k0 + 8 * c) = o; }
    LDS_WAIT(); asm volatile("" ::: "memory");
}
__device__ __forceinline__ gcf p0_row_src(int m, gcf meta, gcf x_prompt, gcf x_sample) {
    if (m < ROWS_P) { const int b = m / LP, i = m - b * LP;
        if (i < FPAD) return nullptr;
        return (i < 128) ? meta + (size_t)(i - FPAD) * DM : x_prompt + ((size_t)b * SEQ + (i - 128)) * DM; }
    return x_sample + (size_t)(m - ROWS_P) * DM;
}
constexpr int P0R = 4;
__device__ __forceinline__ void p0_rows2(Frame& F, int m0, int mstep, gcf meta, gcf x_prompt, gcf x_sample, gcf norm_pre) {
    gcf src[P0R]; int mm[P0R];
#pragma unroll
    for (int q = 0; q < P0R; ++q) { mm[q] = m0 + q * mstep; src[q] = (mm[q] < MROWS) ? p0_row_src(mm[q], meta, x_prompt, x_sample) : nullptr; }
    f32x4 v[P0R][8];
#pragma unroll
    for (int q = 0; q < P0R; ++q)
#pragma unroll
        for (int j = 0; j < 8; ++j) v[q][j] = src[q] ? ((const GAS f32x4*)src[q])[F.lane + 64 * j] : (f32x4){0.f, 0.f, 0.f, 0.f};
#pragma unroll
    for (int q = 0; q < P0R; ++q) { if (mm[q] >= MROWS) continue;
        float s = 0.f;
#pragma unroll
        for (int j = 0; j < 8; ++j) s += (v[q][j].x * v[q][j].x + v[q][j].y * v[q][j].y) + (v[q][j].z * v[q][j].z + v[q][j].w * v[q][j].w);
        const float rstd = rsqrtf(wave_sum(s) * (1.f / DM) + EPSN);
        GAS unsigned long long* o8 = (GAS unsigned long long*)(F.XN() + (size_t)mm[q] * DM) + F.lane;
        if (src[q] == nullptr) { GAS unsigned long long* z8 = (GAS unsigned long long*)(F.MIX() + (size_t)mm[q] * DM) + F.lane;
#pragma unroll
            for (int j = 0; j < 8; ++j) z8[64 * j] = 0ull; }
#pragma unroll
        for (int j = 0; j < 8; ++j) { const f32x4 w = ((const GAS f32x4*)norm_pre)[F.lane + 64 * j];
            o8[64 * j] = (unsigned long long)pk2(v[q][j].x * rstd * w.x, v[q][j].y * rstd * w.y) | ((unsigned long long)pk2(v[q][j].z * rstd * w.z, v[q][j].w * rstd * w.w) << 32); } }
}
__device__ __forceinline__ void p0_prologue(Frame& F, int it_lo, int it_hi, int b_lo, int nb, bool with_rows) { gcf const w_in = ldarg<A_WIN>(); gcf const w_out = ldarg<A_WOUT>();
    LAS float* scr = (LAS float*)(F.lds + SCR_OFF + F.wave * 16640);
    const int gw = ((int)blockIdx.x - b_lo) * NWAVES + F.wave, NGW = nb * NWAVES;
    constexpr int I_IN = (DM / 64) * (NPAD / 64), I_OUT = (DM / 64) * (DM / 64);
    auto mk = [&](int it) { P0Item r; r.on = it < it_hi;
        if (it < I_IN) { r.W = w_in; r.WT = F.WinT(); r.N = NIN; r.kb = it / (NPAD / 64); r.nb = it % (NPAD / 64); }
        else { const int q = r.on ? it - I_IN : 0; r.W = w_out; r.WT = F.WoutT(); r.N = DM; r.kb = q / (DM / 64); r.nb = q % (DM / 64); }
        return r; };
    for (int it = it_lo + gw; it < it_hi; it += 2 * NGW) {
        const P0Item a = mk(it), b = mk(it + NGW);
        f32x4 va[16], vb[16];
        p0_item_load(a, DM, F.lane, va); p0_item_load(b, DM, F.lane, vb);
        p0_item_store(a, DM, F.lane, va, scr); p0_item_store(b, DM, F.lane, vb, scr);
    }
    if (with_rows) {
        gcf const meta = ldarg<A_META>(); gcf const x_prompt = ldarg<A_XP>(); gcf const x_sample = ldarg<A_XS>(); gcf const norm_pre = ldarg<A_NPRE>();
        for (int m = gw; m < MROWS; m += P0R * NGW) p0_rows2(F, m, NGW, meta, x_prompt, x_sample, norm_pre);
    }
}

constexpr int AKP = 72, APP = 168;
constexpr int A_K = 0, A_V = 272 * AKP * 2, A_BIAS = 2 * A_V, A_P = A_BIAS + 2048, A_END = A_P + NWAVES * 16 * APP * 2;
static_assert(A_END <= LDS_BYTES - SCR_OFF, "attention LDS");

struct AttnLds { const LAS unsigned short* AK; const LAS unsigned short* AV; const LAS float* AB; LAS unsigned short* AP; };
template <bool SAMPLE>
__device__ __forceinline__ void attn_tile(Frame& F, const AttnLds& L, const bf16x8 (&qa)[2], int s0, int kmin  ,
                                          int tb, int gb, size_t rowb, gcf sinks, int kvh) {
    int lane = F.lane; asm volatile("" : "+v"(lane));
    const int gq = lane >> 4, i = lane & 15;
    const LAS unsigned short* AK = L.AK; const LAS unsigned short* AV = L.AV; const LAS float* AB = L.AB; LAS unsigned short* AP = L.AP;
    size_t prow[2]; int pcol[2]; v4u gpre[2];
#pragma unroll
    for (int jj = 0; jj < 2; ++jj) { const int q = lane + 64 * jj, rr = q >> 3, ch = q & 7;
        prow[jj] = SAMPLE ? rowb + (rr & 7) : rowb + rr; pcol[jj] = kvh * 256 + (SAMPLE ? gb + (rr >> 3) : gb) * 64 + 8 * ch;
        gpre[jj] = *(const GAS v4u*)(F.P() + prow[jj] * NPAD + C_GA + pcol[jj]); }
    int trow[4], grow[4]; float sinkr[4];
#pragma unroll
    for (int r = 0; r < 4; ++r) { const int rr = 4 * gq + r; trow[r] = SAMPLE ? (rr & 7) : tb + rr; grow[r] = SAMPLE ? gb + (rr >> 3) : gb; sinkr[r] = sinks[kvh * 4 + grow[r]]; }
    f32x4 acc[10];
#pragma unroll
    for (int cb = 0; cb < 10; ++cb) { acc[cb] = (f32x4){0.f, 0.f, 0.f, 0.f};
#pragma unroll
        for (int ks = 0; ks < 2; ++ks) { const bf16x8 kb = *(const LAS bf16x8*)(AK + (s0 + 16 * cb + i) * AKP + 32 * ks + 8 * gq); acc[cb] = MFMA16(qa[ks], kb, acc[cb]); } }
    float mx[4] = {-INFINITY, -INFINITY, -INFINITY, -INFINITY};
#pragma unroll
    for (int cb = 0; cb < 10; ++cb) { const int s = s0 + 16 * cb + i;
#pragma unroll
        for (int r = 0; r < 4; ++r) { const int dist = 128 + trow[r] - s; const bool valid = (dist >= 0) && (dist < 128) && (s >= kmin);
            const int dc = dist < 0 ? 0 : (dist > 127 ? 127 : dist);
            const float v = valid ? acc[cb][r] * 0.125f + AB[grow[r] * 128 + dc] : -INFINITY; acc[cb][r] = v; mx[r] = fmaxf(mx[r], v); } }
    float inv[4];
#pragma unroll
    for (int r = 0; r < 4; ++r) { float m = mx[r];
        m = fmaxf(m, __shfl_xor(m, 1)); m = fmaxf(m, __shfl_xor(m, 2)); m = fmaxf(m, __shfl_xor(m, 4)); m = fmaxf(m, __shfl_xor(m, 8));
        m = fmaxf(m, sinkr[r]); float sum = 0.f;
#pragma unroll
        for (int cb = 0; cb < 10; ++cb) { const float e = __expf(acc[cb][r] - m); acc[cb][r] = e; sum += e; }
        sum += __shfl_xor(sum, 1); sum += __shfl_xor(sum, 2); sum += __shfl_xor(sum, 4); sum += __shfl_xor(sum, 8);
        inv[r] = 1.f / (sum + __expf(sinkr[r] - m)); }
#pragma unroll
    for (int cb = 0; cb < 10; ++cb)
#pragma unroll
        for (int r = 0; r < 4; ++r) AP[(4 * gq + r) * APP + 16 * cb + i] = f2bf16(acc[cb][r]);
    LDS_WAIT(); asm volatile("" ::: "memory");
    f32x4 o[4];
#pragma unroll
    for (int db = 0; db < 4; ++db) o[db] = (f32x4){0.f, 0.f, 0.f, 0.f};
#pragma unroll
    for (int kk = 0; kk < 5; ++kk) { const bf16x8 pa = *(const LAS bf16x8*)(AP + i * APP + 32 * kk + 8 * gq);
#pragma unroll
        for (int db = 0; db < 4; ++db) { const bf16x8 vb = tr_frag(AV, s0 + 32 * kk + 8 * gq, 16 * db, AKP, lane); o[db] = MFMA16(pa, vb, o[db]); } }
    LDS_WAIT(); asm volatile("" ::: "memory");
#pragma unroll
    for (int r = 0; r < 4; ++r)
#pragma unroll
        for (int db = 0; db < 4; ++db) AP[(4 * gq + r) * APP + 16 * db + i] = f2bf16(o[db][r] * inv[r]);
    LDS_WAIT(); asm volatile("" ::: "memory");
#pragma unroll
    for (int jj = 0; jj < 2; ++jj) { const int q = lane + 64 * jj, rr = q >> 3, ch = q & 7;
        const v4u ov = *(const LAS v4u*)(AP + rr * APP + 8 * ch); const v4u gv = gpre[jj];
        v4u res;
        res.x = pk2(bf2f(ov.x & 0xffff) * silu_f(bf2f(gv.x & 0xffff)), bf2f(ov.x >> 16) * silu_f(bf2f(gv.x >> 16)));
        res.y = pk2(bf2f(ov.y & 0xffff) * silu_f(bf2f(gv.y & 0xffff)), bf2f(ov.y >> 16) * silu_f(bf2f(gv.y >> 16)));
        res.z = pk2(bf2f(ov.z & 0xffff) * silu_f(bf2f(gv.z & 0xffff)), bf2f(ov.z >> 16) * silu_f(bf2f(gv.z >> 16)));
        res.w = pk2(bf2f(ov.w & 0xffff) * silu_f(bf2f(gv.w & 0xffff)), bf2f(ov.w >> 16) * silu_f(bf2f(gv.w >> 16)));
        *(GAS v4u*)(F.MIX() + prow[jj] * DM + pcol[jj]) = res; }
    LDS_WAIT(); asm volatile("" ::: "memory");
}

__device__ __forceinline__ void attn_bias_table(Frame& F, LAS float* AB, int kvh) { gcf const rel_bias = ldarg<A_RELB>();
    const int g = F.tid >> 7, d = F.tid & 127;
    int bk = d;
    if (d >= 16) { bk = 16 + (int)(__logf((float)d * (1.f / 16.f)) * (16.f / 2.0794415416798357f)); bk = bk > 31 ? 31 : bk; }
    AB[g * 128 + d] = rel_bias[bk * 16 + kvh * 4 + g];
}

__device__ __forceinline__ void attn_prompt_unit(Frame& F0, LAS unsigned char* scr, int b, int n, int kvh) { Frame F = F0; asm volatile("" : "+v"(F.tid), "+v"(F.lane));     gcf const sinks = ldarg<A_SINK>();
    LAS unsigned short* AK = (LAS unsigned short*)(scr + A_K); LAS unsigned short* AV = (LAS unsigned short*)(scr + A_V);
    __syncthreads();
    const long wrow0 = (long)b * LP + 128 * (n - 1);
#pragma unroll
    for (int j = 0; j < 4; ++j) { const int c = F.tid + 512 * j, row = c >> 3, ch = c & 7; const long gr = wrow0 + row;
        v4u kv = (v4u){0u, 0u, 0u, 0u}, vv = kv;
        if (gr >= 0) { const bf16* p = F.P() + (size_t)gr * NPAD + kvh * 64 + 8 * ch; kv = *(const GAS v4u*)(p + C_KA); vv = *(const GAS v4u*)(p + C_VA); }
        *(LAS v4u*)(AK + row * AKP + 8 * ch) = kv; *(LAS v4u*)(AV + row * AKP + 8 * ch) = vv; }
    if (F.tid < 128) { const int row = 256 + (F.tid >> 3), ch = F.tid & 7; *(LAS v4u*)(AK + row * AKP + 8 * ch) = (v4u){0u, 0u, 0u, 0u}; *(LAS v4u*)(AV + row * AKP + 8 * ch) = (v4u){0u, 0u, 0u, 0u}; }
    attn_bias_table(F, (LAS float*)(scr + A_BIAS), kvh);
    __syncthreads();
    const AttnLds L{AK, AV, (const LAS float*)(scr + A_BIAS), (LAS unsigned short*)(scr + A_P) + F.wave * 16 * APP};
    const int gq = F.lane >> 4, i = F.lane & 15, t0 = (n == 0) ? 112 : 16 * F.wave;
    const int kmin = FPAD - 128 * (n - 1);
    const size_t rbase = (size_t)b * LP + 128 * n;
    const int g_lo = (n == 0) ? F.wave : 0, g_hi = (n == 0) ? (F.wave < 4 ? F.wave + 1 : 0) : 4;
    bf16x8 qn[2] = {(bf16x8){0, 0, 0, 0, 0, 0, 0, 0}, (bf16x8){0, 0, 0, 0, 0, 0, 0, 0}};
    if (g_lo < g_hi) { const bf16* qp = F.P() + (rbase + t0 + i) * NPAD + C_QA + (kvh * 4 + g_lo) * 64; qn[0] = *(const GAS bf16x8*)(qp + 8 * gq); qn[1] = *(const GAS bf16x8*)(qp + 32 + 8 * gq); }
#pragma unroll 1
    for (int g = g_lo; g < g_hi; ++g) {
        const bf16x8 qa[2] = {qn[0], qn[1]};
        if (g + 1 < g_hi) { const bf16* qp = F.P() + (rbase + t0 + i) * NPAD + C_QA + (kvh * 4 + g + 1) * 64; qn[0] = *(const GAS bf16x8*)(qp + 8 * gq); qn[1] = *(const GAS bf16x8*)(qp + 32 + 8 * gq); }
        attn_tile<false>(F, L, qa, t0, kmin, t0, g, rbase + t0, sinks, kvh);
    }
    if (n == NBLK - 1) {
#pragma unroll
        for (int j = 0; j < 16; ++j) { const int e = F.tid + 512 * j, row = e >> 6, d = e & 63;
            const size_t oidx = (((size_t)b * WIN + row) * 4 + kvh) * 64 + d;
            F.out[O_KWP + oidx] = bf2f(AK[(128 + row) * AKP + d]); F.out[O_VWP + oidx] = bf2f(AV[(128 + row) * AKP + d]); }
    }
}

__device__ __forceinline__ void attn_sample_stage(Frame& F, LAS unsigned short* AK, LAS unsigned short* AV, int db, int kvh, gcf cache_k, gcf cache_v) {
#pragma unroll
    for (int j = 0; j < 4; ++j) { const int c = F.tid + 512 * j, row = c >> 4, ch = c & 15;
        const size_t src = (((size_t)db * WIN + row) * 4 + kvh) * 64 + 4 * ch;
        const f32x4 kv = *(const GAS f32x4*)(cache_k + src), vv = *(const GAS f32x4*)(cache_v + src);
        *(LAS unsigned long long*)(AK + row * AKP + 4 * ch) = (unsigned long long)pk2(kv.x, kv.y) | ((unsigned long long)pk2(kv.z, kv.w) << 32);
        *(LAS unsigned long long*)(AV + row * AKP + 4 * ch) = (unsigned long long)pk2(vv.x, vv.y) | ((unsigned long long)pk2(vv.z, vv.w) << 32);
        if (row >= DSEQ) { const size_t dst = (((size_t)db * WIN + row - DSEQ) * 4 + kvh) * 64 + 4 * ch; *(GAS f32x4*)(F.out + O_KWS + dst) = kv; *(GAS f32x4*)(F.out + O_VWS + dst) = vv; } }
    const size_t srow0 = (size_t)ROWS_P + (size_t)db * DSEQ;
    if (F.tid < 64) { const int t = F.tid >> 3, ch = F.tid & 7; const bf16* p = F.P() + (srow0 + t) * NPAD + kvh * 64 + 8 * ch;
        const v4u kv = *(const GAS v4u*)(p + C_KA), vv = *(const GAS v4u*)(p + C_VA);
        *(LAS v4u*)(AK + (128 + t) * AKP + 8 * ch) = kv; *(LAS v4u*)(AV + (128 + t) * AKP + 8 * ch) = vv;
        const size_t dst = (((size_t)db * WIN + (WIN - DSEQ) + t) * 4 + kvh) * 64 + 8 * ch;
        f32x4 a, c2; a.x = bf2f(kv.x & 0xffff); a.y = bf2f(kv.x >> 16); a.z = bf2f(kv.y & 0xffff); a.w = bf2f(kv.y >> 16); c2.x = bf2f(kv.z & 0xffff); c2.y = bf2f(kv.z >> 16); c2.z = bf2f(kv.w & 0xffff); c2.w = bf2f(kv.w >> 16);
        *(GAS f32x4*)(F.out + O_KWS + dst) = a; *(GAS f32x4*)(F.out + O_KWS + dst + 4) = c2;
        a.x = bf2f(vv.x & 0xffff); a.y = bf2f(vv.x >> 16); a.z = bf2f(vv.y & 0xffff); a.w = bf2f(vv.y >> 16); c2.x = bf2f(vv.z & 0xffff); c2.y = bf2f(vv.z >> 16); c2.z = bf2f(vv.w & 0xffff); c2.w = bf2f(vv.w >> 16);
        *(GAS f32x4*)(F.out + O_VWS + dst) = a; *(GAS f32x4*)(F.out + O_VWS + dst + 4) = c2; }
    if (F.tid >= 64 && F.tid < 64 + 192) { const int c = F.tid - 64, row = 136 + (c >> 3), ch = c & 7; *(LAS v4u*)(AK + row * AKP + 8 * ch) = (v4u){0u, 0u, 0u, 0u}; *(LAS v4u*)(AV + row * AKP + 8 * ch) = (v4u){0u, 0u, 0u, 0u}; }
}
__device__ __forceinline__ void attn_sample_tiles(Frame& F, const AttnLds& L, int db, int kvh, int wl, gcf sinks) {
    const int gq = F.lane >> 4, i = F.lane & 15; const size_t srow0 = (size_t)ROWS_P + (size_t)db * DSEQ;
    const bf16* qptr = F.P() + (srow0 + (i & 7)) * NPAD + C_QA + (kvh * 4 + 2 * wl + (i >> 3)) * 64;
    const bf16x8 qa[2] = {*(const GAS bf16x8*)(qptr + 8 * gq), *(const GAS bf16x8*)(qptr + 32 + 8 * gq)};
    attn_tile<true>(F, L, qa, 0, 0, 0, 2 * wl, srow0, sinks, kvh);
}
__device__ __forceinline__ void attn_sample_unit(Frame& F0, LAS unsigned char* scr, int u) { Frame F = F0; asm volatile("" : "+v"(F.tid), "+v"(F.lane));
    gcf const cache_k = ldarg<A_CK>(); gcf const cache_v = ldarg<A_CV>(); gcf const sinks = ldarg<A_SINK>();
    const int kvh = u & 3, db = u >> 2;
    LAS unsigned short* AK = (LAS unsigned short*)(scr + A_K); LAS unsigned short* AV = (LAS unsigned short*)(scr + A_V);
    __syncthreads();
    attn_sample_stage(F, AK, AV, db, kvh, cache_k, cache_v);
    attn_bias_table(F, (LAS float*)(scr + A_BIAS), kvh);
    __syncthreads();
    if (F.wave < 2) { const AttnLds L{AK, AV, (const LAS float*)(scr + A_BIAS), (LAS unsigned short*)(scr + A_P) + F.wave * 16 * APP}; attn_sample_tiles(F, L, db, kvh, F.wave, sinks); }
}
constexpr int SP_SLOT = 160 * AKP * 2, SP_BIAS = 4 * SP_SLOT, SP_P = SP_BIAS + 2048, SP_END = SP_P + 4 * 16 * APP * 2;
static_assert(SP_END <= LDS_BYTES - SCR_OFF, "sample pair LDS");
__device__ __forceinline__ void attn_sample_pair(Frame& F0, LAS unsigned char* scr, int u0, int u1) { Frame F = F0; asm volatile("" : "+v"(F.tid), "+v"(F.lane));
    gcf const cache_k = ldarg<A_CK>(); gcf const cache_v = ldarg<A_CV>(); gcf const sinks = ldarg<A_SINK>();
    const int kvh = u0 & 3;
    LAS unsigned short* K0 = (LAS unsigned short*)(scr); LAS unsigned short* V0 = (LAS unsigned short*)(scr + SP_SLOT);
    LAS unsigned short* K1 = (LAS unsigned short*)(scr + 2 * SP_SLOT); LAS unsigned short* V1 = (LAS unsigned short*)(scr + 3 * SP_SLOT);
    __syncthreads();
    attn_sample_stage(F, K0, V0, u0 >> 2, kvh, cache_k, cache_v);
    attn_sample_stage(F, K1, V1, u1 >> 2, kvh, cache_k, cache_v);
    attn_bias_table(F, (LAS float*)(scr + SP_BIAS), kvh);
    __syncthreads();
    if (F.wave < 4) { const int sl = F.wave >> 1;
        const AttnLds L{sl ? K1 : K0, sl ? V1 : V0, (const LAS float*)(scr + SP_BIAS), (LAS unsigned short*)(scr + SP_P) + F.wave * 16 * APP};
        attn_sample_tiles(F, L, (sl ? u1 : u0) >> 2, kvh, F.wave & 1, sinks); }
}

constexpr int GQP = 136, GVP = 264;
constexpr int G_Q = 0, G_K = 128 * GQP * 2, G_V = 2 * G_K, G_Z = G_V + 128 * GVP * 2, G_TOT = G_Z + 8192, G_D = G_TOT + 2048, G_END = G_D + 512;
static_assert(G_END <= LDS_BYTES - SCR_OFF, "GLA LDS");

template <bool NEED_Q>
__device__ __forceinline__ void gla_gate(Frame& F, LAS unsigned char* scr, int b, int c, int h) { gcf const w_a2 = ldarg<A_WA2>(); gcf const b_a = ldarg<A_BA>();
    LAS unsigned short* GQ = (LAS unsigned short*)(scr + G_Q); LAS unsigned short* GK = (LAS unsigned short*)(scr + G_K); LAS unsigned short* GV = (LAS unsigned short*)(scr + G_V);
    LAS float* GD = (LAS float*)(scr + G_D);
    const size_t R0 = (size_t)b * LP + 128 * c;
    const int lane = F.lane, gq = lane >> 4, i = lane & 15, w = F.wave;
    __syncthreads();
    bf16x8 za[8]; bf16x8 wh, wl; float ba;
    {
        v4u vv[8], kk[4], qq[4];
#pragma unroll
        for (int j = 0; j < 8; ++j) { const int cc = F.tid + 512 * j, row = cc >> 5, ch = cc & 31; vv[j] = *(const GAS v4u*)(F.P() + (R0 + row) * NPAD + C_VG + h * 256 + 8 * ch); }
#pragma unroll
        for (int j = 0; j < 4; ++j) { const int cc = F.tid + 512 * j, row = cc >> 4, ch = cc & 15; const bf16* p = F.P() + (R0 + row) * NPAD + h * 128 + 8 * ch;
            kk[j] = *(const GAS v4u*)(p + C_KG); if (NEED_Q) qq[j] = *(const GAS v4u*)(p + C_QG); }
#pragma unroll
        for (int tb = 0; tb < 8; ++tb) za[tb] = (gq < 2) ? *(const GAS bf16x8*)(F.P() + (R0 + 16 * tb + i) * NPAD + C_ZG + 8 * gq) : (bf16x8){0, 0, 0, 0, 0, 0, 0, 0};
#pragma unroll
        for (int j = 0; j < 8; ++j) { const float wv = (gq < 2) ? w_a2[(8 * gq + j) * 512 + h * 128 + 16 * w + i] : 0.f; const unsigned short hi = f2bf16(wv); wh[j] = (short)hi; wl[j] = (short)f2bf16(wv - bf2f(hi)); }
        ba = b_a[h * 128 + 16 * w + i];
#pragma unroll
        for (int j = 0; j < 8; ++j) { const int cc = F.tid + 512 * j, row = cc >> 5, ch = cc & 31; *(LAS v4u*)(GV + row * GVP + 8 * ch) = vv[j]; }
#pragma unroll
        for (int j = 0; j < 4; ++j) { const int cc = F.tid + 512 * j, row = cc >> 4, ch = cc & 15; *(LAS v4u*)(GK + row * GQP + 8 * ch) = kk[j]; if (NEED_Q) *(LAS v4u*)(GQ + row * GQP + 8 * ch) = qq[j]; }
    }
    f32x4 bc[8]; float run = 0.f;
#pragma unroll
    for (int tb = 0; tb < 8; ++tb) { f32x4 x = (f32x4){ba, ba, ba, ba}; x = MFMA16(za[tb], wh, x); x = MFMA16(za[tb], wl, x);
        float l0 = logsig_f(x[0]) * (1.f / 16.f), l1 = logsig_f(x[1]) * (1.f / 16.f), l2 = logsig_f(x[2]) * (1.f / 16.f), l3 = logsig_f(x[3]) * (1.f / 16.f);
        if (c == 0) { const int t0 = 16 * tb + 4 * gq; if (t0 + 0 < FPAD) l0 = 0.f; if (t0 + 1 < FPAD) l1 = 0.f; if (t0 + 2 < FPAD) l2 = 0.f; if (t0 + 3 < FPAD) l3 = 0.f; }
        const float p0 = l0, p1 = p0 + l1, p2 = p1 + l2, p3 = p2 + l3;
        float a = p3; const float u1 = __shfl_up(a, 16); if (gq >= 1) a += u1; const float u2 = __shfl_up(a, 32); if (gq >= 2) a += u2;
        const float excl = a - p3, tot = __shfl(a, 48 + i);
        bc[tb] = (f32x4){run + excl + p0, run + excl + p1, run + excl + p2, run + excl + p3}; run += tot; }
    __syncthreads();
#pragma unroll
    for (int tb = 0; tb < 8; ++tb)
#pragma unroll
        for (int r = 0; r < 4; ++r) { const int t = 16 * tb + 4 * gq + r, k = 16 * w + i; const float bt = bc[tb][r];
            GK[t * GQP + k] = f2bf16(bf2f(GK[t * GQP + k]) * __expf(-bt));
            if (NEED_Q) GQ[t * GQP + k] = f2bf16(bf2f(GQ[t * GQP + k]) * __expf(bt) * 0.08838834764831845f); }
    if (gq == 0) GD[16 * w + i] = __expf(run);
    __syncthreads();
}

__device__ __forceinline__ void gla_ds_unit(Frame& F0, LAS unsigned char* scr, int b, int c, int h) { Frame F = F0; asm volatile("" : "+v"(F.tid), "+v"(F.lane));
    const int u = (b * NBLK + c) * 4 + h;
    gla_gate<false>(F, scr, b, c, h);
    const LAS unsigned short* GK = (const LAS unsigned short*)(scr + G_K); const LAS unsigned short* GV = (const LAS unsigned short*)(scr + G_V); const LAS float* GD = (const LAS float*)(scr + G_D);
    int lane = F.lane; asm volatile("" : "+v"(lane));
    const int gq = lane >> 4, i = lane & 15, w = F.wave;
    f32x4 acc[8][2];
#pragma unroll
    for (int rb = 0; rb < 8; ++rb) { acc[rb][0] = (f32x4){0.f, 0.f, 0.f, 0.f}; acc[rb][1] = (f32x4){0.f, 0.f, 0.f, 0.f}; }
#pragma unroll
    for (int ks = 0; ks < 4; ++ks) {
        if (c == 0 && ks < 3) continue;
        const bf16x8 vb0 = tr_frag(GV, 32 * ks + 8 * gq, 32 * w, GVP, lane), vb1 = tr_frag(GV, 32 * ks + 8 * gq, 32 * w + 16, GVP, lane);
#pragma unroll
        for (int rb = 0; rb < 8; ++rb) { const bf16x8 ka = tr_frag(GK, 32 * ks + 8 * gq, 16 * rb, GQP, lane); acc[rb][0] = MFMA16(ka, vb0, acc[rb][0]); acc[rb][1] = MFMA16(ka, vb1, acc[rb][1]); } }
    float* dst = F.dST() + (size_t)u * 32768;
#pragma unroll
    for (int rb = 0; rb < 8; ++rb) { const f32x4 d4 = *(const LAS f32x4*)(GD + 16 * rb + 4 * gq);
#pragma unroll
        for (int cb = 0; cb < 2; ++cb) *(GAS f32x4*)(dst + (size_t)(32 * w + 16 * cb + i) * 128 + 16 * rb + 4 * gq) = acc[rb][cb] * d4; }
    if (F.tid < 128) F.dec()[(size_t)u * 128 + F.tid] = GD[F.tid];
}

__device__ __forceinline__ void gla_scan(Frame& F) {
    for (int e = blockIdx.x * NTHREADS + F.tid; e < NBATCH * 4 * 256 * 64; e += F.G * NTHREADS) {
        const int k2 = e & 63, v = (e >> 6) & 255, bh = e >> 14, b = bh >> 2, h = bh & 3;
        float s0 = 0.f, s1 = 0.f;
#pragma unroll 1
        for (int c0 = 0; c0 < NBLK; c0 += 11) {
            f32x2 d[11], ds[11];
#pragma unroll
            for (int q = 0; q < 11; ++q) { const size_t u = ((size_t)b * NBLK + c0 + q) * 4 + h;
                d[q] = *(const GAS f32x2*)(F.dec() + u * 128 + 2 * k2); ds[q] = *(const GAS f32x2*)(F.dST() + u * 32768 + (size_t)v * 128 + 2 * k2); }
#pragma unroll
            for (int q = 0; q < 11; ++q) { const size_t u = ((size_t)b * NBLK + c0 + q) * 4 + h;
                *(GAS unsigned*)(F.St() + u * 32768 + (size_t)v * 128 + 2 * k2) = pk2(s0, s1);
                s0 = d[q].x * s0 + ds[q].x; s1 = d[q].y * s1 + ds[q].y; }
        }
        float* gp = F.out + O_GP + ((size_t)bh * 128 + 2 * k2) * 256 + v; gp[0] = s0; gp[256] = s1;
    }
}

__device__ __forceinline__ void gla_out_unit(Frame& F0, LAS unsigned char* scr, int b, int c, int h) { Frame F = F0; asm volatile("" : "+v"(F.tid), "+v"(F.lane)); gcf const gla_norm = ldarg<A_GNORM>();
    const int u = (b * NBLK + c) * 4 + h;
    const bf16* St = F.St() + (size_t)u * 32768; const size_t R0 = (size_t)b * LP + 128 * c;
    v4u stp[8], gvp[8];
#pragma unroll
    for (int j = 0; j < 8; ++j) { const int cc = F.tid + 512 * j; stp[j] = (c != 0) ? *(const GAS v4u*)(St + (size_t)(cc >> 4) * 128 + 8 * (cc & 15)) : (v4u){0u, 0u, 0u, 0u}; }
#pragma unroll
    for (int j = 0; j < 8; ++j) { const int q = F.lane + 64 * j, row = 16 * F.wave + (q >> 5), ch = q & 31; gvp[j] = *(const GAS v4u*)(F.P() + (R0 + row) * NPAD + C_GG + h * 256 + 8 * ch); }
    gla_gate<true>(F, scr, b, c, h);
    const LAS unsigned short* GQ = (const LAS unsigned short*)(scr + G_Q); LAS unsigned short* GK = (LAS unsigned short*)(scr + G_K); const LAS unsigned short* GV = (const LAS unsigned short*)(scr + G_V);
    int lane = F.lane; asm volatile("" : "+v"(lane));
    const int gq = lane >> 4, i = lane & 15, w = F.wave;
    const bool active = true;
    bf16x8 qa[4];
#pragma unroll
    for (int ks = 0; ks < 4; ++ks) qa[ks] = *(const LAS bf16x8*)(GQ + (16 * w + i) * GQP + 32 * ks + 8 * gq);
    f32x4 aa[8];
#pragma unroll
    for (int sb = 0; sb < 8; ++sb) { aa[sb] = (f32x4){0.f, 0.f, 0.f, 0.f};
        if (active && sb <= w) {
#pragma unroll
            for (int ks = 0; ks < 4; ++ks) { const bf16x8 kb = *(const LAS bf16x8*)(GK + (16 * sb + i) * GQP + 32 * ks + 8 * gq); aa[sb] = MFMA16(qa[ks], kb, aa[sb]); } } }
    __syncthreads();
    f32x4 acc[16];
#pragma unroll
    for (int cb = 0; cb < 16; ++cb) acc[cb] = (f32x4){0.f, 0.f, 0.f, 0.f};
    if (active) {
#pragma unroll
    for (int sb = 0; sb < 8; ++sb)
#pragma unroll
        for (int r = 0; r < 4; ++r) { const int t = 16 * w + 4 * gq + r, s = 16 * sb + i; GK[t * GQP + s] = f2bf16(s <= t ? aa[sb][r] : 0.f); }
    LDS_WAIT(); asm volatile("" ::: "memory");
#pragma unroll
    for (int ks = 0; ks < 4; ++ks) {
        if (2 * ks <= w) {
            const bf16x8 af = *(const LAS bf16x8*)(GK + (16 * w + i) * GQP + 32 * ks + 8 * gq);
#pragma unroll
            for (int cb = 0; cb < 16; ++cb) { const bf16x8 vb = tr_frag(GV, 32 * ks + 8 * gq, 16 * cb, GVP, lane); acc[cb] = MFMA16(af, vb, acc[cb]); } } }
    }
    __syncthreads();
    { LAS unsigned char* GS = scr + G_V;
#pragma unroll
      for (int j = 0; j < 8; ++j) { const int cc = F.tid + 512 * j, v = cc >> 4, ch = cc & 15; *(LAS v4u*)(GS + v * 256 + ((ch ^ (v & 15)) << 4)) = stp[j]; } }
    __syncthreads();
    if (active) {
    if (c != 0) {
        const LAS unsigned char* GS = scr + G_V;
#pragma unroll
    for (int ks = 0; ks < 4; ++ks)
#pragma unroll
        for (int cb = 0; cb < 16; ++cb) { const bf16x8 sb = *(const LAS bf16x8*)(GS + (16 * cb + i) * 256 + (((4 * ks + gq) ^ i) << 4)); acc[cb] = MFMA16(qa[ks], sb, acc[cb]); }
    }
    LDS_WAIT(); asm volatile("" ::: "memory");
    { LAS unsigned short* GQw = (LAS unsigned short*)(scr + G_Q);
#pragma unroll
    for (int r = 0; r < 4; ++r) { float ss = 0.f;
#pragma unroll
        for (int cb = 0; cb < 16; ++cb) ss += acc[cb][r] * acc[cb][r];
        ss += __shfl_xor(ss, 1); ss += __shfl_xor(ss, 2); ss += __shfl_xor(ss, 4); ss += __shfl_xor(ss, 8);
        const float rstd = rsqrtf(ss * (1.f / 256.f) + EPSN); const int row = 16 * w + 4 * gq + r;
#pragma unroll
        for (int cb = 0; cb < 8; ++cb) { GQw[row * GQP + 16 * cb + i] = f2bf16(acc[cb][r] * rstd); GK[row * GQP + 16 * cb + i] = f2bf16(acc[cb + 8][r] * rstd); } }
    LDS_WAIT(); asm volatile("" ::: "memory");
#pragma unroll
    for (int j = 0; j < 8; ++j) { const int q = lane + 64 * j, row = 16 * w + (q >> 5), ch = q & 31;
        const v4u ov = *(const LAS v4u*)((ch < 16 ? GQw : GK) + row * GQP + 8 * (ch & 15));
        const v4u gv = gvp[j];
        const f32x4 n0 = *(const GAS f32x4*)(gla_norm + 8 * ch), n1 = *(const GAS f32x4*)(gla_norm + 8 * ch + 4);
        v4u res;
        res.x = pk2(bf2f(ov.x & 0xffff) * n0.x * silu_f(bf2f(gv.x & 0xffff)), bf2f(ov.x >> 16) * n0.y * silu_f(bf2f(gv.x >> 16)));
        res.y = pk2(bf2f(ov.y & 0xffff) * n0.z * silu_f(bf2f(gv.y & 0xffff)), bf2f(ov.y >> 16) * n0.w * silu_f(bf2f(gv.y >> 16)));
        res.z = pk2(bf2f(ov.z & 0xffff) * n1.x * silu_f(bf2f(gv.z & 0xffff)), bf2f(ov.z >> 16) * n1.y * silu_f(bf2f(gv.z >> 16)));
        res.w = pk2(bf2f(ov.w & 0xffff) * n1.z * silu_f(bf2f(gv.w & 0xffff)), bf2f(ov.w >> 16) * n1.w * silu_f(bf2f(gv.w >> 16)));
        *(GAS v4u*)(F.MIX() + (R0 + row) * DM + 1024 + h * 256 + 8 * ch) = res; } }
    }
}

constexpr int S_Q = 0, S_KH = 4096, S_KT = 8192, S_LG = 12288, S_D = 16384, S_A = 16896, S_Z = 17152, S_OP = 17664, S_END = S_OP + 65536;
static_assert(S_END <= LDS_BYTES - SCR_OFF, "sample GLA LDS");
__device__ __forceinline__ void gla_sample_unit(Frame& F0, LAS unsigned char* scr, int u) { Frame F = F0; asm volatile("" : "+v"(F.tid), "+v"(F.lane));
    gcf const w_a2 = ldarg<A_WA2>(); gcf const b_a = ldarg<A_BA>(); gcf const state = ldarg<A_STATE>(); gcf const gla_norm = ldarg<A_GNORM>();
    const int h = u & 3, db = u >> 2;
    LAS float* SQ = (LAS float*)(scr + S_Q); LAS float* SKH = (LAS float*)(scr + S_KH); LAS float* SKT = (LAS float*)(scr + S_KT); LAS float* SLG = (LAS float*)(scr + S_LG); LAS float* SD = (LAS float*)(scr + S_D);
    LAS float* SA = (LAS float*)(scr + S_A); LAS float* SZ = (LAS float*)(scr + S_Z); LAS float* SOP = (LAS float*)(scr + S_OP);
    const size_t R0 = (size_t)ROWS_P + (size_t)db * DSEQ;
    const int w = F.wave, lane = F.lane;
    f32x4 st[16];
    { const GAS f32x4* sp = (const GAS f32x4*)(state + ((size_t)u * 128 + 16 * w) * 256) + lane;
#pragma unroll
      for (int kk = 0; kk < 16; ++kk) st[kk] = sp[64 * kk]; }
    __syncthreads();
    if (F.tid < 128) SZ[F.tid] = bf2f(F.P()[(R0 + (F.tid >> 4)) * NPAD + C_ZG + (F.tid & 15)]);
    const int k = F.tid & 127, tp = F.tid >> 7;
    float qv[2], kv[2], wv[16];
#pragma unroll
    for (int q = 0; q < 2; ++q) { const bf16* p = F.P() + (R0 + 2 * tp + q) * NPAD + h * 128 + k; qv[q] = bf2f(p[C_QG]); kv[q] = bf2f(p[C_KG]); }
#pragma unroll
    for (int r = 0; r < 16; ++r) wv[r] = w_a2[r * 512 + h * 128 + k];
    const float ba = b_a[h * 128 + k];
    __syncthreads();
#pragma unroll
    for (int q = 0; q < 2; ++q) { const int t = 2 * tp + q; float x = ba;
#pragma unroll
        for (int r = 0; r < 16; ++r) x += SZ[t * 16 + r] * wv[r];
        SLG[t * 128 + k] = logsig_f(x) * (1.f / 16.f); }
    __syncthreads();
    { float run = 0.f, bt[2] = {0.f, 0.f};
#pragma unroll
      for (int t = 0; t < 8; ++t) { run += SLG[t * 128 + k]; if (t == 2 * tp) bt[0] = run; if (t == 2 * tp + 1) bt[1] = run; }
#pragma unroll
      for (int q = 0; q < 2; ++q) { const int t = 2 * tp + q;
          SQ[k * 8 + t] = qv[q] * __expf(bt[q]) * 0.08838834764831845f; SKT[k * 8 + t] = kv[q] * __expf(-bt[q]); SKH[k * 8 + t] = kv[q] * __expf(run - bt[q]); }
      if (tp == 0) SD[k] = __expf(run); }
    __syncthreads();
    if (F.tid < 64) { const int t = F.tid >> 3, s2 = F.tid & 7; float a = 0.f;
        if (s2 <= t) { for (int kk = 0; kk < 128; ++kk) a += SQ[kk * 8 + t] * SKT[kk * 8 + s2]; }
        SA[t * 8 + s2] = a; }
    {   f32x4 vv[8], op[8];
#pragma unroll
        for (int t = 0; t < 8; ++t) { const unsigned long long pv = *(const GAS unsigned long long*)(F.P() + (R0 + t) * NPAD + C_VG + h * 256 + 4 * lane);
            vv[t] = (f32x4){bf2f((unsigned short)pv), bf2f((unsigned short)(pv >> 16)), bf2f((unsigned short)(pv >> 32)), bf2f((unsigned short)(pv >> 48))}; op[t] = (f32x4){0.f, 0.f, 0.f, 0.f}; }
        GAS f32x4* np = (GAS f32x4*)(F.out + O_GS + ((size_t)u * 128 + 16 * w) * 256) + lane;
#pragma unroll
        for (int kk = 0; kk < 16; ++kk) { const int kc = 16 * w + kk; const f32x4 s0 = st[kk];
            const f32x4 q0 = *(const LAS f32x4*)(SQ + kc * 8), q1 = *(const LAS f32x4*)(SQ + kc * 8 + 4), h0 = *(const LAS f32x4*)(SKH + kc * 8), h1 = *(const LAS f32x4*)(SKH + kc * 8 + 4);
            f32x4 sn = s0 * SD[kc];
            sn += vv[0] * h0.x + vv[1] * h0.y + vv[2] * h0.z + vv[3] * h0.w + vv[4] * h1.x + vv[5] * h1.y + vv[6] * h1.z + vv[7] * h1.w;
            np[64 * kk] = sn;
            op[0] += s0 * q0.x; op[1] += s0 * q0.y; op[2] += s0 * q0.z; op[3] += s0 * q0.w; op[4] += s0 * q1.x; op[5] += s0 * q1.y; op[6] += s0 * q1.z; op[7] += s0 * q1.w; }
#pragma unroll
        for (int t = 0; t < 8; ++t) *(LAS f32x4*)(SOP + (w * 8 + t) * 256 + 4 * lane) = op[t];
    }
    __syncthreads();
    {   const int t = w; f32x4 a = (f32x4){0.f, 0.f, 0.f, 0.f};
#pragma unroll
        for (int w2 = 0; w2 < 8; ++w2) a += *(const LAS f32x4*)(SOP + (w2 * 8 + t) * 256 + 4 * lane);
        for (int s2 = 0; s2 <= t; ++s2) { const unsigned long long pv = *(const GAS unsigned long long*)(F.P() + (R0 + s2) * NPAD + C_VG + h * 256 + 4 * lane); const float c = SA[t * 8 + s2];
            a += (f32x4){bf2f((unsigned short)pv), bf2f((unsigned short)(pv >> 16)), bf2f((unsigned short)(pv >> 32)), bf2f((unsigned short)(pv >> 48))} * c; }
        const float ss = (a.x * a.x + a.y * a.y) + (a.z * a.z + a.w * a.w);
        const float rstd = rsqrtf(wave_sum(ss) * (1.f / 256.f) + EPSN);
        const unsigned long long gv = *(const GAS unsigned long long*)(F.P() + (R0 + t) * NPAD + C_GG + h * 256 + 4 * lane); const f32x4 gn = *(const GAS f32x4*)(gla_norm + 4 * lane);
        const float g0 = bf2f((unsigned short)gv), g1 = bf2f((unsigned short)(gv >> 16)), g2 = bf2f((unsigned short)(gv >> 32)), g3 = bf2f((unsigned short)(gv >> 48));
        *(GAS unsigned long long*)(F.MIX() + (R0 + t) * DM + 1024 + h * 256 + 4 * lane) =
            (unsigned long long)pk2(a.x * rstd * gn.x * silu_f(g0), a.y * rstd * gn.y * silu_f(g1)) | ((unsigned long long)pk2(a.z * rstd * gn.z * silu_f(g2), a.w * rstd * gn.w * silu_f(g3)) << 32);
    }
}

__device__ __forceinline__ void final_rows(Frame& F) { gcf const x_prompt = ldarg<A_XP>(); gcf const x_sample = ldarg<A_XS>(); gcf const norm_post = ldarg<A_NPOST>();
    const int gw = blockIdx.x * NWAVES + F.wave, NGW = F.G * NWAVES; constexpr int NR = NBATCH * SEQ + ROWS_S;
    for (int idx0 = gw; idx0 < NR; idx0 += 2 * NGW) {
        f32x4 v[2][8], xx[2][8]; float* yp[2]; bool on[2];
#pragma unroll
        for (int q = 0; q < 2; ++q) { const int idx = idx0 + q * NGW; on[q] = idx < NR; const int id2 = on[q] ? idx : idx0;
            size_t grow; gcf x;
            if (id2 < NBATCH * SEQ) { const int b = id2 / SEQ, s2 = id2 - b * SEQ; grow = (size_t)b * LP + 128 + s2; x = x_prompt + (size_t)id2 * DM; yp[q] = F.out + O_YP + (size_t)id2 * DM; }
            else { const int j = id2 - NBATCH * SEQ; grow = (size_t)ROWS_P + j; x = x_sample + (size_t)j * DM; yp[q] = F.out + O_YS + (size_t)j * DM; }
            const GAS f32x4* o4 = (const GAS f32x4*)yp[q] + F.lane;   const GAS f32x4* x4 = (const GAS f32x4*)x + F.lane;
#pragma unroll
            for (int j = 0; j < 8; ++j) { v[q][j] = o4[64 * j]; xx[q][j] = x4[64 * j]; } }
#pragma unroll
        for (int q = 0; q < 2; ++q) { float s2 = 0.f;
#pragma unroll
            for (int j = 0; j < 8; ++j) s2 += (v[q][j].x * v[q][j].x + v[q][j].y * v[q][j].y) + (v[q][j].z * v[q][j].z + v[q][j].w * v[q][j].w);
            const float rstd = rsqrtf(wave_sum(s2) * (1.f / DM) + EPSN);
            if (on[q]) { GAS f32x4* y4 = (GAS f32x4*)yp[q] + F.lane;
#pragma unroll
                for (int j = 0; j < 8; ++j) { const f32x4 w = ((const GAS f32x4*)norm_post)[F.lane + 64 * j]; y4[64 * j] = xx[q][j] + v[q][j] * rstd * w; } } }
    }
}

#ifndef MK_PER_PHASE
#define MK_PER_PHASE 0
#endif
constexpr int N_PHASES = 7;
struct Args { const float* in[15]; float* out; unsigned char* ws; int ph_lo, ph_hi; };
__global__ void __launch_bounds__(NTHREADS, 2) hymba_fwd(Args args) {
    extern __shared__ __attribute__((aligned(16))) unsigned char lds_raw[];
    Frame F;
    F.lds = (LAS unsigned char*)lds_raw;
    F.tid = threadIdx.x; F.lane = F.tid & 63; F.wave = __builtin_amdgcn_readfirstlane(F.tid >> 6); F.G = gridDim.x;
    F.out = args.out; F.ws = args.ws;
    unsigned char* ws = args.ws;
    for (int u = F.tid; u < LDS_CTL_BYTES / 4; u += NTHREADS) ((LAS unsigned*)F.lds)[u] = 0u;
    __syncthreads();
    volatile LAS unsigned* MISC = (volatile LAS unsigned*)(F.lds + 512);
    XcdBarrier bar; bar.bar = (unsigned*)(ws + WS_CTL) + CW_BAR; bar.x = 0; bar.st = nullptr;
    if (!MK_PER_PHASE) bar = xcd_barrier_post((unsigned*)(ws + WS_CTL) + CW_BAR, MISC + 8);
    LAS unsigned char* scr = F.lds + SCR_OFF;
    const int lo = args.ph_lo, hi = args.ph_hi;
#define IN(k) (lo <= (k) && (k) < hi)
#define SEAM(k) do { if (IN(k) && IN((k) + 1)) xcd_barrier(bar); } while (0)

#ifndef PROBE_PHASE
#define PROBE_PHASE -1
#endif
#ifndef PROBE_REP
#define PROBE_REP 1
#endif
#define REPS(k) for (int rep_ = 0; rep_ < ((k) == PROBE_PHASE ? PROBE_REP : 1); ++rep_)
    constexpr int P0_I_IN = (DM / 64) * (NPAD / 64), P0_I_ALL = P0_I_IN + (DM / 64) * (DM / 64);
    constexpr int G1_TAIL = (MROWS / 256) * (NPAD / 256) % 256;
    const bool wout_late = (F.G == 256) && !MK_PER_PHASE && IN(0) && IN(1) && IN(2) && PROBE_PHASE < 0;
    REPS(0) if (IN(0)) { p0_prologue(F, 0, wout_late ? P0_I_IN : P0_I_ALL, 0, F.G, true); if (PROBE_PHASE == 0) xcd_barrier(bar); }
    SEAM(0);
#define UNIT_BCH(idx, b_, c_, h_) const int b_ = (idx) < 256 ? (idx) >> 7 : ((idx) - 256) >> 2, c_ = (idx) < 256 ? 1 + (((idx) >> 2) & 31) : 0, h_ = (idx) & 3
    const bool split12 = (F.G == 256) && !MK_PER_PHASE && IN(0) && IN(1) && IN(2) && PROBE_PHASE < 0;
    if (split12) {
        constexpr int G1_MP = ROWS_P / 256, G1_MS = ROWS_S / 256, G1_N = NPAD / 256, G1_FULL = (G1_MP + G1_MS) * G1_N / 256;
        const int cb_ = (int)blockIdx.x;
        { pg8::Gemm g{F.XN(), F.WinT(), MROWS, NPAD, DM}; pg8::OrderPF S{G1_MP, G1_MS, G1_N, F.G, cb_, 0, G1_FULL};
          pg8::EpiBf16<0> E{F.P(), NPAD, nullptr, 0, 0, 1.f}; pg8::gemm_phase<pg8::EpiBf16<0>, pg8::OrderPF, true, true>(scr, g, S, E); }
        xcd_barrier(bar);
        if (cb_ < G1_TAIL) {
            { pg8::Gemm g{F.XN(), F.WinT(), MROWS, NPAD, DM}; pg8::OrderPF S{G1_MP, G1_MS, G1_N, F.G, cb_, G1_FULL, G1_FULL + 1};
              pg8::EpiBf16<0> E{F.P(), NPAD, nullptr, 0, 0, 1.f}; pg8::gemm_phase<pg8::EpiBf16<0>, pg8::OrderPF, true, true>(scr, g, S, E); }
        } else { { UNIT_BCH(cb_, b_, c_, h_); attn_prompt_unit(F, scr, b_, c_, h_); gla_ds_unit(F, scr, b_, c_, h_); }
            __syncthreads(); p0_prologue(F, P0_I_IN, P0_I_ALL, G1_TAIL, F.G - G1_TAIL, false); }
        xcd_barrier(bar);
        if (cb_ < G1_TAIL) { { UNIT_BCH(cb_, b_, c_, h_); attn_prompt_unit(F, scr, b_, c_, h_); gla_ds_unit(F, scr, b_, c_, h_); } gla_sample_unit(F, scr, cb_); }
        else if (cb_ < G1_TAIL + 8) { UNIT_BCH(256 + (cb_ - G1_TAIL), b_, c_, h_); attn_prompt_unit(F, scr, b_, c_, h_); gla_ds_unit(F, scr, b_, c_, h_); gla_out_unit(F, scr, b_, c_, h_); }
        else { const int v = cb_ - (G1_TAIL + 8), nb = 256 - (G1_TAIL + 8);
            attn_sample_pair(F, scr, v, 256 + v); if (nb + v < 256) attn_sample_pair(F, scr, nb + v, 256 + nb + v);
            gla_sample_unit(F, scr, G1_TAIL + v); gla_sample_unit(F, scr, G1_TAIL + nb + v); { const int n3 = DBATCH * 4 - (G1_TAIL + 2 * nb), v3 = v - (nb - n3); if (v3 >= 0) gla_sample_unit(F, scr, G1_TAIL + 2 * nb + v3); } }
    } else {
    REPS(1) if (IN(1)) {
        pg8::Gemm g{F.XN(), F.WinT(), MROWS, NPAD, DM}; pg8::StaticOrder S; S.init(MROWS, NPAD, F.G, (int)blockIdx.x);
        pg8::EpiBf16<0> E{F.P(), NPAD, nullptr, 0, 0, 1.f};
        pg8::gemm_phase<pg8::EpiBf16<0>, pg8::StaticOrder, true, true>(scr, g, S, E);
        if (wout_late && (int)blockIdx.x >= G1_TAIL) { __syncthreads(); p0_prologue(F, P0_I_IN, P0_I_ALL, G1_TAIL, F.G - G1_TAIL, false); }
        if (PROBE_PHASE == 1) xcd_barrier(bar);
    }
    SEAM(1);
    REPS(2) if (IN(2)) {
        REPS(20) for (int u = blockIdx.x; u < NBATCH * NBLK * 4; u += F.G) { UNIT_BCH(u, b_, c_, h_); attn_prompt_unit(F, scr, b_, c_, h_); }
        REPS(21) for (int u = blockIdx.x; u < NBATCH * NBLK * 4; u += F.G) { UNIT_BCH(u, b_, c_, h_); gla_ds_unit(F, scr, b_, c_, h_); }
        if (F.G == 256) {
            if (blockIdx.x < 8) { UNIT_BCH(256 + (int)blockIdx.x, b_, c_, h_); gla_out_unit(F, scr, b_, c_, h_); }
            else { const int v = (int)blockIdx.x - 8;
                attn_sample_pair(F, scr, v, 248 + v); if (v < 16) attn_sample_unit(F, scr, 496 + v);
                gla_sample_unit(F, scr, v); gla_sample_unit(F, scr, 248 + v); if (v >= 16 && v < 32) gla_sample_unit(F, scr, 496 + v - 16); }
        } else {
            for (int u = 256 + blockIdx.x; u < NBATCH * NBLK * 4; u += F.G) { UNIT_BCH(u, b_, c_, h_); gla_out_unit(F, scr, b_, c_, h_); }
            REPS(22) for (int u = blockIdx.x; u < DBATCH * 4; u += F.G) attn_sample_unit(F, scr, u);
            REPS(23) for (int u = blockIdx.x; u < DBATCH * 4; u += F.G) gla_sample_unit(F, scr, u);
        }
        if (PROBE_PHASE == 2) xcd_barrier(bar);
    }
    }
    SEAM(2);
    REPS(3) if (IN(3)) { gla_scan(F); if (PROBE_PHASE == 3) xcd_barrier(bar); }
    SEAM(3);
    REPS(4) if (IN(4)) {
        for (int u = blockIdx.x; u < 256; u += F.G) { UNIT_BCH(u, b_, c_, h_); gla_out_unit(F, scr, b_, c_, h_); }
        __syncthreads();
        if (PROBE_PHASE == 4) xcd_barrier(bar);
    }
    SEAM(4);
    REPS(5) if (IN(5)) {
        pg8::Gemm g{F.MIX(), F.WoutT(), MROWS, DM, DM}; pg8::StaticOrder S; S.init(MROWS, DM, F.G, (int)blockIdx.x);
        pg8::EpiY E{F.out + O_YP, F.out + O_YS, LP, SEQ, ROWS_P};
        pg8::gemm_phase<pg8::EpiY, pg8::StaticOrder, true, true>(scr, g, S, E);
        if (PROBE_PHASE == 5) xcd_barrier(bar);
    }
    SEAM(5);
    REPS(6) if (IN(6)) { final_rows(F); if (PROBE_PHASE == 6) xcd_barrier(bar); }
#undef IN
#undef SEAM
}

extern "C" void kernel_launch(void* const* d_in, const int* in_sizes, int n_in, void* d_out, int out_size, void* d_ws, size_t ws_size, hipStream_t stream) {
    static int grid = 0;
    if (grid == 0) {
        if (n_in != 15 || out_size != (int)O_END || ws_size < WS_END) { fprintf(stderr, "kernel_launch: unexpected problem: n_in %d out %d ws %zu\n", n_in, out_size, ws_size); grid = -1; return; }
        int dev = 0, cus = 0, per_cu = 0;
        if (hipGetDevice(&dev) != hipSuccess || hipDeviceGetAttribute(&cus, hipDeviceAttributeMultiprocessorCount, dev) != hipSuccess) { grid = -1; return; }
        if (hipFuncSetAttribute((const void*)hymba_fwd, hipFuncAttributeMaxDynamicSharedMemorySize, LDS_BYTES) != hipSuccess) { fprintf(stderr, "kernel_launch: hipFuncSetAttribute failed\n"); grid = -1; return; }
        if (hipOccupancyMaxActiveBlocksPerMultiprocessor(&per_cu, (const void*)hymba_fwd, NTHREADS, LDS_BYTES) != hipSuccess || per_cu < 1) fprintf(stderr, "kernel_launch: note: occupancy query reports %d\n", per_cu);
        (void)hipGetLastError();
        grid = cus;
    }
    if (grid < 0) return;
    (void)hipMemsetAsync((char*)d_ws + WS_CTL, 0, CTL_ZERO_BYTES, stream);
    Args a{};
    for (int i = 0; i < 15; ++i) a.in[i] = (const float*)d_in[i];
    a.out = (float*)d_out; a.ws = (unsigned char*)d_ws;
#if MK_PER_PHASE
    for (int p = 0; p < N_PHASES; ++p) { a.ph_lo = p; a.ph_hi = p + 1; hipLaunchKernelGGL(hymba_fwd, dim3(grid), dim3(NTHREADS), LDS_BYTES, stream, a); }
#else
    a.ph_lo = 0; a.ph_hi = N_PHASES;
    hipLaunchKernelGGL(hymba_fwd, dim3(grid), dim3(NTHREADS), LDS_BYTES, stream, a);
#endif
}
```

```cpp
#include <hip/hip_runtime.h>
#include <cstdio>
#include <cstdint>
#include <cmath>
namespace pg8 {
#define PG8_LAS __attribute__((address_space(3)))
typedef unsigned short bf16_t;
typedef short bf16x8 __attribute__((ext_vector_type(8)));
typedef float f32x4 __attribute__((ext_vector_type(4)));
typedef unsigned u32x4 __attribute__((ext_vector_type(4)));
constexpr int BM = 256, BK = 64, HALF = 128, HTB = HALF * BK * 2  , STAGE_BYTES = 8 * HTB, NXCD = 8, WGM = 8;

__host__ __device__ __forceinline__ int lds_byte(int r, int c) { const int st = (r >> 4) * 2 + (c >> 5), rr = r & 15, cc = c & 31, ob = rr * 64 + cc * 2; return st * 1024 + (ob ^ (((ob >> 9) & 1) << 5)); }
__host__ __device__ __forceinline__ void stage_rc(int b, int& R, int& C) { const int st = b / 1024, sb = b % 1024, swz = sb ^ (((sb >> 9) & 1) << 5); R = (st >> 1) * 16 + swz / 64; C = (st & 1) * 32 + (swz % 64) / 2; }
__host__ __device__ __forceinline__ int perm32(int rho) { const int n = rho >> 4, i = rho & 15; return 8 * (i >> 2) + 4 * n + (i & 3); }

struct Unit { int pm, pn; };
struct Gemm { const bf16_t* A; const bf16_t* Bt; int M, N, K; };

struct StaticOrder {
    int nM, nN, nwg, G, c;
    __host__ __device__ void init(int M, int N, int G_, int c_) { nM = M / BM; nN = N / BM; nwg = nM * nN; G = G_; c = c_; }
    __host__ __device__ bool next(int i, Unit& u) const {
        const long L = (long)i * G + c; if (L >= nwg) return false;
        int wgid = (int)L; { const int q = nwg / NXCD, r = nwg % NXCD, xcd = wgid % NXCD, off = wgid / NXCD; wgid = (xcd < r ? xcd * (q + 1) : r * (q + 1) + (xcd - r) * q) + off; }
        const int nig = WGM * nN, gid = wgid / nig, fm = gid * WGM, gsz = (nM - fm) < WGM ? (nM - fm) : WGM;
        u.pm = fm + ((wgid % nig) % gsz); u.pn = (wgid % nig) / gsz; return true;
    }
    __device__ __forceinline__ void a_ready(const Unit&) const {}
    __device__ __forceinline__ void done(const Unit&) const {}
};

struct OrderPF {
    int nMp, nMs, nN, G, c, r0, r1;
    __device__ bool next(int i, Unit& u) const {
        const int ii = r0 + i; if (ii >= r1) return false;
        const int nP = nMp * nN, nT = (nMp + nMs) * nN; const int e = ii * G + c; if (e >= nT) return false;
        if (e < nP) { int wgid = e; { const int q = nP / NXCD, r = nP % NXCD, xcd = wgid % NXCD, off = wgid / NXCD; wgid = (xcd < r ? xcd * (q + 1) : r * (q + 1) + (xcd - r) * q) + off; }
            const int nig = WGM * nN, gid = wgid / nig, fm = gid * WGM, gsz = (nMp - fm) < WGM ? (nMp - fm) : WGM; u.pm = fm + ((wgid % nig) % gsz); u.pn = (wgid % nig) / gsz; }
        else { const int q = e - nP; u.pm = nMp + q % nMs; u.pn = q / nMs; }
        return true;
    }
    __device__ __forceinline__ void a_ready(const Unit&) const {}
    __device__ __forceinline__ void done(const Unit&) const {}
};

__device__ __forceinline__ unsigned cvt_pk_bf16(float lo, float hi) { unsigned r; asm volatile("v_cvt_pk_bf16_f32 %0, %1, %2" : "=v"(r) : "v"(lo), "v"(hi)); return r; }
typedef float f32x2 __attribute__((ext_vector_type(2)));
__device__ __forceinline__ f32x2 gelu_pk(f32x2 v) {
    const f32x2 av = __builtin_elementwise_abs(v), d = av * 0.2316418882f + 1.0f;
    f32x2 t; t.x = __builtin_amdgcn_rcpf(d.x); t.y = __builtin_amdgcn_rcpf(d.y);
    f32x2 q = t * 0.5307027145f + (-0.7265760135f); q = q * t + 0.7107068705f; q = q * t + (-0.142248368f); q = q * t + 0.127414796f; q = q * t;
    const f32x2 s = (v * v) * (-0.72134752044f);
    f32x2 e; e.x = __builtin_amdgcn_exp2f(s.x); e.y = __builtin_amdgcn_exp2f(s.y);
    const f32x2 m = v * (q * e), r = v - m;
    f32x2 o; o.x = v.x < 0.f ? m.x : r.x; o.y = v.y < 0.f ? m.y : r.y; return o;
}

template <int ACT  > struct EpiBf16 {
    static constexpr bool PERM = true, AFTER_DRAIN = false; static_assert(ACT == 0 || ACT == 1, "EpiBf16: ACT is 0 (none) or 1 (gelu_pk)");
    bf16_t* O; int ldc; const float* bias; int split_cols; size_t split_stride; float scale0;
    __device__ __forceinline__ void operator()(const f32x4 (&acc)[2][2][4][2], const Unit& u, int wr, int wc, int fr, int fq) const {
        const int row0 = u.pm * BM + wr * 64 + fr; int colt = u.pn * BM; bf16_t* base = O;
        float sc = 1.f; if (split_cols) { const int t = colt / split_cols; base += (size_t)t * split_stride; colt -= t * split_cols; if (t == 0) sc = scale0; }
        const int col0 = colt + wc * 32 + 8 * fq, bcol0 = u.pn * BM + wc * 32 + 8 * fq;
        f32x4 bv[2][2];
#pragma unroll
        for (int bj = 0; bj < 2; ++bj)
#pragma unroll
            for (int n = 0; n < 2; ++n) bv[bj][n] = bias ? *(const f32x4*)(bias + bcol0 + bj * HALF + 4 * n) : (f32x4){0.f, 0.f, 0.f, 0.f};
#pragma unroll
        for (int ai = 0; ai < 2; ++ai)
#pragma unroll
            for (int m = 0; m < 4; ++m) { bf16_t* rowp = base + (size_t)(row0 + ai * HALF + m * 16) * ldc + col0;
#pragma unroll
                for (int bj = 0; bj < 2; ++bj) { f32x4 v0 = acc[ai][bj][m][0] + bv[bj][0], v1 = acc[ai][bj][m][1] + bv[bj][1];
                    if (ACT == 1) { f32x2 a = gelu_pk((f32x2){v0[0], v0[1]}), b = gelu_pk((f32x2){v0[2], v0[3]}), c = gelu_pk((f32x2){v1[0], v1[1]}), d = gelu_pk((f32x2){v1[2], v1[3]});
                        v0 = (f32x4){a.x, a.y, b.x, b.y}; v1 = (f32x4){c.x, c.y, d.x, d.y}; }
                    v0 = v0 * sc; v1 = v1 * sc; u32x4 w; w.x = cvt_pk_bf16(v0[0], v0[1]); w.y = cvt_pk_bf16(v0[2], v0[3]); w.z = cvt_pk_bf16(v1[0], v1[1]); w.w = cvt_pk_bf16(v1[2], v1[3]);
                    *(u32x4*)(rowp + bj * HALF) = w; } }
    }
};

struct EpiF32 {
    static constexpr bool PERM = false, AFTER_DRAIN = false;
    float* O; int ldc;
    __device__ __forceinline__ void operator()(const f32x4 (&acc)[2][2][4][2], const Unit& u, int wr, int wc, int fr, int fq) const {
        const int row0 = u.pm * BM + wr * 64 + fr, col0 = u.pn * BM + wc * 32 + 4 * fq;
#pragma unroll
        for (int ai = 0; ai < 2; ++ai)
#pragma unroll
            for (int m = 0; m < 4; ++m) { float* rowp = O + (size_t)(row0 + ai * HALF + m * 16) * ldc + col0;
#pragma unroll
                for (int bj = 0; bj < 2; ++bj)
#pragma unroll
                    for (int n = 0; n < 2; ++n) *(f32x4*)(rowp + bj * HALF + n * 16) = acc[ai][bj][m][n]; }
    }
};
struct EpiY {
    static constexpr bool PERM = false, AFTER_DRAIN = false;
    float* yp; float* ys; int lp, seq, rows_p;
    __device__ __forceinline__ void operator()(const f32x4 (&acc)[2][2][4][2], const Unit& u, int wr, int wc, int fr, int fq) const {
        const int row0 = u.pm * BM + wr * 64 + fr, col0 = u.pn * BM + wc * 32 + 4 * fq;
#pragma unroll
        for (int ai = 0; ai < 2; ++ai)
#pragma unroll
            for (int m = 0; m < 4; ++m) { const int row = row0 + ai * HALF + m * 16; float* rowp;
                if (row < rows_p) { const int b = row / lp, i = row - b * lp; if (i < 128) continue; rowp = yp + ((size_t)b * seq + (i - 128)) * 2048 + col0; }
                else rowp = ys + (size_t)(row - rows_p) * 2048 + col0;
#pragma unroll
                for (int bj = 0; bj < 2; ++bj)
#pragma unroll
                    for (int n = 0; n < 2; ++n) *(f32x4*)(rowp + bj * HALF + n * 16) = acc[ai][bj][m][n]; }
    }
};
struct EpiY16 {
    static constexpr bool PERM = true, AFTER_DRAIN = false;
    float* yp; float* ys; int lp, seq, rows_p;
    __device__ __forceinline__ void operator()(const f32x4 (&acc)[2][2][4][2], const Unit& u, int wr, int wc, int fr, int fq) const {
        const int row0 = u.pm * BM + wr * 64 + fr, col0 = u.pn * BM + wc * 32 + 8 * fq;
#pragma unroll
        for (int ai = 0; ai < 2; ++ai)
#pragma unroll
            for (int m = 0; m < 4; ++m) { const int row = row0 + ai * HALF + m * 16; bf16_t* rowp;
                if (row < rows_p) { const int b = row / lp, i = row - b * lp; if (i < 128) continue; rowp = (bf16_t*)(yp + ((size_t)b * seq + (i - 128)) * 2048) + col0; }
                else rowp = (bf16_t*)(ys + (size_t)(row - rows_p) * 2048) + col0;
#pragma unroll
                for (int bj = 0; bj < 2; ++bj) { const f32x4 v0 = acc[ai][bj][m][0], v1 = acc[ai][bj][m][1];
                    u32x4 w; w.x = cvt_pk_bf16(v0[0], v0[1]); w.y = cvt_pk_bf16(v0[2], v0[3]); w.z = cvt_pk_bf16(v1[0], v1[1]); w.w = cvt_pk_bf16(v1[2], v1[3]);
                    *(u32x4*)(rowp + bj * HALF) = w; } }
    }
};
template <class Epi, class Sched, bool ALIGN_EPI = false, bool SP2 = false>
__device__ __forceinline__ void gemm_phase(PG8_LAS unsigned char* lds, const Gemm g, const Sched& S, const Epi& E) {
    const int tid = threadIdx.x, wid = __builtin_amdgcn_readfirstlane(tid >> 6), lane = tid & 63, wr = wid >> 2, wc = wid & 3, fr = lane & 15, fq = lane >> 4;
    const int K = g.K, nt = K / BK;
    unsigned voffA[2], voffB[2];
#pragma unroll
    for (int i = 0; i < 2; ++i) { int R, C; stage_rc(tid * 16 + i * 8192, R, C); const int Rb = Epi::PERM ? ((R & ~31) + perm32(R & 31)) : R;
        voffA[i] = (unsigned)(R * K + C) * 2u; voffB[i] = (unsigned)(Rb * K + C) * 2u; }
    const size_t kstep = (size_t)(BK * 2);
    const size_t hstep = (size_t)HALF * K * 2;
    const size_t tstep = 2 * hstep;
    const unsigned ldsw = (unsigned)wid * 1024u;
    const int aoff = lds_byte(wr * 64 + fr, fq * 8), boff = lds_byte(wc * 32 + fr, fq * 8);
#define PG8_SA(b, h) (((b) * 2 + (h)) * HTB)
#define PG8_SB(b, h) ((4 + (b) * 2 + (h)) * HTB)
#define PG8_STAGE(bufoff, gbase, voff) do { _Pragma("unroll") for (int _i = 0; _i < 2; ++_i) \
        __builtin_amdgcn_global_load_lds((const unsigned*)((const char*)(gbase) + (voff)[_i]), (PG8_LAS unsigned*)(lds + (bufoff) + ldsw + _i * 8192), 16, 0, 0); } while (0)
#define PG8_LDA(dst, b, h) do { _Pragma("unroll") for (int m = 0; m < 4; ++m) _Pragma("unroll") for (int k = 0; k < 2; ++k) dst[m][k] = *(const PG8_LAS bf16x8*)(lds + PG8_SA(b, h) + aoff + m * 2048 + k * 1024); } while (0)
#define PG8_LDB(dst, b, h) do { _Pragma("unroll") for (int n = 0; n < 2; ++n) _Pragma("unroll") for (int k = 0; k < 2; ++k) dst[n][k] = *(const PG8_LAS bf16x8*)(lds + PG8_SB(b, h) + boff + n * 2048 + k * 1024); } while (0)
#define PG8_MMA(ai, bj, At, Bt) do { __builtin_amdgcn_s_setprio(1); _Pragma("unroll") for (int m = 0; m < 4; ++m) _Pragma("unroll") for (int n = 0; n < 2; ++n) _Pragma("unroll") for (int k = 0; k < 2; ++k) \
        acc[ai][bj][m][n] = __builtin_amdgcn_mfma_f32_16x16x32_bf16(Bt[n][k], At[m][k], acc[ai][bj][m][n], 0, 0, 0); __builtin_amdgcn_s_setprio(0); } while (0)
#define PG8_WAIT_V(n) asm volatile("s_waitcnt vmcnt(" #n ")" ::: "memory")
#define PG8_WAIT_L(n) asm volatile("s_waitcnt lgkmcnt(" #n ")" ::: "memory")
#define PG8_BAR __builtin_amdgcn_s_barrier()
#define PG8_SCHED __builtin_amdgcn_sched_barrier(0)
    Unit cur, nxt; int ui = 0;
    if (!S.next(0, cur)) return;
    f32x4 acc[2][2][4][2];
#pragma unroll
    for (int a = 0; a < 2; ++a)
#pragma unroll
        for (int b = 0; b < 2; ++b)
#pragma unroll
            for (int m = 0; m < 4; ++m)
#pragma unroll
                for (int n = 0; n < 2; ++n) acc[a][b][m][n] = (f32x4){0.f, 0.f, 0.f, 0.f};
    bf16x8 At[4][2], B0[2][2], B1[2][2];
    const char* cA = (const char*)g.A + (size_t)cur.pm * tstep; const char* cB = (const char*)g.Bt + (size_t)cur.pn * tstep;
    S.a_ready(cur);
    if constexpr (SP2) {
        PG8_STAGE(PG8_SB(0, 0), cB, voffB); PG8_STAGE(PG8_SB(0, 1), cB + hstep, voffB); PG8_STAGE(PG8_SA(0, 0), cA, voffA); PG8_STAGE(PG8_SA(0, 1), cA + hstep, voffA);
        if (wr == 1) PG8_BAR;
        PG8_WAIT_V(2); PG8_BAR;
        PG8_STAGE(PG8_SB(1, 0), cB + kstep, voffB); PG8_STAGE(PG8_SA(1, 0), cA + kstep, voffA); PG8_STAGE(PG8_SB(1, 1), cB + hstep + kstep, voffB);
        PG8_WAIT_V(6); PG8_BAR;
    } else {
        PG8_STAGE(PG8_SB(0, 0), cB, voffB); PG8_STAGE(PG8_SA(0, 0), cA, voffA); PG8_STAGE(PG8_SB(0, 1), cB + hstep, voffB); PG8_STAGE(PG8_SA(0, 1), cA + hstep, voffA);
        if (wr == 1) PG8_BAR;
        PG8_WAIT_V(4); PG8_BAR;
        PG8_STAGE(PG8_SB(1, 0), cB + kstep, voffB); PG8_STAGE(PG8_SA(1, 0), cA + kstep, voffA); PG8_STAGE(PG8_SB(1, 1), cB + hstep + kstep, voffB);
        PG8_WAIT_V(6); PG8_BAR;
    }
    for (;;) {
        const bool has_next = S.next(ui + 1, nxt);
        const char* nA = has_next ? (const char*)g.A + (size_t)nxt.pm * tstep : cA; const char* nB = has_next ? (const char*)g.Bt + (size_t)nxt.pn * tstep : cB;
        for (int t = 0; t < nt; t += 2) {
            const bool last = (t == nt - 2);
            const char* a1 = cA + (size_t)(t + 1) * kstep;
            const char* a2 = last ? nA : cA + (size_t)(t + 2) * kstep; const char* b2 = last ? nB : cB + (size_t)(t + 2) * kstep;
            const char* a3 = a2 + kstep; const char* b3 = b2 + kstep;
            if (last && has_next) S.a_ready(nxt);
            if constexpr (SP2) {
            PG8_LDB(B0, 0, 0); PG8_LDB(B1, 0, 1); PG8_SCHED; PG8_LDA(At, 0, 0); PG8_STAGE(PG8_SA(1, 1), a1 + hstep, voffA);
            PG8_WAIT_V(8); PG8_WAIT_L(0); PG8_BAR; PG8_MMA(0, 0, At, B0); PG8_MMA(0, 1, At, B1); PG8_BAR; PG8_SCHED;
            PG8_LDA(At, 0, 1); PG8_STAGE(PG8_SB(0, 0), b2, voffB); PG8_STAGE(PG8_SB(0, 1), b2 + hstep, voffB); PG8_STAGE(PG8_SA(0, 0), a2, voffA);
            PG8_WAIT_V(8); PG8_WAIT_L(0); PG8_BAR; PG8_MMA(1, 0, At, B0); PG8_MMA(1, 1, At, B1); PG8_BAR; PG8_SCHED;
            PG8_LDB(B0, 1, 0); PG8_LDB(B1, 1, 1); PG8_SCHED; PG8_LDA(At, 1, 0); PG8_STAGE(PG8_SA(0, 1), a2 + hstep, voffA);
            PG8_WAIT_V(8); PG8_WAIT_L(0); PG8_BAR; PG8_MMA(0, 0, At, B0); PG8_MMA(0, 1, At, B1); PG8_BAR; PG8_SCHED;
            PG8_LDA(At, 1, 1); PG8_STAGE(PG8_SB(1, 0), b3, voffB); PG8_STAGE(PG8_SB(1, 1), b3 + hstep, voffB); PG8_STAGE(PG8_SA(1, 0), a3, voffA);
            PG8_WAIT_V(8); PG8_WAIT_L(0); PG8_BAR; PG8_MMA(1, 0, At, B0); PG8_MMA(1, 1, At, B1); PG8_BAR; PG8_SCHED;
            } else {
            PG8_LDB(B0, 0, 0); PG8_SCHED; PG8_LDA(At, 0, 0); PG8_STAGE(PG8_SA(1, 1), a1 + hstep, voffA);
            PG8_WAIT_L(8); PG8_BAR; PG8_WAIT_L(0); PG8_MMA(0, 0, At, B0); PG8_BAR; PG8_SCHED;
            PG8_LDB(B1, 0, 1); PG8_STAGE(PG8_SB(0, 0), b2, voffB);
            PG8_BAR; PG8_WAIT_L(0); PG8_MMA(0, 1, At, B1); PG8_BAR;
            PG8_LDA(At, 0, 1); PG8_STAGE(PG8_SA(0, 0), a2, voffA);
            PG8_BAR; PG8_WAIT_L(0); PG8_MMA(1, 0, At, B0); PG8_BAR; PG8_SCHED;
            PG8_STAGE(PG8_SB(0, 1), b2 + hstep, voffB);
            PG8_WAIT_V(6); PG8_BAR; PG8_MMA(1, 1, At, B1); PG8_BAR;
            PG8_LDB(B0, 1, 0); PG8_SCHED; PG8_LDA(At, 1, 0); PG8_STAGE(PG8_SA(0, 1), a2 + hstep, voffA);
            PG8_WAIT_L(8); PG8_BAR; PG8_WAIT_L(0); PG8_MMA(0, 0, At, B0); PG8_BAR; PG8_SCHED;
            PG8_LDB(B1, 1, 1); PG8_STAGE(PG8_SB(1, 0), b3, voffB);
            PG8_BAR; PG8_WAIT_L(0); PG8_MMA(0, 1, At, B1); PG8_BAR;
            PG8_LDA(At, 1, 1); PG8_STAGE(PG8_SA(1, 0), a3, voffA);
            PG8_BAR; PG8_WAIT_L(0); PG8_MMA(1, 0, At, B0); PG8_BAR; PG8_SCHED;
            PG8_STAGE(PG8_SB(1, 1), b3 + hstep, voffB);
            PG8_WAIT_V(6); PG8_BAR; PG8_MMA(1, 1, At, B1); PG8_BAR;
            }
        }
        if constexpr (ALIGN_EPI) { if (wr == 0) PG8_BAR; }
        if constexpr (!Epi::AFTER_DRAIN) { E(acc, cur, wr, wc, fr, fq); S.done(cur); }
        if (!has_next) break;
#pragma unroll
        for (int a = 0; a < 2; ++a)
#pragma unroll
            for (int b = 0; b < 2; ++b)
#pragma unroll
                for (int m = 0; m < 4; ++m)
#pragma unroll
                    for (int n = 0; n < 2; ++n) acc[a][b][m][n] = (f32x4){0.f, 0.f, 0.f, 0.f};
        cur = nxt; cA = nA; cB = nB; ++ui;
        if constexpr (ALIGN_EPI) { if (wr == 1) PG8_BAR; }
    }
    PG8_WAIT_V(0);
    if constexpr (!ALIGN_EPI) { if (wr == 0) PG8_BAR; }
    PG8_BAR;
    if constexpr (Epi::AFTER_DRAIN) { E.fused(acc, cur, wr, wc, fr, fq, lds, wid, lane); S.done(cur); }
#undef PG8_SA
#undef PG8_SB
#undef PG8_STAGE
#undef PG8_LDA
#undef PG8_LDB
#undef PG8_MMA
#undef PG8_WAIT_V
#undef PG8_WAIT_L
#undef PG8_BAR
#undef PG8_SCHED
}
}

#define GAS __attribute__((address_space(1)))
#define LAS __attribute__((address_space(3)))
typedef unsigned short bf16;
typedef unsigned v4u __attribute__((ext_vector_type(4)));
typedef float f32x4 __attribute__((ext_vector_type(4)));
typedef short bf16x8 __attribute__((ext_vector_type(8)));
typedef GAS unsigned gu32;
typedef GAS unsigned long long gu64;
#define RLX_AGENT __ATOMIC_RELAXED, __HIP_MEMORY_SCOPE_AGENT
#define LDS_WAIT() asm volatile("s_waitcnt lgkmcnt(0)" ::: "memory")
#define VM_WAIT() asm volatile("s_waitcnt vmcnt(0)" ::: "memory")
__device__ __forceinline__ unsigned long long rt() { return __builtin_amdgcn_s_memrealtime(); }
__device__ __forceinline__ unsigned f2bf(float f) { unsigned u = __builtin_bit_cast(unsigned, f); return (u + 0x7fffu + ((u >> 16) & 1u)) >> 16; }
__device__ __forceinline__ unsigned pk2(float lo, float hi) { return f2bf(lo) | (f2bf(hi) << 16); }
#define XB_TMO      128
#define XB_XCNT(j)  (256  + 64 * (j))
#define XB_XSUB(j)  (1280 + 64 * (j))
#define XB_XGEN(j)  (2304 + 64 * (j))
#define XB_TOP      3328
#define XB_TOPGEN   3392
#define XCD_BAR_WORDS 3456
#define XB_SPIN_CAP (1u << 18)

__device__ __forceinline__ unsigned xb_ld(unsigned* p)              { return __hip_atomic_load(p, __ATOMIC_RELAXED, __HIP_MEMORY_SCOPE_AGENT); }
__device__ __forceinline__ unsigned xb_add(unsigned* p, unsigned v) { return __hip_atomic_fetch_add(p, v, __ATOMIC_RELAXED, __HIP_MEMORY_SCOPE_AGENT); }
__device__ __forceinline__ unsigned xb_xcc_id() { return (unsigned)__builtin_amdgcn_s_getreg((3 << 11) | 20) & 0xFu; }
#define XB_SPIN(cond, bar) do { unsigned _sp = 0; while (cond) { __builtin_amdgcn_s_sleep(1); \
    if ((++_sp & 255u) == 0u) { if (xb_ld(&(bar)[XB_TMO])) break; if (_sp > XB_SPIN_CAP) { atomicAdd(&(bar)[XB_TMO], 1u); break; } } } } while (0)

struct XcdBarrier {
    unsigned* bar; unsigned x;
    volatile LAS unsigned* st;
};

__device__ __forceinline__ XcdBarrier xcd_barrier_post(unsigned* bar, volatile LAS unsigned* st) {
    XcdBarrier b; b.bar = bar; b.x = xb_xcc_id(); b.st = st;
    if (threadIdx.x == 0) (void)xb_add(&bar[XB_XCNT(b.x)], 1u);
    return b;
}
__device__ __forceinline__ void xcd_barrier_complete(unsigned* bar, unsigned x, unsigned& nloc, unsigned& nx) {
    const unsigned G = gridDim.x * gridDim.y * gridDim.z;
    unsigned sum, cnt, mine, sp = 0u;
    for (;;) {
        sum = 0u; cnt = 0u; mine = 0u;
#pragma unroll
        for (unsigned j = 0; j < 16; ++j) { const unsigned c = xb_ld(&bar[XB_XCNT(j)]); sum += c; cnt += (c > 0u) ? 1u : 0u; mine = (j == x) ? c : mine; }
        if (sum == G) break;
        __builtin_amdgcn_s_sleep(1);
        if ((++sp & 255u) == 0u) { if (xb_ld(&bar[XB_TMO])) break; if (sp > XB_SPIN_CAP) { atomicAdd(&bar[XB_TMO], 1u); break; } }
    }
    nloc = mine > 0u ? mine : 1u; nx = cnt > 0u ? cnt : 1u;
}

__device__ __forceinline__ void xcd_barrier(const XcdBarrier& b) {
    asm volatile("s_waitcnt vmcnt(0)" ::: "memory");
    __syncthreads();
    if (threadIdx.x == 0) {
        unsigned* bar = b.bar;
        __builtin_amdgcn_s_waitcnt(0);
        unsigned nloc = b.st[0], nx = b.st[1];
        if (nloc == 0u) { xcd_barrier_complete(bar, b.x, nloc, nx); b.st[0] = nloc; b.st[1] = nx; }
        const unsigned old = xb_add(&bar[XB_XSUB(b.x)], 1u);
        const unsigned gen = old / nloc;
        if (old + 1u == (gen + 1u) * nloc) {
            __builtin_amdgcn_fence(__ATOMIC_RELEASE, "agent");
            asm volatile("s_waitcnt vmcnt(0)" ::: "memory");
            const unsigned og = xb_add(&bar[XB_TOP], 1u);
            const unsigned tg = og / nx;
            if (og + 1u == (tg + 1u) * nx) xb_add(&bar[XB_TOPGEN], 1u);
            else XB_SPIN(xb_ld(&bar[XB_TOPGEN]) == tg, bar);
            __builtin_amdgcn_fence(__ATOMIC_ACQUIRE, "agent");
            xb_add(&bar[XB_XGEN(b.x)], 1u);
            asm volatile("s_waitcnt vmcnt(0)" ::: "memory");
        } else {
            XB_SPIN(xb_ld(&bar[XB_XGEN(b.x)]) == gen, bar);
            __builtin_amdgcn_fence(__ATOMIC_ACQUIRE, "agent");
            asm volatile("s_waitcnt vmcnt(0)" ::: "memory");
        }
    }
    __syncthreads();
}


constexpr int NWAVES = 8, NTHREADS = 512;
constexpr int DM = 2048, NBATCH = 2, SEQ = 4096, NMETA = 16, FPAD = 112, LP = 4224, NBLK = 33;
constexpr int DBATCH = 128, DSEQ = 8, WIN = 128;
constexpr int ROWS_P = NBATCH * LP, ROWS_S = DBATCH * DSEQ, MROWS = ROWS_P + ROWS_S;
constexpr int NIN = 5648, NPAD = 5888;
constexpr int C_QA = 0, C_KA = 1024, C_VA = 1280, C_GA = 1536, C_QG = 2560, C_KG = 3072, C_VG = 3584, C_GG = 4608, C_ZG = 5632;
constexpr float EPSN = 1e-6f;
static_assert(MROWS % 256 == 0 && NPAD % 256 == 0, "tiles");

constexpr size_t O_YP = 0, O_YS = 16777216, O_KWP = 18874368, O_VWP = 18939904, O_GP = 19005440, O_KWS = 19267584, O_VWS = 23461888, O_GS = 27656192, O_END = 44433408;

constexpr size_t MiB = 1u << 20;
constexpr size_t WS_CTL = 0, CTL_ZERO_BYTES = 64 * 1024;
constexpr size_t WS_WIN = 1 * MiB;
constexpr size_t WS_WOUT = 24 * MiB;
constexpr size_t WS_XN = 32 * MiB;
constexpr size_t WS_P = 69 * MiB;
constexpr size_t WS_DST = 176 * MiB;
constexpr size_t WS_ST = 209 * MiB;
constexpr size_t WS_DEC = 226 * MiB;
constexpr size_t WS_END = 227 * MiB;
constexpr int CW_BAR = 1024;

constexpr int LDS_CTL_BYTES = 1024;
constexpr int SCR_OFF = 1024;
constexpr int LDS_BYTES = 156 * 1024;

typedef short bf16x4 __attribute__((ext_vector_type(4)));
typedef short v4i16_t __attribute__((ext_vector_type(4)));
typedef float f32x2 __attribute__((ext_vector_type(2)));

__device__ __forceinline__ float bf2f(unsigned short b) { return __uint_as_float(((unsigned)b) << 16); }
__device__ __forceinline__ unsigned short f2bf16(float f) { return (unsigned short)f2bf(f); }
__device__ __forceinline__ float wave_sum(float v) {
#pragma unroll
    for (int o = 1; o < 64; o <<= 1) v += __shfl_xor(v, o);
    return v;
}
__device__ __forceinline__ float silu_f(float x) { return x / (1.f + __expf(-x)); }
__device__ __forceinline__ float logsig_f(float x) { return fminf(x, 0.f) - __logf(1.f + __expf(-fabsf(x))); }

#ifndef USE_TR
#define USE_TR 1
#endif
__device__ __forceinline__ bf16x8 tr_frag(const LAS unsigned short* M, int row0, int col0, int pitch, int lane) {
#if USE_TR
    const int q = (lane & 15) >> 2, p = lane & 3;
    const LAS unsigned short* a0 = M + (row0 + q) * pitch + col0 + 4 * p;
    const v4i16_t lo = __builtin_amdgcn_ds_read_tr16_b64_v4i16((LAS v4i16_t*)a0);
    const v4i16_t hi = __builtin_amdgcn_ds_read_tr16_b64_v4i16((LAS v4i16_t*)(a0 + 4 * pitch));
    return (bf16x8){lo[0], lo[1], lo[2], lo[3], hi[0], hi[1], hi[2], hi[3]};
#else
    bf16x8 r; const LAS unsigned short* a0 = M + row0 * pitch + col0 + (lane & 15);
#pragma unroll
    for (int j = 0; j < 8; ++j) r[j] = (short)a0[j * pitch];
    return r;
#endif
}
#define MFMA16(a, b, c) __builtin_amdgcn_mfma_f32_16x16x32_bf16((a), (b), (c), 0, 0, 0)

struct Frame {
    LAS unsigned char* lds;
    int tid, lane, wave, G;
    unsigned char* ws; float* out;
    __device__ __forceinline__ bf16* WinT() const { return (bf16*)(ws + WS_WIN); }
    __device__ __forceinline__ bf16* WoutT() const { return (bf16*)(ws + WS_WOUT); }
    __device__ __forceinline__ bf16* XN() const { return (bf16*)(out + O_GS); }
    __device__ __forceinline__ bf16* MIX() const { return (bf16*)(ws + WS_XN); }
    __device__ __forceinline__ bf16* P() const { return (bf16*)(ws + WS_P); }
    __device__ __forceinline__ float* O2() const { return (float*)(ws + WS_P); }
    __device__ __forceinline__ float* dST() const { return (float*)(ws + WS_DST); }
    __device__ __forceinline__ bf16* St() const { return (bf16*)(ws + WS_ST); }
    __device__ __forceinline__ float* dec() const { return (float*)(ws + WS_DEC); }
};
enum { A_XP = 0, A_XS, A_CK, A_CV, A_STATE, A_META, A_RELB, A_NPRE, A_NPOST, A_WIN, A_WA2, A_BA, A_SINK, A_GNORM, A_WOUT, A_OUT, A_WS };
typedef const GAS float* gcf;
template <int IDX> __device__ __forceinline__ gcf ldarg() {
    const unsigned long long ka = (unsigned long long)__builtin_amdgcn_kernarg_segment_ptr();
    unsigned long long v;
    asm volatile("s_load_dwordx2 %0, %1, %2\n\ts_waitcnt lgkmcnt(0)" : "=s"(v) : "s"(ka), "i"(IDX * 8) : "memory");
    return (gcf)v;
}

struct P0Item { gcf W; bf16* WT; int N, kb, nb; bool on; };
__device__ __forceinline__ void p0_item_load(const P0Item& it, int K, int lane, f32x4 (&v)[16]) {
    const int k0 = 64 * it.kb, n0 = 64 * it.nb; const int nq = 4 * (lane & 15), kr = lane >> 4; const bool ok = it.on && (n0 + nq) < it.N;
#pragma unroll
    for (int i = 0; i < 16; ++i) v[i] = ok ? *(const GAS f32x4*)(it.W + (size_t)(k0 + 4 * i + kr) * it.N + n0 + nq) : (f32x4){0.f, 0.f, 0.f, 0.f};
}
__device__ __forceinline__ void p0_item_store(const P0Item& it, int K, int lane, const f32x4 (&v)[16], LAS float* scr) {
    if (!it.on) return;
    const int k0 = 64 * it.kb, n0 = 64 * it.nb; const int nq = 4 * (lane & 15), kr = lane >> 4;
#pragma unroll
    for (int i = 0; i < 16; ++i) { LAS float* d = scr + (4 * i + kr) * 65 + nq; d[0] = v[i].x; d[1] = v[i].y; d[2] = v[i].z; d[3] = v[i].w; }
    LDS_WAIT(); asm volatile("" ::: "memory");
    const int c = lane & 7;
#pragma unroll
    for (int j = 0; j < 8; ++j) { const int nn = (lane >> 3) + 8 * j; const LAS float* s = scr + (8 * c) * 65 + nn;
        v4u o; o.x = pk2(s[0 * 65], s[1 * 65]); o.y = pk2(s[2 * 65], s[3 * 65]); o.z = pk2(s[4 * 65], s[5 * 65]); o.w = pk2(s[6 * 65], s[7 * 65]);
        *(GAS v4u*)(it.WT + (size_t)(n0 + nn) * K + k0 + 8 * c) = o; }
    LDS_WAIT(); asm volatile("" ::: "memory");
}
__device__ __forceinline__ gcf p0_row_src(int m, gcf meta, gcf x_prompt, gcf x_sample) {
    if (m < ROWS_P) { const int b = m / LP, i = m - b * LP;
        if (i < FPAD) return nullptr;
        return (i < 128) ? meta + (size_t)(i - FPAD) * DM : x_prompt + ((size_t)b * SEQ + (i - 128)) * DM; }
    return x_sample + (size_t)(m - ROWS_P) * DM;
}
constexpr int P0R = 4;
__device__ __forceinline__ void p0_rows2(Frame& F, int m0, int mstep, gcf meta, gcf x_prompt, gcf x_sample, gcf norm_pre) {
    gcf src[P0R]; int mm[P0R];
#pragma unroll
    for (int q = 0; q < P0R; ++q) { mm[q] = m0 + q * mstep; src[q] = (mm[q] < MROWS) ? p0_row_src(mm[q], meta, x_prompt, x_sample) : nullptr; }
    f32x4 v[P0R][8];
#pragma unroll
    for (int q = 0; q < P0R; ++q)
#pragma unroll
        for (int j = 0; j < 8; ++j) v[q][j] = src[q] ? ((const GAS f32x4*)src[q])[F.lane + 64 * j] : (f32x4){0.f, 0.f, 0.f, 0.f};
#pragma unroll
    for (int q = 0; q < P0R; ++q) { if (mm[q] >= MROWS) continue;
        float s = 0.f;
#pragma unroll
        for (int j = 0; j < 8; ++j) s += (v[q][j].x * v[q][j].x + v[q][j].y * v[q][j].y) + (v[q][j].z * v[q][j].z + v[q][j].w * v[q][j].w);
        const float rstd = rsqrtf(wave_sum(s) * (1.f / DM) + EPSN);
        GAS unsigned long long* o8 = (GAS unsigned long long*)(F.XN() + (size_t)mm[q] * DM) + F.lane;
        if (src[q] == nullptr) { GAS unsigned long long* z8 = (GAS unsigned long long*)(F.MIX() + (size_t)mm[q] * DM) + F.lane;
#pragma unroll
            for (int j = 0; j < 8; ++j) z8[64 * j] = 0ull; }
#pragma unroll
        for (int j = 0; j < 8; ++j) { const f32x4 w = ((const GAS f32x4*)norm_pre)[F.lane + 64 * j];
            o8[64 * j] = (unsigned long long)pk2(v[q][j].x * rstd * w.x, v[q][j].y * rstd * w.y) | ((unsigned long long)pk2(v[q][j].z * rstd * w.z, v[q][j].w * rstd * w.w) << 32); } }
}
__device__ __forceinline__ void p0_prologue(Frame& F, int it_lo, int it_hi, int b_lo, int nb, bool with_rows) { gcf const w_in = ldarg<A_WIN>(); gcf const w_out = ldarg<A_WOUT>();
    LAS float* scr = (LAS float*)(F.lds + SCR_OFF + F.wave * 16640);
    const int gw = ((int)blockIdx.x - b_lo) * NWAVES + F.wave, NGW = nb * NWAVES;
    constexpr int I_IN = (DM / 64) * (NPAD / 64), I_OUT = (DM / 64) * (DM / 64);
    auto mk = [&](int it) { P0Item r; r.on = it < it_hi;
        if (it < I_IN) { r.W = w_in; r.WT = F.WinT(); r.N = NIN; r.kb = it / (NPAD / 64); r.nb = it % (NPAD / 64); }
        else { const int q = r.on ? it - I_IN : 0; r.W = w_out; r.WT = F.WoutT(); r.N = DM; r.kb = q / (DM / 64); r.nb = q % (DM / 64); }
        return r; };
    for (int it = it_lo + gw; it < it_hi; it += 2 * NGW) {
        const P0Item a = mk(it), b = mk(it + NGW);
        f32x4 va[16], vb[16];
        p0_item_load(a, DM, F.lane, va); p0_item_load(b, DM, F.lane, vb);
        p0_item_store(a, DM, F.lane, va, scr); p0_item_store(b, DM, F.lane, vb, scr);
    }
    if (with_rows) {
        gcf const meta = ldarg<A_META>(); gcf const x_prompt = ldarg<A_XP>(); gcf const x_sample = ldarg<A_XS>(); gcf const norm_pre = ldarg<A_NPRE>();
        for (int m = gw; m < MROWS; m += P0R * NGW) p0_rows2(F, m, NGW, meta, x_prompt, x_sample, norm_pre);
    }
}

constexpr int AKP = 72, APP = 168;
constexpr int A_K = 0, A_V = 272 * AKP * 2, A_BIAS = 2 * A_V, A_P = A_BIAS + 2048, A_END = A_P + NWAVES * 16 * APP * 2;
static_assert(A_END <= LDS_BYTES - SCR_OFF, "attention LDS");

struct AttnLds { const LAS unsigned short* AK; const LAS unsigned short* AV; const LAS float* AB; LAS unsigned short* AP; };
template <bool SAMPLE>
__device__ __forceinline__ void attn_tile(Frame& F, const AttnLds& L, const bf16x8 (&qa)[2], int s0, int kmin  ,
                                          int tb, int gb, size_t rowb, gcf sinks, int kvh) {
    int lane = F.lane; asm volatile("" : "+v"(lane));
    const int gq = lane >> 4, i = lane & 15;
    const LAS unsigned short* AK = L.AK; const LAS unsigned short* AV = L.AV; const LAS float* AB = L.AB; LAS unsigned short* AP = L.AP;
    size_t prow[2]; int pcol[2]; v4u gpre[2];
#pragma unroll
    for (int jj = 0; jj < 2; ++jj) { const int q = lane + 64 * jj, rr = q >> 3, ch = q & 7;
        prow[jj] = SAMPLE ? rowb + (rr & 7) : rowb + rr; pcol[jj] = kvh * 256 + (SAMPLE ? gb + (rr >> 3) : gb) * 64 + 8 * ch;
        gpre[jj] = *(const GAS v4u*)(F.P() + prow[jj] * NPAD + C_GA + pcol[jj]); }
    int trow[4], grow[4]; float sinkr[4];
#pragma unroll
    for (int r = 0; r < 4; ++r) { const int rr = 4 * gq + r; trow[r] = SAMPLE ? (rr & 7) : tb + rr; grow[r] = SAMPLE ? gb + (rr >> 3) : gb; sinkr[r] = sinks[kvh * 4 + grow[r]]; }
    f32x4 acc[10];
#pragma unroll
    for (int cb = 0; cb < 10; ++cb) { acc[cb] = (f32x4){0.f, 0.f, 0.f, 0.f};
#pragma unroll
        for (int ks = 0; ks < 2; ++ks) { const bf16x8 kb = *(const LAS bf16x8*)(AK + (s0 + 16 * cb + i) * AKP + 32 * ks + 8 * gq); acc[cb] = MFMA16(qa[ks], kb, acc[cb]); } }
    float mx[4] = {-INFINITY, -INFINITY, -INFINITY, -INFINITY};
#pragma unroll
    for (int cb = 0; cb < 10; ++cb) { const int s = s0 + 16 * cb + i;
#pragma unroll
        for (int r = 0; r < 4; ++r) { const int dist = 128 + trow[r] - s; const bool valid = (dist >= 0) && (dist < 128) && (s >= kmin);
            const int dc = dist < 0 ? 0 : (dist > 127 ? 127 : dist);
            const float v = valid ? acc[cb][r] * 0.125f + AB[grow[r] * 128 + dc] : -INFINITY; acc[cb][r] = v; mx[r] = fmaxf(mx[r], v); } }
    float inv[4];
#pragma unroll
    for (int r = 0; r < 4; ++r) { float m = mx[r];
        m = fmaxf(m, __shfl_xor(m, 1)); m = fmaxf(m, __shfl_xor(m, 2)); m = fmaxf(m, __shfl_xor(m, 4)); m = fmaxf(m, __shfl_xor(m, 8));
        m = fmaxf(m, sinkr[r]); float sum = 0.f;
#pragma unroll
        for (int cb = 0; cb < 10; ++cb) { const float e = __expf(acc[cb][r] - m); acc[cb][r] = e; sum += e; }
        sum += __shfl_xor(sum, 1); sum += __shfl_xor(sum, 2); sum += __shfl_xor(sum, 4); sum += __shfl_xor(sum, 8);
        inv[r] = 1.f / (sum + __expf(sinkr[r] - m)); }
#pragma unroll
    for (int cb = 0; cb < 10; ++cb)
#pragma unroll
        for (int r = 0; r < 4; ++r) AP[(4 * gq + r) * APP + 16 * cb + i] = f2bf16(acc[cb][r]);
    LDS_WAIT(); asm volatile("" ::: "memory");
    f32x4 o[4];
#pragma unroll
    for (int db = 0; db < 4; ++db) o[db] = (f32x4){0.f, 0.f, 0.f, 0.f};
#pragma unroll
    for (int kk = 0; kk < 5; ++kk) { const bf16x8 pa = *(const LAS bf16x8*)(AP + i * APP + 32 * kk + 8 * gq);
#pragma unroll
        for (int db = 0; db < 4; ++db) { const bf16x8 vb = tr_frag(AV, s0 + 32 * kk + 8 * gq, 16 * db, AKP, lane); o[db] = MFMA16(pa, vb, o[db]); } }
    LDS_WAIT(); asm volatile("" ::: "memory");
#pragma unroll
    for (int r = 0; r < 4; ++r)
#pragma unroll
        for (int db = 0; db < 4; ++db) AP[(4 * gq + r) * APP + 16 * db + i] = f2bf16(o[db][r] * inv[r]);
    LDS_WAIT(); asm volatile("" ::: "memory");
#pragma unroll
    for (int jj = 0; jj < 2; ++jj) { const int q = lane + 64 * jj, rr = q >> 3, ch = q & 7;
        const v4u ov = *(const LAS v4u*)(AP + rr * APP + 8 * ch); const v4u gv = gpre[jj];
        v4u res;
        res.x = pk2(bf2f(ov.x & 0xffff) * silu_f(bf2f(gv.x & 0xffff)), bf2f(ov.x >> 16) * silu_f(bf2f(gv.x >> 16)));
        res.y = pk2(bf2f(ov.y & 0xffff) * silu_f(bf2f(gv.y & 0xffff)), bf2f(ov.y >> 16) * silu_f(bf2f(gv.y >> 16)));
        res.z = pk2(bf2f(ov.z & 0xffff) * silu_f(bf2f(gv.z & 0xffff)), bf2f(ov.z >> 16) * silu_f(bf2f(gv.z >> 16)));
        res.w = pk2(bf2f(ov.w & 0xffff) * silu_f(bf2f(gv.w & 0xffff)), bf2f(ov.w >> 16) * silu_f(bf2f(gv.w >> 16)));
        *(GAS v4u*)(F.MIX() + prow[jj] * DM + pcol[jj]) = res; }
    LDS_WAIT(); asm volatile("" ::: "memory");
}

__device__ __forceinline__ void attn_bias_table(Frame& F, LAS float* AB, int kvh) { gcf const rel_bias = ldarg<A_RELB>();
    const int g = F.tid >> 7, d = F.tid & 127;
    int bk = d;
    if (d >= 16) { bk = 16 + (int)(__logf((float)d * (1.f / 16.f)) * (16.f / 2.0794415416798357f)); bk = bk > 31 ? 31 : bk; }
    AB[g * 128 + d] = rel_bias[bk * 16 + kvh * 4 + g];
}

__device__ __forceinline__ void attn_prompt_unit(Frame& F0, LAS unsigned char* scr, int b, int n, int kvh) { Frame F = F0; asm volatile("" : "+v"(F.tid), "+v"(F.lane));     gcf const sinks = ldarg<A_SINK>();
    LAS unsigned short* AK = (LAS unsigned short*)(scr + A_K); LAS unsigned short* AV = (LAS unsigned short*)(scr + A_V);
    __syncthreads();
    const long wrow0 = (long)b * LP + 128 * (n - 1);
#pragma unroll
    for (int j = 0; j < 4; ++j) { const int c = F.tid + 512 * j, row = c >> 3, ch = c & 7; const long gr = wrow0 + row;
        v4u kv = (v4u){0u, 0u, 0u, 0u}, vv = kv;
        if (gr >= 0) { const bf16* p = F.P() + (size_t)gr * NPAD + kvh * 64 + 8 * ch; kv = *(const GAS v4u*)(p + C_KA); vv = *(const GAS v4u*)(p + C_VA); }
        *(LAS v4u*)(AK + row * AKP + 8 * ch) = kv; *(LAS v4u*)(AV + row * AKP + 8 * ch) = vv; }
    if (F.tid < 128) { const int row = 256 + (F.tid >> 3), ch = F.tid & 7; *(LAS v4u*)(AK + row * AKP + 8 * ch) = (v4u){0u, 0u, 0u, 0u}; *(LAS v4u*)(AV + row * AKP + 8 * ch) = (v4u){0u, 0u, 0u, 0u}; }
    attn_bias_table(F, (LAS float*)(scr + A_BIAS), kvh);
    __syncthreads();
    const AttnLds L{AK, AV, (const LAS float*)(scr + A_BIAS), (LAS unsigned short*)(scr + A_P) + F.wave * 16 * APP};
    const int gq = F.lane >> 4, i = F.lane & 15, t0 = (n == 0) ? 112 : 16 * F.wave;
    const int kmin = FPAD - 128 * (n - 1);
    const size_t rbase = (size_t)b * LP + 128 * n;
    const int g_lo = (n == 0) ? F.wave : 0, g_hi = (n == 0) ? (F.wave < 4 ? F.wave + 1 : 0) : 4;
    bf16x8 qn[2] = {(bf16x8){0, 0, 0, 0, 0, 0, 0, 0}, (bf16x8){0, 0, 0, 0, 0, 0, 0, 0}};
    if (g_lo < g_hi) { const bf16* qp = F.P() + (rbase + t0 + i) * NPAD + C_QA + (kvh * 4 + g_lo) * 64; qn[0] = *(const GAS bf16x8*)(qp + 8 * gq); qn[1] = *(const GAS bf16x8*)(qp + 32 + 8 * gq); }
#pragma unroll 1
    for (int g = g_lo; g < g_hi; ++g) {
        const bf16x8 qa[2] = {qn[0], qn[1]};
        if (g + 1 < g_hi) { const bf16* qp = F.P() + (rbase + t0 + i) * NPAD + C_QA + (kvh * 4 + g + 1) * 64; qn[0] = *(const GAS bf16x8*)(qp + 8 * gq); qn[1] = *(const GAS bf16x8*)(qp + 32 + 8 * gq); }
        attn_tile<false>(F, L, qa, t0, kmin, t0, g, rbase + t0, sinks, kvh);
    }
    if (n == NBLK - 1) {
#pragma unroll
        for (int j = 0; j < 16; ++j) { const int e = F.tid + 512 * j, row = e >> 6, d = e & 63;
            const size_t oidx = (((size_t)b * WIN + row) * 4 + kvh) * 64 + d;
            F.out[O_KWP + oidx] = bf2f(AK[(128 + row) * AKP + d]); F.out[O_VWP + oidx] = bf2f(AV[(128 + row) * AKP + d]); }
    }
}

__device__ __forceinline__ void attn_sample_stage(Frame& F, LAS unsigned short* AK, LAS unsigned short* AV, int db, int kvh, gcf cache_k, gcf cache_v) {
#pragma unroll
    for (int j = 0; j < 4; ++j) { const int c = F.tid + 512 * j, row = c >> 4, ch = c & 15;
        const size_t src = (((size_t)db * WIN + row) * 4 + kvh) * 64 + 4 * ch;
        const f32x4 kv = *(const GAS f32x4*)(cache_k + src), vv = *(const GAS f32x4*)(cache_v + src);
        *(LAS unsigned long long*)(AK + row * AKP + 4 * ch) = (unsigned long long)pk2(kv.x, kv.y) | ((unsigned long long)pk2(kv.z, kv.w) << 32);
        *(LAS unsigned long long*)(AV + row * AKP + 4 * ch) = (unsigned long long)pk2(vv.x, vv.y) | ((unsigned long long)pk2(vv.z, vv.w) << 32);
        if (row >= DSEQ) { const size_t dst = (((size_t)db * WIN + row - DSEQ) * 4 + kvh) * 64 + 4 * ch; *(GAS f32x4*)(F.out + O_KWS + dst) = kv; *(GAS f32x4*)(F.out + O_VWS + dst) = vv; } }
    const size_t srow0 = (size_t)ROWS_P + (size_t)db * DSEQ;
    if (F.tid < 64) { const int t = F.tid >> 3, ch = F.tid & 7; const bf16* p = F.P() + (srow0 + t) * NPAD + kvh * 64 + 8 * ch;
        const v4u kv = *(const GAS v4u*)(p + C_KA), vv = *(const GAS v4u*)(p + C_VA);
        *(LAS v4u*)(AK + (128 + t) * AKP + 8 * ch) = kv; *(LAS v4u*)(AV + (128 + t) * AKP + 8 * ch) = vv;
        const size_t dst = (((size_t)db * WIN + (WIN - DSEQ) + t) * 4 + kvh) * 64 + 8 * ch;
        f32x4 a, c2; a.x = bf2f(kv.x & 0xffff); a.y = bf2f(kv.x >> 16); a.z = bf2f(kv.y & 0xffff); a.w = bf2f(kv.y >> 16); c2.x = bf2f(kv.z & 0xffff); c2.y = bf2f(kv.z >> 16); c2.z = bf2f(kv.w & 0xffff); c2.w = bf2f(kv.w >> 16);
        *(GAS f32x4*)(F.out + O_KWS + dst) = a; *(GAS f32x4*)(F.out + O_KWS + dst + 4) = c2;
        a.x = bf2f(vv.x & 0xffff); a.y = bf2f(vv.x >> 16); a.z = bf2f(vv.y & 0xffff); a.w = bf2f(vv.y >> 16); c2.x = bf2f(vv.z & 0xffff); c2.y = bf2f(vv.z >> 16); c2.z = bf2f(vv.w & 0xffff); c2.w = bf2f(vv.w >> 16);
        *(GAS f32x4*)(F.out + O_VWS + dst) = a; *(GAS f32x4*)(F.out + O_VWS + dst + 4) = c2; }
    if (F.tid >= 64 && F.tid < 64 + 192) { const int c = F.tid - 64, row = 136 + (c >> 3), ch = c & 7; *(LAS v4u*)(AK + row * AKP + 8 * ch) = (v4u){0u, 0u, 0u, 0u}; *(LAS v4u*)(AV + row * AKP + 8 * ch) = (v4u){0u, 0u, 0u, 0u}; }
}
__device__ __forceinline__ void attn_sample_tiles(Frame& F, const AttnLds& L, int db, int kvh, int wl, gcf sinks) {
    const int gq = F.lane >> 4, i = F.lane & 15; const size_t srow0 = (size_t)ROWS_P + (size_t)db * DSEQ;
    const bf16* qptr = F.P() + (srow0 + (i & 7)) * NPAD + C_QA + (kvh * 4 + 2 * wl + (i >> 3)) * 64;
    const bf16x8 qa[2] = {*(const GAS bf16x8*)(qptr + 8 * gq), *(const GAS bf16x8*)(qptr + 32 + 8 * gq)};
    attn_tile<true>(F, L, qa, 0, 0, 0, 2 * wl, srow0, sinks, kvh);
}
__device__ __forceinline__ void attn_sample_unit(Frame& F0, LAS unsigned char* scr, int u) { Frame F = F0; asm volatile("" : "+v"(F.tid), "+v"(F.lane));
    gcf const cache_k = ldarg<A_CK>(); gcf const cache_v = ldarg<A_CV>(); gcf const sinks = ldarg<A_SINK>();
    const int kvh = u & 3, db = u >> 2;
    LAS unsigned short* AK = (LAS unsigned short*)(scr + A_K); LAS unsigned short* AV = (LAS unsigned short*)(scr + A_V);
    __syncthreads();
    attn_sample_stage(F, AK, AV, db, kvh, cache_k, cache_v);
    attn_bias_table(F, (LAS float*)(scr + A_BIAS), kvh);
    __syncthreads();
    if (F.wave < 2) { const AttnLds L{AK, AV, (const LAS float*)(scr + A_BIAS), (LAS unsigned short*)(scr + A_P) + F.wave * 16 * APP}; attn_sample_tiles(F, L, db, kvh, F.wave, sinks); }
}
constexpr int SP_SLOT = 160 * AKP * 2, SP_BIAS = 4 * SP_SLOT, SP_P = SP_BIAS + 2048, SP_END = SP_P + 4 * 16 * APP * 2;
static_assert(SP_END <= LDS_BYTES - SCR_OFF, "sample pair LDS");
__device__ __forceinline__ void attn_sample_pair(Frame& F0, LAS unsigned char* scr, int u0, int u1) { Frame F = F0; asm volatile("" : "+v"(F.tid), "+v"(F.lane));
    gcf const cache_k = ldarg<A_CK>(); gcf const cache_v = ldarg<A_CV>(); gcf const sinks = ldarg<A_SINK>();
    const int kvh = u0 & 3;
    LAS unsigned short* K0 = (LAS unsigned short*)(scr); LAS unsigned short* V0 = (LAS unsigned short*)(scr + SP_SLOT);
    LAS unsigned short* K1 = (LAS unsigned short*)(scr + 2 * SP_SLOT); LAS unsigned short* V1 = (LAS unsigned short*)(scr + 3 * SP_SLOT);
    __syncthreads();
    attn_sample_stage(F, K0, V0, u0 >> 2, kvh, cache_k, cache_v);
    attn_sample_stage(F, K1, V1, u1 >> 2, kvh, cache_k, cache_v);
    attn_bias_table(F, (LAS float*)(scr + SP_BIAS), kvh);
    __syncthreads();
    if (F.wave < 4) { const int sl = F.wave >> 1;
        const AttnLds L{sl ? K1 : K0, sl ? V1 : V0, (const LAS float*)(scr + SP_BIAS), (LAS unsigned short*)(scr + SP_P) + F.wave * 16 * APP};
        attn_sample_tiles(F, L, (sl ? u1 : u0) >> 2, kvh, F.wave & 1, sinks); }
}

constexpr int GQP = 136, GVP = 264;
constexpr int G_Q = 0, G_K = 128 * GQP * 2, G_V = 2 * G_K, G_Z = G_V + 128 * GVP * 2, G_TOT = G_Z + 8192, G_D = G_TOT + 2048, G_END = G_D + 512;
static_assert(G_END <= LDS_BYTES - SCR_OFF, "GLA LDS");

template <bool NEED_Q>
__device__ __forceinline__ void gla_gate(Frame& F, LAS unsigned char* scr, int b, int c, int h) { gcf const w_a2 = ldarg<A_WA2>(); gcf const b_a = ldarg<A_BA>();
    LAS unsigned short* GQ = (LAS unsigned short*)(scr + G_Q); LAS unsigned short* GK = (LAS unsigned short*)(scr + G_K); LAS unsigned short* GV = (LAS unsigned short*)(scr + G_V);
    LAS float* GD = (LAS float*)(scr + G_D);
    const size_t R0 = (size_t)b * LP + 128 * c;
    const int lane = F.lane, gq = lane >> 4, i = lane & 15, w = F.wave;
    __syncthreads();
    bf16x8 za[8]; bf16x8 wh, wl; float ba;
    {
        v4u vv[8], kk[4], qq[4];
#pragma unroll
        for (int j = 0; j < 8; ++j) { const int cc = F.tid + 512 * j, row = cc >> 5, ch = cc & 31; vv[j] = *(const GAS v4u*)(F.P() + (R0 + row) * NPAD + C_VG + h * 256 + 8 * ch); }
#pragma unroll
        for (int j = 0; j < 4; ++j) { const int cc = F.tid + 512 * j, row = cc >> 4, ch = cc & 15; const bf16* p = F.P() + (R0 + row) * NPAD + h * 128 + 8 * ch;
            kk[j] = *(const GAS v4u*)(p + C_KG); if (NEED_Q) qq[j] = *(const GAS v4u*)(p + C_QG); }
#pragma unroll
        for (int tb = 0; tb < 8; ++tb) za[tb] = (gq < 2) ? *(const GAS bf16x8*)(F.P() + (R0 + 16 * tb + i) * NPAD + C_ZG + 8 * gq) : (bf16x8){0, 0, 0, 0, 0, 0, 0, 0};
#pragma unroll
        for (int j = 0; j < 8; ++j) { const float wv = (gq < 2) ? w_a2[(8 * gq + j) * 512 + h * 128 + 16 * w + i] : 0.f; const unsigned short hi = f2bf16(wv); wh[j] = (short)hi; wl[j] = (short)f2bf16(wv - bf2f(hi)); }
        ba = b_a[h * 128 + 16 * w + i];
#pragma unroll
        for (int j = 0; j < 8; ++j) { const int cc = F.tid + 512 * j, row = cc >> 5, ch = cc & 31; *(LAS v4u*)(GV + row * GVP + 8 * ch) = vv[j]; }
#pragma unroll
        for (int j = 0; j < 4; ++j) { const int cc = F.tid + 512 * j, row = cc >> 4, ch = cc & 15; *(LAS v4u*)(GK + row * GQP + 8 * ch) = kk[j]; if (NEED_Q) *(LAS v4u*)(GQ + row * GQP + 8 * ch) = qq[j]; }
    }
    f32x4 bc[8]; float run = 0.f;
#pragma unroll
    for (int tb = 0; tb < 8; ++tb) { f32x4 x = (f32x4){ba, ba, ba, ba}; x = MFMA16(za[tb], wh, x); x = MFMA16(za[tb], wl, x);
        float l0 = logsig_f(x[0]) * (1.f / 16.f), l1 = logsig_f(x[1]) * (1.f / 16.f), l2 = logsig_f(x[2]) * (1.f / 16.f), l3 = logsig_f(x[3]) * (1.f / 16.f);
        if (c == 0) { const int t0 = 16 * tb + 4 * gq; if (t0 + 0 < FPAD) l0 = 0.f; if (t0 + 1 < FPAD) l1 = 0.f; if (t0 + 2 < FPAD) l2 = 0.f; if (t0 + 3 < FPAD) l3 = 0.f; }
        const float p0 = l0, p1 = p0 + l1, p2 = p1 + l2, p3 = p2 + l3;
        float a = p3; const float u1 = __shfl_up(a, 16); if (gq >= 1) a += u1; const float u2 = __shfl_up(a, 32); if (gq >= 2) a += u2;
        const float excl = a - p3, tot = __shfl(a, 48 + i);
        bc[tb] = (f32x4){run + excl + p0, run + excl + p1, run + excl + p2, run + excl + p3}; run += tot; }
    __syncthreads();
#pragma unroll
    for (int tb = 0; tb < 8; ++tb)
#pragma unroll
        for (int r = 0; r < 4; ++r) { const int t = 16 * tb + 4 * gq + r, k = 16 * w + i; const float bt = bc[tb][r];
            GK[t * GQP + k] = f2bf16(bf2f(GK[t * GQP + k]) * __expf(-bt));
            if (NEED_Q) GQ[t * GQP + k] = f2bf16(bf2f(GQ[t * GQP + k]) * __expf(bt) * 0.08838834764831845f); }
    if (gq == 0) GD[16 * w + i] = __expf(run);
    __syncthreads();
}

__device__ __forceinline__ void gla_ds_unit(Frame& F0, LAS unsigned char* scr, int b, int c, int h) { Frame F = F0; asm volatile("" : "+v"(F.tid), "+v"(F.lane));
    const int u = (b * NBLK + c) * 4 + h;
    gla_gate<false>(F, scr, b, c, h);
    const LAS unsigned short* GK = (const LAS unsigned short*)(scr + G_K); const LAS unsigned short* GV = (const LAS unsigned short*)(scr + G_V); const LAS float* GD = (const LAS float*)(scr + G_D);
    int lane = F.lane; asm volatile("" : "+v"(lane));
    const int gq = lane >> 4, i = lane & 15, w = F.wave;
    f32x4 acc[8][2];
#pragma unroll
    for (int rb = 0; rb < 8; ++rb) { acc[rb][0] = (f32x4){0.f, 0.f, 0.f, 0.f}; acc[rb][1] = (f32x4){0.f, 0.f, 0.f, 0.f}; }
#pragma unroll
    for (int ks = 0; ks < 4; ++ks) {
        if (c == 0 && ks < 3) continue;
        const bf16x8 vb0 = tr_frag(GV, 32 * ks + 8 * gq, 32 * w, GVP, lane), vb1 = tr_frag(GV, 32 * ks + 8 * gq, 32 * w + 16, GVP, lane);
#pragma unroll
        for (int rb = 0; rb < 8; ++rb) { const bf16x8 ka = tr_frag(GK, 32 * ks + 8 * gq, 16 * rb, GQP, lane); acc[rb][0] = MFMA16(ka, vb0, acc[rb][0]); acc[rb][1] = MFMA16(ka, vb1, acc[rb][1]); } }
    float* dst = F.dST() + (size_t)u * 32768;
#pragma unroll
    for (int rb = 0; rb < 8; ++rb) { const f32x4 d4 = *(const LAS f32x4*)(GD + 16 * rb + 4 * gq);
#pragma unroll
        for (int cb = 0; cb < 2; ++cb) *(GAS f32x4*)(dst + (size_t)(32 * w + 16 * cb + i) * 128 + 16 * rb + 4 * gq) = acc[rb][cb] * d4; }
    if (F.tid < 128) F.dec()[(size_t)u * 128 + F.tid] = GD[F.tid];
}

__device__ __forceinline__ void gla_scan(Frame& F) {
    for (int e = blockIdx.x * NTHREADS + F.tid; e < NBATCH * 4 * 256 * 64; e += F.G * NTHREADS) {
        const int k2 = e & 63, v = (e >> 6) & 255, bh = e >> 14, b = bh >> 2, h = bh & 3;
        float s0 = 0.f, s1 = 0.f;
#pragma unroll 1
        for (int c0 = 0; c0 < NBLK; c0 += 11) {
            f32x2 d[11], ds[11];
#pragma unroll
            for (int q = 0; q < 11; ++q) { const size_t u = ((size_t)b * NBLK + c0 + q) * 4 + h;
                d[q] = *(const GAS f32x2*)(F.dec() + u * 128 + 2 * k2); ds[q] = *(const GAS f32x2*)(F.dST() + u * 32768 + (size_t)v * 128 + 2 * k2); }
#pragma unroll
            for (int q = 0; q < 11; ++q) { const size_t u = ((size_t)b * NBLK + c0 + q) * 4 + h;
                *(GAS unsigned*)(F.St() + u * 32768 + (size_t)v * 128 + 2 * k2) = pk2(s0, s1);
                s0 = d[q].x * s0 + ds[q].x; s1 = d[q].y * s1 + ds[q].y; }
        }
        float* gp = F.out + O_GP + ((size_t)bh * 128 + 2 * k2) * 256 + v; gp[0] = s0; gp[256] = s1;
    }
}

__device__ __forceinline__ void gla_out_unit(Frame& F0, LAS unsigned char* scr, int b, int c, int h) { Frame F = F0; asm volatile("" : "+v"(F.tid), "+v"(F.lane)); gcf const gla_norm = ldarg<A_GNORM>();
    const int u = (b * NBLK + c) * 4 + h;
    const bf16* St = F.St() + (size_t)u * 32768; const size_t R0 = (size_t)b * LP + 128 * c;
    v4u stp[8], gvp[8];
#pragma unroll
    for (int j = 0; j < 8; ++j) { const int cc = F.tid + 512 * j; stp[j] = (c != 0) ? *(const GAS v4u*)(St + (size_t)(cc >> 4) * 128 + 8 * (cc & 15)) : (v4u){0u, 0u, 0u, 0u}; }
#pragma unroll
    for (int j = 0; j < 8; ++j) { const int q = F.lane + 64 * j, row = 16 * F.wave + (q >> 5), ch = q & 31; gvp[j] = *(const GAS v4u*)(F.P() + (R0 + row) * NPAD + C_GG + h * 256 + 8 * ch); }
    gla_gate<true>(F, scr, b, c, h);
    const LAS unsigned short* GQ = (const LAS unsigned short*)(scr + G_Q); LAS unsigned short* GK = (LAS unsigned short*)(scr + G_K); const LAS unsigned short* GV = (const LAS unsigned short*)(scr + G_V);
    int lane = F.lane; asm volatile("" : "+v"(lane));
    const int gq = lane >> 4, i = lane & 15, w = F.wave;
    const bool active = true;
    bf16x8 qa[4];
#pragma unroll
    for (int ks = 0; ks < 4; ++ks) qa[ks] = *(const LAS bf16x8*)(GQ + (16 * w + i) * GQP + 32 * ks + 8 * gq);
    f32x4 aa[8];
#pragma unroll
    for (int sb = 0; sb < 8; ++sb) { aa[sb] = (f32x4){0.f, 0.f, 0.f, 0.f};
        if (active && sb <= w) {
#pragma unroll
            for (int ks = 0; ks < 4; ++ks) { const bf16x8 kb = *(const LAS bf16x8*)(GK + (16 * sb + i) * GQP + 32 * ks + 8 * gq); aa[sb] = MFMA16(qa[ks], kb, aa[sb]); } } }
    __syncthreads();
    f32x4 acc[16];
#pragma unroll
    for (int cb = 0; cb < 16; ++cb) acc[cb] = (f32x4){0.f, 0.f, 0.f, 0.f};
    if (active) {
#pragma unroll
    for (int sb = 0; sb < 8; ++sb)
#pragma unroll
        for (int r = 0; r < 4; ++r) { const int t = 16 * w + 4 * gq + r, s = 16 * sb + i; GK[t * GQP + s] = f2bf16(s <= t ? aa[sb][r] : 0.f); }
    LDS_WAIT(); asm volatile("" ::: "memory");
#pragma unroll
    for (int ks = 0; ks < 4; ++ks) {
        if (2 * ks <= w) {
            const bf16x8 af = *(const LAS bf16x8*)(GK + (16 * w + i) * GQP + 32 * ks + 8 * gq);
#pragma unroll
            for (int cb = 0; cb < 16; ++cb) { const bf16x8 vb = tr_frag(GV, 32 * ks + 8 * gq, 16 * cb, GVP, lane); acc[cb] = MFMA16(af, vb, acc[cb]); } } }
    }
    __syncthreads();
    { LAS unsigned char* GS = scr + G_V;
#pragma unroll
      for (int j = 0; j < 8; ++j) { const int cc = F.tid + 512 * j, v = cc >> 4, ch = cc & 15; *(LAS v4u*)(GS + v * 256 + ((ch ^ (v & 15)) << 4)) = stp[j]; } }
    __syncthreads();
    if (active) {
    if (c != 0) {
        const LAS unsigned char* GS = scr + G_V;
#pragma unroll
    for (int ks = 0; ks < 4; ++ks)
#pragma unroll
        for (int cb = 0; cb < 16; ++cb) { const bf16x8 sb = *(const LAS bf16x8*)(GS + (16 * cb + i) * 256 + (((4 * ks + gq) ^ i) << 4)); acc[cb] = MFMA16(qa[ks], sb, acc[cb]); }
    }
    LDS_WAIT(); asm volatile("" ::: "memory");
    { LAS unsigned short* GQw = (LAS unsigned short*)(scr + G_Q);
#pragma unroll
    for (int r = 0; r < 4; ++r) { float ss = 0.f;
#pragma unroll
        for (int cb = 0; cb < 16; ++cb) ss += acc[cb][r] * acc[cb][r];
        ss += __shfl_xor(ss, 1); ss += __shfl_xor(ss, 2); ss += __shfl_xor(ss, 4); ss += __shfl_xor(ss, 8);
        const float rstd = rsqrtf(ss * (1.f / 256.f) + EPSN); const int row = 16 * w + 4 * gq + r;
#pragma unroll
        for (int cb = 0; cb < 8; ++cb) { GQw[row * GQP + 16 * cb + i] = f2bf16(acc[cb][r] * rstd); GK[row * GQP + 16 * cb + i] = f2bf16(acc[cb + 8][r] * rstd); } }
    LDS_WAIT(); asm volatile("" ::: "memory");
#pragma unroll
    for (int j = 0; j < 8; ++j) { const int q = lane + 64 * j, row = 16 * w + (q >> 5), ch = q & 31;
        const v4u ov = *(const LAS v4u*)((ch < 16 ? GQw : GK) + row * GQP + 8 * (ch & 15));
        const v4u gv = gvp[j];
        const f32x4 n0 = *(const GAS f32x4*)(gla_norm + 8 * ch), n1 = *(const GAS f32x4*)(gla_norm + 8 * ch + 4);
        v4u res;
        res.x = pk2(bf2f(ov.x & 0xffff) * n0.x * silu_f(bf2f(gv.x & 0xffff)), bf2f(ov.x >> 16) * n0.y * silu_f(bf2f(gv.x >> 16)));
        res.y = pk2(bf2f(ov.y & 0xffff) * n0.z * silu_f(bf2f(gv.y & 0xffff)), bf2f(ov.y >> 16) * n0.w * silu_f(bf2f(gv.y >> 16)));
        res.z = pk2(bf2f(ov.z & 0xffff) * n1.x * silu_f(bf2f(gv.z & 0xffff)), bf2f(ov.z >> 16) * n1.y * silu_f(bf2f(gv.z >> 16)));
        res.w = pk2(bf2f(ov.w & 0xffff) * n1.z * silu_f(bf2f(gv.w & 0xffff)), bf2f(ov.w >> 16) * n1.w * silu_f(bf2f(gv.w >> 16)));
        *(GAS v4u*)(F.MIX() + (R0 + row) * DM + 1024 + h * 256 + 8 * ch) = res; } }
    }
}

constexpr int S_Q = 0, S_KH = 4096, S_KT = 8192, S_LG = 12288, S_D = 16384, S_A = 16896, S_Z = 17152, S_OP = 17664, S_END = S_OP + 65536;
static_assert(S_END <= LDS_BYTES - SCR_OFF, "sample GLA LDS");
__device__ __forceinline__ void gla_sample_unit(Frame& F0, LAS unsigned char* scr, int u) { Frame F = F0; asm volatile("" : "+v"(F.tid), "+v"(F.lane));
    gcf const w_a2 = ldarg<A_WA2>(); gcf const b_a = ldarg<A_BA>(); gcf const state = ldarg<A_STATE>(); gcf const gla_norm = ldarg<A_GNORM>();
    const int h = u & 3, db = u >> 2;
    LAS float* SQ = (LAS float*)(scr + S_Q); LAS float* SKH = (LAS float*)(scr + S_KH); LAS float* SKT = (LAS float*)(scr + S_KT); LAS float* SLG = (LAS float*)(scr + S_LG); LAS float* SD = (LAS float*)(scr + S_D);
    LAS float* SA = (LAS float*)(scr + S_A); LAS float* SZ = (LAS float*)(scr + S_Z); LAS float* SOP = (LAS float*)(scr + S_OP);
    const size_t R0 = (size_t)ROWS_P + (size_t)db * DSEQ;
    const int w = F.wave, lane = F.lane;
    f32x4 st[16];
    { const GAS f32x4* sp = (const GAS f32x4*)(state + ((size_t)u * 128 + 16 * w) * 256) + lane;
#pragma unroll
      for (int kk = 0; kk < 16; ++kk) st[kk] = sp[64 * kk]; }
    __syncthreads();
    if (F.tid < 128) SZ[F.tid] = bf2f(F.P()[(R0 + (F.tid >> 4)) * NPAD + C_ZG + (F.tid & 15)]);
    const int k = F.tid & 127, tp = F.tid >> 7;
    float qv[2], kv[2], wv[16];
#pragma unroll
    for (int q = 0; q < 2; ++q) { const bf16* p = F.P() + (R0 + 2 * tp + q) * NPAD + h * 128 + k; qv[q] = bf2f(p[C_QG]); kv[q] = bf2f(p[C_KG]); }
#pragma unroll
    for (int r = 0; r < 16; ++r) wv[r] = w_a2[r * 512 + h * 128 + k];
    const float ba = b_a[h * 128 + k];
    __syncthreads();
#pragma unroll
    for (int q = 0; q < 2; ++q) { const int t = 2 * tp + q; float x = ba;
#pragma unroll
        for (int r = 0; r < 16; ++r) x += SZ[t * 16 + r] * wv[r];
        SLG[t * 128 + k] = logsig_f(x) * (1.f / 16.f); }
    __syncthreads();
    { float run = 0.f, bt[2] = {0.f, 0.f};
#pragma unroll
      for (int t = 0; t < 8; ++t) { run += SLG[t * 128 + k]; if (t == 2 * tp) bt[0] = run; if (t == 2 * tp + 1) bt[1] = run; }
#pragma unroll
      for (int q = 0; q < 2; ++q) { const int t = 2 * tp + q;
          SQ[k * 8 + t] = qv[q] * __expf(bt[q]) * 0.08838834764831845f; SKT[k * 8 + t] = kv[q] * __expf(-bt[q]); SKH[k * 8 + t] = kv[q] * __expf(run - bt[q]); }
      if (tp == 0) SD[k] = __expf(run); }
    __syncthreads();
    if (F.tid < 64) { const int t = F.tid >> 3, s2 = F.tid & 7; float a = 0.f;
        if (s2 <= t) { for (int kk = 0; kk < 128; ++kk) a += SQ[kk * 8 + t] * SKT[kk * 8 + s2]; }
        SA[t * 8 + s2] = a; }
    {   f32x4 vv[8], op[8];
#pragma unroll
        for (int t = 0; t < 8; ++t) { const unsigned long long pv = *(const GAS unsigned long long*)(F.P() + (R0 + t) * NPAD + C_VG + h * 256 + 4 * lane);
            vv[t] = (f32x4){bf2f((unsigned short)pv), bf2f((unsigned short)(pv >> 16)), bf2f((unsigned short)(pv >> 32)), bf2f((unsigned short)(pv >> 48))}; op[t] = (f32x4){0.f, 0.f, 0.f, 0.f}; }
        GAS f32x4* np = (GAS f32x4*)(F.out + O_GS + ((size_t)u * 128 + 16 * w) * 256) + lane;
#pragma unroll
        for (int kk = 0; kk < 16; ++kk) { const int kc = 16 * w + kk; const f32x4 s0 = st[kk];
            const f32x4 q0 = *(const LAS f32x4*)(SQ + kc * 8), q1 = *(const LAS f32x4*)(SQ + kc * 8 + 4), h0 = *(const LAS f32x4*)(SKH + kc * 8), h1 = *(const LAS f32x4*)(SKH + kc * 8 + 4);
            f32x4 sn = s0 * SD[kc];
            sn += vv[0] * h0.x + vv[1] * h0.y + vv[2] * h0.z + vv[3] * h0.w + vv[4] * h1.x + vv[5] * h1.y + vv[6] * h1.z + vv[7] * h1.w;
            np[64 * kk] = sn;
            op[0] += s0 * q0.x; op[1] += s0 * q0.y; op[2] += s0 * q0.z; op[3] += s0 * q0.w; op[4] += s0 * q1.x; op[5] += s0 * q1.y; op[6] += s0 * q1.z; op[7] += s0 * q1.w; }
#pragma unroll
        for (int t = 0; t < 8; ++t) *(LAS f32x4*)(SOP + (w * 8 + t) * 256 + 4 * lane) = op[t];
    }
    __syncthreads();
    {   const int t = w; f32x4 a = (f32x4){0.f, 0.f, 0.f, 0.f};
#pragma unroll
        for (int w2 = 0; w2 < 8; ++w2) a += *(const LAS f32x4*)(SOP + (w2 * 8 + t) * 256 + 4 * lane);
        for (int s2 = 0; s2 <= t; ++s2) { const unsigned long long pv = *(const GAS unsigned long long*)(F.P() + (R0 + s2) * NPAD + C_VG + h * 256 + 4 * lane); const float c = SA[t * 8 + s2];
            a += (f32x4){bf2f((unsigned short)pv), bf2f((unsigned short)(pv >> 16)), bf2f((unsigned short)(pv >> 32)), bf2f((unsigned short)(pv >> 48))} * c; }
        const float ss = (a.x * a.x + a.y * a.y) + (a.z * a.z + a.w * a.w);
        const float rstd = rsqrtf(wave_sum(ss) * (1.f / 256.f) + EPSN);
        const unsigned long long gv = *(const GAS unsigned long long*)(F.P() + (R0 + t) * NPAD + C_GG + h * 256 + 4 * lane); const f32x4 gn = *(const GAS f32x4*)(gla_norm + 4 * lane);
        const float g0 = bf2f((unsigned short)gv), g1 = bf2f((unsigned short)(gv >> 16)), g2 = bf2f((unsigned short)(gv >> 32)), g3 = bf2f((unsigned short)(gv >> 48));
        *(GAS unsigned long long*)(F.MIX() + (R0 + t) * DM + 1024 + h * 256 + 4 * lane) =
            (unsigned long long)pk2(a.x * rstd * gn.x * silu_f(g0), a.y * rstd * gn.y * silu_f(g1)) | ((unsigned long long)pk2(a.z * rstd * gn.z * silu_f(g2), a.w * rstd * gn.w * silu_f(g3)) << 32);
    }
}

__device__ __forceinline__ void final_rows(Frame& F) { gcf const x_prompt = ldarg<A_XP>(); gcf const x_sample = ldarg<A_XS>(); gcf const norm_post = ldarg<A_NPOST>();
    const int gw = blockIdx.x * NWAVES + F.wave, NGW = F.G * NWAVES; constexpr int NR = NBATCH * SEQ + ROWS_S;
    for (int idx0 = gw; idx0 < NR; idx0 += 2 * NGW) {
        f32x4 v[2][8], xx[2][8]; float* yp[2]; bool on[2];
#pragma unroll
        for (int q = 0; q < 2; ++q) { const int idx = idx0 + q * NGW; on[q] = idx < NR; const int id2 = on[q] ? idx : idx0;
            size_t grow; gcf x;
            if (id2 < NBATCH * SEQ) { const int b = id2 / SEQ, s2 = id2 - b * SEQ; grow = (size_t)b * LP + 128 + s2; x = x_prompt + (size_t)id2 * DM; yp[q] = F.out + O_YP + (size_t)id2 * DM; }
            else { const int j = id2 - NBATCH * SEQ; grow = (size_t)ROWS_P + j; x = x_sample + (size_t)j * DM; yp[q] = F.out + O_YS + (size_t)j * DM; }
            const GAS unsigned long long* o4 = (const GAS unsigned long long*)yp[q] + F.lane;   const GAS f32x4* x4 = (const GAS f32x4*)x + F.lane;
#pragma unroll
            for (int j = 0; j < 8; ++j) { const unsigned long long ov = o4[64 * j]; v[q][j] = (f32x4){bf2f((unsigned short)ov), bf2f((unsigned short)(ov >> 16)), bf2f((unsigned short)(ov >> 32)), bf2f((unsigned short)(ov >> 48))}; xx[q][j] = x4[64 * j]; } }
#pragma unroll
        for (int q = 0; q < 2; ++q) { float s2 = 0.f;
#pragma unroll
            for (int j = 0; j < 8; ++j) s2 += (v[q][j].x * v[q][j].x + v[q][j].y * v[q][j].y) + (v[q][j].z * v[q][j].z + v[q][j].w * v[q][j].w);
            const float rstd = rsqrtf(wave_sum(s2) * (1.f / DM) + EPSN);
            if (on[q]) { GAS f32x4* y4 = (GAS f32x4*)yp[q] + F.lane;
#pragma unroll
                for (int j = 0; j < 8; ++j) { const f32x4 w = ((const GAS f32x4*)norm_post)[F.lane + 64 * j]; y4[64 * j] = xx[q][j] + v[q][j] * rstd * w; } } }
    }
}

#ifndef MK_PER_PHASE
#define MK_PER_PHASE 0
#endif
constexpr int N_PHASES = 7;
struct Args { const float* in[15]; float* out; unsigned char* ws; int ph_lo, ph_hi; };
__global__ void __launch_bounds__(NTHREADS, 2) hymba_fwd(Args args) {
    extern __shared__ __attribute__((aligned(16))) unsigned char lds_raw[];
    Frame F;
    F.lds = (LAS unsigned char*)lds_raw;
    F.tid = threadIdx.x; F.lane = F.tid & 63; F.wave = __builtin_amdgcn_readfirstlane(F.tid >> 6); F.G = gridDim.x;
    F.out = args.out; F.ws = args.ws;
    unsigned char* ws = args.ws;
    for (int u = F.tid; u < LDS_CTL_BYTES / 4; u += NTHREADS) ((LAS unsigned*)F.lds)[u] = 0u;
    __syncthreads();
    volatile LAS unsigned* MISC = (volatile LAS unsigned*)(F.lds + 512);
    XcdBarrier bar; bar.bar = (unsigned*)(ws + WS_CTL) + CW_BAR; bar.x = 0; bar.st = nullptr;
    if (!MK_PER_PHASE) bar = xcd_barrier_post((unsigned*)(ws + WS_CTL) + CW_BAR, MISC + 8);
    LAS unsigned char* scr = F.lds + SCR_OFF;
    const int lo = args.ph_lo, hi = args.ph_hi;
#define IN(k) (lo <= (k) && (k) < hi)
#define SEAM(k) do { if (IN(k) && IN((k) + 1)) xcd_barrier(bar); } while (0)

#ifndef PROBE_PHASE
#define PROBE_PHASE -1
#endif
#ifndef PROBE_REP
#define PROBE_REP 1
#endif
#define REPS(k) for (int rep_ = 0; rep_ < ((k) == PROBE_PHASE ? PROBE_REP : 1); ++rep_)
    constexpr int P0_I_IN = (DM / 64) * (NPAD / 64), P0_I_ALL = P0_I_IN + (DM / 64) * (DM / 64);
    constexpr int G1_TAIL = (MROWS / 256) * (NPAD / 256) % 256;
    const bool wout_late = (F.G == 256) && !MK_PER_PHASE && IN(0) && IN(1) && IN(2) && PROBE_PHASE < 0;
    REPS(0) if (IN(0)) { p0_prologue(F, 0, wout_late ? P0_I_IN : P0_I_ALL, 0, F.G, true); if (PROBE_PHASE == 0) xcd_barrier(bar); }
    SEAM(0);
#define UNIT_BCH(idx, b_, c_, h_) const int b_ = (idx) < 256 ? (idx) >> 7 : ((idx) - 256) >> 2, c_ = (idx) < 256 ? 1 + (((idx) >> 2) & 31) : 0, h_ = (idx) & 3
    const bool split12 = (F.G == 256) && !MK_PER_PHASE && IN(0) && IN(1) && IN(2) && PROBE_PHASE < 0;
    if (split12) {
        constexpr int G1_MP = ROWS_P / 256, G1_MS = ROWS_S / 256, G1_N = NPAD / 256, G1_FULL = (G1_MP + G1_MS) * G1_N / 256;
        const int cb_ = (int)blockIdx.x;
        { pg8::Gemm g{F.XN(), F.WinT(), MROWS, NPAD, DM}; pg8::OrderPF S{G1_MP, G1_MS, G1_N, F.G, cb_, 0, G1_FULL};
          pg8::EpiBf16<0> E{F.P(), NPAD, nullptr, 0, 0, 1.f}; pg8::gemm_phase<pg8::EpiBf16<0>, pg8::OrderPF, true, true>(scr, g, S, E); }
        xcd_barrier(bar);
        if (cb_ < G1_TAIL) {
            { pg8::Gemm g{F.XN(), F.WinT(), MROWS, NPAD, DM}; pg8::OrderPF S{G1_MP, G1_MS, G1_N, F.G, cb_, G1_FULL, G1_FULL + 1};
              pg8::EpiBf16<0> E{F.P(), NPAD, nullptr, 0, 0, 1.f}; pg8::gemm_phase<pg8::EpiBf16<0>, pg8::OrderPF, true, true>(scr, g, S, E); }
        } else { { UNIT_BCH(cb_, b_, c_, h_); attn_prompt_unit(F, scr, b_, c_, h_); gla_ds_unit(F, scr, b_, c_, h_); }
            __syncthreads(); p0_prologue(F, P0_I_IN, P0_I_ALL, G1_TAIL, F.G - G1_TAIL, false); }
        xcd_barrier(bar);
        if (cb_ < G1_TAIL) { { UNIT_BCH(cb_, b_, c_, h_); attn_prompt_unit(F, scr, b_, c_, h_); gla_ds_unit(F, scr, b_, c_, h_); } gla_sample_unit(F, scr, cb_); }
        else if (cb_ < G1_TAIL + 8) { UNIT_BCH(256 + (cb_ - G1_TAIL), b_, c_, h_); attn_prompt_unit(F, scr, b_, c_, h_); gla_ds_unit(F, scr, b_, c_, h_); gla_out_unit(F, scr, b_, c_, h_); }
        else { const int v = cb_ - (G1_TAIL + 8), nb = 256 - (G1_TAIL + 8);
            attn_sample_pair(F, scr, v, 256 + v); if (nb + v < 256) attn_sample_pair(F, scr, nb + v, 256 + nb + v);
            gla_sample_unit(F, scr, G1_TAIL + v); gla_sample_unit(F, scr, G1_TAIL + nb + v); { const int n3 = DBATCH * 4 - (G1_TAIL + 2 * nb), v3 = v - (nb - n3); if (v3 >= 0) gla_sample_unit(F, scr, G1_TAIL + 2 * nb + v3); } }
    } else {
    REPS(1) if (IN(1)) {
        pg8::Gemm g{F.XN(), F.WinT(), MROWS, NPAD, DM}; pg8::StaticOrder S; S.init(MROWS, NPAD, F.G, (int)blockIdx.x);
        pg8::EpiBf16<0> E{F.P(), NPAD, nullptr, 0, 0, 1.f};
        pg8::gemm_phase<pg8::EpiBf16<0>, pg8::StaticOrder, true, true>(scr, g, S, E);
        if (wout_late && (int)blockIdx.x >= G1_TAIL) { __syncthreads(); p0_prologue(F, P0_I_IN, P0_I_ALL, G1_TAIL, F.G - G1_TAIL, false); }
        if (PROBE_PHASE == 1) xcd_barrier(bar);
    }
    SEAM(1);
    REPS(2) if (IN(2)) {
        REPS(20) for (int u = blockIdx.x; u < NBATCH * NBLK * 4; u += F.G) { UNIT_BCH(u, b_, c_, h_); attn_prompt_unit(F, scr, b_, c_, h_); }
        REPS(21) for (int u = blockIdx.x; u < NBATCH * NBLK * 4; u += F.G) { UNIT_BCH(u, b_, c_, h_); gla_ds_unit(F, scr, b_, c_, h_); }
        if (F.G == 256) {
            if (blockIdx.x < 8) { UNIT_BCH(256 + (int)blockIdx.x, b_, c_, h_); gla_out_unit(F, scr, b_, c_, h_); }
            else { const int v = (int)blockIdx.x - 8;
                attn_sample_pair(F, scr, v, 248 + v); if (v < 16) attn_sample_unit(F, scr, 496 + v);
                gla_sample_unit(F, scr, v); gla_sample_unit(F, scr, 248 + v); if (v >= 16 && v < 32) gla_sample_unit(F, scr, 496 + v - 16); }
        } else {
            for (int u = 256 + blockIdx.x; u < NBATCH * NBLK * 4; u += F.G) { UNIT_BCH(u, b_, c_, h_); gla_out_unit(F, scr, b_, c_, h_); }
            REPS(22) for (int u = blockIdx.x; u < DBATCH * 4; u += F.G) attn_sample_unit(F, scr, u);
            REPS(23) for (int u = blockIdx.x; u < DBATCH * 4; u += F.G) gla_sample_unit(F, scr, u);
        }
        if (PROBE_PHASE == 2) xcd_barrier(bar);
    }
    }
    SEAM(2);
    REPS(3) if (IN(3)) { gla_scan(F); if (PROBE_PHASE == 3) xcd_barrier(bar); }
    SEAM(3);
    REPS(4) if (IN(4)) {
        for (int u = blockIdx.x; u < 256; u += F.G) { UNIT_BCH(u, b_, c_, h_); gla_out_unit(F, scr, b_, c_, h_); }
        __syncthreads();
        if (PROBE_PHASE == 4) xcd_barrier(bar);
    }
    SEAM(4);
    REPS(5) if (IN(5)) {
        pg8::Gemm g{F.MIX(), F.WoutT(), MROWS, DM, DM}; pg8::StaticOrder S; S.init(MROWS, DM, F.G, (int)blockIdx.x);
        pg8::EpiY16 E{F.out + O_YP, F.out + O_YS, LP, SEQ, ROWS_P};
        pg8::gemm_phase<pg8::EpiY16, pg8::StaticOrder, true, true>(scr, g, S, E);
        if (PROBE_PHASE == 5) xcd_barrier(bar);
    }
    SEAM(5);
    REPS(6) if (IN(6)) { final_rows(F); if (PROBE_PHASE == 6) xcd_barrier(bar); }
#undef IN
#undef SEAM
}

extern "C" void kernel_launch(void* const* d_in, const int* in_sizes, int n_in, void* d_out, int out_size, void* d_ws, size_t ws_size, hipStream_t stream) {
    static int grid = 0;
    if (grid == 0) {
        if (n_in != 15 || out_size != (int)O_END || ws_size < WS_END) { fprintf(stderr, "kernel_launch: unexpected problem: n_in %d out %d ws %zu\n", n_in, out_size, ws_size); grid = -1; return; }
        int dev = 0, cus = 0, per_cu = 0;
        if (hipGetDevice(&dev) != hipSuccess || hipDeviceGetAttribute(&cus, hipDeviceAttributeMultiprocessorCount, dev) != hipSuccess) { grid = -1; return; }
        if (hipFuncSetAttribute((const void*)hymba_fwd, hipFuncAttributeMaxDynamicSharedMemorySize, LDS_BYTES) != hipSuccess) { fprintf(stderr, "kernel_launch: hipFuncSetAttribute failed\n"); grid = -1; return; }
        if (hipOccupancyMaxActiveBlocksPerMultiprocessor(&per_cu, (const void*)hymba_fwd, NTHREADS, LDS_BYTES) != hipSuccess || per_cu < 1) fprintf(stderr, "kernel_launch: note: occupancy query reports %d\n", per_cu);
        (void)hipGetLastError();
        grid = cus;
    }
    if (grid < 0) return;
    (void)hipMemsetAsync((char*)d_ws + WS_CTL, 0, CTL_ZERO_BYTES, stream);
    Args a{};
    for (int i = 0; i < 15; ++i) a.in[i] = (const float*)d_in[i];
    a.out = (float*)d_out; a.ws = (unsigned char*)d_ws;
#if MK_PER_PHASE
    for (int p = 0; p < N_PHASES; ++p) { a.ph_lo = p; a.ph_hi = p + 1; hipLaunchKernelGGL(hymba_fwd, dim3(grid), dim3(NTHREADS), LDS_BYTES, stream, a); }
#else
    a.ph_lo = 0; a.ph_hi = N_PHASES;
    hipLaunchKernelGGL(hymba_fwd, dim3(grid), dim3(NTHREADS), LDS_BYTES, stream, a);
#endif
}
```

```cpp
#include <hip/hip_runtime.h>
#include <cstdio>
#include <cstdint>
#include <cmath>
namespace pg8 {
#define PG8_LAS __attribute__((address_space(3)))
typedef unsigned short bf16_t;
typedef short bf16x8 __attribute__((ext_vector_type(8)));
typedef float f32x4 __attribute__((ext_vector_type(4)));
typedef unsigned u32x4 __attribute__((ext_vector_type(4)));
constexpr int BM = 256, BK = 64, HALF = 128, HTB = HALF * BK * 2  , STAGE_BYTES = 8 * HTB, NXCD = 8, WGM = 8;

__host__ __device__ __forceinline__ int lds_byte(int r, int c) { const int st = (r >> 4) * 2 + (c >> 5), rr = r & 15, cc = c & 31, ob = rr * 64 + cc * 2; return st * 1024 + (ob ^ (((ob >> 9) & 1) << 5)); }
__host__ __device__ __forceinline__ void stage_rc(int b, int& R, int& C) { const int st = b / 1024, sb = b % 1024, swz = sb ^ (((sb >> 9) & 1) << 5); R = (st >> 1) * 16 + swz / 64; C = (st & 1) * 32 + (swz % 64) / 2; }
__host__ __device__ __forceinline__ int perm32(int rho) { const int n = rho >> 4, i = rho & 15; return 8 * (i >> 2) + 4 * n + (i & 3); }

struct Unit { int pm, pn; };
struct Gemm { const bf16_t* A; const bf16_t* Bt; int M, N, K; };

struct StaticOrder {
    int nM, nN, nwg, G, c;
    __host__ __device__ void init(int M, int N, int G_, int c_) { nM = M / BM; nN = N / BM; nwg = nM * nN; G = G_; c = c_; }
    __host__ __device__ bool next(int i, Unit& u) const {
        const long L = (long)i * G + c; if (L >= nwg) return false;
        int wgid = (int)L; { const int q = nwg / NXCD, r = nwg % NXCD, xcd = wgid % NXCD, off = wgid / NXCD; wgid = (xcd < r ? xcd * (q + 1) : r * (q + 1) + (xcd - r) * q) + off; }
        const int nig = WGM * nN, gid = wgid / nig, fm = gid * WGM, gsz = (nM - fm) < WGM ? (nM - fm) : WGM;
        u.pm = fm + ((wgid % nig) % gsz); u.pn = (wgid % nig) / gsz; return true;
    }
    __device__ __forceinline__ void a_ready(const Unit&) const {}
    __device__ __forceinline__ void done(const Unit&) const {}
};

struct OrderPF {
    int nMp, nMs, nN, G, c, r0, r1;
    __device__ bool next(int i, Unit& u) const {
        const int ii = r0 + i; if (ii >= r1) return false;
        const int nP = nMp * nN, nT = (nMp + nMs) * nN; const int e = ii * G + c; if (e >= nT) return false;
        if (e < nP) { int wgid = e; { const int q = nP / NXCD, r = nP % NXCD, xcd = wgid % NXCD, off = wgid / NXCD; wgid = (xcd < r ? xcd * (q + 1) : r * (q + 1) + (xcd - r) * q) + off; }
            const int nig = WGM * nN, gid = wgid / nig, fm = gid * WGM, gsz = (nMp - fm) < WGM ? (nMp - fm) : WGM; u.pm = fm + ((wgid % nig) % gsz); u.pn = (wgid % nig) / gsz; }
        else { const int q = e - nP; u.pm = nMp + q % nMs; u.pn = q / nMs; }
        return true;
    }
    __device__ __forceinline__ void a_ready(const Unit&) const {}
    __device__ __forceinline__ void done(const Unit&) const {}
};

__device__ __forceinline__ unsigned cvt_pk_bf16(float lo, float hi) { unsigned r; asm volatile("v_cvt_pk_bf16_f32 %0, %1, %2" : "=v"(r) : "v"(lo), "v"(hi)); return r; }
typedef float f32x2 __attribute__((ext_vector_type(2)));
__device__ __forceinline__ f32x2 gelu_pk(f32x2 v) {
    const f32x2 av = __builtin_elementwise_abs(v), d = av * 0.2316418882f + 1.0f;
    f32x2 t; t.x = __builtin_amdgcn_rcpf(d.x); t.y = __builtin_amdgcn_rcpf(d.y);
    f32x2 q = t * 0.5307027145f + (-0.7265760135f); q = q * t + 0.7107068705f; q = q * t + (-0.142248368f); q = q * t + 0.127414796f; q = q * t;
    const f32x2 s = (v * v) * (-0.72134752044f);
    f32x2 e; e.x = __builtin_amdgcn_exp2f(s.x); e.y = __builtin_amdgcn_exp2f(s.y);
    const f32x2 m = v * (q * e), r = v - m;
    f32x2 o; o.x = v.x < 0.f ? m.x : r.x; o.y = v.y < 0.f ? m.y : r.y; return o;
}

template <int ACT  > struct EpiBf16 {
    static constexpr bool PERM = true, AFTER_DRAIN = false; static_assert(ACT == 0 || ACT == 1, "EpiBf16: ACT is 0 (none) or 1 (gelu_pk)");
    bf16_t* O; int ldc; const float* bias; int split_cols; size_t split_stride; float scale0;
    __device__ __forceinline__ void operator()(const f32x4 (&acc)[2][2][4][2], const Unit& u, int wr, int wc, int fr, int fq) const {
        const int row0 = u.pm * BM + wr * 64 + fr; int colt = u.pn * BM; bf16_t* base = O;
        float sc = 1.f; if (split_cols) { const int t = colt / split_cols; base += (size_t)t * split_stride; colt -= t * split_cols; if (t == 0) sc = scale0; }
        const int col0 = colt + wc * 32 + 8 * fq, bcol0 = u.pn * BM + wc * 32 + 8 * fq;
        f32x4 bv[2][2];
#pragma unroll
        for (int bj = 0; bj < 2; ++bj)
#pragma unroll
            for (int n = 0; n < 2; ++n) bv[bj][n] = bias ? *(const f32x4*)(bias + bcol0 + bj * HALF + 4 * n) : (f32x4){0.f, 0.f, 0.f, 0.f};
#pragma unroll
        for (int ai = 0; ai < 2; ++ai)
#pragma unroll
            for (int m = 0; m < 4; ++m) { bf16_t* rowp = base + (size_t)(row0 + ai * HALF + m * 16) * ldc + col0;
#pragma unroll
                for (int bj = 0; bj < 2; ++bj) { f32x4 v0 = acc[ai][bj][m][0] + bv[bj][0], v1 = acc[ai][bj][m][1] + bv[bj][1];
                    if (ACT == 1) { f32x2 a = gelu_pk((f32x2){v0[0], v0[1]}), b = gelu_pk((f32x2){v0[2], v0[3]}), c = gelu_pk((f32x2){v1[0], v1[1]}), d = gelu_pk((f32x2){v1[2], v1[3]});
                        v0 = (f32x4){a.x, a.y, b.x, b.y}; v1 = (f32x4){c.x, c.y, d.x, d.y}; }
                    v0 = v0 * sc; v1 = v1 * sc; u32x4 w; w.x = cvt_pk_bf16(v0[0], v0[1]); w.y = cvt_pk_bf16(v0[2], v0[3]); w.z = cvt_pk_bf16(v1[0], v1[1]); w.w = cvt_pk_bf16(v1[2], v1[3]);
                    *(u32x4*)(rowp + bj * HALF) = w; } }
    }
};

struct EpiF32 {
    static constexpr bool PERM = false, AFTER_DRAIN = false;
    float* O; int ldc;
    __device__ __forceinline__ void operator()(const f32x4 (&acc)[2][2][4][2], const Unit& u, int wr, int wc, int fr, int fq) const {
        const int row0 = u.pm * BM + wr * 64 + fr, col0 = u.pn * BM + wc * 32 + 4 * fq;
#pragma unroll
        for (int ai = 0; ai < 2; ++ai)
#pragma unroll
            for (int m = 0; m < 4; ++m) { float* rowp = O + (size_t)(row0 + ai * HALF + m * 16) * ldc + col0;
#pragma unroll
                for (int bj = 0; bj < 2; ++bj)
#pragma unroll
                    for (int n = 0; n < 2; ++n) *(f32x4*)(rowp + bj * HALF + n * 16) = acc[ai][bj][m][n]; }
    }
};
struct EpiY {
    static constexpr bool PERM = false, AFTER_DRAIN = false;
    float* yp; float* ys; int lp, seq, rows_p;
    __device__ __forceinline__ void operator()(const f32x4 (&acc)[2][2][4][2], const Unit& u, int wr, int wc, int fr, int fq) const {
        const int row0 = u.pm * BM + wr * 64 + fr, col0 = u.pn * BM + wc * 32 + 4 * fq;
#pragma unroll
        for (int ai = 0; ai < 2; ++ai)
#pragma unroll
            for (int m = 0; m < 4; ++m) { const int row = row0 + ai * HALF + m * 16; float* rowp;
                if (row < rows_p) { const int b = row / lp, i = row - b * lp; if (i < 128) continue; rowp = yp + ((size_t)b * seq + (i - 128)) * 2048 + col0; }
                else rowp = ys + (size_t)(row - rows_p) * 2048 + col0;
#pragma unroll
                for (int bj = 0; bj < 2; ++bj)
#pragma unroll
                    for (int n = 0; n < 2; ++n) *(f32x4*)(rowp + bj * HALF + n * 16) = acc[ai][bj][m][n]; }
    }
};
struct EpiY16 {
    static constexpr bool PERM = true, AFTER_DRAIN = false;
    float* yp; float* ys; int lp, seq, rows_p;
    __device__ __forceinline__ void operator()(const f32x4 (&acc)[2][2][4][2], const Unit& u, int wr, int wc, int fr, int fq) const {
        const int row0 = u.pm * BM + wr * 64 + fr, col0 = u.pn * BM + wc * 32 + 8 * fq;
#pragma unroll
        for (int ai = 0; ai < 2; ++ai)
#pragma unroll
            for (int m = 0; m < 4; ++m) { const int row = row0 + ai * HALF + m * 16; bf16_t* rowp;
                if (row < rows_p) { const int b = row / lp, i = row - b * lp; if (i < 128) continue; rowp = (bf16_t*)(yp + ((size_t)b * seq + (i - 128)) * 2048) + col0; }
                else rowp = (bf16_t*)(ys + (size_t)(row - rows_p) * 2048) + col0;
#pragma unroll
                for (int bj = 0; bj < 2; ++bj) { const f32x4 v0 = acc[ai][bj][m][0], v1 = acc[ai][bj][m][1];
                    u32x4 w; w.x = cvt_pk_bf16(v0[0], v0[1]); w.y = cvt_pk_bf16(v0[2], v0[3]); w.z = cvt_pk_bf16(v1[0], v1[1]); w.w = cvt_pk_bf16(v1[2], v1[3]);
                    *(u32x4*)(rowp + bj * HALF) = w; } }
    }
};
template <class Epi, class Sched, bool ALIGN_EPI = false, bool SP2 = false>
__device__ __forceinline__ void gemm_phase(PG8_LAS unsigned char* lds, const Gemm g, const Sched& S, const Epi& E) {
    const int tid = threadIdx.x, wid = __builtin_amdgcn_readfirstlane(tid >> 6), lane = tid & 63, wr = wid >> 2, wc = wid & 3, fr = lane & 15, fq = lane >> 4;
    const int K = g.K, nt = K / BK;
    unsigned voffA[2], voffB[2];
#pragma unroll
    for (int i = 0; i < 2; ++i) { int R, C; stage_rc(tid * 16 + i * 8192, R, C); const int Rb = Epi::PERM ? ((R & ~31) + perm32(R & 31)) : R;
        voffA[i] = (unsigned)(R * K + C) * 2u; voffB[i] = (unsigned)(Rb * K + C) * 2u; }
    const size_t kstep = (size_t)(BK * 2);
    const size_t hstep = (size_t)HALF * K * 2;
    const size_t tstep = 2 * hstep;
    const unsigned ldsw = (unsigned)wid * 1024u;
    const int aoff = lds_byte(wr * 64 + fr, fq * 8), boff = lds_byte(wc * 32 + fr, fq * 8);
#define PG8_SA(b, h) (((b) * 2 + (h)) * HTB)
#define PG8_SB(b, h) ((4 + (b) * 2 + (h)) * HTB)
#define PG8_STAGE(bufoff, gbase, voff) do { _Pragma("unroll") for (int _i = 0; _i < 2; ++_i) \
        __builtin_amdgcn_global_load_lds((const unsigned*)((const char*)(gbase) + (voff)[_i]), (PG8_LAS unsigned*)(lds + (bufoff) + ldsw + _i * 8192), 16, 0, 0); } while (0)
#define PG8_LDA(dst, b, h) do { _Pragma("unroll") for (int m = 0; m < 4; ++m) _Pragma("unroll") for (int k = 0; k < 2; ++k) dst[m][k] = *(const PG8_LAS bf16x8*)(lds + PG8_SA(b, h) + aoff + m * 2048 + k * 1024); } while (0)
#define PG8_LDB(dst, b, h) do { _Pragma("unroll") for (int n = 0; n < 2; ++n) _Pragma("unroll") for (int k = 0; k < 2; ++k) dst[n][k] = *(const PG8_LAS bf16x8*)(lds + PG8_SB(b, h) + boff + n * 2048 + k * 1024); } while (0)
#define PG8_MMA(ai, bj, At, Bt) do { __builtin_amdgcn_s_setprio(1); _Pragma("unroll") for (int m = 0; m < 4; ++m) _Pragma("unroll") for (int n = 0; n < 2; ++n) _Pragma("unroll") for (int k = 0; k < 2; ++k) \
        acc[ai][bj][m][n] = __builtin_amdgcn_mfma_f32_16x16x32_bf16(Bt[n][k], At[m][k], acc[ai][bj][m][n], 0, 0, 0); __builtin_amdgcn_s_setprio(0); } while (0)
#define PG8_WAIT_V(n) asm volatile("s_waitcnt vmcnt(" #n ")" ::: "memory")
#define PG8_WAIT_L(n) asm volatile("s_waitcnt lgkmcnt(" #n ")" ::: "memory")
#define PG8_BAR __builtin_amdgcn_s_barrier()
#define PG8_SCHED __builtin_amdgcn_sched_barrier(0)
    Unit cur, nxt; int ui = 0;
    if (!S.next(0, cur)) return;
    f32x4 acc[2][2][4][2];
#pragma unroll
    for (int a = 0; a < 2; ++a)
#pragma unroll
        for (int b = 0; b < 2; ++b)
#pragma unroll
            for (int m = 0; m < 4; ++m)
#pragma unroll
                for (int n = 0; n < 2; ++n) acc[a][b][m][n] = (f32x4){0.f, 0.f, 0.f, 0.f};
    bf16x8 At[4][2], B0[2][2], B1[2][2];
    const char* cA = (const char*)g.A + (size_t)cur.pm * tstep; const char* cB = (const char*)g.Bt + (size_t)cur.pn * tstep;
    S.a_ready(cur);
    if constexpr (SP2) {
        PG8_STAGE(PG8_SB(0, 0), cB, voffB); PG8_STAGE(PG8_SB(0, 1), cB + hstep, voffB); PG8_STAGE(PG8_SA(0, 0), cA, voffA); PG8_STAGE(PG8_SA(0, 1), cA + hstep, voffA);
        if (wr == 1) PG8_BAR;
        PG8_WAIT_V(2); PG8_BAR;
        PG8_STAGE(PG8_SB(1, 0), cB + kstep, voffB); PG8_STAGE(PG8_SA(1, 0), cA + kstep, voffA); PG8_STAGE(PG8_SB(1, 1), cB + hstep + kstep, voffB);
        PG8_WAIT_V(6); PG8_BAR;
    } else {
        PG8_STAGE(PG8_SB(0, 0), cB, voffB); PG8_STAGE(PG8_SA(0, 0), cA, voffA); PG8_STAGE(PG8_SB(0, 1), cB + hstep, voffB); PG8_STAGE(PG8_SA(0, 1), cA + hstep, voffA);
        if (wr == 1) PG8_BAR;
        PG8_WAIT_V(4); PG8_BAR;
        PG8_STAGE(PG8_SB(1, 0), cB + kstep, voffB); PG8_STAGE(PG8_SA(1, 0), cA + kstep, voffA); PG8_STAGE(PG8_SB(1, 1), cB + hstep + kstep, voffB);
        PG8_WAIT_V(6); PG8_BAR;
    }
    for (;;) {
        const bool has_next = S.next(ui + 1, nxt);
        const char* nA = has_next ? (const char*)g.A + (size_t)nxt.pm * tstep : cA; const char* nB = has_next ? (const char*)g.Bt + (size_t)nxt.pn * tstep : cB;
        for (int t = 0; t < nt; t += 2) {
            const bool last = (t == nt - 2);
            const char* a1 = cA + (size_t)(t + 1) * kstep;
            const char* a2 = last ? nA : cA + (size_t)(t + 2) * kstep; const char* b2 = last ? nB : cB + (size_t)(t + 2) * kstep;
            const char* a3 = a2 + kstep; const char* b3 = b2 + kstep;
            if (last && has_next) S.a_ready(nxt);
            if constexpr (SP2) {
            PG8_LDB(B0, 0, 0); PG8_LDB(B1, 0, 1); PG8_SCHED; PG8_LDA(At, 0, 0); PG8_STAGE(PG8_SA(1, 1), a1 + hstep, voffA);
            PG8_WAIT_V(8); PG8_WAIT_L(0); PG8_BAR; PG8_MMA(0, 0, At, B0); PG8_MMA(0, 1, At, B1); PG8_BAR; PG8_SCHED;
            PG8_LDA(At, 0, 1); PG8_STAGE(PG8_SB(0, 0), b2, voffB); PG8_STAGE(PG8_SB(0, 1), b2 + hstep, voffB); PG8_STAGE(PG8_SA(0, 0), a2, voffA);
            PG8_WAIT_V(8); PG8_WAIT_L(0); PG8_BAR; PG8_MMA(1, 0, At, B0); PG8_MMA(1, 1, At, B1); PG8_BAR; PG8_SCHED;
            PG8_LDB(B0, 1, 0); PG8_LDB(B1, 1, 1); PG8_SCHED; PG8_LDA(At, 1, 0); PG8_STAGE(PG8_SA(0, 1), a2 + hstep, voffA);
            PG8_WAIT_V(8); PG8_WAIT_L(0); PG8_BAR; PG8_MMA(0, 0, At, B0); PG8_MMA(0, 1, At, B1); PG8_BAR; PG8_SCHED;
            PG8_LDA(At, 1, 1); PG8_STAGE(PG8_SB(1, 0), b3, voffB); PG8_STAGE(PG8_SB(1, 1), b3 + hstep, voffB); PG8_STAGE(PG8_SA(1, 0), a3, voffA);
            PG8_WAIT_V(8); PG8_WAIT_L(0); PG8_BAR; PG8_MMA(1, 0, At, B0); PG8_MMA(1, 1, At, B1); PG8_BAR; PG8_SCHED;
            } else {
            PG8_LDB(B0, 0, 0); PG8_SCHED; PG8_LDA(At, 0, 0); PG8_STAGE(PG8_SA(1, 1), a1 + hstep, voffA);
            PG8_WAIT_L(8); PG8_BAR; PG8_WAIT_L(0); PG8_MMA(0, 0, At, B0); PG8_BAR; PG8_SCHED;
            PG8_LDB(B1, 0, 1); PG8_STAGE(PG8_SB(0, 0), b2, voffB);
            PG8_BAR; PG8_WAIT_L(0); PG8_MMA(0, 1, At, B1); PG8_BAR;
            PG8_LDA(At, 0, 1); PG8_STAGE(PG8_SA(0, 0), a2, voffA);
            PG8_BAR; PG8_WAIT_L(0); PG8_MMA(1, 0, At, B0); PG8_BAR; PG8_SCHED;
            PG8_STAGE(PG8_SB(0, 1), b2 + hstep, voffB);
            PG8_WAIT_V(6); PG8_BAR; PG8_MMA(1, 1, At, B1); PG8_BAR;
            PG8_LDB(B0, 1, 0); PG8_SCHED; PG8_LDA(At, 1, 0); PG8_STAGE(PG8_SA(0, 1), a2 + hstep, voffA);
            PG8_WAIT_L(8); PG8_BAR; PG8_WAIT_L(0); PG8_MMA(0, 0, At, B0); PG8_BAR; PG8_SCHED;
            PG8_LDB(B1, 1, 1); PG8_STAGE(PG8_SB(1, 0), b3, voffB);
            PG8_BAR; PG8_WAIT_L(0); PG8_MMA(0, 1, At, B1); PG8_BAR;
            PG8_LDA(At, 1, 1); PG8_STAGE(PG8_SA(1, 0), a3, voffA);
            PG8_BAR; PG8_WAIT_L(0); PG8_MMA(1, 0, At, B0); PG8_BAR; PG8_SCHED;
            PG8_STAGE(PG8_SB(1, 1), b3 + hstep, voffB);
            PG8_WAIT_V(6); PG8_BAR; PG8_MMA(1, 1, At, B1); PG8_BAR;
            }
        }
        if constexpr (ALIGN_EPI) { if (wr == 0) PG8_BAR; }
        if constexpr (!Epi::AFTER_DRAIN) { E(acc, cur, wr, wc, fr, fq); S.done(cur); }
        if (!has_next) break;
#pragma unroll
        for (int a = 0; a < 2; ++a)
#pragma unroll
            for (int b = 0; b < 2; ++b)
#pragma unroll
                for (int m = 0; m < 4; ++m)
#pragma unroll
                    for (int n = 0; n < 2; ++n) acc[a][b][m][n] = (f32x4){0.f, 0.f, 0.f, 0.f};
        cur = nxt; cA = nA; cB = nB; ++ui;
        if constexpr (ALIGN_EPI) { if (wr == 1) PG8_BAR; }
    }
    PG8_WAIT_V(0);
    if constexpr (!ALIGN_EPI) { if (wr == 0) PG8_BAR; }
    PG8_BAR;
    if constexpr (Epi::AFTER_DRAIN) { E.fused(acc, cur, wr, wc, fr, fq, lds, wid, lane); S.done(cur); }
#undef PG8_SA
#undef PG8_SB
#undef PG8_STAGE
#undef PG8_LDA
#undef PG8_LDB
#undef PG8_MMA
#undef PG8_WAIT_V
#undef PG8_WAIT_L
#undef PG8_BAR
#undef PG8_SCHED
}
}

#define GAS __attribute__((address_space(1)))
#define LAS __attribute__((address_space(3)))
typedef unsigned short bf16;
typedef unsigned v4u __attribute__((ext_vector_type(4)));
typedef float f32x4 __attribute__((ext_vector_type(4)));
typedef short bf16x8 __attribute__((ext_vector_type(8)));
typedef GAS unsigned gu32;
typedef GAS unsigned long long gu64;
#define RLX_AGENT __ATOMIC_RELAXED, __HIP_MEMORY_SCOPE_AGENT
#define LDS_WAIT() asm volatile("s_waitcnt lgkmcnt(0)" ::: "memory")
#define VM_WAIT() asm volatile("s_waitcnt vmcnt(0)" ::: "memory")
__device__ __forceinline__ unsigned long long rt() { return __builtin_amdgcn_s_memrealtime(); }
__device__ __forceinline__ unsigned f2bf(float f) { unsigned u = __builtin_bit_cast(unsigned, f); return (u + 0x7fffu + ((u >> 16) & 1u)) >> 16; }
__device__ __forceinline__ unsigned pk2(float lo, float hi) { return f2bf(lo) | (f2bf(hi) << 16); }
#define XB_TMO      128
#define XB_XCNT(j)  (256  + 64 * (j))
#define XB_XSUB(j)  (1280 + 64 * (j))
#define XB_XGEN(j)  (2304 + 64 * (j))
#define XB_TOP      3328
#define XB_TOPGEN   3392
#define XCD_BAR_WORDS 3456
#define XB_SPIN_CAP (1u << 18)

__device__ __forceinline__ unsigned xb_ld(unsigned* p)              { return __hip_atomic_load(p, __ATOMIC_RELAXED, __HIP_MEMORY_SCOPE_AGENT); }
__device__ __forceinline__ unsigned xb_add(unsigned* p, unsigned v) { return __hip_atomic_fetch_add(p, v, __ATOMIC_RELAXED, __HIP_MEMORY_SCOPE_AGENT); }
__device__ __forceinline__ unsigned xb_xcc_id() { return (unsigned)__builtin_amdgcn_s_getreg((3 << 11) | 20) & 0xFu; }
#define XB_SPIN(cond, bar) do { unsigned _sp = 0; while (cond) { __builtin_amdgcn_s_sleep(1); \
    if ((++_sp & 255u) == 0u) { if (xb_ld(&(bar)[XB_TMO])) break; if (_sp > XB_SPIN_CAP) { atomicAdd(&(bar)[XB_TMO], 1u); break; } } } } while (0)

struct XcdBarrier {
    unsigned* bar; unsigned x;
    volatile LAS unsigned* st;
};

__device__ __forceinline__ XcdBarrier xcd_barrier_post(unsigned* bar, volatile LAS unsigned* st) {
    XcdBarrier b; b.bar = bar; b.x = xb_xcc_id(); b.st = st;
    if (threadIdx.x == 0) (void)xb_add(&bar[XB_XCNT(b.x)], 1u);
    return b;
}
__device__ __forceinline__ void xcd_barrier_complete(unsigned* bar, unsigned x, unsigned& nloc, unsigned& nx) {
    const unsigned G = gridDim.x * gridDim.y * gridDim.z;
    unsigned sum, cnt, mine, sp = 0u;
    for (;;) {
        sum = 0u; cnt = 0u; mine = 0u;
#pragma unroll
        for (unsigned j = 0; j < 16; ++j) { const unsigned c = xb_ld(&bar[XB_XCNT(j)]); sum += c; cnt += (c > 0u) ? 1u : 0u; mine = (j == x) ? c : mine; }
        if (sum == G) break;
        __builtin_amdgcn_s_sleep(1);
        if ((++sp & 255u) == 0u) { if (xb_ld(&bar[XB_TMO])) break; if (sp > XB_SPIN_CAP) { atomicAdd(&bar[XB_TMO], 1u); break; } }
    }
    nloc = mine > 0u ? mine : 1u; nx = cnt > 0u ? cnt : 1u;
}

__device__ __forceinline__ void xcd_barrier(const XcdBarrier& b) {
    asm volatile("s_waitcnt vmcnt(0)" ::: "memory");
    __syncthreads();
    if (threadIdx.x == 0) {
        unsigned* bar = b.bar;
        __builtin_amdgcn_s_waitcnt(0);
        unsigned nloc = b.st[0], nx = b.st[1];
        if (nloc == 0u) { xcd_barrier_complete(bar, b.x, nloc, nx); b.st[0] = nloc; b.st[1] = nx; }
        const unsigned old = xb_add(&bar[XB_XSUB(b.x)], 1u);
        const unsigned gen = old / nloc;
        if (old + 1u == (gen + 1u) * nloc) {
            __builtin_amdgcn_fence(__ATOMIC_RELEASE, "agent");
            asm volatile("s_waitcnt vmcnt(0)" ::: "memory");
            const unsigned og = xb_add(&bar[XB_TOP], 1u);
            const unsigned tg = og / nx;
            if (og + 1u == (tg + 1u) * nx) xb_add(&bar[XB_TOPGEN], 1u);
            else XB_SPIN(xb_ld(&bar[XB_TOPGEN]) == tg, bar);
            __builtin_amdgcn_fence(__ATOMIC_ACQUIRE, "agent");
            xb_add(&bar[XB_XGEN(b.x)], 1u);
            asm volatile("s_waitcnt vmcnt(0)" ::: "memory");
        } else {
            XB_SPIN(xb_ld(&bar[XB_XGEN(b.x)]) == gen, bar);
            __builtin_amdgcn_fence(__ATOMIC_ACQUIRE, "agent");
            asm volatile("s_waitcnt vmcnt(0)" ::: "memory");
        }
    }
    __syncthreads();
}


constexpr int NWAVES = 8, NTHREADS = 512;
constexpr int DM = 2048, NBATCH = 2, SEQ = 4096, NMETA = 16, FPAD = 112, LP = 4224, NBLK = 33;
constexpr int DBATCH = 128, DSEQ = 8, WIN = 128;
constexpr int ROWS_P = NBATCH * LP, ROWS_S = DBATCH * DSEQ, MROWS = ROWS_P + ROWS_S;
constexpr int NIN = 5648, NPAD = 5888;
constexpr int C_QA = 0, C_KA = 1024, C_VA = 1280, C_GA = 1536, C_QG = 2560, C_KG = 3072, C_VG = 3584, C_GG = 4608, C_ZG = 5632;
constexpr float EPSN = 1e-6f;
static_assert(MROWS % 256 == 0 && NPAD % 256 == 0, "tiles");

constexpr size_t O_YP = 0, O_YS = 16777216, O_KWP = 18874368, O_VWP = 18939904, O_GP = 19005440, O_KWS = 19267584, O_VWS = 23461888, O_GS = 27656192, O_END = 44433408;

constexpr size_t MiB = 1u << 20;
constexpr size_t WS_CTL = 0, CTL_ZERO_BYTES = 64 * 1024;
constexpr size_t WS_WIN = 1 * MiB;
constexpr size_t WS_WOUT = 24 * MiB;
constexpr size_t WS_XN = 32 * MiB;
constexpr size_t WS_P = 69 * MiB;
constexpr size_t WS_DST = 176 * MiB;
constexpr size_t WS_ST = 209 * MiB;
constexpr size_t WS_DEC = 226 * MiB;
constexpr size_t WS_END = 227 * MiB;
constexpr int CW_BAR = 1024;

constexpr int LDS_CTL_BYTES = 1024;
constexpr int SCR_OFF = 1024;
constexpr int LDS_BYTES = 156 * 1024;

typedef short bf16x4 __attribute__((ext_vector_type(4)));
typedef short v4i16_t __attribute__((ext_vector_type(4)));
typedef float f32x2 __attribute__((ext_vector_type(2)));

__device__ __forceinline__ float bf2f(unsigned short b) { return __uint_as_float(((unsigned)b) << 16); }
__device__ __forceinline__ unsigned short f2bf16(float f) { return (unsigned short)f2bf(f); }
__device__ __forceinline__ float wave_sum(float v) {
#pragma unroll
    for (int o = 1; o < 64; o <<= 1) v += __shfl_xor(v, o);
    return v;
}
__device__ __forceinline__ float silu_f(float x) { return x / (1.f + __expf(-x)); }
__device__ __forceinline__ float logsig_f(float x) { return fminf(x, 0.f) - __logf(1.f + __expf(-fabsf(x))); }

#ifndef USE_TR
#define USE_TR 1
#endif
__device__ __forceinline__ bf16x8 tr_frag(const LAS unsigned short* M, int row0, int col0, int pitch, int lane) {
#if USE_TR
    const int q = (lane & 15) >> 2, p = lane & 3;
    const LAS unsigned short* a0 = M + (row0 + q) * pitch + col0 + 4 * p;
    const v4i16_t lo = __builtin_amdgcn_ds_read_tr16_b64_v4i16((LAS v4i16_t*)a0);
    const v4i16_t hi = __builtin_amdgcn_ds_read_tr16_b64_v4i16((LAS v4i16_t*)(a0 + 4 * pitch));
    return (bf16x8){lo[0], lo[1], lo[2], lo[3], hi[0], hi[1], hi[2], hi[3]};
#else
    bf16x8 r; const LAS unsigned short* a0 = M + row0 * pitch + col0 + (lane & 15);
#pragma unroll
    for (int j = 0; j < 8; ++j) r[j] = (short)a0[j * pitch];
    return r;
#endif
}
#define MFMA16(a, b, c) __builtin_amdgcn_mfma_f32_16x16x32_bf16((a), (b), (c), 0, 0, 0)

struct Frame {
    LAS unsigned char* lds;
    int tid, lane, wave, G;
    unsigned char* ws; float* out;
    __device__ __forceinline__ bf16* WinT() const { return (bf16*)(ws + WS_WIN); }
    __device__ __forceinline__ bf16* WoutT() const { return (bf16*)(ws + WS_WOUT); }
    __device__ __forceinline__ bf16* XN() const { return (bf16*)(out + O_GS); }
    __device__ __forceinline__ bf16* MIX() const { return (bf16*)(ws + WS_XN); }
    __device__ __forceinline__ bf16* P() const { return (bf16*)(ws + WS_P); }
    __device__ __forceinline__ float* O2() const { return (float*)(ws + WS_P); }
    __device__ __forceinline__ float* dST() const { return (float*)(ws + WS_DST); }
    __device__ __forceinline__ bf16* St() const { return (bf16*)(ws + WS_ST); }
    __device__ __forceinline__ float* dec() const { return (float*)(ws + WS_DEC); }
};
enum { A_XP = 0, A_XS, A_CK, A_CV, A_STATE, A_META, A_RELB, A_NPRE, A_NPOST, A_WIN, A_WA2, A_BA, A_SINK, A_GNORM, A_WOUT, A_OUT, A_WS };
typedef const GAS float* gcf;
template <int IDX> __device__ __forceinline__ gcf ldarg() {
    const unsigned long long ka = (unsigned long long)__builtin_amdgcn_kernarg_segment_ptr();
    unsigned long long v;
    asm volatile("s_load_dwordx2 %0, %1, %2\n\ts_waitcnt lgkmcnt(0)" : "=s"(v) : "s"(ka), "i"(IDX * 8) : "memory");
    return (gcf)v;
}

struct P0Item { gcf W; bf16* WT; int N, kb, nb; bool on; };
__device__ __forceinline__ void p0_item_load(const P0Item& it, int K, int lane, f32x4 (&v)[16]) {
    const int k0 = 64 * it.kb, n0 = 64 * it.nb; const int nq = 4 * (lane & 15), kr = lane >> 4; const bool ok = it.on && (n0 + nq) < it.N;
#pragma unroll
    for (int i = 0; i < 16; ++i) v[i] = ok ? *(const GAS f32x4*)(it.W + (size_t)(k0 + 4 * i + kr) * it.N + n0 + nq) : (f32x4){0.f, 0.f, 0.f, 0.f};
}
__device__ __forceinline__ void p0_item_store(const P0Item& it, int K, int lane, const f32x4 (&v)[16], LAS float* scr) {
    if (!it.on) return;
    const int k0 = 64 * it.kb, n0 = 64 * it.nb; const int nq = 4 * (lane & 15), kr = lane >> 4;
#pragma unroll
    for (int i = 0; i < 16; ++i) { LAS float* d = scr + (4 * i + kr) * 65 + nq; d[0] = v[i].x; d[1] = v[i].y; d[2] = v[i].z; d[3] = v[i].w; }
    LDS_WAIT(); asm volatile("" ::: "memory");
    const int c = lane & 7;
#pragma unroll
    for (int j = 0; j < 8; ++j) { const int nn = (lane >> 3) + 8 * j; const LAS float* s = scr + (8 * c) * 65 + nn;
        v4u o; o.x = pk2(s[0 * 65], s[1 * 65]); o.y = pk2(s[2 * 65], s[3 * 65]); o.z = pk2(s[4 * 65], s[5 * 65]); o.w = pk2(s[6 * 65], s[7 * 65]);
        *(GAS v4u*)(it.WT + (size_t)(n0 + nn) * K + k0 + 8 * c) = o; }
    LDS_WAIT(); asm volatile("" ::: "memory");
}
__device__ __forceinline__ gcf p0_row_src(int m, gcf meta, gcf x_prompt, gcf x_sample) {
    if (m < ROWS_P) { const int b = m / LP, i = m - b * LP;
        if (i < FPAD) return nullptr;
        return (i < 128) ? meta + (size_t)(i - FPAD) * DM : x_prompt + ((size_t)b * SEQ + (i - 128)) * DM; }
    return x_sample + (size_t)(m - ROWS_P) * DM;
}
constexpr int P0R = 4;
__device__ __forceinline__ void p0_rows2(Frame& F, int m0, int mstep, gcf meta, gcf x_prompt, gcf x_sample, gcf norm_pre) {
    gcf src[P0R]; int mm[P0R];
#pragma unroll
    for (int q = 0; q < P0R; ++q) { mm[q] = m0 + q * mstep; src[q] = (mm[q] < MROWS) ? p0_row_src(mm[q], meta, x_prompt, x_sample) : nullptr; }
    f32x4 v[P0R][8];
#pragma unroll
    for (int q = 0; q < P0R; ++q)
#pragma unroll
        for (int j = 0; j < 8; ++j) v[q][j] = src[q] ? ((const GAS f32x4*)src[q])[F.lane + 64 * j] : (f32x4){0.f, 0.f, 0.f, 0.f};
#pragma unroll
    for (int q = 0; q < P0R; ++q) { if (mm[q] >= MROWS) continue;
        float s = 0.f;
#pragma unroll
        for (int j = 0; j < 8; ++j) s += (v[q][j].x * v[q][j].x + v[q][j].y * v[q][j].y) + (v[q][j].z * v[q][j].z + v[q][j].w * v[q][j].w);
        const float rstd = rsqrtf(wave_sum(s) * (1.f / DM) + EPSN);
        GAS unsigned long long* o8 = (GAS unsigned long long*)(F.XN() + (size_t)mm[q] * DM) + F.lane;
        if (src[q] == nullptr) { GAS unsigned long long* z8 = (GAS unsigned long long*)(F.MIX() + (size_t)mm[q] * DM) + F.lane;
#pragma unroll
            for (int j = 0; j < 8; ++j) z8[64 * j] = 0ull; }
#pragma unroll
        for (int j = 0; j < 8; ++j) { const f32x4 w = ((const GAS f32x4*)norm_pre)[F.lane + 64 * j];
            o8[64 * j] = (unsigned long long)pk2(v[q][j].x * rstd * w.x, v[q][j].y * rstd * w.y) | ((unsigned long long)pk2(v[q][j].z * rstd * w.z, v[q][j].w * rstd * w.w) << 32); } }
}
__device__ __forceinline__ void p0_prologue(Frame& F, int it_lo, int it_hi, int b_lo, int nb, bool with_rows) { gcf const w_in = ldarg<A_WIN>(); gcf const w_out = ldarg<A_WOUT>();
    LAS float* scr = (LAS float*)(F.lds + SCR_OFF + F.wave * 16640);
    const int gw = ((int)blockIdx.x - b_lo) * NWAVES + F.wave, NGW = nb * NWAVES;
    constexpr int I_IN = (DM / 64) * (NPAD / 64), I_OUT = (DM / 64) * (DM / 64);
    auto mk = [&](int it) { P0Item r; r.on = it < it_hi;
        if (it < I_IN) { r.W = w_in; r.WT = F.WinT(); r.N = NIN; r.kb = it / (NPAD / 64); r.nb = it % (NPAD / 64); }
        else { const int q = r.on ? it - I_IN : 0; r.W = w_out; r.WT = F.WoutT(); r.N = DM; r.kb = q / (DM / 64); r.nb = q % (DM / 64); }
        return r; };
    for (int it = it_lo + gw; it < it_hi; it += 2 * NGW) {
        const P0Item a = mk(it), b = mk(it + NGW);
        f32x4 va[16], vb[16];
        p0_item_load(a, DM, F.lane, va); p0_item_load(b, DM, F.lane, vb);
        p0_item_store(a, DM, F.lane, va, scr); p0_item_store(b, DM, F.lane, vb, scr);
    }
    if (with_rows) {
        gcf const meta = ldarg<A_META>(); gcf const x_prompt = ldarg<A_XP>(); gcf const x_sample = ldarg<A_XS>(); gcf const norm_pre = ldarg<A_NPRE>();
        for (int m = gw; m < MROWS; m += P0R * NGW) p0_rows2(F, m, NGW, meta, x_prompt, x_sample, norm_pre);
    }
}

constexpr int AKP = 72, APP = 168;
constexpr int A_K = 0, A_V = 272 * AKP * 2, A_BIAS = 2 * A_V, A_P = A_BIAS + 2048, A_END = A_P + NWAVES * 16 * APP * 2;
static_assert(A_END <= LDS_BYTES - SCR_OFF, "attention LDS");

struct AttnLds { const LAS unsigned short* AK; const LAS unsigned short* AV; const LAS float* AB; LAS unsigned short* AP; };
template <bool SAMPLE>
__device__ __forceinline__ void attn_tile(Frame& F, const AttnLds& L, const bf16x8 (&qa)[2], int s0, int kmin  ,
                                          int tb, int gb, size_t rowb, gcf sinks, int kvh) {
    int lane = F.lane; asm volatile("" : "+v"(lane));
    const int gq = lane >> 4, i = lane & 15;
    const LAS unsigned short* AK = L.AK; const LAS unsigned short* AV = L.AV; const LAS float* AB = L.AB; LAS unsigned short* AP = L.AP;
    size_t prow[2]; int pcol[2]; v4u gpre[2];
#pragma unroll
    for (int jj = 0; jj < 2; ++jj) { const int q = lane + 64 * jj, rr = q >> 3, ch = q & 7;
        prow[jj] = SAMPLE ? rowb + (rr & 7) : rowb + rr; pcol[jj] = kvh * 256 + (SAMPLE ? gb + (rr >> 3) : gb) * 64 + 8 * ch;
        gpre[jj] = *(const GAS v4u*)(F.P() + prow[jj] * NPAD + C_GA + pcol[jj]); }
    int trow[4], grow[4]; float sinkr[4];
#pragma unroll
    for (int r = 0; r < 4; ++r) { const int rr = 4 * gq + r; trow[r] = SAMPLE ? (rr & 7) : tb + rr; grow[r] = SAMPLE ? gb + (rr >> 3) : gb; sinkr[r] = sinks[kvh * 4 + grow[r]]; }
    f32x4 acc[10];
#pragma unroll
    for (int cb = 0; cb < 10; ++cb) { acc[cb] = (f32x4){0.f, 0.f, 0.f, 0.f};
#pragma unroll
        for (int ks = 0; ks < 2; ++ks) { const bf16x8 kb = *(const LAS bf16x8*)(AK + (s0 + 16 * cb + i) * AKP + 32 * ks + 8 * gq); acc[cb] = MFMA16(qa[ks], kb, acc[cb]); } }
    float mx[4] = {-INFINITY, -INFINITY, -INFINITY, -INFINITY};
#pragma unroll
    for (int cb = 0; cb < 10; ++cb) { const int s = s0 + 16 * cb + i;
#pragma unroll
        for (int r = 0; r < 4; ++r) { const int dist = 128 + trow[r] - s; const bool valid = (dist >= 0) && (dist < 128) && (s >= kmin);
            const int dc = dist < 0 ? 0 : (dist > 127 ? 127 : dist);
            const float v = valid ? acc[cb][r] * 0.125f + AB[grow[r] * 128 + dc] : -INFINITY; acc[cb][r] = v; mx[r] = fmaxf(mx[r], v); } }
    float inv[4];
#pragma unroll
    for (int r = 0; r < 4; ++r) { float m = mx[r];
        m = fmaxf(m, __shfl_xor(m, 1)); m = fmaxf(m, __shfl_xor(m, 2)); m = fmaxf(m, __shfl_xor(m, 4)); m = fmaxf(m, __shfl_xor(m, 8));
        m = fmaxf(m, sinkr[r]); float sum = 0.f;
#pragma unroll
        for (int cb = 0; cb < 10; ++cb) { const float e = __expf(acc[cb][r] - m); acc[cb][r] = e; sum += e; }
        sum += __shfl_xor(sum, 1); sum += __shfl_xor(sum, 2); sum += __shfl_xor(sum, 4); sum += __shfl_xor(sum, 8);
        inv[r] = 1.f / (sum + __expf(sinkr[r] - m)); }
#pragma unroll
    for (int cb = 0; cb < 10; ++cb)
#pragma unroll
        for (int r = 0; r < 4; ++r) AP[(4 * gq + r) * APP + 16 * cb + i] = f2bf16(acc[cb][r]);
    LDS_WAIT(); asm volatile("" ::: "memory");
    f32x4 o[4];
#pragma unroll
    for (int db = 0; db < 4; ++db) o[db] = (f32x4){0.f, 0.f, 0.f, 0.f};
#pragma unroll
    for (int kk = 0; kk < 5; ++kk) { const bf16x8 pa = *(const LAS bf16x8*)(AP + i * APP + 32 * kk + 8 * gq);
#pragma unroll
        for (int db = 0; db < 4; ++db) { const bf16x8 vb = tr_frag(AV, s0 + 32 * kk + 8 * gq, 16 * db, AKP, lane); o[db] = MFMA16(pa, vb, o[db]); } }
    LDS_WAIT(); asm volatile("" ::: "memory");
#pragma unroll
    for (int r = 0; r < 4; ++r)
#pragma unroll
        for (int db = 0; db < 4; ++db) AP[(4 * gq + r) * APP + 16 * db + i] = f2bf16(o[db][r] * inv[r]);
    LDS_WAIT(); asm volatile("" ::: "memory");
#pragma unroll
    for (int jj = 0; jj < 2; ++jj) { const int q = lane + 64 * jj, rr = q >> 3, ch = q & 7;
        const v4u ov = *(const LAS v4u*)(AP + rr * APP + 8 * ch); const v4u gv = gpre[jj];
        v4u res;
        res.x = pk2(bf2f(ov.x & 0xffff) * silu_f(bf2f(gv.x & 0xffff)), bf2f(ov.x >> 16) * silu_f(bf2f(gv.x >> 16)));
        res.y = pk2(bf2f(ov.y & 0xffff) * silu_f(bf2f(gv.y & 0xffff)), bf2f(ov.y >> 16) * silu_f(bf2f(gv.y >> 16)));
        res.z = pk2(bf2f(ov.z & 0xffff) * silu_f(bf2f(gv.z & 0xffff)), bf2f(ov.z >> 16) * silu_f(bf2f(gv.z >> 16)));
        res.w = pk2(bf2f(ov.w & 0xffff) * silu_f(bf2f(gv.w & 0xffff)), bf2f(ov.w >> 16) * silu_f(bf2f(gv.w >> 16)));
        *(GAS v4u*)(F.MIX() + prow[jj] * DM + pcol[jj]) = res; }
    LDS_WAIT(); asm volatile("" ::: "memory");
}

__device__ __forceinline__ void attn_bias_table(Frame& F, LAS float* AB, int kvh) { gcf const rel_bias = ldarg<A_RELB>();
    const int g = F.tid >> 7, d = F.tid & 127;
    int bk = d;
    if (d >= 16) { bk = 16 + (int)(__logf((float)d * (1.f / 16.f)) * (16.f / 2.0794415416798357f)); bk = bk > 31 ? 31 : bk; }
    AB[g * 128 + d] = rel_bias[bk * 16 + kvh * 4 + g];
}

__device__ __forceinline__ void attn_prompt_unit(Frame& F0, LAS unsigned char* scr, int b, int n, int kvh) { Frame F = F0; asm volatile("" : "+v"(F.tid), "+v"(F.lane));     gcf const sinks = ldarg<A_SINK>();
    LAS unsigned short* AK = (LAS unsigned short*)(scr + A_K); LAS unsigned short* AV = (LAS unsigned short*)(scr + A_V);
    __syncthreads();
    const long wrow0 = (long)b * LP + 128 * (n - 1);
#pragma unroll
    for (int j = 0; j < 4; ++j) { const int c = F.tid + 512 * j, row = c >> 3, ch = c & 7; const long gr = wrow0 + row;
        v4u kv = (v4u){0u, 0u, 0u, 0u}, vv = kv;
        if (gr >= 0) { const bf16* p = F.P() + (size_t)gr * NPAD + kvh * 64 + 8 * ch; kv = *(const GAS v4u*)(p + C_KA); vv = *(const GAS v4u*)(p + C_VA); }
        *(LAS v4u*)(AK + row * AKP + 8 * ch) = kv; *(LAS v4u*)(AV + row * AKP + 8 * ch) = vv; }
    if (F.tid < 128) { const int row = 256 + (F.tid >> 3), ch = F.tid & 7; *(LAS v4u*)(AK + row * AKP + 8 * ch) = (v4u){0u, 0u, 0u, 0u}; *(LAS v4u*)(AV + row * AKP + 8 * ch) = (v4u){0u, 0u, 0u, 0u}; }
    attn_bias_table(F, (LAS float*)(scr + A_BIAS), kvh);
    __syncthreads();
    const AttnLds L{AK, AV, (const LAS float*)(scr + A_BIAS), (LAS unsigned short*)(scr + A_P) + F.wave * 16 * APP};
    const int gq = F.lane >> 4, i = F.lane & 15, t0 = (n == 0) ? 112 : 16 * F.wave;
    const int kmin = FPAD - 128 * (n - 1);
    const size_t rbase = (size_t)b * LP + 128 * n;
    const int g_lo = (n == 0) ? F.wave : 0, g_hi = (n == 0) ? (F.wave < 4 ? F.wave + 1 : 0) : 4;
    bf16x8 qn[2] = {(bf16x8){0, 0, 0, 0, 0, 0, 0, 0}, (bf16x8){0, 0, 0, 0, 0, 0, 0, 0}};
    if (g_lo < g_hi) { const bf16* qp = F.P() + (rbase + t0 + i) * NPAD + C_QA + (kvh * 4 + g_lo) * 64; qn[0] = *(const GAS bf16x8*)(qp + 8 * gq); qn[1] = *(const GAS bf16x8*)(qp + 32 + 8 * gq); }
#pragma unroll 1
    for (int g = g_lo; g < g_hi; ++g) {
        const bf16x8 qa[2] = {qn[0], qn[1]};
        if (g + 1 < g_hi) { const bf16* qp = F.P() + (rbase + t0 + i) * NPAD + C_QA + (kvh * 4 + g + 1) * 64; qn[0] = *(const GAS bf16x8*)(qp + 8 * gq); qn[1] = *(const GAS bf16x8*)(qp + 32 + 8 * gq); }
        attn_tile<false>(F, L, qa, t0, kmin, t0, g, rbase + t0, sinks, kvh);
    }
    if (n == NBLK - 1) {
#pragma unroll
        for (int j = 0; j < 16; ++j) { const int e = F.tid + 512 * j, row = e >> 6, d = e & 63;
            const size_t oidx = (((size_t)b * WIN + row) * 4 + kvh) * 64 + d;
            F.out[O_KWP + oidx] = bf2f(AK[(128 + row) * AKP + d]); F.out[O_VWP + oidx] = bf2f(AV[(128 + row) * AKP + d]); }
    }
}

__device__ __forceinline__ void attn_sample_stage(Frame& F, LAS unsigned short* AK, LAS unsigned short* AV, int db, int kvh, gcf cache_k, gcf cache_v) {
#pragma unroll
    for (int j = 0; j < 4; ++j) { const int c = F.tid + 512 * j, row = c >> 4, ch = c & 15;
        const size_t src = (((size_t)db * WIN + row) * 4 + kvh) * 64 + 4 * ch;
        const f32x4 kv = *(const GAS f32x4*)(cache_k + src), vv = *(const GAS f32x4*)(cache_v + src);
        *(LAS unsigned long long*)(AK + row * AKP + 4 * ch) = (unsigned long long)pk2(kv.x, kv.y) | ((unsigned long long)pk2(kv.z, kv.w) << 32);
        *(LAS unsigned long long*)(AV + row * AKP + 4 * ch) = (unsigned long long)pk2(vv.x, vv.y) | ((unsigned long long)pk2(vv.z, vv.w) << 32);
        if (row >= DSEQ) { const size_t dst = (((size_t)db * WIN + row - DSEQ) * 4 + kvh) * 64 + 4 * ch; *(GAS f32x4*)(F.out + O_KWS + dst) = kv; *(GAS f32x4*)(F.out + O_VWS + dst) = vv; } }
    const size_t srow0 = (size_t)ROWS_P + (size_t)db * DSEQ;
    if (F.tid < 64) { const int t = F.tid >> 3, ch = F.tid & 7; const bf16* p = F.P() + (srow0 + t) * NPAD + kvh * 64 + 8 * ch;
        const v4u kv = *(const GAS v4u*)(p + C_KA), vv = *(const GAS v4u*)(p + C_VA);
        *(LAS v4u*)(AK + (128 + t) * AKP + 8 * ch) = kv; *(LAS v4u*)(AV + (128 + t) * AKP + 8 * ch) = vv;
        const size_t dst = (((size_t)db * WIN + (WIN - DSEQ) + t) * 4 + kvh) * 64 + 8 * ch;
        f32x4 a, c2; a.x = bf2f(kv.x & 0xffff); a.y = bf2f(kv.x >> 16); a.z = bf2f(kv.y & 0xffff); a.w = bf2f(kv.y >> 16); c2.x = bf2f(kv.z & 0xffff); c2.y = bf2f(kv.z >> 16); c2.z = bf2f(kv.w & 0xffff); c2.w = bf2f(kv.w >> 16);
        *(GAS f32x4*)(F.out + O_KWS + dst) = a; *(GAS f32x4*)(F.out + O_KWS + dst + 4) = c2;
        a.x = bf2f(vv.x & 0xffff); a.y = bf2f(vv.x >> 16); a.z = bf2f(vv.y & 0xffff); a.w = bf2f(vv.y >> 16); c2.x = bf2f(vv.z & 0xffff); c2.y = bf2f(vv.z >> 16); c2.z = bf2f(vv.w & 0xffff); c2.w = bf2f(vv.w >> 16);
        *(GAS f32x4*)(F.out + O_VWS + dst) = a; *(GAS f32x4*)(F.out + O_VWS + dst + 4) = c2; }
    if (F.tid >= 64 && F.tid < 64 + 192) { const int c = F.tid - 64, row = 136 + (c >> 3), ch = c & 7; *(LAS v4u*)(AK + row * AKP + 8 * ch) = (v4u){0u, 0u, 0u, 0u}; *(LAS v4u*)(AV + row * AKP + 8 * ch) = (v4u){0u, 0u, 0u, 0u}; }
}
__device__ __forceinline__ void attn_sample_tiles(Frame& F, const AttnLds& L, int db, int kvh, int wl, gcf sinks) {
    const int gq = F.lane >> 4, i = F.lane & 15; const size_t srow0 = (size_t)ROWS_P + (size_t)db * DSEQ;
    const bf16* qptr = F.P() + (srow0 + (i & 7)) * NPAD + C_QA + (kvh * 4 + 2 * wl + (i >> 3)) * 64;
    const bf16x8 qa[2] = {*(const GAS bf16x8*)(qptr + 8 * gq), *(const GAS bf16x8*)(qptr + 32 + 8 * gq)};
    attn_tile<true>(F, L, qa, 0, 0, 0, 2 * wl, srow0, sinks, kvh);
}
__device__ __forceinline__ void attn_sample_unit(Frame& F0, LAS unsigned char* scr, int u) { Frame F = F0; asm volatile("" : "+v"(F.tid), "+v"(F.lane));
    gcf const cache_k = ldarg<A_CK>(); gcf const cache_v = ldarg<A_CV>(); gcf const sinks = ldarg<A_SINK>();
    const int kvh = u & 3, db = u >> 2;
    LAS unsigned short* AK = (LAS unsigned short*)(scr + A_K); LAS unsigned short* AV = (LAS unsigned short*)(scr + A_V);
    __syncthreads();
    attn_sample_stage(F, AK, AV, db, kvh, cache_k, cache_v);
    attn_bias_table(F, (LAS float*)(scr + A_BIAS), kvh);
    __syncthreads();
    if (F.wave < 2) { const AttnLds L{AK, AV, (const LAS float*)(scr + A_BIAS), (LAS unsigned short*)(scr + A_P) + F.wave * 16 * APP}; attn_sample_tiles(F, L, db, kvh, F.wave, sinks); }
}
constexpr int SP_SLOT = 160 * AKP * 2, SP_BIAS = 4 * SP_SLOT, SP_P = SP_BIAS + 2048, SP_END = SP_P + 4 * 16 * APP * 2;
static_assert(SP_END <= LDS_BYTES - SCR_OFF, "sample pair LDS");
__device__ __forceinline__ void attn_sample_pair(Frame& F0, LAS unsigned char* scr, int u0, int u1) { Frame F = F0; asm volatile("" : "+v"(F.tid), "+v"(F.lane));
    gcf const cache_k = ldarg<A_CK>(); gcf const cache_v = ldarg<A_CV>(); gcf const sinks = ldarg<A_SINK>();
    const int kvh = u0 & 3;
    LAS unsigned short* K0 = (LAS unsigned short*)(scr); LAS unsigned short* V0 = (LAS unsigned short*)(scr + SP_SLOT);
    LAS unsigned short* K1 = (LAS unsigned short*)(scr + 2 * SP_SLOT); LAS unsigned short* V1 = (LAS unsigned short*)(scr + 3 * SP_SLOT);
    __syncthreads();
    attn_sample_stage(F, K0, V0, u0 >> 2, kvh, cache_k, cache_v);
    attn_sample_stage(F, K1, V1, u1 >> 2, kvh, cache_k, cache_v);
    attn_bias_table(F, (LAS float*)(scr + SP_BIAS), kvh);
    __syncthreads();
    if (F.wave < 4) { const int sl = F.wave >> 1;
        const AttnLds L{sl ? K1 : K0, sl ? V1 : V0, (const LAS float*)(scr + SP_BIAS), (LAS unsigned short*)(scr + SP_P) + F.wave * 16 * APP};
        attn_sample_tiles(F, L, (sl ? u1 : u0) >> 2, kvh, F.wave & 1, sinks); }
}

constexpr int GQP = 136, GVP = 264;
constexpr int G_Q = 0, G_K = 128 * GQP * 2, G_V = 2 * G_K, G_Z = G_V + 128 * GVP * 2, G_TOT = G_Z + 8192, G_D = G_TOT + 2048, G_END = G_D + 512;
static_assert(G_END <= LDS_BYTES - SCR_OFF, "GLA LDS");

template <bool NEED_Q>
__device__ __forceinline__ void gla_gate(Frame& F, LAS unsigned char* scr, int b, int c, int h) { gcf const w_a2 = ldarg<A_WA2>(); gcf const b_a = ldarg<A_BA>();
    LAS unsigned short* GQ = (LAS unsigned short*)(scr + G_Q); LAS unsigned short* GK = (LAS unsigned short*)(scr + G_K); LAS unsigned short* GV = (LAS unsigned short*)(scr + G_V);
    LAS float* GD = (LAS float*)(scr + G_D);
    const size_t R0 = (size_t)b * LP + 128 * c;
    const int lane = F.lane, gq = lane >> 4, i = lane & 15, w = F.wave;
    __syncthreads();
    bf16x8 za[8]; bf16x8 wh, wl; float ba;
    {
        v4u vv[8], kk[4], qq[4];
#pragma unroll
        for (int j = 0; j < 8; ++j) { const int cc = F.tid + 512 * j, row = cc >> 5, ch = cc & 31; vv[j] = *(const GAS v4u*)(F.P() + (R0 + row) * NPAD + C_VG + h * 256 + 8 * ch); }
#pragma unroll
        for (int j = 0; j < 4; ++j) { const int cc = F.tid + 512 * j, row = cc >> 4, ch = cc & 15; const bf16* p = F.P() + (R0 + row) * NPAD + h * 128 + 8 * ch;
            kk[j] = *(const GAS v4u*)(p + C_KG); if (NEED_Q) qq[j] = *(const GAS v4u*)(p + C_QG); }
#pragma unroll
        for (int tb = 0; tb < 8; ++tb) za[tb] = (gq < 2) ? *(const GAS bf16x8*)(F.P() + (R0 + 16 * tb + i) * NPAD + C_ZG + 8 * gq) : (bf16x8){0, 0, 0, 0, 0, 0, 0, 0};
#pragma unroll
        for (int j = 0; j < 8; ++j) { const float wv = (gq < 2) ? w_a2[(8 * gq + j) * 512 + h * 128 + 16 * w + i] : 0.f; const unsigned short hi = f2bf16(wv); wh[j] = (short)hi; wl[j] = (short)f2bf16(wv - bf2f(hi)); }
        ba = b_a[h * 128 + 16 * w + i];
#pragma unroll
        for (int j = 0; j < 8; ++j) { const int cc = F.tid + 512 * j, row = cc >> 5, ch = cc & 31; *(LAS v4u*)(GV + row * GVP + 8 * ch) = vv[j]; }
#pragma unroll
        for (int j = 0; j < 4; ++j) { const int cc = F.tid + 512 * j, row = cc >> 4, ch = cc & 15; *(LAS v4u*)(GK + row * GQP + 8 * ch) = kk[j]; if (NEED_Q) *(LAS v4u*)(GQ + row * GQP + 8 * ch) = qq[j]; }
    }
    f32x4 bc[8]; float run = 0.f;
#pragma unroll
    for (int tb = 0; tb < 8; ++tb) { f32x4 x = (f32x4){ba, ba, ba, ba}; x = MFMA16(za[tb], wh, x); x = MFMA16(za[tb], wl, x);
        float l0 = logsig_f(x[0]) * (1.f / 16.f), l1 = logsig_f(x[1]) * (1.f / 16.f), l2 = logsig_f(x[2]) * (1.f / 16.f), l3 = logsig_f(x[3]) * (1.f / 16.f);
        if (c == 0) { const int t0 = 16 * tb + 4 * gq; if (t0 + 0 < FPAD) l0 = 0.f; if (t0 + 1 < FPAD) l1 = 0.f; if (t0 + 2 < FPAD) l2 = 0.f; if (t0 + 3 < FPAD) l3 = 0.f; }
        const float p0 = l0, p1 = p0 + l1, p2 = p1 + l2, p3 = p2 + l3;
        float a = p3; const float u1 = __shfl_up(a, 16); if (gq >= 1) a += u1; const float u2 = __shfl_up(a, 32); if (gq >= 2) a += u2;
        const float excl = a - p3, tot = __shfl(a, 48 + i);
        bc[tb] = (f32x4){run + excl + p0, run + excl + p1, run + excl + p2, run + excl + p3}; run += tot; }
    __syncthreads();
#pragma unroll
    for (int tb = 0; tb < 8; ++tb)
#pragma unroll
        for (int r = 0; r < 4; ++r) { const int t = 16 * tb + 4 * gq + r, k = 16 * w + i; const float bt = bc[tb][r];
            GK[t * GQP + k] = f2bf16(bf2f(GK[t * GQP + k]) * __expf(-bt));
            if (NEED_Q) GQ[t * GQP + k] = f2bf16(bf2f(GQ[t * GQP + k]) * __expf(bt) * 0.08838834764831845f); }
    if (gq == 0) GD[16 * w + i] = __expf(run);
    __syncthreads();
}

__device__ __forceinline__ void gla_ds_unit(Frame& F0, LAS unsigned char* scr, int b, int c, int h) { Frame F = F0; asm volatile("" : "+v"(F.tid), "+v"(F.lane));
    const int u = (b * NBLK + c) * 4 + h;
    gla_gate<false>(F, scr, b, c, h);
    const LAS unsigned short* GK = (const LAS unsigned short*)(scr + G_K); const LAS unsigned short* GV = (const LAS unsigned short*)(scr + G_V); const LAS float* GD = (const LAS float*)(scr + G_D);
    int lane = F.lane; asm volatile("" : "+v"(lane));
    const int gq = lane >> 4, i = lane & 15, w = F.wave;
    f32x4 acc[8][2];
#pragma unroll
    for (int rb = 0; rb < 8; ++rb) { acc[rb][0] = (f32x4){0.f, 0.f, 0.f, 0.f}; acc[rb][1] = (f32x4){0.f, 0.f, 0.f, 0.f}; }
#pragma unroll
    for (int ks = 0; ks < 4; ++ks) {
        if (c == 0 && ks < 3) continue;
        const bf16x8 vb0 = tr_frag(GV, 32 * ks + 8 * gq, 32 * w, GVP, lane), vb1 = tr_frag(GV, 32 * ks + 8 * gq, 32 * w + 16, GVP, lane);
#pragma unroll
        for (int rb = 0; rb < 8; ++rb) { const bf16x8 ka = tr_frag(GK, 32 * ks + 8 * gq, 16 * rb, GQP, lane); acc[rb][0] = MFMA16(ka, vb0, acc[rb][0]); acc[rb][1] = MFMA16(ka, vb1, acc[rb][1]); } }
    bf16* dst = (bf16*)F.dST() + (size_t)u * 32768;
#pragma unroll
    for (int rb = 0; rb < 8; ++rb) { const f32x4 d4 = *(const LAS f32x4*)(GD + 16 * rb + 4 * gq);
#pragma unroll
        for (int cb = 0; cb < 2; ++cb) { const f32x4 o = acc[rb][cb] * d4; *(GAS unsigned long long*)(dst + (size_t)(32 * w + 16 * cb + i) * 128 + 16 * rb + 4 * gq) = (unsigned long long)pk2(o[0], o[1]) | ((unsigned long long)pk2(o[2], o[3]) << 32); } }
    if (F.tid < 128) F.dec()[(size_t)u * 128 + F.tid] = GD[F.tid];
}

__device__ __forceinline__ void gla_scan(Frame& F) {
    for (int e = blockIdx.x * NTHREADS + F.tid; e < NBATCH * 4 * 256 * 64; e += F.G * NTHREADS) {
        const int k2 = e & 63, v = (e >> 6) & 255, bh = e >> 14, b = bh >> 2, h = bh & 3;
        float s0 = 0.f, s1 = 0.f;
#pragma unroll 1
        for (int c0 = 0; c0 < NBLK; c0 += 11) {
            f32x2 d[11], ds[11];
#pragma unroll
            for (int q = 0; q < 11; ++q) { const size_t u = ((size_t)b * NBLK + c0 + q) * 4 + h;
                d[q] = *(const GAS f32x2*)(F.dec() + u * 128 + 2 * k2); { const unsigned dv = *(const GAS unsigned*)((const bf16*)F.dST() + u * 32768 + (size_t)v * 128 + 2 * k2); ds[q] = (f32x2){bf2f((unsigned short)dv), bf2f((unsigned short)(dv >> 16))}; } }
#pragma unroll
            for (int q = 0; q < 11; ++q) { const size_t u = ((size_t)b * NBLK + c0 + q) * 4 + h;
                *(GAS unsigned*)(F.St() + u * 32768 + (size_t)v * 128 + 2 * k2) = pk2(s0, s1);
                s0 = d[q].x * s0 + ds[q].x; s1 = d[q].y * s1 + ds[q].y; }
        }
        float* gp = F.out + O_GP + ((size_t)bh * 128 + 2 * k2) * 256 + v; gp[0] = s0; gp[256] = s1;
    }
}

__device__ __forceinline__ void gla_out_unit(Frame& F0, LAS unsigned char* scr, int b, int c, int h) { Frame F = F0; asm volatile("" : "+v"(F.tid), "+v"(F.lane)); gcf const gla_norm = ldarg<A_GNORM>();
    const int u = (b * NBLK + c) * 4 + h;
    const bf16* St = F.St() + (size_t)u * 32768; const size_t R0 = (size_t)b * LP + 128 * c;
    v4u stp[8], gvp[8];
#pragma unroll
    for (int j = 0; j < 8; ++j) { const int cc = F.tid + 512 * j; stp[j] = (c != 0) ? *(const GAS v4u*)(St + (size_t)(cc >> 4) * 128 + 8 * (cc & 15)) : (v4u){0u, 0u, 0u, 0u}; }
#pragma unroll
    for (int j = 0; j < 8; ++j) { const int q = F.lane + 64 * j, row = 16 * F.wave + (q >> 5), ch = q & 31; gvp[j] = *(const GAS v4u*)(F.P() + (R0 + row) * NPAD + C_GG + h * 256 + 8 * ch); }
    gla_gate<true>(F, scr, b, c, h);
    const LAS unsigned short* GQ = (const LAS unsigned short*)(scr + G_Q); LAS unsigned short* GK = (LAS unsigned short*)(scr + G_K); const LAS unsigned short* GV = (const LAS unsigned short*)(scr + G_V);
    int lane = F.lane; asm volatile("" : "+v"(lane));
    const int gq = lane >> 4, i = lane & 15, w = F.wave;
    const bool active = true;
    bf16x8 qa[4];
#pragma unroll
    for (int ks = 0; ks < 4; ++ks) qa[ks] = *(const LAS bf16x8*)(GQ + (16 * w + i) * GQP + 32 * ks + 8 * gq);
    f32x4 aa[8];
#pragma unroll
    for (int sb = 0; sb < 8; ++sb) { aa[sb] = (f32x4){0.f, 0.f, 0.f, 0.f};
        if (active && sb <= w) {
#pragma unroll
            for (int ks = 0; ks < 4; ++ks) { const bf16x8 kb = *(const LAS bf16x8*)(GK + (16 * sb + i) * GQP + 32 * ks + 8 * gq); aa[sb] = MFMA16(qa[ks], kb, aa[sb]); } } }
    __syncthreads();
    f32x4 acc[16];
#pragma unroll
    for (int cb = 0; cb < 16; ++cb) acc[cb] = (f32x4){0.f, 0.f, 0.f, 0.f};
    if (active) {
#pragma unroll
    for (int sb = 0; sb < 8; ++sb)
#pragma unroll
        for (int r = 0; r < 4; ++r) { const int t = 16 * w + 4 * gq + r, s = 16 * sb + i; GK[t * GQP + s] = f2bf16(s <= t ? aa[sb][r] : 0.f); }
    LDS_WAIT(); asm volatile("" ::: "memory");
#pragma unroll
    for (int ks = 0; ks < 4; ++ks) {
        if (2 * ks <= w) {
            const bf16x8 af = *(const LAS bf16x8*)(GK + (16 * w + i) * GQP + 32 * ks + 8 * gq);
#pragma unroll
            for (int cb = 0; cb < 16; ++cb) { const bf16x8 vb = tr_frag(GV, 32 * ks + 8 * gq, 16 * cb, GVP, lane); acc[cb] = MFMA16(af, vb, acc[cb]); } } }
    }
    __syncthreads();
    { LAS unsigned char* GS = scr + G_V;
#pragma unroll
      for (int j = 0; j < 8; ++j) { const int cc = F.tid + 512 * j, v = cc >> 4, ch = cc & 15; *(LAS v4u*)(GS + v * 256 + ((ch ^ (v & 15)) << 4)) = stp[j]; } }
    __syncthreads();
    if (active) {
    if (c != 0) {
        const LAS unsigned char* GS = scr + G_V;
#pragma unroll
    for (int ks = 0; ks < 4; ++ks)
#pragma unroll
        for (int cb = 0; cb < 16; ++cb) { const bf16x8 sb = *(const LAS bf16x8*)(GS + (16 * cb + i) * 256 + (((4 * ks + gq) ^ i) << 4)); acc[cb] = MFMA16(qa[ks], sb, acc[cb]); }
    }
    LDS_WAIT(); asm volatile("" ::: "memory");
    { LAS unsigned short* GQw = (LAS unsigned short*)(scr + G_Q);
#pragma unroll
    for (int r = 0; r < 4; ++r) { float ss = 0.f;
#pragma unroll
        for (int cb = 0; cb < 16; ++cb) ss += acc[cb][r] * acc[cb][r];
        ss += __shfl_xor(ss, 1); ss += __shfl_xor(ss, 2); ss += __shfl_xor(ss, 4); ss += __shfl_xor(ss, 8);
        const float rstd = rsqrtf(ss * (1.f / 256.f) + EPSN); const int row = 16 * w + 4 * gq + r;
#pragma unroll
        for (int cb = 0; cb < 8; ++cb) { GQw[row * GQP + 16 * cb + i] = f2bf16(acc[cb][r] * rstd); GK[row * GQP + 16 * cb + i] = f2bf16(acc[cb + 8][r] * rstd); } }
    LDS_WAIT(); asm volatile("" ::: "memory");
#pragma unroll
    for (int j = 0; j < 8; ++j) { const int q = lane + 64 * j, row = 16 * w + (q >> 5), ch = q & 31;
        const v4u ov = *(const LAS v4u*)((ch < 16 ? GQw : GK) + row * GQP + 8 * (ch & 15));
        const v4u gv = gvp[j];
        const f32x4 n0 = *(const GAS f32x4*)(gla_norm + 8 * ch), n1 = *(const GAS f32x4*)(gla_norm + 8 * ch + 4);
        v4u res;
        res.x = pk2(bf2f(ov.x & 0xffff) * n0.x * silu_f(bf2f(gv.x & 0xffff)), bf2f(ov.x >> 16) * n0.y * silu_f(bf2f(gv.x >> 16)));
        res.y = pk2(bf2f(ov.y & 0xffff) * n0.z * silu_f(bf2f(gv.y & 0xffff)), bf2f(ov.y >> 16) * n0.w * silu_f(bf2f(gv.y >> 16)));
        res.z = pk2(bf2f(ov.z & 0xffff) * n1.x * silu_f(bf2f(gv.z & 0xffff)), bf2f(ov.z >> 16) * n1.y * silu_f(bf2f(gv.z >> 16)));
        res.w = pk2(bf2f(ov.w & 0xffff) * n1.z * silu_f(bf2f(gv.w & 0xffff)), bf2f(ov.w >> 16) * n1.w * silu_f(bf2f(gv.w >> 16)));
        *(GAS v4u*)(F.MIX() + (R0 + row) * DM + 1024 + h * 256 + 8 * ch) = res; } }
    }
}

constexpr int S_Q = 0, S_KH = 4096, S_KT = 8192, S_LG = 12288, S_D = 16384, S_A = 16896, S_Z = 17152, S_OP = 17664, S_END = S_OP + 65536;
static_assert(S_END <= LDS_BYTES - SCR_OFF, "sample GLA LDS");
__device__ __forceinline__ void gla_sample_unit(Frame& F0, LAS unsigned char* scr, int u) { Frame F = F0; asm volatile("" : "+v"(F.tid), "+v"(F.lane));
    gcf const w_a2 = ldarg<A_WA2>(); gcf const b_a = ldarg<A_BA>(); gcf const state = ldarg<A_STATE>(); gcf const gla_norm = ldarg<A_GNORM>();
    const int h = u & 3, db = u >> 2;
    LAS float* SQ = (LAS float*)(scr + S_Q); LAS float* SKH = (LAS float*)(scr + S_KH); LAS float* SKT = (LAS float*)(scr + S_KT); LAS float* SLG = (LAS float*)(scr + S_LG); LAS float* SD = (LAS float*)(scr + S_D);
    LAS float* SA = (LAS float*)(scr + S_A); LAS float* SZ = (LAS float*)(scr + S_Z); LAS float* SOP = (LAS float*)(scr + S_OP);
    const size_t R0 = (size_t)ROWS_P + (size_t)db * DSEQ;
    const int w = F.wave, lane = F.lane;
    f32x4 st[16];
    { const GAS f32x4* sp = (const GAS f32x4*)(state + ((size_t)u * 128 + 16 * w) * 256) + lane;
#pragma unroll
      for (int kk = 0; kk < 16; ++kk) st[kk] = sp[64 * kk]; }
    __syncthreads();
    if (F.tid < 128) SZ[F.tid] = bf2f(F.P()[(R0 + (F.tid >> 4)) * NPAD + C_ZG + (F.tid & 15)]);
    const int k = F.tid & 127, tp = F.tid >> 7;
    float qv[2], kv[2], wv[16];
#pragma unroll
    for (int q = 0; q < 2; ++q) { const bf16* p = F.P() + (R0 + 2 * tp + q) * NPAD + h * 128 + k; qv[q] = bf2f(p[C_QG]); kv[q] = bf2f(p[C_KG]); }
#pragma unroll
    for (int r = 0; r < 16; ++r) wv[r] = w_a2[r * 512 + h * 128 + k];
    const float ba = b_a[h * 128 + k];
    __syncthreads();
#pragma unroll
    for (int q = 0; q < 2; ++q) { const int t = 2 * tp + q; float x = ba;
#pragma unroll
        for (int r = 0; r < 16; ++r) x += SZ[t * 16 + r] * wv[r];
        SLG[t * 128 + k] = logsig_f(x) * (1.f / 16.f); }
    __syncthreads();
    { float run = 0.f, bt[2] = {0.f, 0.f};
#pragma unroll
      for (int t = 0; t < 8; ++t) { run += SLG[t * 128 + k]; if (t == 2 * tp) bt[0] = run; if (t == 2 * tp + 1) bt[1] = run; }
#pragma unroll
      for (int q = 0; q < 2; ++q) { const int t = 2 * tp + q;
          SQ[k * 8 + t] = qv[q] * __expf(bt[q]) * 0.08838834764831845f; SKT[k * 8 + t] = kv[q] * __expf(-bt[q]); SKH[k * 8 + t] = kv[q] * __expf(run - bt[q]); }
      if (tp == 0) SD[k] = __expf(run); }
    __syncthreads();
    if (F.tid < 64) { const int t = F.tid >> 3, s2 = F.tid & 7; float a = 0.f;
        if (s2 <= t) { for (int kk = 0; kk < 128; ++kk) a += SQ[kk * 8 + t] * SKT[kk * 8 + s2]; }
        SA[t * 8 + s2] = a; }
    {   f32x4 vv[8], op[8];
#pragma unroll
        for (int t = 0; t < 8; ++t) { const unsigned long long pv = *(const GAS unsigned long long*)(F.P() + (R0 + t) * NPAD + C_VG + h * 256 + 4 * lane);
            vv[t] = (f32x4){bf2f((unsigned short)pv), bf2f((unsigned short)(pv >> 16)), bf2f((unsigned short)(pv >> 32)), bf2f((unsigned short)(pv >> 48))}; op[t] = (f32x4){0.f, 0.f, 0.f, 0.f}; }
        GAS f32x4* np = (GAS f32x4*)(F.out + O_GS + ((size_t)u * 128 + 16 * w) * 256) + lane;
#pragma unroll
        for (int kk = 0; kk < 16; ++kk) { const int kc = 16 * w + kk; const f32x4 s0 = st[kk];
            const f32x4 q0 = *(const LAS f32x4*)(SQ + kc * 8), q1 = *(const LAS f32x4*)(SQ + kc * 8 + 4), h0 = *(const LAS f32x4*)(SKH + kc * 8), h1 = *(const LAS f32x4*)(SKH + kc * 8 + 4);
            f32x4 sn = s0 * SD[kc];
            sn += vv[0] * h0.x + vv[1] * h0.y + vv[2] * h0.z + vv[3] * h0.w + vv[4] * h1.x + vv[5] * h1.y + vv[6] * h1.z + vv[7] * h1.w;
            np[64 * kk] = sn;
            op[0] += s0 * q0.x; op[1] += s0 * q0.y; op[2] += s0 * q0.z; op[3] += s0 * q0.w; op[4] += s0 * q1.x; op[5] += s0 * q1.y; op[6] += s0 * q1.z; op[7] += s0 * q1.w; }
#pragma unroll
        for (int t = 0; t < 8; ++t) *(LAS f32x4*)(SOP + (w * 8 + t) * 256 + 4 * lane) = op[t];
    }
    __syncthreads();
    {   const int t = w; f32x4 a = (f32x4){0.f, 0.f, 0.f, 0.f};
#pragma unroll
        for (int w2 = 0; w2 < 8; ++w2) a += *(const LAS f32x4*)(SOP + (w2 * 8 + t) * 256 + 4 * lane);
        for (int s2 = 0; s2 <= t; ++s2) { const unsigned long long pv = *(const GAS unsigned long long*)(F.P() + (R0 + s2) * NPAD + C_VG + h * 256 + 4 * lane); const float c = SA[t * 8 + s2];
            a += (f32x4){bf2f((unsigned short)pv), bf2f((unsigned short)(pv >> 16)), bf2f((unsigned short)(pv >> 32)), bf2f((unsigned short)(pv >> 48))} * c; }
        const float ss = (a.x * a.x + a.y * a.y) + (a.z * a.z + a.w * a.w);
        const float rstd = rsqrtf(wave_sum(ss) * (1.f / 256.f) + EPSN);
        const unsigned long long gv = *(const GAS unsigned long long*)(F.P() + (R0 + t) * NPAD + C_GG + h * 256 + 4 * lane); const f32x4 gn = *(const GAS f32x4*)(gla_norm + 4 * lane);
        const float g0 = bf2f((unsigned short)gv), g1 = bf2f((unsigned short)(gv >> 16)), g2 = bf2f((unsigned short)(gv >> 32)), g3 = bf2f((unsigned short)(gv >> 48));
        *(GAS unsigned long long*)(F.MIX() + (R0 + t) * DM + 1024 + h * 256 + 4 * lane) =
            (unsigned long long)pk2(a.x * rstd * gn.x * silu_f(g0), a.y * rstd * gn.y * silu_f(g1)) | ((unsigned long long)pk2(a.z * rstd * gn.z * silu_f(g2), a.w * rstd * gn.w * silu_f(g3)) << 32);
    }
}

__device__ __forceinline__ void final_rows(Frame& F) { gcf const x_prompt = ldarg<A_XP>(); gcf const x_sample = ldarg<A_XS>(); gcf const norm_post = ldarg<A_NPOST>();
    const int gw = blockIdx.x * NWAVES + F.wave, NGW = F.G * NWAVES; constexpr int NR = NBATCH * SEQ + ROWS_S;
    for (int idx0 = gw; idx0 < NR; idx0 += 2 * NGW) {
        f32x4 v[2][8], xx[2][8]; float* yp[2]; bool on[2];
#pragma unroll
        for (int q = 0; q < 2; ++q) { const int idx = idx0 + q * NGW; on[q] = idx < NR; const int id2 = on[q] ? idx : idx0;
            size_t grow; gcf x;
            if (id2 < NBATCH * SEQ) { const int b = id2 / SEQ, s2 = id2 - b * SEQ; grow = (size_t)b * LP + 128 + s2; x = x_prompt + (size_t)id2 * DM; yp[q] = F.out + O_YP + (size_t)id2 * DM; }
            else { const int j = id2 - NBATCH * SEQ; grow = (size_t)ROWS_P + j; x = x_sample + (size_t)j * DM; yp[q] = F.out + O_YS + (size_t)j * DM; }
            const GAS unsigned long long* o4 = (const GAS unsigned long long*)yp[q] + F.lane;   const GAS f32x4* x4 = (const GAS f32x4*)x + F.lane;
#pragma unroll
            for (int j = 0; j < 8; ++j) { const unsigned long long ov = o4[64 * j]; v[q][j] = (f32x4){bf2f((unsigned short)ov), bf2f((unsigned short)(ov >> 16)), bf2f((unsigned short)(ov >> 32)), bf2f((unsigned short)(ov >> 48))}; xx[q][j] = x4[64 * j]; } }
#pragma unroll
        for (int q = 0; q < 2; ++q) { float s2 = 0.f;
#pragma unroll
            for (int j = 0; j < 8; ++j) s2 += (v[q][j].x * v[q][j].x + v[q][j].y * v[q][j].y) + (v[q][j].z * v[q][j].z + v[q][j].w * v[q][j].w);
            const float rstd = rsqrtf(wave_sum(s2) * (1.f / DM) + EPSN);
            if (on[q]) { GAS f32x4* y4 = (GAS f32x4*)yp[q] + F.lane;
#pragma unroll
                for (int j = 0; j < 8; ++j) { const f32x4 w = ((const GAS f32x4*)norm_post)[F.lane + 64 * j]; y4[64 * j] = xx[q][j] + v[q][j] * rstd * w; } } }
    }
}

#ifndef MK_PER_PHASE
#define MK_PER_PHASE 0
#endif
constexpr int N_PHASES = 7;
struct Args { const float* in[15]; float* out; unsigned char* ws; int ph_lo, ph_hi; };
__global__ void __launch_bounds__(NTHREADS, 2) hymba_fwd(Args args) {
    extern __shared__ __attribute__((aligned(16))) unsigned char lds_raw[];
    Frame F;
    F.lds = (LAS unsigned char*)lds_raw;
    F.tid = threadIdx.x; F.lane = F.tid & 63; F.wave = __builtin_amdgcn_readfirstlane(F.tid >> 6); F.G = gridDim.x;
    F.out = args.out; F.ws = args.ws;
    unsigned char* ws = args.ws;
    for (int u = F.tid; u < LDS_CTL_BYTES / 4; u += NTHREADS) ((LAS unsigned*)F.lds)[u] = 0u;
    __syncthreads();
    volatile LAS unsigned* MISC = (volatile LAS unsigned*)(F.lds + 512);
    XcdBarrier bar; bar.bar = (unsigned*)(ws + WS_CTL) + CW_BAR; bar.x = 0; bar.st = nullptr;
    if (!MK_PER_PHASE) bar = xcd_barrier_post((unsigned*)(ws + WS_CTL) + CW_BAR, MISC + 8);
    LAS unsigned char* scr = F.lds + SCR_OFF;
    const int lo = args.ph_lo, hi = args.ph_hi;
#define IN(k) (lo <= (k) && (k) < hi)
#define SEAM(k) do { if (IN(k) && IN((k) + 1)) xcd_barrier(bar); } while (0)

#ifndef PROBE_PHASE
#define PROBE_PHASE -1
#endif
#ifndef PROBE_REP
#define PROBE_REP 1
#endif
#define REPS(k) for (int rep_ = 0; rep_ < ((k) == PROBE_PHASE ? PROBE_REP : 1); ++rep_)
    constexpr int P0_I_IN = (DM / 64) * (NPAD / 64), P0_I_ALL = P0_I_IN + (DM / 64) * (DM / 64);
    constexpr int G1_TAIL = (MROWS / 256) * (NPAD / 256) % 256;
    const bool wout_late = (F.G == 256) && !MK_PER_PHASE && IN(0) && IN(1) && IN(2) && PROBE_PHASE < 0;
    REPS(0) if (IN(0)) { p0_prologue(F, 0, wout_late ? P0_I_IN : P0_I_ALL, 0, F.G, true); if (PROBE_PHASE == 0) xcd_barrier(bar); }
    SEAM(0);
#define UNIT_BCH(idx, b_, c_, h_) const int b_ = (idx) < 256 ? (idx) >> 7 : ((idx) - 256) >> 2, c_ = (idx) < 256 ? 1 + (((idx) >> 2) & 31) : 0, h_ = (idx) & 3
    const bool split12 = (F.G == 256) && !MK_PER_PHASE && IN(0) && IN(1) && IN(2) && PROBE_PHASE < 0;
    if (split12) {
        constexpr int G1_MP = ROWS_P / 256, G1_MS = ROWS_S / 256, G1_N = NPAD / 256, G1_FULL = (G1_MP + G1_MS) * G1_N / 256;
        const int cb_ = (int)blockIdx.x;
        { pg8::Gemm g{F.XN(), F.WinT(), MROWS, NPAD, DM}; pg8::OrderPF S{G1_MP, G1_MS, G1_N, F.G, cb_, 0, G1_FULL};
          pg8::EpiBf16<0> E{F.P(), NPAD, nullptr, 0, 0, 1.f}; pg8::gemm_phase<pg8::EpiBf16<0>, pg8::OrderPF, true, true>(scr, g, S, E); }
        xcd_barrier(bar);
        if (cb_ < G1_TAIL) {
            { pg8::Gemm g{F.XN(), F.WinT(), MROWS, NPAD, DM}; pg8::OrderPF S{G1_MP, G1_MS, G1_N, F.G, cb_, G1_FULL, G1_FULL + 1};
              pg8::EpiBf16<0> E{F.P(), NPAD, nullptr, 0, 0, 1.f}; pg8::gemm_phase<pg8::EpiBf16<0>, pg8::OrderPF, true, true>(scr, g, S, E); }
        } else { { UNIT_BCH(cb_, b_, c_, h_); attn_prompt_unit(F, scr, b_, c_, h_); gla_ds_unit(F, scr, b_, c_, h_); }
            __syncthreads(); p0_prologue(F, P0_I_IN, P0_I_ALL, G1_TAIL, F.G - G1_TAIL, false); }
        xcd_barrier(bar);
        if (cb_ < G1_TAIL) { { UNIT_BCH(cb_, b_, c_, h_); attn_prompt_unit(F, scr, b_, c_, h_); gla_ds_unit(F, scr, b_, c_, h_); } gla_sample_unit(F, scr, cb_); }
        else if (cb_ < G1_TAIL + 8) { UNIT_BCH(256 + (cb_ - G1_TAIL), b_, c_, h_); attn_prompt_unit(F, scr, b_, c_, h_); gla_ds_unit(F, scr, b_, c_, h_); gla_out_unit(F, scr, b_, c_, h_); }
        else { const int v = cb_ - (G1_TAIL + 8), nb = 256 - (G1_TAIL + 8);
            attn_sample_pair(F, scr, v, 256 + v); if (nb + v < 256) attn_sample_pair(F, scr, nb + v, 256 + nb + v);
            gla_sample_unit(F, scr, G1_TAIL + v); gla_sample_unit(F, scr, G1_TAIL + nb + v); { const int n3 = DBATCH * 4 - (G1_TAIL + 2 * nb), v3 = v - (nb - n3); if (v3 >= 0) gla_sample_unit(F, scr, G1_TAIL + 2 * nb + v3); } }
    } else {
    REPS(1) if (IN(1)) {
        pg8::Gemm g{F.XN(), F.WinT(), MROWS, NPAD, DM}; pg8::StaticOrder S; S.init(MROWS, NPAD, F.G, (int)blockIdx.x);
        pg8::EpiBf16<0> E{F.P(), NPAD, nullptr, 0, 0, 1.f};
        pg8::gemm_phase<pg8::EpiBf16<0>, pg8::StaticOrder, true, true>(scr, g, S, E);
        if (wout_late && (int)blockIdx.x >= G1_TAIL) { __syncthreads(); p0_prologue(F, P0_I_IN, P0_I_ALL, G1_TAIL, F.G - G1_TAIL, false); }
        if (PROBE_PHASE == 1) xcd_barrier(bar);
    }
    SEAM(1);
    REPS(2) if (IN(2)) {
        REPS(20) for (int u = blockIdx.x; u < NBATCH * NBLK * 4; u += F.G) { UNIT_BCH(u, b_, c_, h_); attn_prompt_unit(F, scr, b_, c_, h_); }
        REPS(21) for (int u = blockIdx.x; u < NBATCH * NBLK * 4; u += F.G) { UNIT_BCH(u, b_, c_, h_); gla_ds_unit(F, scr, b_, c_, h_); }
        if (F.G == 256) {
            if (blockIdx.x < 8) { UNIT_BCH(256 + (int)blockIdx.x, b_, c_, h_); gla_out_unit(F, scr, b_, c_, h_); }
            else { const int v = (int)blockIdx.x - 8;
                attn_sample_pair(F, scr, v, 248 + v); if (v < 16) attn_sample_unit(F, scr, 496 + v);
                gla_sample_unit(F, scr, v); gla_sample_unit(F, scr, 248 + v); if (v >= 16 && v < 32) gla_sample_unit(F, scr, 496 + v - 16); }
        } else {
            for (int u = 256 + blockIdx.x; u < NBATCH * NBLK * 4; u += F.G) { UNIT_BCH(u, b_, c_, h_); gla_out_unit(F, scr, b_, c_, h_); }
            REPS(22) for (int u = blockIdx.x; u < DBATCH * 4; u += F.G) attn_sample_unit(F, scr, u);
            REPS(23) for (int u = blockIdx.x; u < DBATCH * 4; u += F.G) gla_sample_unit(F, scr, u);
        }
        if (PROBE_PHASE == 2) xcd_barrier(bar);
    }
    }
    SEAM(2);
    REPS(3) if (IN(3)) { gla_scan(F); if (PROBE_PHASE == 3) xcd_barrier(bar); }
    SEAM(3);
    REPS(4) if (IN(4)) {
        for (int u = blockIdx.x; u < 256; u += F.G) { UNIT_BCH(u, b_, c_, h_); gla_out_unit(F, scr, b_, c_, h_); }
        __syncthreads();
        if (PROBE_PHASE == 4) xcd_barrier(bar);
    }
    SEAM(4);
    REPS(5) if (IN(5)) {
        pg8::Gemm g{F.MIX(), F.WoutT(), MROWS, DM, DM}; pg8::StaticOrder S; S.init(MROWS, DM, F.G, (int)blockIdx.x);
        pg8::EpiY16 E{F.out + O_YP, F.out + O_YS, LP, SEQ, ROWS_P};
        pg8::gemm_phase<pg8::EpiY16, pg8::StaticOrder, true, true>(scr, g, S, E);
        if (PROBE_PHASE == 5) xcd_barrier(bar);
    }
    SEAM(5);
    REPS(6) if (IN(6)) { final_rows(F); if (PROBE_PHASE == 6) xcd_barrier(bar); }
#undef IN
#undef SEAM
}

extern "C" void kernel_launch(void* const* d_in, const int* in_sizes, int n_in, void* d_out, int out_size, void* d_ws, size_t ws_size, hipStream_t stream) {
    static int grid = 0;
    if (grid == 0) {
        if (n_in != 15 || out_size != (int)O_END || ws_size < WS_END) { fprintf(stderr, "kernel_launch: unexpected problem: n_in %d out %d ws %zu\n", n_in, out_size, ws_size); grid = -1; return; }
        int dev = 0, cus = 0, per_cu = 0;
        if (hipGetDevice(&dev) != hipSuccess || hipDeviceGetAttribute(&cus, hipDeviceAttributeMultiprocessorCount, dev) != hipSuccess) { grid = -1; return; }
        if (hipFuncSetAttribute((const void*)hymba_fwd, hipFuncAttributeMaxDynamicSharedMemorySize, LDS_BYTES) != hipSuccess) { fprintf(stderr, "kernel_launch: hipFuncSetAttribute failed\n"); grid = -1; return; }
        if (hipOccupancyMaxActiveBlocksPerMultiprocessor(&per_cu, (const void*)hymba_fwd, NTHREADS, LDS_BYTES) != hipSuccess || per_cu < 1) fprintf(stderr, "kernel_launch: note: occupancy query reports %d\n", per_cu);
        (void)hipGetLastError();
        grid = cus;
    }
    if (grid < 0) return;
    (void)hipMemsetAsync((char*)d_ws + WS_CTL, 0, CTL_ZERO_BYTES, stream);
    Args a{};
    for (int i = 0; i < 15; ++i) a.in[i] = (const float*)d_in[i];
    a.out = (float*)d_out; a.ws = (unsigned char*)d_ws;
#if MK_PER_PHASE
    for (int p = 0; p < N_PHASES; ++p) { a.ph_lo = p; a.ph_hi = p + 1; hipLaunchKernelGGL(hymba_fwd, dim3(grid), dim3(NTHREADS), LDS_BYTES, stream, a); }
#else
    a.ph_lo = 0; a.ph_hi = N_PHASES;
    hipLaunchKernelGGL(hymba_fwd, dim3(grid), dim3(NTHREADS), LDS_BYTES, stream, a);
#endif
}
```

```cpp
#include <hip/hip_runtime.h>
#include <cstdio>
#include <cstdint>
#include <cmath>
namespace pg8 {
#define PG8_LAS __attribute__((address_space(3)))
typedef unsigned short bf16_t;
typedef short bf16x8 __attribute__((ext_vector_type(8)));
typedef float f32x4 __attribute__((ext_vector_type(4)));
typedef unsigned u32x4 __attribute__((ext_vector_type(4)));
constexpr int BM = 256, BK = 64, HALF = 128, HTB = HALF * BK * 2  , STAGE_BYTES = 8 * HTB, NXCD = 8, WGM = 8;

__host__ __device__ __forceinline__ int lds_byte(int r, int c) { const int st = (r >> 4) * 2 + (c >> 5), rr = r & 15, cc = c & 31, ob = rr * 64 + cc * 2; return st * 1024 + (ob ^ (((ob >> 9) & 1) << 5)); }
__host__ __device__ __forceinline__ void stage_rc(int b, int& R, int& C) { const int st = b / 1024, sb = b % 1024, swz = sb ^ (((sb >> 9) & 1) << 5); R = (st >> 1) * 16 + swz / 64; C = (st & 1) * 32 + (swz % 64) / 2; }
__host__ __device__ __forceinline__ int perm32(int rho) { const int n = rho >> 4, i = rho & 15; return 8 * (i >> 2) + 4 * n + (i & 3); }

struct Unit { int pm, pn; };
struct Gemm { const bf16_t* A; const bf16_t* Bt; int M, N, K; };

struct StaticOrder {
    int nM, nN, nwg, G, c;
    __host__ __device__ void init(int M, int N, int G_, int c_) { nM = M / BM; nN = N / BM; nwg = nM * nN; G = G_; c = c_; }
    __host__ __device__ bool next(int i, Unit& u) const {
        const long L = (long)i * G + c; if (L >= nwg) return false;
        int wgid = (int)L; { const int q = nwg / NXCD, r = nwg % NXCD, xcd = wgid % NXCD, off = wgid / NXCD; wgid = (xcd < r ? xcd * (q + 1) : r * (q + 1) + (xcd - r) * q) + off; }
        const int nig = WGM * nN, gid = wgid / nig, fm = gid * WGM, gsz = (nM - fm) < WGM ? (nM - fm) : WGM;
        u.pm = fm + ((wgid % nig) % gsz); u.pn = (wgid % nig) / gsz; return true;
    }
    __device__ __forceinline__ void a_ready(const Unit&) const {}
    __device__ __forceinline__ void done(const Unit&) const {}
};

struct OrderPF {
    int nMp, nMs, nN, G, c, r0, r1;
    __device__ bool next(int i, Unit& u) const {
        const int ii = r0 + i; if (ii >= r1) return false;
        const int nP = nMp * nN, nT = (nMp + nMs) * nN; const int e = ii * G + c; if (e >= nT) return false;
        if (e < nP) { int wgid = e; { const int q = nP / NXCD, r = nP % NXCD, xcd = wgid % NXCD, off = wgid / NXCD; wgid = (xcd < r ? xcd * (q + 1) : r * (q + 1) + (xcd - r) * q) + off; }
            const int nig = WGM * nN, gid = wgid / nig, fm = gid * WGM, gsz = (nMp - fm) < WGM ? (nMp - fm) : WGM; u.pm = fm + ((wgid % nig) % gsz); u.pn = (wgid % nig) / gsz; }
        else { const int q = e - nP; u.pm = nMp + q % nMs; u.pn = q / nMs; }
        return true;
    }
    __device__ __forceinline__ void a_ready(const Unit&) const {}
    __device__ __forceinline__ void done(const Unit&) const {}
};

__device__ __forceinline__ unsigned cvt_pk_bf16(float lo, float hi) { unsigned r; asm volatile("v_cvt_pk_bf16_f32 %0, %1, %2" : "=v"(r) : "v"(lo), "v"(hi)); return r; }
typedef float f32x2 __attribute__((ext_vector_type(2)));
__device__ __forceinline__ f32x2 gelu_pk(f32x2 v) {
    const f32x2 av = __builtin_elementwise_abs(v), d = av * 0.2316418882f + 1.0f;
    f32x2 t; t.x = __builtin_amdgcn_rcpf(d.x); t.y = __builtin_amdgcn_rcpf(d.y);
    f32x2 q = t * 0.5307027145f + (-0.7265760135f); q = q * t + 0.7107068705f; q = q * t + (-0.142248368f); q = q * t + 0.127414796f; q = q * t;
    const f32x2 s = (v * v) * (-0.72134752044f);
    f32x2 e; e.x = __builtin_amdgcn_exp2f(s.x); e.y = __builtin_amdgcn_exp2f(s.y);
    const f32x2 m = v * (q * e), r = v - m;
    f32x2 o; o.x = v.x < 0.f ? m.x : r.x; o.y = v.y < 0.f ? m.y : r.y; return o;
}

template <int ACT  > struct EpiBf16 {
    static constexpr bool PERM = true, AFTER_DRAIN = false; static_assert(ACT == 0 || ACT == 1, "EpiBf16: ACT is 0 (none) or 1 (gelu_pk)");
    bf16_t* O; int ldc; const float* bias; int split_cols; size_t split_stride; float scale0;
    __device__ __forceinline__ void operator()(const f32x4 (&acc)[2][2][4][2], const Unit& u, int wr, int wc, int fr, int fq) const {
        const int row0 = u.pm * BM + wr * 64 + fr; int colt = u.pn * BM; bf16_t* base = O;
        float sc = 1.f; if (split_cols) { const int t = colt / split_cols; base += (size_t)t * split_stride; colt -= t * split_cols; if (t == 0) sc = scale0; }
        const int col0 = colt + wc * 32 + 8 * fq, bcol0 = u.pn * BM + wc * 32 + 8 * fq;
        f32x4 bv[2][2];
#pragma unroll
        for (int bj = 0; bj < 2; ++bj)
#pragma unroll
            for (int n = 0; n < 2; ++n) bv[bj][n] = bias ? *(const f32x4*)(bias + bcol0 + bj * HALF + 4 * n) : (f32x4){0.f, 0.f, 0.f, 0.f};
#pragma unroll
        for (int ai = 0; ai < 2; ++ai)
#pragma unroll
            for (int m = 0; m < 4; ++m) { bf16_t* rowp = base + (size_t)(row0 + ai * HALF + m * 16) * ldc + col0;
#pragma unroll
                for (int bj = 0; bj < 2; ++bj) { f32x4 v0 = acc[ai][bj][m][0] + bv[bj][0], v1 = acc[ai][bj][m][1] + bv[bj][1];
                    if (ACT == 1) { f32x2 a = gelu_pk((f32x2){v0[0], v0[1]}), b = gelu_pk((f32x2){v0[2], v0[3]}), c = gelu_pk((f32x2){v1[0], v1[1]}), d = gelu_pk((f32x2){v1[2], v1[3]});
                        v0 = (f32x4){a.x, a.y, b.x, b.y}; v1 = (f32x4){c.x, c.y, d.x, d.y}; }
                    v0 = v0 * sc; v1 = v1 * sc; u32x4 w; w.x = cvt_pk_bf16(v0[0], v0[1]); w.y = cvt_pk_bf16(v0[2], v0[3]); w.z = cvt_pk_bf16(v1[0], v1[1]); w.w = cvt_pk_bf16(v1[2], v1[3]);
                    *(u32x4*)(rowp + bj * HALF) = w; } }
    }
};

struct EpiF32 {
    static constexpr bool PERM = false, AFTER_DRAIN = false;
    float* O; int ldc;
    __device__ __forceinline__ void operator()(const f32x4 (&acc)[2][2][4][2], const Unit& u, int wr, int wc, int fr, int fq) const {
        const int row0 = u.pm * BM + wr * 64 + fr, col0 = u.pn * BM + wc * 32 + 4 * fq;
#pragma unroll
        for (int ai = 0; ai < 2; ++ai)
#pragma unroll
            for (int m = 0; m < 4; ++m) { float* rowp = O + (size_t)(row0 + ai * HALF + m * 16) * ldc + col0;
#pragma unroll
                for (int bj = 0; bj < 2; ++bj)
#pragma unroll
                    for (int n = 0; n < 2; ++n) *(f32x4*)(rowp + bj * HALF + n * 16) = acc[ai][bj][m][n]; }
    }
};
struct EpiY {
    static constexpr bool PERM = false, AFTER_DRAIN = false;
    float* yp; float* ys; int lp, seq, rows_p;
    __device__ __forceinline__ void operator()(const f32x4 (&acc)[2][2][4][2], const Unit& u, int wr, int wc, int fr, int fq) const {
        const int row0 = u.pm * BM + wr * 64 + fr, col0 = u.pn * BM + wc * 32 + 4 * fq;
#pragma unroll
        for (int ai = 0; ai < 2; ++ai)
#pragma unroll
            for (int m = 0; m < 4; ++m) { const int row = row0 + ai * HALF + m * 16; float* rowp;
                if (row < rows_p) { const int b = row / lp, i = row - b * lp; if (i < 128) continue; rowp = yp + ((size_t)b * seq + (i - 128)) * 2048 + col0; }
                else rowp = ys + (size_t)(row - rows_p) * 2048 + col0;
#pragma unroll
                for (int bj = 0; bj < 2; ++bj)
#pragma unroll
                    for (int n = 0; n < 2; ++n) *(f32x4*)(rowp + bj * HALF + n * 16) = acc[ai][bj][m][n]; }
    }
};
struct EpiY16 {
    static constexpr bool PERM = true, AFTER_DRAIN = false;
    float* yp; float* ys; int lp, seq, rows_p;
    __device__ __forceinline__ void operator()(const f32x4 (&acc)[2][2][4][2], const Unit& u, int wr, int wc, int fr, int fq) const {
        const int row0 = u.pm * BM + wr * 64 + fr, col0 = u.pn * BM + wc * 32 + 8 * fq;
#pragma unroll
        for (int ai = 0; ai < 2; ++ai)
#pragma unroll
            for (int m = 0; m < 4; ++m) { const int row = row0 + ai * HALF + m * 16; bf16_t* rowp;
                if (row < rows_p) { const int b = row / lp, i = row - b * lp; if (i < 128) continue; rowp = (bf16_t*)(yp + ((size_t)b * seq + (i - 128)) * 2048) + col0; }
                else rowp = (bf16_t*)(ys + (size_t)(row - rows_p) * 2048) + col0;
#pragma unroll
                for (int bj = 0; bj < 2; ++bj) { const f32x4 v0 = acc[ai][bj][m][0], v1 = acc[ai][bj][m][1];
                    u32x4 w; w.x = cvt_pk_bf16(v0[0], v0[1]); w.y = cvt_pk_bf16(v0[2], v0[3]); w.z = cvt_pk_bf16(v1[0], v1[1]); w.w = cvt_pk_bf16(v1[2], v1[3]);
                    *(u32x4*)(rowp + bj * HALF) = w; } }
    }
};
template <class Epi, class Sched, bool ALIGN_EPI = false, bool SP2 = false>
__device__ __forceinline__ void gemm_phase(PG8_LAS unsigned char* lds, const Gemm g, const Sched& S, const Epi& E) {
    const int tid = threadIdx.x, wid = __builtin_amdgcn_readfirstlane(tid >> 6), lane = tid & 63, wr = wid >> 2, wc = wid & 3, fr = lane & 15, fq = lane >> 4;
    const int K = g.K, nt = K / BK;
    unsigned voffA[2], voffB[2];
#pragma unroll
    for (int i = 0; i < 2; ++i) { int R, C; stage_rc(tid * 16 + i * 8192, R, C); const int Rb = Epi::PERM ? ((R & ~31) + perm32(R & 31)) : R;
        voffA[i] = (unsigned)(R * K + C) * 2u; voffB[i] = (unsigned)(Rb * K + C) * 2u; }
    const size_t kstep = (size_t)(BK * 2);
    const size_t hstep = (size_t)HALF * K * 2;
    const size_t tstep = 2 * hstep;
    const unsigned ldsw = (unsigned)wid * 1024u;
    const int aoff = lds_byte(wr * 64 + fr, fq * 8), boff = lds_byte(wc * 32 + fr, fq * 8);
#define PG8_SA(b, h) (((b) * 2 + (h)) * HTB)
#define PG8_SB(b, h) ((4 + (b) * 2 + (h)) * HTB)
#define PG8_STAGE(bufoff, gbase, voff) do { _Pragma("unroll") for (int _i = 0; _i < 2; ++_i) \
        __builtin_amdgcn_global_load_lds((const unsigned*)((const char*)(gbase) + (voff)[_i]), (PG8_LAS unsigned*)(lds + (bufoff) + ldsw + _i * 8192), 16, 0, 0); } while (0)
#define PG8_LDA(dst, b, h) do { _Pragma("unroll") for (int m = 0; m < 4; ++m) _Pragma("unroll") for (int k = 0; k < 2; ++k) dst[m][k] = *(const PG8_LAS bf16x8*)(lds + PG8_SA(b, h) + aoff + m * 2048 + k * 1024); } while (0)
#define PG8_LDB(dst, b, h) do { _Pragma("unroll") for (int n = 0; n < 2; ++n) _Pragma("unroll") for (int k = 0; k < 2; ++k) dst[n][k] = *(const PG8_LAS bf16x8*)(lds + PG8_SB(b, h) + boff + n * 2048 + k * 1024); } while (0)
#define PG8_MMA(ai, bj, At, Bt) do { __builtin_amdgcn_s_setprio(1); _Pragma("unroll") for (int m = 0; m < 4; ++m) _Pragma("unroll") for (int n = 0; n < 2; ++n) _Pragma("unroll") for (int k = 0; k < 2; ++k) \
        acc[ai][bj][m][n] = __builtin_amdgcn_mfma_f32_16x16x32_bf16(Bt[n][k], At[m][k], acc[ai][bj][m][n], 0, 0, 0); __builtin_amdgcn_s_setprio(0); } while (0)
#define PG8_WAIT_V(n) asm volatile("s_waitcnt vmcnt(" #n ")" ::: "memory")
#define PG8_WAIT_L(n) asm volatile("s_waitcnt lgkmcnt(" #n ")" ::: "memory")
#define PG8_BAR __builtin_amdgcn_s_barrier()
#define PG8_SCHED __builtin_amdgcn_sched_barrier(0)
    Unit cur, nxt; int ui = 0;
    if (!S.next(0, cur)) return;
    f32x4 acc[2][2][4][2];
#pragma unroll
    for (int a = 0; a < 2; ++a)
#pragma unroll
        for (int b = 0; b < 2; ++b)
#pragma unroll
            for (int m = 0; m < 4; ++m)
#pragma unroll
                for (int n = 0; n < 2; ++n) acc[a][b][m][n] = (f32x4){0.f, 0.f, 0.f, 0.f};
    bf16x8 At[4][2], B0[2][2], B1[2][2];
    const char* cA = (const char*)g.A + (size_t)cur.pm * tstep; const char* cB = (const char*)g.Bt + (size_t)cur.pn * tstep;
    S.a_ready(cur);
    if constexpr (SP2) {
        PG8_STAGE(PG8_SB(0, 0), cB, voffB); PG8_STAGE(PG8_SB(0, 1), cB + hstep, voffB); PG8_STAGE(PG8_SA(0, 0), cA, voffA); PG8_STAGE(PG8_SA(0, 1), cA + hstep, voffA);
        if (wr == 1) PG8_BAR;
        PG8_WAIT_V(2); PG8_BAR;
        PG8_STAGE(PG8_SB(1, 0), cB + kstep, voffB); PG8_STAGE(PG8_SA(1, 0), cA + kstep, voffA); PG8_STAGE(PG8_SB(1, 1), cB + hstep + kstep, voffB);
        PG8_WAIT_V(6); PG8_BAR;
    } else {
        PG8_STAGE(PG8_SB(0, 0), cB, voffB); PG8_STAGE(PG8_SA(0, 0), cA, voffA); PG8_STAGE(PG8_SB(0, 1), cB + hstep, voffB); PG8_STAGE(PG8_SA(0, 1), cA + hstep, voffA);
        if (wr == 1) PG8_BAR;
        PG8_WAIT_V(4); PG8_BAR;
        PG8_STAGE(PG8_SB(1, 0), cB + kstep, voffB); PG8_STAGE(PG8_SA(1, 0), cA + kstep, voffA); PG8_STAGE(PG8_SB(1, 1), cB + hstep + kstep, voffB);
        PG8_WAIT_V(6); PG8_BAR;
    }
    for (;;) {
        const bool has_next = S.next(ui + 1, nxt);
        const char* nA = has_next ? (const char*)g.A + (size_t)nxt.pm * tstep : cA; const char* nB = has_next ? (const char*)g.Bt + (size_t)nxt.pn * tstep : cB;
        for (int t = 0; t < nt; t += 2) {
            const bool last = (t == nt - 2);
            const char* a1 = cA + (size_t)(t + 1) * kstep;
            const char* a2 = last ? nA : cA + (size_t)(t + 2) * kstep; const char* b2 = last ? nB : cB + (size_t)(t + 2) * kstep;
            const char* a3 = a2 + kstep; const char* b3 = b2 + kstep;
            if (last && has_next) S.a_ready(nxt);
            if constexpr (SP2) {
            PG8_LDB(B0, 0, 0); PG8_LDB(B1, 0, 1); PG8_SCHED; PG8_LDA(At, 0, 0); PG8_STAGE(PG8_SA(1, 1), a1 + hstep, voffA);
            PG8_WAIT_V(8); PG8_WAIT_L(0); PG8_BAR; PG8_MMA(0, 0, At, B0); PG8_MMA(0, 1, At, B1); PG8_BAR; PG8_SCHED;
            PG8_LDA(At, 0, 1); PG8_STAGE(PG8_SB(0, 0), b2, voffB); PG8_STAGE(PG8_SB(0, 1), b2 + hstep, voffB); PG8_STAGE(PG8_SA(0, 0), a2, voffA);
            PG8_WAIT_V(8); PG8_WAIT_L(0); PG8_BAR; PG8_MMA(1, 0, At, B0); PG8_MMA(1, 1, At, B1); PG8_BAR; PG8_SCHED;
            PG8_LDB(B0, 1, 0); PG8_LDB(B1, 1, 1); PG8_SCHED; PG8_LDA(At, 1, 0); PG8_STAGE(PG8_SA(0, 1), a2 + hstep, voffA);
            PG8_WAIT_V(8); PG8_WAIT_L(0); PG8_BAR; PG8_MMA(0, 0, At, B0); PG8_MMA(0, 1, At, B1); PG8_BAR; PG8_SCHED;
            PG8_LDA(At, 1, 1); PG8_STAGE(PG8_SB(1, 0), b3, voffB); PG8_STAGE(PG8_SB(1, 1), b3 + hstep, voffB); PG8_STAGE(PG8_SA(1, 0), a3, voffA);
            PG8_WAIT_V(8); PG8_WAIT_L(0); PG8_BAR; PG8_MMA(1, 0, At, B0); PG8_MMA(1, 1, At, B1); PG8_BAR; PG8_SCHED;
            } else {
            PG8_LDB(B0, 0, 0); PG8_SCHED; PG8_LDA(At, 0, 0); PG8_STAGE(PG8_SA(1, 1), a1 + hstep, voffA);
            PG8_WAIT_L(8); PG8_BAR; PG8_WAIT_L(0); PG8_MMA(0, 0, At, B0); PG8_BAR; PG8_SCHED;
            PG8_LDB(B1, 0, 1); PG8_STAGE(PG8_SB(0, 0), b2, voffB);
            PG8_BAR; PG8_WAIT_L(0); PG8_MMA(0, 1, At, B1); PG8_BAR;
            PG8_LDA(At, 0, 1); PG8_STAGE(PG8_SA(0, 0), a2, voffA);
            PG8_BAR; PG8_WAIT_L(0); PG8_MMA(1, 0, At, B0); PG8_BAR; PG8_SCHED;
            PG8_STAGE(PG8_SB(0, 1), b2 + hstep, voffB);
            PG8_WAIT_V(6); PG8_BAR; PG8_MMA(1, 1, At, B1); PG8_BAR;
            PG8_LDB(B0, 1, 0); PG8_SCHED; PG8_LDA(At, 1, 0); PG8_STAGE(PG8_SA(0, 1), a2 + hstep, voffA);
            PG8_WAIT_L(8); PG8_BAR; PG8_WAIT_L(0); PG8_MMA(0, 0, At, B0); PG8_BAR; PG8_SCHED;
            PG8_LDB(B1, 1, 1); PG8_STAGE(PG8_SB(1, 0), b3, voffB);
            PG8_BAR; PG8_WAIT_L(0); PG8_MMA(0, 1, At, B1); PG8_BAR;
            PG8_LDA(At, 1, 1); PG8_STAGE(PG8_SA(1, 0), a3, voffA);
            PG8_BAR; PG8_WAIT_L(0); PG8_MMA(1, 0, At, B0); PG8_BAR; PG8_SCHED;
            PG8_STAGE(PG8_SB(1, 1), b3 + hstep, voffB);
            PG8_WAIT_V(6); PG8_BAR; PG8_MMA(1, 1, At, B1); PG8_BAR;
            }
        }
        if constexpr (ALIGN_EPI) { if (wr == 0) PG8_BAR; }
        if constexpr (!Epi::AFTER_DRAIN) { E(acc, cur, wr, wc, fr, fq); S.done(cur); }
        if (!has_next) break;
#pragma unroll
        for (int a = 0; a < 2; ++a)
#pragma unroll
            for (int b = 0; b < 2; ++b)
#pragma unroll
                for (int m = 0; m < 4; ++m)
#pragma unroll
                    for (int n = 0; n < 2; ++n) acc[a][b][m][n] = (f32x4){0.f, 0.f, 0.f, 0.f};
        cur = nxt; cA = nA; cB = nB; ++ui;
        if constexpr (ALIGN_EPI) { if (wr == 1) PG8_BAR; }
    }
    PG8_WAIT_V(0);
    if constexpr (!ALIGN_EPI) { if (wr == 0) PG8_BAR; }
    PG8_BAR;
    if constexpr (Epi::AFTER_DRAIN) { E.fused(acc, cur, wr, wc, fr, fq, lds, wid, lane); S.done(cur); }
#undef PG8_SA
#undef PG8_SB
#undef PG8_STAGE
#undef PG8_LDA
#undef PG8_LDB
#undef PG8_MMA
#undef PG8_WAIT_V
#undef PG8_WAIT_L
#undef PG8_BAR
#undef PG8_SCHED
}
}

#define GAS __attribute__((address_space(1)))
#define LAS __attribute__((address_space(3)))
typedef unsigned short bf16;
typedef unsigned v4u __attribute__((ext_vector_type(4)));
typedef float f32x4 __attribute__((ext_vector_type(4)));
typedef short bf16x8 __attribute__((ext_vector_type(8)));
typedef GAS unsigned gu32;
typedef GAS unsigned long long gu64;
#define RLX_AGENT __ATOMIC_RELAXED, __HIP_MEMORY_SCOPE_AGENT
#define LDS_WAIT() asm volatile("s_waitcnt lgkmcnt(0)" ::: "memory")
#define VM_WAIT() asm volatile("s_waitcnt vmcnt(0)" ::: "memory")
__device__ __forceinline__ unsigned long long rt() { return __builtin_amdgcn_s_memrealtime(); }
__device__ __forceinline__ unsigned f2bf(float f) { unsigned u = __builtin_bit_cast(unsigned, f); return (u + 0x7fffu + ((u >> 16) & 1u)) >> 16; }
__device__ __forceinline__ unsigned pk2(float lo, float hi) { return f2bf(lo) | (f2bf(hi) << 16); }
#define XB_TMO      128
#define XB_XCNT(j)  (256  + 64 * (j))
#define XB_XSUB(j)  (1280 + 64 * (j))
#define XB_XGEN(j)  (2304 + 64 * (j))
#define XB_TOP      3328
#define XB_TOPGEN   3392
#define XCD_BAR_WORDS 3456
#define XB_SPIN_CAP (1u << 18)

__device__ __forceinline__ unsigned xb_ld(unsigned* p)              { return __hip_atomic_load(p, __ATOMIC_RELAXED, __HIP_MEMORY_SCOPE_AGENT); }
__device__ __forceinline__ unsigned xb_add(unsigned* p, unsigned v) { return __hip_atomic_fetch_add(p, v, __ATOMIC_RELAXED, __HIP_MEMORY_SCOPE_AGENT); }
__device__ __forceinline__ unsigned xb_xcc_id() { return (unsigned)__builtin_amdgcn_s_getreg((3 << 11) | 20) & 0xFu; }
#define XB_SPIN(cond, bar) do { unsigned _sp = 0; while (cond) { __builtin_amdgcn_s_sleep(1); \
    if ((++_sp & 255u) == 0u) { if (xb_ld(&(bar)[XB_TMO])) break; if (_sp > XB_SPIN_CAP) { atomicAdd(&(bar)[XB_TMO], 1u); break; } } } } while (0)

struct XcdBarrier {
    unsigned* bar; unsigned x;
    volatile LAS unsigned* st;
};

__device__ __forceinline__ XcdBarrier xcd_barrier_post(unsigned* bar, volatile LAS unsigned* st) {
    XcdBarrier b; b.bar = bar; b.x = xb_xcc_id(); b.st = st;
    if (threadIdx.x == 0) (void)xb_add(&bar[XB_XCNT(b.x)], 1u);
    return b;
}
__device__ __forceinline__ void xcd_barrier_complete(unsigned* bar, unsigned x, unsigned& nloc, unsigned& nx) {
    const unsigned G = gridDim.x * gridDim.y * gridDim.z;
    unsigned sum, cnt, mine, sp = 0u;
    for (;;) {
        sum = 0u; cnt = 0u; mine = 0u;
#pragma unroll
        for (unsigned j = 0; j < 16; ++j) { const unsigned c = xb_ld(&bar[XB_XCNT(j)]); sum += c; cnt += (c > 0u) ? 1u : 0u; mine = (j == x) ? c : mine; }
        if (sum == G) break;
        __builtin_amdgcn_s_sleep(1);
        if ((++sp & 255u) == 0u) { if (xb_ld(&bar[XB_TMO])) break; if (sp > XB_SPIN_CAP) { atomicAdd(&bar[XB_TMO], 1u); break; } }
    }
    nloc = mine > 0u ? mine : 1u; nx = cnt > 0u ? cnt : 1u;
}

__device__ __forceinline__ void xcd_barrier(const XcdBarrier& b) {
    asm volatile("s_waitcnt vmcnt(0)" ::: "memory");
    __syncthreads();
    if (threadIdx.x == 0) {
        unsigned* bar = b.bar;
        __builtin_amdgcn_s_waitcnt(0);
        unsigned nloc = b.st[0], nx = b.st[1];
        if (nloc == 0u) { xcd_barrier_complete(bar, b.x, nloc, nx); b.st[0] = nloc; b.st[1] = nx; }
        const unsigned old = xb_add(&bar[XB_XSUB(b.x)], 1u);
        const unsigned gen = old / nloc;
        if (old + 1u == (gen + 1u) * nloc) {
            __builtin_amdgcn_fence(__ATOMIC_RELEASE, "agent");
            asm volatile("s_waitcnt vmcnt(0)" ::: "memory");
            const unsigned og = xb_add(&bar[XB_TOP], 1u);
            const unsigned tg = og / nx;
            if (og + 1u == (tg + 1u) * nx) xb_add(&bar[XB_TOPGEN], 1u);
            else XB_SPIN(xb_ld(&bar[XB_TOPGEN]) == tg, bar);
            __builtin_amdgcn_fence(__ATOMIC_ACQUIRE, "agent");
            xb_add(&bar[XB_XGEN(b.x)], 1u);
            asm volatile("s_waitcnt vmcnt(0)" ::: "memory");
        } else {
            XB_SPIN(xb_ld(&bar[XB_XGEN(b.x)]) == gen, bar);
            __builtin_amdgcn_fence(__ATOMIC_ACQUIRE, "agent");
            asm volatile("s_waitcnt vmcnt(0)" ::: "memory");
        }
    }
    __syncthreads();
}


constexpr int NWAVES = 8, NTHREADS = 512;
constexpr int DM = 2048, NBATCH = 2, SEQ = 4096, NMETA = 16, FPAD = 112, LP = 4224, NBLK = 33;
constexpr int DBATCH = 128, DSEQ = 8, WIN = 128;
constexpr int ROWS_P = NBATCH * LP, ROWS_S = DBATCH * DSEQ, MROWS = ROWS_P + ROWS_S;
constexpr int NIN = 5648, NPAD = 5888;
constexpr int C_QA = 0, C_KA = 1024, C_VA = 1280, C_GA = 1536, C_QG = 2560, C_KG = 3072, C_VG = 3584, C_GG = 4608, C_ZG = 5632;
constexpr float EPSN = 1e-6f;
static_assert(MROWS % 256 == 0 && NPAD % 256 == 0, "tiles");

constexpr size_t O_YP = 0, O_YS = 16777216, O_KWP = 18874368, O_VWP = 18939904, O_GP = 19005440, O_KWS = 19267584, O_VWS = 23461888, O_GS = 27656192, O_END = 44433408;

constexpr size_t MiB = 1u << 20;
constexpr size_t WS_CTL = 0, CTL_ZERO_BYTES = 64 * 1024;
constexpr size_t WS_WIN = 1 * MiB;
constexpr size_t WS_WOUT = 24 * MiB;
constexpr size_t WS_XN = 32 * MiB;
constexpr size_t WS_P = 69 * MiB;
constexpr size_t WS_DST = 176 * MiB;
constexpr size_t WS_ST = 209 * MiB;
constexpr size_t WS_DEC = 226 * MiB;
constexpr size_t WS_QT = 227 * MiB, WS_KT = 236 * MiB;
constexpr size_t WS_END = 245 * MiB;
constexpr int CW_BAR = 1024;

constexpr int LDS_CTL_BYTES = 1024;
constexpr int SCR_OFF = 1024;
constexpr int LDS_BYTES = 156 * 1024;

typedef short bf16x4 __attribute__((ext_vector_type(4)));
typedef short v4i16_t __attribute__((ext_vector_type(4)));
typedef float f32x2 __attribute__((ext_vector_type(2)));

__device__ __forceinline__ float bf2f(unsigned short b) { return __uint_as_float(((unsigned)b) << 16); }
__device__ __forceinline__ unsigned short f2bf16(float f) { return (unsigned short)f2bf(f); }
__device__ __forceinline__ float wave_sum(float v) {
#pragma unroll
    for (int o = 1; o < 64; o <<= 1) v += __shfl_xor(v, o);
    return v;
}
__device__ __forceinline__ float silu_f(float x) { return x / (1.f + __expf(-x)); }
__device__ __forceinline__ float logsig_f(float x) { return fminf(x, 0.f) - __logf(1.f + __expf(-fabsf(x))); }

#ifndef USE_TR
#define USE_TR 1
#endif
__device__ __forceinline__ bf16x8 tr_frag(const LAS unsigned short* M, int row0, int col0, int pitch, int lane) {
#if USE_TR
    const int q = (lane & 15) >> 2, p = lane & 3;
    const LAS unsigned short* a0 = M + (row0 + q) * pitch + col0 + 4 * p;
    const v4i16_t lo = __builtin_amdgcn_ds_read_tr16_b64_v4i16((LAS v4i16_t*)a0);
    const v4i16_t hi = __builtin_amdgcn_ds_read_tr16_b64_v4i16((LAS v4i16_t*)(a0 + 4 * pitch));
    return (bf16x8){lo[0], lo[1], lo[2], lo[3], hi[0], hi[1], hi[2], hi[3]};
#else
    bf16x8 r; const LAS unsigned short* a0 = M + row0 * pitch + col0 + (lane & 15);
#pragma unroll
    for (int j = 0; j < 8; ++j) r[j] = (short)a0[j * pitch];
    return r;
#endif
}
#define MFMA16(a, b, c) __builtin_amdgcn_mfma_f32_16x16x32_bf16((a), (b), (c), 0, 0, 0)

struct Frame {
    LAS unsigned char* lds;
    int tid, lane, wave, G;
    unsigned char* ws; float* out;
    __device__ __forceinline__ bf16* WinT() const { return (bf16*)(ws + WS_WIN); }
    __device__ __forceinline__ bf16* WoutT() const { return (bf16*)(ws + WS_WOUT); }
    __device__ __forceinline__ bf16* XN() const { return (bf16*)(out + O_GS); }
    __device__ __forceinline__ bf16* MIX() const { return (bf16*)(ws + WS_XN); }
    __device__ __forceinline__ bf16* P() const { return (bf16*)(ws + WS_P); }
    __device__ __forceinline__ float* O2() const { return (float*)(ws + WS_P); }
    __device__ __forceinline__ float* dST() const { return (float*)(ws + WS_DST); }
    __device__ __forceinline__ bf16* St() const { return (bf16*)(ws + WS_ST); }
    __device__ __forceinline__ float* dec() const { return (float*)(ws + WS_DEC); }
    __device__ __forceinline__ bf16* QT() const { return (bf16*)(ws + WS_QT); }
    __device__ __forceinline__ bf16* KT() const { return (bf16*)(ws + WS_KT); }
};
enum { A_XP = 0, A_XS, A_CK, A_CV, A_STATE, A_META, A_RELB, A_NPRE, A_NPOST, A_WIN, A_WA2, A_BA, A_SINK, A_GNORM, A_WOUT, A_OUT, A_WS };
typedef const GAS float* gcf;
template <int IDX> __device__ __forceinline__ gcf ldarg() {
    const unsigned long long ka = (unsigned long long)__builtin_amdgcn_kernarg_segment_ptr();
    unsigned long long v;
    asm volatile("s_load_dwordx2 %0, %1, %2\n\ts_waitcnt lgkmcnt(0)" : "=s"(v) : "s"(ka), "i"(IDX * 8) : "memory");
    return (gcf)v;
}

struct P0Item { gcf W; bf16* WT; int N, kb, nb; bool on; };
__device__ __forceinline__ void p0_item_load(const P0Item& it, int K, int lane, f32x4 (&v)[16]) {
    const int k0 = 64 * it.kb, n0 = 64 * it.nb; const int nq = 4 * (lane & 15), kr = lane >> 4; const bool ok = it.on && (n0 + nq) < it.N;
#pragma unroll
    for (int i = 0; i < 16; ++i) v[i] = ok ? *(const GAS f32x4*)(it.W + (size_t)(k0 + 4 * i + kr) * it.N + n0 + nq) : (f32x4){0.f, 0.f, 0.f, 0.f};
}
__device__ __forceinline__ void p0_item_store(const P0Item& it, int K, int lane, const f32x4 (&v)[16], LAS float* scr) {
    if (!it.on) return;
    const int k0 = 64 * it.kb, n0 = 64 * it.nb; const int nq = 4 * (lane & 15), kr = lane >> 4;
#pragma unroll
    for (int i = 0; i < 16; ++i) { LAS float* d = scr + (4 * i + kr) * 65 + nq; d[0] = v[i].x; d[1] = v[i].y; d[2] = v[i].z; d[3] = v[i].w; }
    LDS_WAIT(); asm volatile("" ::: "memory");
    const int c = lane & 7;
#pragma unroll
    for (int j = 0; j < 8; ++j) { const int nn = (lane >> 3) + 8 * j; const LAS float* s = scr + (8 * c) * 65 + nn;
        v4u o; o.x = pk2(s[0 * 65], s[1 * 65]); o.y = pk2(s[2 * 65], s[3 * 65]); o.z = pk2(s[4 * 65], s[5 * 65]); o.w = pk2(s[6 * 65], s[7 * 65]);
        *(GAS v4u*)(it.WT + (size_t)(n0 + nn) * K + k0 + 8 * c) = o; }
    LDS_WAIT(); asm volatile("" ::: "memory");
}
__device__ __forceinline__ gcf p0_row_src(int m, gcf meta, gcf x_prompt, gcf x_sample) {
    if (m < ROWS_P) { const int b = m / LP, i = m - b * LP;
        if (i < FPAD) return nullptr;
        return (i < 128) ? meta + (size_t)(i - FPAD) * DM : x_prompt + ((size_t)b * SEQ + (i - 128)) * DM; }
    return x_sample + (size_t)(m - ROWS_P) * DM;
}
constexpr int P0R = 4;
__device__ __forceinline__ void p0_rows2(Frame& F, int m0, int mstep, gcf meta, gcf x_prompt, gcf x_sample, gcf norm_pre) {
    gcf src[P0R]; int mm[P0R];
#pragma unroll
    for (int q = 0; q < P0R; ++q) { mm[q] = m0 + q * mstep; src[q] = (mm[q] < MROWS) ? p0_row_src(mm[q], meta, x_prompt, x_sample) : nullptr; }
    f32x4 v[P0R][8];
#pragma unroll
    for (int q = 0; q < P0R; ++q)
#pragma unroll
        for (int j = 0; j < 8; ++j) v[q][j] = src[q] ? ((const GAS f32x4*)src[q])[F.lane + 64 * j] : (f32x4){0.f, 0.f, 0.f, 0.f};
#pragma unroll
    for (int q = 0; q < P0R; ++q) { if (mm[q] >= MROWS) continue;
        float s = 0.f;
#pragma unroll
        for (int j = 0; j < 8; ++j) s += (v[q][j].x * v[q][j].x + v[q][j].y * v[q][j].y) + (v[q][j].z * v[q][j].z + v[q][j].w * v[q][j].w);
        const float rstd = rsqrtf(wave_sum(s) * (1.f / DM) + EPSN);
        GAS unsigned long long* o8 = (GAS unsigned long long*)(F.XN() + (size_t)mm[q] * DM) + F.lane;
        if (src[q] == nullptr) { GAS unsigned long long* z8 = (GAS unsigned long long*)(F.MIX() + (size_t)mm[q] * DM) + F.lane;
#pragma unroll
            for (int j = 0; j < 8; ++j) z8[64 * j] = 0ull; }
#pragma unroll
        for (int j = 0; j < 8; ++j) { const f32x4 w = ((const GAS f32x4*)norm_pre)[F.lane + 64 * j];
            o8[64 * j] = (unsigned long long)pk2(v[q][j].x * rstd * w.x, v[q][j].y * rstd * w.y) | ((unsigned long long)pk2(v[q][j].z * rstd * w.z, v[q][j].w * rstd * w.w) << 32); } }
}
__device__ __forceinline__ void p0_prologue(Frame& F, int it_lo, int it_hi, int b_lo, int nb, bool with_rows) { gcf const w_in = ldarg<A_WIN>(); gcf const w_out = ldarg<A_WOUT>();
    LAS float* scr = (LAS float*)(F.lds + SCR_OFF + F.wave * 16640);
    const int gw = ((int)blockIdx.x - b_lo) * NWAVES + F.wave, NGW = nb * NWAVES;
    constexpr int I_IN = (DM / 64) * (NPAD / 64), I_OUT = (DM / 64) * (DM / 64);
    auto mk = [&](int it) { P0Item r; r.on = it < it_hi;
        if (it < I_IN) { r.W = w_in; r.WT = F.WinT(); r.N = NIN; r.kb = it / (NPAD / 64); r.nb = it % (NPAD / 64); }
        else { const int q = r.on ? it - I_IN : 0; r.W = w_out; r.WT = F.WoutT(); r.N = DM; r.kb = q / (DM / 64); r.nb = q % (DM / 64); }
        return r; };
    for (int it = it_lo + gw; it < it_hi; it += 2 * NGW) {
        const P0Item a = mk(it), b = mk(it + NGW);
        f32x4 va[16], vb[16];
        p0_item_load(a, DM, F.lane, va); p0_item_load(b, DM, F.lane, vb);
        p0_item_store(a, DM, F.lane, va, scr); p0_item_store(b, DM, F.lane, vb, scr);
    }
    if (with_rows) {
        gcf const meta = ldarg<A_META>(); gcf const x_prompt = ldarg<A_XP>(); gcf const x_sample = ldarg<A_XS>(); gcf const norm_pre = ldarg<A_NPRE>();
        for (int m = gw; m < MROWS; m += P0R * NGW) p0_rows2(F, m, NGW, meta, x_prompt, x_sample, norm_pre);
    }
}

constexpr int AKP = 72, APP = 168;
constexpr int A_K = 0, A_V = 272 * AKP * 2, A_BIAS = 2 * A_V, A_P = A_BIAS + 2048, A_END = A_P + NWAVES * 16 * APP * 2;
static_assert(A_END <= LDS_BYTES - SCR_OFF, "attention LDS");

struct AttnLds { const LAS unsigned short* AK; const LAS unsigned short* AV; const LAS float* AB; LAS unsigned short* AP; };
template <bool SAMPLE>
__device__ __forceinline__ void attn_tile(Frame& F, const AttnLds& L, const bf16x8 (&qa)[2], int s0, int kmin  ,
                                          int tb, int gb, size_t rowb, gcf sinks, int kvh) {
    int lane = F.lane; asm volatile("" : "+v"(lane));
    const int gq = lane >> 4, i = lane & 15;
    const LAS unsigned short* AK = L.AK; const LAS unsigned short* AV = L.AV; const LAS float* AB = L.AB; LAS unsigned short* AP = L.AP;
    size_t prow[2]; int pcol[2]; v4u gpre[2];
#pragma unroll
    for (int jj = 0; jj < 2; ++jj) { const int q = lane + 64 * jj, rr = q >> 3, ch = q & 7;
        prow[jj] = SAMPLE ? rowb + (rr & 7) : rowb + rr; pcol[jj] = kvh * 256 + (SAMPLE ? gb + (rr >> 3) : gb) * 64 + 8 * ch;
        gpre[jj] = *(const GAS v4u*)(F.P() + prow[jj] * NPAD + C_GA + pcol[jj]); }
    int trow[4], grow[4]; float sinkr[4];
#pragma unroll
    for (int r = 0; r < 4; ++r) { const int rr = 4 * gq + r; trow[r] = SAMPLE ? (rr & 7) : tb + rr; grow[r] = SAMPLE ? gb + (rr >> 3) : gb; sinkr[r] = sinks[kvh * 4 + grow[r]]; }
    f32x4 acc[10];
#pragma unroll
    for (int cb = 0; cb < 10; ++cb) { acc[cb] = (f32x4){0.f, 0.f, 0.f, 0.f};
#pragma unroll
        for (int ks = 0; ks < 2; ++ks) { const bf16x8 kb = *(const LAS bf16x8*)(AK + (s0 + 16 * cb + i) * AKP + 32 * ks + 8 * gq); acc[cb] = MFMA16(qa[ks], kb, acc[cb]); } }
    float mx[4] = {-INFINITY, -INFINITY, -INFINITY, -INFINITY};
#pragma unroll
    for (int cb = 0; cb < 10; ++cb) { const int s = s0 + 16 * cb + i;
#pragma unroll
        for (int r = 0; r < 4; ++r) { const int dist = 128 + trow[r] - s; const bool valid = (dist >= 0) && (dist < 128) && (s >= kmin);
            const int dc = dist < 0 ? 0 : (dist > 127 ? 127 : dist);
            const float v = valid ? acc[cb][r] * 0.125f + AB[grow[r] * 128 + dc] : -INFINITY; acc[cb][r] = v; mx[r] = fmaxf(mx[r], v); } }
    float inv[4];
#pragma unroll
    for (int r = 0; r < 4; ++r) { float m = mx[r];
        m = fmaxf(m, __shfl_xor(m, 1)); m = fmaxf(m, __shfl_xor(m, 2)); m = fmaxf(m, __shfl_xor(m, 4)); m = fmaxf(m, __shfl_xor(m, 8));
        m = fmaxf(m, sinkr[r]); float sum = 0.f;
#pragma unroll
        for (int cb = 0; cb < 10; ++cb) { const float e = __expf(acc[cb][r] - m); acc[cb][r] = e; sum += e; }
        sum += __shfl_xor(sum, 1); sum += __shfl_xor(sum, 2); sum += __shfl_xor(sum, 4); sum += __shfl_xor(sum, 8);
        inv[r] = 1.f / (sum + __expf(sinkr[r] - m)); }
#pragma unroll
    for (int cb = 0; cb < 10; ++cb)
#pragma unroll
        for (int r = 0; r < 4; ++r) AP[(4 * gq + r) * APP + 16 * cb + i] = f2bf16(acc[cb][r]);
    LDS_WAIT(); asm volatile("" ::: "memory");
    f32x4 o[4];
#pragma unroll
    for (int db = 0; db < 4; ++db) o[db] = (f32x4){0.f, 0.f, 0.f, 0.f};
#pragma unroll
    for (int kk = 0; kk < 5; ++kk) { const bf16x8 pa = *(const LAS bf16x8*)(AP + i * APP + 32 * kk + 8 * gq);
#pragma unroll
        for (int db = 0; db < 4; ++db) { const bf16x8 vb = tr_frag(AV, s0 + 32 * kk + 8 * gq, 16 * db, AKP, lane); o[db] = MFMA16(pa, vb, o[db]); } }
    LDS_WAIT(); asm volatile("" ::: "memory");
#pragma unroll
    for (int r = 0; r < 4; ++r)
#pragma unroll
        for (int db = 0; db < 4; ++db) AP[(4 * gq + r) * APP + 16 * db + i] = f2bf16(o[db][r] * inv[r]);
    LDS_WAIT(); asm volatile("" ::: "memory");
#pragma unroll
    for (int jj = 0; jj < 2; ++jj) { const int q = lane + 64 * jj, rr = q >> 3, ch = q & 7;
        const v4u ov = *(const LAS v4u*)(AP + rr * APP + 8 * ch); const v4u gv = gpre[jj];
        v4u res;
        res.x = pk2(bf2f(ov.x & 0xffff) * silu_f(bf2f(gv.x & 0xffff)), bf2f(ov.x >> 16) * silu_f(bf2f(gv.x >> 16)));
        res.y = pk2(bf2f(ov.y & 0xffff) * silu_f(bf2f(gv.y & 0xffff)), bf2f(ov.y >> 16) * silu_f(bf2f(gv.y >> 16)));
        res.z = pk2(bf2f(ov.z & 0xffff) * silu_f(bf2f(gv.z & 0xffff)), bf2f(ov.z >> 16) * silu_f(bf2f(gv.z >> 16)));
        res.w = pk2(bf2f(ov.w & 0xffff) * silu_f(bf2f(gv.w & 0xffff)), bf2f(ov.w >> 16) * silu_f(bf2f(gv.w >> 16)));
        *(GAS v4u*)(F.MIX() + prow[jj] * DM + pcol[jj]) = res; }
    LDS_WAIT(); asm volatile("" ::: "memory");
}

__device__ __forceinline__ void attn_bias_table(Frame& F, LAS float* AB, int kvh) { gcf const rel_bias = ldarg<A_RELB>();
    const int g = F.tid >> 7, d = F.tid & 127;
    int bk = d;
    if (d >= 16) { bk = 16 + (int)(__logf((float)d * (1.f / 16.f)) * (16.f / 2.0794415416798357f)); bk = bk > 31 ? 31 : bk; }
    AB[g * 128 + d] = rel_bias[bk * 16 + kvh * 4 + g];
}

__device__ __forceinline__ void attn_prompt_unit(Frame& F0, LAS unsigned char* scr, int b, int n, int kvh) { Frame F = F0; asm volatile("" : "+v"(F.tid), "+v"(F.lane));     gcf const sinks = ldarg<A_SINK>();
    LAS unsigned short* AK = (LAS unsigned short*)(scr + A_K); LAS unsigned short* AV = (LAS unsigned short*)(scr + A_V);
    __syncthreads();
    const long wrow0 = (long)b * LP + 128 * (n - 1);
#pragma unroll
    for (int j = 0; j < 4; ++j) { const int c = F.tid + 512 * j, row = c >> 3, ch = c & 7; const long gr = wrow0 + row;
        v4u kv = (v4u){0u, 0u, 0u, 0u}, vv = kv;
        if (gr >= 0) { const bf16* p = F.P() + (size_t)gr * NPAD + kvh * 64 + 8 * ch; kv = *(const GAS v4u*)(p + C_KA); vv = *(const GAS v4u*)(p + C_VA); }
        *(LAS v4u*)(AK + row * AKP + 8 * ch) = kv; *(LAS v4u*)(AV + row * AKP + 8 * ch) = vv; }
    if (F.tid < 128) { const int row = 256 + (F.tid >> 3), ch = F.tid & 7; *(LAS v4u*)(AK + row * AKP + 8 * ch) = (v4u){0u, 0u, 0u, 0u}; *(LAS v4u*)(AV + row * AKP + 8 * ch) = (v4u){0u, 0u, 0u, 0u}; }
    attn_bias_table(F, (LAS float*)(scr + A_BIAS), kvh);
    __syncthreads();
    const AttnLds L{AK, AV, (const LAS float*)(scr + A_BIAS), (LAS unsigned short*)(scr + A_P) + F.wave * 16 * APP};
    const int gq = F.lane >> 4, i = F.lane & 15, t0 = (n == 0) ? 112 : 16 * F.wave;
    const int kmin = FPAD - 128 * (n - 1);
    const size_t rbase = (size_t)b * LP + 128 * n;
    const int g_lo = (n == 0) ? F.wave : 0, g_hi = (n == 0) ? (F.wave < 4 ? F.wave + 1 : 0) : 4;
    bf16x8 qn[2] = {(bf16x8){0, 0, 0, 0, 0, 0, 0, 0}, (bf16x8){0, 0, 0, 0, 0, 0, 0, 0}};
    if (g_lo < g_hi) { const bf16* qp = F.P() + (rbase + t0 + i) * NPAD + C_QA + (kvh * 4 + g_lo) * 64; qn[0] = *(const GAS bf16x8*)(qp + 8 * gq); qn[1] = *(const GAS bf16x8*)(qp + 32 + 8 * gq); }
#pragma unroll 1
    for (int g = g_lo; g < g_hi; ++g) {
        const bf16x8 qa[2] = {qn[0], qn[1]};
        if (g + 1 < g_hi) { const bf16* qp = F.P() + (rbase + t0 + i) * NPAD + C_QA + (kvh * 4 + g + 1) * 64; qn[0] = *(const GAS bf16x8*)(qp + 8 * gq); qn[1] = *(const GAS bf16x8*)(qp + 32 + 8 * gq); }
        attn_tile<false>(F, L, qa, t0, kmin, t0, g, rbase + t0, sinks, kvh);
    }
    if (n == NBLK - 1) {
#pragma unroll
        for (int j = 0; j < 16; ++j) { const int e = F.tid + 512 * j, row = e >> 6, d = e & 63;
            const size_t oidx = (((size_t)b * WIN + row) * 4 + kvh) * 64 + d;
            F.out[O_KWP + oidx] = bf2f(AK[(128 + row) * AKP + d]); F.out[O_VWP + oidx] = bf2f(AV[(128 + row) * AKP + d]); }
    }
}

__device__ __forceinline__ void attn_sample_stage(Frame& F, LAS unsigned short* AK, LAS unsigned short* AV, int db, int kvh, gcf cache_k, gcf cache_v) {
#pragma unroll
    for (int j = 0; j < 4; ++j) { const int c = F.tid + 512 * j, row = c >> 4, ch = c & 15;
        const size_t src = (((size_t)db * WIN + row) * 4 + kvh) * 64 + 4 * ch;
        const f32x4 kv = *(const GAS f32x4*)(cache_k + src), vv = *(const GAS f32x4*)(cache_v + src);
        *(LAS unsigned long long*)(AK + row * AKP + 4 * ch) = (unsigned long long)pk2(kv.x, kv.y) | ((unsigned long long)pk2(kv.z, kv.w) << 32);
        *(LAS unsigned long long*)(AV + row * AKP + 4 * ch) = (unsigned long long)pk2(vv.x, vv.y) | ((unsigned long long)pk2(vv.z, vv.w) << 32);
        if (row >= DSEQ) { const size_t dst = (((size_t)db * WIN + row - DSEQ) * 4 + kvh) * 64 + 4 * ch; *(GAS f32x4*)(F.out + O_KWS + dst) = kv; *(GAS f32x4*)(F.out + O_VWS + dst) = vv; } }
    const size_t srow0 = (size_t)ROWS_P + (size_t)db * DSEQ;
    if (F.tid < 64) { const int t = F.tid >> 3, ch = F.tid & 7; const bf16* p = F.P() + (srow0 + t) * NPAD + kvh * 64 + 8 * ch;
        const v4u kv = *(const GAS v4u*)(p + C_KA), vv = *(const GAS v4u*)(p + C_VA);
        *(LAS v4u*)(AK + (128 + t) * AKP + 8 * ch) = kv; *(LAS v4u*)(AV + (128 + t) * AKP + 8 * ch) = vv;
        const size_t dst = (((size_t)db * WIN + (WIN - DSEQ) + t) * 4 + kvh) * 64 + 8 * ch;
        f32x4 a, c2; a.x = bf2f(kv.x & 0xffff); a.y = bf2f(kv.x >> 16); a.z = bf2f(kv.y & 0xffff); a.w = bf2f(kv.y >> 16); c2.x = bf2f(kv.z & 0xffff); c2.y = bf2f(kv.z >> 16); c2.z = bf2f(kv.w & 0xffff); c2.w = bf2f(kv.w >> 16);
        *(GAS f32x4*)(F.out + O_KWS + dst) = a; *(GAS f32x4*)(F.out + O_KWS + dst + 4) = c2;
        a.x = bf2f(vv.x & 0xffff); a.y = bf2f(vv.x >> 16); a.z = bf2f(vv.y & 0xffff); a.w = bf2f(vv.y >> 16); c2.x = bf2f(vv.z & 0xffff); c2.y = bf2f(vv.z >> 16); c2.z = bf2f(vv.w & 0xffff); c2.w = bf2f(vv.w >> 16);
        *(GAS f32x4*)(F.out + O_VWS + dst) = a; *(GAS f32x4*)(F.out + O_VWS + dst + 4) = c2; }
    if (F.tid >= 64 && F.tid < 64 + 192) { const int c = F.tid - 64, row = 136 + (c >> 3), ch = c & 7; *(LAS v4u*)(AK + row * AKP + 8 * ch) = (v4u){0u, 0u, 0u, 0u}; *(LAS v4u*)(AV + row * AKP + 8 * ch) = (v4u){0u, 0u, 0u, 0u}; }
}
__device__ __forceinline__ void attn_sample_tiles(Frame& F, const AttnLds& L, int db, int kvh, int wl, gcf sinks) {
    const int gq = F.lane >> 4, i = F.lane & 15; const size_t srow0 = (size_t)ROWS_P + (size_t)db * DSEQ;
    const bf16* qptr = F.P() + (srow0 + (i & 7)) * NPAD + C_QA + (kvh * 4 + 2 * wl + (i >> 3)) * 64;
    const bf16x8 qa[2] = {*(const GAS bf16x8*)(qptr + 8 * gq), *(const GAS bf16x8*)(qptr + 32 + 8 * gq)};
    attn_tile<true>(F, L, qa, 0, 0, 0, 2 * wl, srow0, sinks, kvh);
}
__device__ __forceinline__ void attn_sample_unit(Frame& F0, LAS unsigned char* scr, int u) { Frame F = F0; asm volatile("" : "+v"(F.tid), "+v"(F.lane));
    gcf const cache_k = ldarg<A_CK>(); gcf const cache_v = ldarg<A_CV>(); gcf const sinks = ldarg<A_SINK>();
    const int kvh = u & 3, db = u >> 2;
    LAS unsigned short* AK = (LAS unsigned short*)(scr + A_K); LAS unsigned short* AV = (LAS unsigned short*)(scr + A_V);
    __syncthreads();
    attn_sample_stage(F, AK, AV, db, kvh, cache_k, cache_v);
    attn_bias_table(F, (LAS float*)(scr + A_BIAS), kvh);
    __syncthreads();
    if (F.wave < 2) { const AttnLds L{AK, AV, (const LAS float*)(scr + A_BIAS), (LAS unsigned short*)(scr + A_P) + F.wave * 16 * APP}; attn_sample_tiles(F, L, db, kvh, F.wave, sinks); }
}
constexpr int SP_SLOT = 160 * AKP * 2, SP_BIAS = 4 * SP_SLOT, SP_P = SP_BIAS + 2048, SP_END = SP_P + 4 * 16 * APP * 2;
static_assert(SP_END <= LDS_BYTES - SCR_OFF, "sample pair LDS");
__device__ __forceinline__ void attn_sample_pair(Frame& F0, LAS unsigned char* scr, int u0, int u1) { Frame F = F0; asm volatile("" : "+v"(F.tid), "+v"(F.lane));
    gcf const cache_k = ldarg<A_CK>(); gcf const cache_v = ldarg<A_CV>(); gcf const sinks = ldarg<A_SINK>();
    const int kvh = u0 & 3;
    LAS unsigned short* K0 = (LAS unsigned short*)(scr); LAS unsigned short* V0 = (LAS unsigned short*)(scr + SP_SLOT);
    LAS unsigned short* K1 = (LAS unsigned short*)(scr + 2 * SP_SLOT); LAS unsigned short* V1 = (LAS unsigned short*)(scr + 3 * SP_SLOT);
    __syncthreads();
    attn_sample_stage(F, K0, V0, u0 >> 2, kvh, cache_k, cache_v);
    attn_sample_stage(F, K1, V1, u1 >> 2, kvh, cache_k, cache_v);
    attn_bias_table(F, (LAS float*)(scr + SP_BIAS), kvh);
    __syncthreads();
    if (F.wave < 4) { const int sl = F.wave >> 1;
        const AttnLds L{sl ? K1 : K0, sl ? V1 : V0, (const LAS float*)(scr + SP_BIAS), (LAS unsigned short*)(scr + SP_P) + F.wave * 16 * APP};
        attn_sample_tiles(F, L, (sl ? u1 : u0) >> 2, kvh, F.wave & 1, sinks); }
}

constexpr int GQP = 136, GVP = 264;
constexpr int G_Q = 0, G_K = 128 * GQP * 2, G_V = 2 * G_K, G_Z = G_V + 128 * GVP * 2, G_TOT = G_Z + 8192, G_D = G_TOT + 2048, G_END = G_D + 512;
static_assert(G_END <= LDS_BYTES - SCR_OFF, "GLA LDS");

template <bool NEED_Q>
__device__ __forceinline__ void gla_gate(Frame& F, LAS unsigned char* scr, int b, int c, int h) { gcf const w_a2 = ldarg<A_WA2>(); gcf const b_a = ldarg<A_BA>();
    LAS unsigned short* GQ = (LAS unsigned short*)(scr + G_Q); LAS unsigned short* GK = (LAS unsigned short*)(scr + G_K); LAS unsigned short* GV = (LAS unsigned short*)(scr + G_V);
    LAS float* GD = (LAS float*)(scr + G_D);
    const size_t R0 = (size_t)b * LP + 128 * c;
    const int lane = F.lane, gq = lane >> 4, i = lane & 15, w = F.wave;
    __syncthreads();
    bf16x8 za[8]; bf16x8 wh, wl; float ba;
    {
        v4u vv[8], kk[4], qq[4];
#pragma unroll
        for (int j = 0; j < 8; ++j) { const int cc = F.tid + 512 * j, row = cc >> 5, ch = cc & 31; vv[j] = *(const GAS v4u*)(F.P() + (R0 + row) * NPAD + C_VG + h * 256 + 8 * ch); }
#pragma unroll
        for (int j = 0; j < 4; ++j) { const int cc = F.tid + 512 * j, row = cc >> 4, ch = cc & 15; const bf16* p = F.P() + (R0 + row) * NPAD + h * 128 + 8 * ch;
            kk[j] = *(const GAS v4u*)(p + C_KG); if (NEED_Q) qq[j] = *(const GAS v4u*)(p + C_QG); }
#pragma unroll
        for (int tb = 0; tb < 8; ++tb) za[tb] = (gq < 2) ? *(const GAS bf16x8*)(F.P() + (R0 + 16 * tb + i) * NPAD + C_ZG + 8 * gq) : (bf16x8){0, 0, 0, 0, 0, 0, 0, 0};
#pragma unroll
        for (int j = 0; j < 8; ++j) { const float wv = (gq < 2) ? w_a2[(8 * gq + j) * 512 + h * 128 + 16 * w + i] : 0.f; const unsigned short hi = f2bf16(wv); wh[j] = (short)hi; wl[j] = (short)f2bf16(wv - bf2f(hi)); }
        ba = b_a[h * 128 + 16 * w + i];
#pragma unroll
        for (int j = 0; j < 8; ++j) { const int cc = F.tid + 512 * j, row = cc >> 5, ch = cc & 31; *(LAS v4u*)(GV + row * GVP + 8 * ch) = vv[j]; }
#pragma unroll
        for (int j = 0; j < 4; ++j) { const int cc = F.tid + 512 * j, row = cc >> 4, ch = cc & 15; *(LAS v4u*)(GK + row * GQP + 8 * ch) = kk[j]; if (NEED_Q) *(LAS v4u*)(GQ + row * GQP + 8 * ch) = qq[j]; }
    }
    f32x4 bc[8]; float run = 0.f;
#pragma unroll
    for (int tb = 0; tb < 8; ++tb) { f32x4 x = (f32x4){ba, ba, ba, ba}; x = MFMA16(za[tb], wh, x); x = MFMA16(za[tb], wl, x);
        float l0 = logsig_f(x[0]) * (1.f / 16.f), l1 = logsig_f(x[1]) * (1.f / 16.f), l2 = logsig_f(x[2]) * (1.f / 16.f), l3 = logsig_f(x[3]) * (1.f / 16.f);
        if (c == 0) { const int t0 = 16 * tb + 4 * gq; if (t0 + 0 < FPAD) l0 = 0.f; if (t0 + 1 < FPAD) l1 = 0.f; if (t0 + 2 < FPAD) l2 = 0.f; if (t0 + 3 < FPAD) l3 = 0.f; }
        const float p0 = l0, p1 = p0 + l1, p2 = p1 + l2, p3 = p2 + l3;
        float a = p3; const float u1 = __shfl_up(a, 16); if (gq >= 1) a += u1; const float u2 = __shfl_up(a, 32); if (gq >= 2) a += u2;
        const float excl = a - p3, tot = __shfl(a, 48 + i);
        bc[tb] = (f32x4){run + excl + p0, run + excl + p1, run + excl + p2, run + excl + p3}; run += tot; }
    __syncthreads();
#pragma unroll
    for (int tb = 0; tb < 8; ++tb)
#pragma unroll
        for (int r = 0; r < 4; ++r) { const int t = 16 * tb + 4 * gq + r, k = 16 * w + i; const float bt = bc[tb][r];
            GK[t * GQP + k] = f2bf16(bf2f(GK[t * GQP + k]) * __expf(-bt));
            if (NEED_Q) GQ[t * GQP + k] = f2bf16(bf2f(GQ[t * GQP + k]) * __expf(bt) * 0.08838834764831845f); }
    if (gq == 0) GD[16 * w + i] = __expf(run);
    __syncthreads();
}

__device__ __forceinline__ void gla_ds_unit(Frame& F0, LAS unsigned char* scr, int b, int c, int h) { Frame F = F0; asm volatile("" : "+v"(F.tid), "+v"(F.lane));
    const int u = (b * NBLK + c) * 4 + h;
    gla_gate<true>(F, scr, b, c, h);
    if (c != 0) {
        const LAS unsigned short* GQs = (const LAS unsigned short*)(scr + G_Q); const LAS unsigned short* GKs = (const LAS unsigned short*)(scr + G_K);
        bf16* qt = F.QT() + (size_t)u * 16384; bf16* kt = F.KT() + (size_t)u * 16384;
#pragma unroll
        for (int j = 0; j < 4; ++j) { const int cc = F.tid + 512 * j, row = cc >> 4, ch = cc & 15;
            *(GAS v4u*)(qt + row * 128 + 8 * ch) = *(const LAS v4u*)(GQs + row * GQP + 8 * ch); *(GAS v4u*)(kt + row * 128 + 8 * ch) = *(const LAS v4u*)(GKs + row * GQP + 8 * ch); } }
    const LAS unsigned short* GK = (const LAS unsigned short*)(scr + G_K); const LAS unsigned short* GV = (const LAS unsigned short*)(scr + G_V); const LAS float* GD = (const LAS float*)(scr + G_D);
    int lane = F.lane; asm volatile("" : "+v"(lane));
    const int gq = lane >> 4, i = lane & 15, w = F.wave;
    f32x4 acc[8][2];
#pragma unroll
    for (int rb = 0; rb < 8; ++rb) { acc[rb][0] = (f32x4){0.f, 0.f, 0.f, 0.f}; acc[rb][1] = (f32x4){0.f, 0.f, 0.f, 0.f}; }
#pragma unroll
    for (int ks = 0; ks < 4; ++ks) {
        if (c == 0 && ks < 3) continue;
        const bf16x8 vb0 = tr_frag(GV, 32 * ks + 8 * gq, 32 * w, GVP, lane), vb1 = tr_frag(GV, 32 * ks + 8 * gq, 32 * w + 16, GVP, lane);
#pragma unroll
        for (int rb = 0; rb < 8; ++rb) { const bf16x8 ka = tr_frag(GK, 32 * ks + 8 * gq, 16 * rb, GQP, lane); acc[rb][0] = MFMA16(ka, vb0, acc[rb][0]); acc[rb][1] = MFMA16(ka, vb1, acc[rb][1]); } }
    bf16* dst = (bf16*)F.dST() + (size_t)u * 32768;
#pragma unroll
    for (int rb = 0; rb < 8; ++rb) { const f32x4 d4 = *(const LAS f32x4*)(GD + 16 * rb + 4 * gq);
#pragma unroll
        for (int cb = 0; cb < 2; ++cb) { const f32x4 o = acc[rb][cb] * d4; *(GAS unsigned long long*)(dst + (size_t)(32 * w + 16 * cb + i) * 128 + 16 * rb + 4 * gq) = (unsigned long long)pk2(o[0], o[1]) | ((unsigned long long)pk2(o[2], o[3]) << 32); } }
    if (F.tid < 128) F.dec()[(size_t)u * 128 + F.tid] = GD[F.tid];
}

__device__ __forceinline__ void gla_scan(Frame& F) {
    for (int e = blockIdx.x * NTHREADS + F.tid; e < NBATCH * 4 * 256 * 64; e += F.G * NTHREADS) {
        const int k2 = e & 63, v = (e >> 6) & 255, bh = e >> 14, b = bh >> 2, h = bh & 3;
        float s0 = 0.f, s1 = 0.f;
#pragma unroll 1
        for (int c0 = 0; c0 < NBLK; c0 += 11) {
            f32x2 d[11], ds[11];
#pragma unroll
            for (int q = 0; q < 11; ++q) { const size_t u = ((size_t)b * NBLK + c0 + q) * 4 + h;
                d[q] = *(const GAS f32x2*)(F.dec() + u * 128 + 2 * k2); { const unsigned dv = *(const GAS unsigned*)((const bf16*)F.dST() + u * 32768 + (size_t)v * 128 + 2 * k2); ds[q] = (f32x2){bf2f((unsigned short)dv), bf2f((unsigned short)(dv >> 16))}; } }
#pragma unroll
            for (int q = 0; q < 11; ++q) { const size_t u = ((size_t)b * NBLK + c0 + q) * 4 + h;
                *(GAS unsigned*)(F.St() + u * 32768 + (size_t)v * 128 + 2 * k2) = pk2(s0, s1);
                s0 = d[q].x * s0 + ds[q].x; s1 = d[q].y * s1 + ds[q].y; }
        }
        float* gp = F.out + O_GP + ((size_t)bh * 128 + 2 * k2) * 256 + v; gp[0] = s0; gp[256] = s1;
    }
}

__device__ __forceinline__ void gla_out_unit(Frame& F0, LAS unsigned char* scr, int b, int c, int h) { Frame F = F0; asm volatile("" : "+v"(F.tid), "+v"(F.lane)); gcf const gla_norm = ldarg<A_GNORM>();
    const int u = (b * NBLK + c) * 4 + h;
    const bf16* St = F.St() + (size_t)u * 32768; const size_t R0 = (size_t)b * LP + 128 * c;
    v4u stp[8], gvp[8];
#pragma unroll
    for (int j = 0; j < 8; ++j) { const int cc = F.tid + 512 * j; stp[j] = (c != 0) ? *(const GAS v4u*)(St + (size_t)(cc >> 4) * 128 + 8 * (cc & 15)) : (v4u){0u, 0u, 0u, 0u}; }
#pragma unroll
    for (int j = 0; j < 8; ++j) { const int q = F.lane + 64 * j, row = 16 * F.wave + (q >> 5), ch = q & 31; gvp[j] = *(const GAS v4u*)(F.P() + (R0 + row) * NPAD + C_GG + h * 256 + 8 * ch); }
    if (c == 0) gla_gate<true>(F, scr, b, c, h);
    else {
        LAS unsigned short* GQs = (LAS unsigned short*)(scr + G_Q); LAS unsigned short* GKs = (LAS unsigned short*)(scr + G_K); LAS unsigned short* GVs = (LAS unsigned short*)(scr + G_V);
        const bf16* qt = F.QT() + (size_t)u * 16384; const bf16* kt = F.KT() + (size_t)u * 16384;
        __syncthreads();
        v4u vv[8], qq[4], kk[4];
#pragma unroll
        for (int j = 0; j < 8; ++j) { const int cc = F.tid + 512 * j, row = cc >> 5, ch = cc & 31; vv[j] = *(const GAS v4u*)(F.P() + (R0 + row) * NPAD + C_VG + h * 256 + 8 * ch); }
#pragma unroll
        for (int j = 0; j < 4; ++j) { const int cc = F.tid + 512 * j, row = cc >> 4, ch = cc & 15; qq[j] = *(const GAS v4u*)(qt + row * 128 + 8 * ch); kk[j] = *(const GAS v4u*)(kt + row * 128 + 8 * ch); }
#pragma unroll
        for (int j = 0; j < 8; ++j) { const int cc = F.tid + 512 * j, row = cc >> 5, ch = cc & 31; *(LAS v4u*)(GVs + row * GVP + 8 * ch) = vv[j]; }
#pragma unroll
        for (int j = 0; j < 4; ++j) { const int cc = F.tid + 512 * j, row = cc >> 4, ch = cc & 15; *(LAS v4u*)(GQs + row * GQP + 8 * ch) = qq[j]; *(LAS v4u*)(GKs + row * GQP + 8 * ch) = kk[j]; }
        __syncthreads();
    }
    const LAS unsigned short* GQ = (const LAS unsigned short*)(scr + G_Q); LAS unsigned short* GK = (LAS unsigned short*)(scr + G_K); const LAS unsigned short* GV = (const LAS unsigned short*)(scr + G_V);
    int lane = F.lane; asm volatile("" : "+v"(lane));
    const int gq = lane >> 4, i = lane & 15, w = F.wave;
    const bool active = true;
    bf16x8 qa[4];
#pragma unroll
    for (int ks = 0; ks < 4; ++ks) qa[ks] = *(const LAS bf16x8*)(GQ + (16 * w + i) * GQP + 32 * ks + 8 * gq);
    f32x4 aa[8];
#pragma unroll
    for (int sb = 0; sb < 8; ++sb) { aa[sb] = (f32x4){0.f, 0.f, 0.f, 0.f};
        if (active && sb <= w) {
#pragma unroll
            for (int ks = 0; ks < 4; ++ks) { const bf16x8 kb = *(const LAS bf16x8*)(GK + (16 * sb + i) * GQP + 32 * ks + 8 * gq); aa[sb] = MFMA16(qa[ks], kb, aa[sb]); } } }
    __syncthreads();
    f32x4 acc[16];
#pragma unroll
    for (int cb = 0; cb < 16; ++cb) acc[cb] = (f32x4){0.f, 0.f, 0.f, 0.f};
    if (active) {
#pragma unroll
    for (int sb = 0; sb < 8; ++sb)
#pragma unroll
        for (int r = 0; r < 4; ++r) { const int t = 16 * w + 4 * gq + r, s = 16 * sb + i; GK[t * GQP + s] = f2bf16(s <= t ? aa[sb][r] : 0.f); }
    LDS_WAIT(); asm volatile("" ::: "memory");
#pragma unroll
    for (int ks = 0; ks < 4; ++ks) {
        if (2 * ks <= w) {
            const bf16x8 af = *(const LAS bf16x8*)(GK + (16 * w + i) * GQP + 32 * ks + 8 * gq);
#pragma unroll
            for (int cb = 0; cb < 16; ++cb) { const bf16x8 vb = tr_frag(GV, 32 * ks + 8 * gq, 16 * cb, GVP, lane); acc[cb] = MFMA16(af, vb, acc[cb]); } } }
    }
    __syncthreads();
    { LAS unsigned char* GS = scr + G_V;
#pragma unroll
      for (int j = 0; j < 8; ++j) { const int cc = F.tid + 512 * j, v = cc >> 4, ch = cc & 15; *(LAS v4u*)(GS + v * 256 + ((ch ^ (v & 15)) << 4)) = stp[j]; } }
    __syncthreads();
    if (active) {
    if (c != 0) {
        const LAS unsigned char* GS = scr + G_V;
#pragma unroll
    for (int ks = 0; ks < 4; ++ks)
#pragma unroll
        for (int cb = 0; cb < 16; ++cb) { const bf16x8 sb = *(const LAS bf16x8*)(GS + (16 * cb + i) * 256 + (((4 * ks + gq) ^ i) << 4)); acc[cb] = MFMA16(qa[ks], sb, acc[cb]); }
    }
    LDS_WAIT(); asm volatile("" ::: "memory");
    { LAS unsigned short* GQw = (LAS unsigned short*)(scr + G_Q);
#pragma unroll
    for (int r = 0; r < 4; ++r) { float ss = 0.f;
#pragma unroll
        for (int cb = 0; cb < 16; ++cb) ss += acc[cb][r] * acc[cb][r];
        ss += __shfl_xor(ss, 1); ss += __shfl_xor(ss, 2); ss += __shfl_xor(ss, 4); ss += __shfl_xor(ss, 8);
        const float rstd = rsqrtf(ss * (1.f / 256.f) + EPSN); const int row = 16 * w + 4 * gq + r;
#pragma unroll
        for (int cb = 0; cb < 8; ++cb) { GQw[row * GQP + 16 * cb + i] = f2bf16(acc[cb][r] * rstd); GK[row * GQP + 16 * cb + i] = f2bf16(acc[cb + 8][r] * rstd); } }
    LDS_WAIT(); asm volatile("" ::: "memory");
#pragma unroll
    for (int j = 0; j < 8; ++j) { const int q = lane + 64 * j, row = 16 * w + (q >> 5), ch = q & 31;
        const v4u ov = *(const LAS v4u*)((ch < 16 ? GQw : GK) + row * GQP + 8 * (ch & 15));
        const v4u gv = gvp[j];
        const f32x4 n0 = *(const GAS f32x4*)(gla_norm + 8 * ch), n1 = *(const GAS f32x4*)(gla_norm + 8 * ch + 4);
        v4u res;
        res.x = pk2(bf2f(ov.x & 0xffff) * n0.x * silu_f(bf2f(gv.x & 0xffff)), bf2f(ov.x >> 16) * n0.y * silu_f(bf2f(gv.x >> 16)));
        res.y = pk2(bf2f(ov.y & 0xffff) * n0.z * silu_f(bf2f(gv.y & 0xffff)), bf2f(ov.y >> 16) * n0.w * silu_f(bf2f(gv.y >> 16)));
        res.z = pk2(bf2f(ov.z & 0xffff) * n1.x * silu_f(bf2f(gv.z & 0xffff)), bf2f(ov.z >> 16) * n1.y * silu_f(bf2f(gv.z >> 16)));
        res.w = pk2(bf2f(ov.w & 0xffff) * n1.z * silu_f(bf2f(gv.w & 0xffff)), bf2f(ov.w >> 16) * n1.w * silu_f(bf2f(gv.w >> 16)));
        *(GAS v4u*)(F.MIX() + (R0 + row) * DM + 1024 + h * 256 + 8 * ch) = res; } }
    }
}

constexpr int S_Q = 0, S_KH = 4096, S_KT = 8192, S_LG = 12288, S_D = 16384, S_A = 16896, S_Z = 17152, S_OP = 17664, S_END = S_OP + 65536;
static_assert(S_END <= LDS_BYTES - SCR_OFF, "sample GLA LDS");
__device__ __forceinline__ void gla_sample_unit(Frame& F0, LAS unsigned char* scr, int u) { Frame F = F0; asm volatile("" : "+v"(F.tid), "+v"(F.lane));
    gcf const w_a2 = ldarg<A_WA2>(); gcf const b_a = ldarg<A_BA>(); gcf const state = ldarg<A_STATE>(); gcf const gla_norm = ldarg<A_GNORM>();
    const int h = u & 3, db = u >> 2;
    LAS float* SQ = (LAS float*)(scr + S_Q); LAS float* SKH = (LAS float*)(scr + S_KH); LAS float* SKT = (LAS float*)(scr + S_KT); LAS float* SLG = (LAS float*)(scr + S_LG); LAS float* SD = (LAS float*)(scr + S_D);
    LAS float* SA = (LAS float*)(scr + S_A); LAS float* SZ = (LAS float*)(scr + S_Z); LAS float* SOP = (LAS float*)(scr + S_OP);
    const size_t R0 = (size_t)ROWS_P + (size_t)db * DSEQ;
    const int w = F.wave, lane = F.lane;
    f32x4 st[16];
    { const GAS f32x4* sp = (const GAS f32x4*)(state + ((size_t)u * 128 + 16 * w) * 256) + lane;
#pragma unroll
      for (int kk = 0; kk < 16; ++kk) st[kk] = sp[64 * kk]; }
    __syncthreads();
    if (F.tid < 128) SZ[F.tid] = bf2f(F.P()[(R0 + (F.tid >> 4)) * NPAD + C_ZG + (F.tid & 15)]);
    const int k = F.tid & 127, tp = F.tid >> 7;
    float qv[2], kv[2], wv[16];
#pragma unroll
    for (int q = 0; q < 2; ++q) { const bf16* p = F.P() + (R0 + 2 * tp + q) * NPAD + h * 128 + k; qv[q] = bf2f(p[C_QG]); kv[q] = bf2f(p[C_KG]); }
#pragma unroll
    for (int r = 0; r < 16; ++r) wv[r] = w_a2[r * 512 + h * 128 + k];
    const float ba = b_a[h * 128 + k];
    __syncthreads();
#pragma unroll
    for (int q = 0; q < 2; ++q) { const int t = 2 * tp + q; float x = ba;
#pragma unroll
        for (int r = 0; r < 16; ++r) x += SZ[t * 16 + r] * wv[r];
        SLG[t * 128 + k] = logsig_f(x) * (1.f / 16.f); }
    __syncthreads();
    { float run = 0.f, bt[2] = {0.f, 0.f};
#pragma unroll
      for (int t = 0; t < 8; ++t) { run += SLG[t * 128 + k]; if (t == 2 * tp) bt[0] = run; if (t == 2 * tp + 1) bt[1] = run; }
#pragma unroll
      for (int q = 0; q < 2; ++q) { const int t = 2 * tp + q;
          SQ[k * 8 + t] = qv[q] * __expf(bt[q]) * 0.08838834764831845f; SKT[k * 8 + t] = kv[q] * __expf(-bt[q]); SKH[k * 8 + t] = kv[q] * __expf(run - bt[q]); }
      if (tp == 0) SD[k] = __expf(run); }
    __syncthreads();
    if (F.tid < 64) { const int t = F.tid >> 3, s2 = F.tid & 7; float a = 0.f;
        if (s2 <= t) { for (int kk = 0; kk < 128; ++kk) a += SQ[kk * 8 + t] * SKT[kk * 8 + s2]; }
        SA[t * 8 + s2] = a; }
    {   f32x4 vv[8], op[8];
#pragma unroll
        for (int t = 0; t < 8; ++t) { const unsigned long long pv = *(const GAS unsigned long long*)(F.P() + (R0 + t) * NPAD + C_VG + h * 256 + 4 * lane);
            vv[t] = (f32x4){bf2f((unsigned short)pv), bf2f((unsigned short)(pv >> 16)), bf2f((unsigned short)(pv >> 32)), bf2f((unsigned short)(pv >> 48))}; op[t] = (f32x4){0.f, 0.f, 0.f, 0.f}; }
        GAS f32x4* np = (GAS f32x4*)(F.out + O_GS + ((size_t)u * 128 + 16 * w) * 256) + lane;
#pragma unroll
        for (int kk = 0; kk < 16; ++kk) { const int kc = 16 * w + kk; const f32x4 s0 = st[kk];
            const f32x4 q0 = *(const LAS f32x4*)(SQ + kc * 8), q1 = *(const LAS f32x4*)(SQ + kc * 8 + 4), h0 = *(const LAS f32x4*)(SKH + kc * 8), h1 = *(const LAS f32x4*)(SKH + kc * 8 + 4);
            f32x4 sn = s0 * SD[kc];
            sn += vv[0] * h0.x + vv[1] * h0.y + vv[2] * h0.z + vv[3] * h0.w + vv[4] * h1.x + vv[5] * h1.y + vv[6] * h1.z + vv[7] * h1.w;
            np[64 * kk] = sn;
            op[0] += s0 * q0.x; op[1] += s0 * q0.y; op[2] += s0 * q0.z; op[3] += s0 * q0.w; op[4] += s0 * q1.x; op[5] += s0 * q1.y; op[6] += s0 * q1.z; op[7] += s0 * q1.w; }
#pragma unroll
        for (int t = 0; t < 8; ++t) *(LAS f32x4*)(SOP + (w * 8 + t) * 256 + 4 * lane) = op[t];
    }
    __syncthreads();
    {   const int t = w; f32x4 a = (f32x4){0.f, 0.f, 0.f, 0.f};
#pragma unroll
        for (int w2 = 0; w2 < 8; ++w2) a += *(const LAS f32x4*)(SOP + (w2 * 8 + t) * 256 + 4 * lane);
        for (int s2 = 0; s2 <= t; ++s2) { const unsigned long long pv = *(const GAS unsigned long long*)(F.P() + (R0 + s2) * NPAD + C_VG + h * 256 + 4 * lane); const float c = SA[t * 8 + s2];
            a += (f32x4){bf2f((unsigned short)pv), bf2f((unsigned short)(pv >> 16)), bf2f((unsigned short)(pv >> 32)), bf2f((unsigned short)(pv >> 48))} * c; }
        const float ss = (a.x * a.x + a.y * a.y) + (a.z * a.z + a.w * a.w);
        const float rstd = rsqrtf(wave_sum(ss) * (1.f / 256.f) + EPSN);
        const unsigned long long gv = *(const GAS unsigned long long*)(F.P() + (R0 + t) * NPAD + C_GG + h * 256 + 4 * lane); const f32x4 gn = *(const GAS f32x4*)(gla_norm + 4 * lane);
        const float g0 = bf2f((unsigned short)gv), g1 = bf2f((unsigned short)(gv >> 16)), g2 = bf2f((unsigned short)(gv >> 32)), g3 = bf2f((unsigned short)(gv >> 48));
        *(GAS unsigned long long*)(F.MIX() + (R0 + t) * DM + 1024 + h * 256 + 4 * lane) =
            (unsigned long long)pk2(a.x * rstd * gn.x * silu_f(g0), a.y * rstd * gn.y * silu_f(g1)) | ((unsigned long long)pk2(a.z * rstd * gn.z * silu_f(g2), a.w * rstd * gn.w * silu_f(g3)) << 32);
    }
}

__device__ __forceinline__ void final_rows(Frame& F) { gcf const x_prompt = ldarg<A_XP>(); gcf const x_sample = ldarg<A_XS>(); gcf const norm_post = ldarg<A_NPOST>();
    const int gw = blockIdx.x * NWAVES + F.wave, NGW = F.G * NWAVES; constexpr int NR = NBATCH * SEQ + ROWS_S;
    for (int idx0 = gw; idx0 < NR; idx0 += 2 * NGW) {
        f32x4 v[2][8], xx[2][8]; float* yp[2]; bool on[2];
#pragma unroll
        for (int q = 0; q < 2; ++q) { const int idx = idx0 + q * NGW; on[q] = idx < NR; const int id2 = on[q] ? idx : idx0;
            size_t grow; gcf x;
            if (id2 < NBATCH * SEQ) { const int b = id2 / SEQ, s2 = id2 - b * SEQ; grow = (size_t)b * LP + 128 + s2; x = x_prompt + (size_t)id2 * DM; yp[q] = F.out + O_YP + (size_t)id2 * DM; }
            else { const int j = id2 - NBATCH * SEQ; grow = (size_t)ROWS_P + j; x = x_sample + (size_t)j * DM; yp[q] = F.out + O_YS + (size_t)j * DM; }
            const GAS unsigned long long* o4 = (const GAS unsigned long long*)yp[q] + F.lane;   const GAS f32x4* x4 = (const GAS f32x4*)x + F.lane;
#pragma unroll
            for (int j = 0; j < 8; ++j) { const unsigned long long ov = o4[64 * j]; v[q][j] = (f32x4){bf2f((unsigned short)ov), bf2f((unsigned short)(ov >> 16)), bf2f((unsigned short)(ov >> 32)), bf2f((unsigned short)(ov >> 48))}; xx[q][j] = x4[64 * j]; } }
#pragma unroll
        for (int q = 0; q < 2; ++q) { float s2 = 0.f;
#pragma unroll
            for (int j = 0; j < 8; ++j) s2 += (v[q][j].x * v[q][j].x + v[q][j].y * v[q][j].y) + (v[q][j].z * v[q][j].z + v[q][j].w * v[q][j].w);
            const float rstd = rsqrtf(wave_sum(s2) * (1.f / DM) + EPSN);
            if (on[q]) { GAS f32x4* y4 = (GAS f32x4*)yp[q] + F.lane;
#pragma unroll
                for (int j = 0; j < 8; ++j) { const f32x4 w = ((const GAS f32x4*)norm_post)[F.lane + 64 * j]; y4[64 * j] = xx[q][j] + v[q][j] * rstd * w; } } }
    }
}

#ifndef MK_PER_PHASE
#define MK_PER_PHASE 0
#endif
constexpr int N_PHASES = 7;
struct Args { const float* in[15]; float* out; unsigned char* ws; int ph_lo, ph_hi; };
__global__ void __launch_bounds__(NTHREADS, 2) hymba_fwd(Args args) {
    extern __shared__ __attribute__((aligned(16))) unsigned char lds_raw[];
    Frame F;
    F.lds = (LAS unsigned char*)lds_raw;
    F.tid = threadIdx.x; F.lane = F.tid & 63; F.wave = __builtin_amdgcn_readfirstlane(F.tid >> 6); F.G = gridDim.x;
    F.out = args.out; F.ws = args.ws;
    unsigned char* ws = args.ws;
    for (int u = F.tid; u < LDS_CTL_BYTES / 4; u += NTHREADS) ((LAS unsigned*)F.lds)[u] = 0u;
    __syncthreads();
    volatile LAS unsigned* MISC = (volatile LAS unsigned*)(F.lds + 512);
    XcdBarrier bar; bar.bar = (unsigned*)(ws + WS_CTL) + CW_BAR; bar.x = 0; bar.st = nullptr;
    if (!MK_PER_PHASE) bar = xcd_barrier_post((unsigned*)(ws + WS_CTL) + CW_BAR, MISC + 8);
    LAS unsigned char* scr = F.lds + SCR_OFF;
    const int lo = args.ph_lo, hi = args.ph_hi;
#define IN(k) (lo <= (k) && (k) < hi)
#define SEAM(k) do { if (IN(k) && IN((k) + 1)) xcd_barrier(bar); } while (0)

#ifndef PROBE_PHASE
#define PROBE_PHASE -1
#endif
#ifndef PROBE_REP
#define PROBE_REP 1
#endif
#define REPS(k) for (int rep_ = 0; rep_ < ((k) == PROBE_PHASE ? PROBE_REP : 1); ++rep_)
    constexpr int P0_I_IN = (DM / 64) * (NPAD / 64), P0_I_ALL = P0_I_IN + (DM / 64) * (DM / 64);
    constexpr int G1_TAIL = (MROWS / 256) * (NPAD / 256) % 256;
    const bool wout_late = (F.G == 256) && !MK_PER_PHASE && IN(0) && IN(1) && IN(2) && PROBE_PHASE < 0;
    REPS(0) if (IN(0)) { p0_prologue(F, 0, wout_late ? P0_I_IN : P0_I_ALL, 0, F.G, true); if (PROBE_PHASE == 0) xcd_barrier(bar); }
    SEAM(0);
#define UNIT_BCH(idx, b_, c_, h_) const int b_ = (idx) < 256 ? (idx) >> 7 : ((idx) - 256) >> 2, c_ = (idx) < 256 ? 1 + (((idx) >> 2) & 31) : 0, h_ = (idx) & 3
    const bool split12 = (F.G == 256) && !MK_PER_PHASE && IN(0) && IN(1) && IN(2) && PROBE_PHASE < 0;
    if (split12) {
        constexpr int G1_MP = ROWS_P / 256, G1_MS = ROWS_S / 256, G1_N = NPAD / 256, G1_FULL = (G1_MP + G1_MS) * G1_N / 256;
        const int cb_ = (int)blockIdx.x;
        { pg8::Gemm g{F.XN(), F.WinT(), MROWS, NPAD, DM}; pg8::OrderPF S{G1_MP, G1_MS, G1_N, F.G, cb_, 0, G1_FULL};
          pg8::EpiBf16<0> E{F.P(), NPAD, nullptr, 0, 0, 1.f}; pg8::gemm_phase<pg8::EpiBf16<0>, pg8::OrderPF, true, true>(scr, g, S, E); }
        xcd_barrier(bar);
        if (cb_ < G1_TAIL) {
            { pg8::Gemm g{F.XN(), F.WinT(), MROWS, NPAD, DM}; pg8::OrderPF S{G1_MP, G1_MS, G1_N, F.G, cb_, G1_FULL, G1_FULL + 1};
              pg8::EpiBf16<0> E{F.P(), NPAD, nullptr, 0, 0, 1.f}; pg8::gemm_phase<pg8::EpiBf16<0>, pg8::OrderPF, true, true>(scr, g, S, E); }
        } else { { UNIT_BCH(cb_, b_, c_, h_); attn_prompt_unit(F, scr, b_, c_, h_); gla_ds_unit(F, scr, b_, c_, h_); }
            __syncthreads(); p0_prologue(F, P0_I_IN, P0_I_ALL, G1_TAIL, F.G - G1_TAIL, false); }
        xcd_barrier(bar);
        if (cb_ < G1_TAIL) { { UNIT_BCH(cb_, b_, c_, h_); attn_prompt_unit(F, scr, b_, c_, h_); gla_ds_unit(F, scr, b_, c_, h_); } gla_sample_unit(F, scr, cb_); }
        else if (cb_ < G1_TAIL + 8) { UNIT_BCH(256 + (cb_ - G1_TAIL), b_, c_, h_); attn_prompt_unit(F, scr, b_, c_, h_); gla_ds_unit(F, scr, b_, c_, h_); gla_out_unit(F, scr, b_, c_, h_); }
        else { const int v = cb_ - (G1_TAIL + 8), nb = 256 - (G1_TAIL + 8);
            attn_sample_pair(F, scr, v, 256 + v); if (nb + v < 256) attn_sample_pair(F, scr, nb + v, 256 + nb + v);
            gla_sample_unit(F, scr, G1_TAIL + v); gla_sample_unit(F, scr, G1_TAIL + nb + v); { const int n3 = DBATCH * 4 - (G1_TAIL + 2 * nb), v3 = v - (nb - n3); if (v3 >= 0) gla_sample_unit(F, scr, G1_TAIL + 2 * nb + v3); } }
    } else {
    REPS(1) if (IN(1)) {
        pg8::Gemm g{F.XN(), F.WinT(), MROWS, NPAD, DM}; pg8::StaticOrder S; S.init(MROWS, NPAD, F.G, (int)blockIdx.x);
        pg8::EpiBf16<0> E{F.P(), NPAD, nullptr, 0, 0, 1.f};
        pg8::gemm_phase<pg8::EpiBf16<0>, pg8::StaticOrder, true, true>(scr, g, S, E);
        if (wout_late && (int)blockIdx.x >= G1_TAIL) { __syncthreads(); p0_prologue(F, P0_I_IN, P0_I_ALL, G1_TAIL, F.G - G1_TAIL, false); }
        if (PROBE_PHASE == 1) xcd_barrier(bar);
    }
    SEAM(1);
    REPS(2) if (IN(2)) {
        REPS(20) for (int u = blockIdx.x; u < NBATCH * NBLK * 4; u += F.G) { UNIT_BCH(u, b_, c_, h_); attn_prompt_unit(F, scr, b_, c_, h_); }
        REPS(21) for (int u = blockIdx.x; u < NBATCH * NBLK * 4; u += F.G) { UNIT_BCH(u, b_, c_, h_); gla_ds_unit(F, scr, b_, c_, h_); }
        if (F.G == 256) {
            if (blockIdx.x < 8) { UNIT_BCH(256 + (int)blockIdx.x, b_, c_, h_); gla_out_unit(F, scr, b_, c_, h_); }
            else { const int v = (int)blockIdx.x - 8;
                attn_sample_pair(F, scr, v, 248 + v); if (v < 16) attn_sample_unit(F, scr, 496 + v);
                gla_sample_unit(F, scr, v); gla_sample_unit(F, scr, 248 + v); if (v >= 16 && v < 32) gla_sample_unit(F, scr, 496 + v - 16); }
        } else {
            for (int u = 256 + blockIdx.x; u < NBATCH * NBLK * 4; u += F.G) { UNIT_BCH(u, b_, c_, h_); gla_out_unit(F, scr, b_, c_, h_); }
            REPS(22) for (int u = blockIdx.x; u < DBATCH * 4; u += F.G) attn_sample_unit(F, scr, u);
            REPS(23) for (int u = blockIdx.x; u < DBATCH * 4; u += F.G) gla_sample_unit(F, scr, u);
        }
        if (PROBE_PHASE == 2) xcd_barrier(bar);
    }
    }
    SEAM(2);
    REPS(3) if (IN(3)) { gla_scan(F); if (PROBE_PHASE == 3) xcd_barrier(bar); }
    SEAM(3);
    REPS(4) if (IN(4)) {
        for (int u = blockIdx.x; u < 256; u += F.G) { UNIT_BCH(u, b_, c_, h_); gla_out_unit(F, scr, b_, c_, h_); }
        __syncthreads();
        if (PROBE_PHASE == 4) xcd_barrier(bar);
    }
    SEAM(4);
    REPS(5) if (IN(5)) {
        pg8::Gemm g{F.MIX(), F.WoutT(), MROWS, DM, DM}; pg8::StaticOrder S; S.init(MROWS, DM, F.G, (int)blockIdx.x);
        pg8::EpiY16 E{F.out + O_YP, F.out + O_YS, LP, SEQ, ROWS_P};
        pg8::gemm_phase<pg8::EpiY16, pg8::StaticOrder, true, true>(scr, g, S, E);
        if (PROBE_PHASE == 5) xcd_barrier(bar);
    }
    SEAM(5);
    REPS(6) if (IN(6)) { final_rows(F); if (PROBE_PHASE == 6) xcd_barrier(bar); }
#undef IN
#undef SEAM
}

extern "C" void kernel_launch(void* const* d_in, const int* in_sizes, int n_in, void* d_out, int out_size, void* d_ws, size_t ws_size, hipStream_t stream) {
    static int grid = 0;
    if (grid == 0) {
        if (n_in != 15 || out_size != (int)O_END || ws_size < WS_END) { fprintf(stderr, "kernel_launch: unexpected problem: n_in %d out %d ws %zu\n", n_in, out_size, ws_size); grid = -1; return; }
        int dev = 0, cus = 0, per_cu = 0;
        if (hipGetDevice(&dev) != hipSuccess || hipDeviceGetAttribute(&cus, hipDeviceAttributeMultiprocessorCount, dev) != hipSuccess) { grid = -1; return; }
        if (hipFuncSetAttribute((const void*)hymba_fwd, hipFuncAttributeMaxDynamicSharedMemorySize, LDS_BYTES) != hipSuccess) { fprintf(stderr, "kernel_launch: hipFuncSetAttribute failed\n"); grid = -1; return; }
        if (hipOccupancyMaxActiveBlocksPerMultiprocessor(&per_cu, (const void*)hymba_fwd, NTHREADS, LDS_BYTES) != hipSuccess || per_cu < 1) fprintf(stderr, "kernel_launch: note: occupancy query reports %d\n", per_cu);
        (void)hipGetLastError();
        grid = cus;
    }
    if (grid < 0) return;
    (void)hipMemsetAsync((char*)d_ws + WS_CTL, 0, CTL_ZERO_BYTES, stream);
    Args a{};
    for (int i = 0; i < 15; ++i) a.in[i] = (const float*)d_in[i];
    a.out = (float*)d_out; a.ws = (unsigned char*)d_ws;
#if MK_PER_PHASE
    for (int p = 0; p < N_PHASES; ++p) { a.ph_lo = p; a.ph_hi = p + 1; hipLaunchKernelGGL(hymba_fwd, dim3(grid), dim3(NTHREADS), LDS_BYTES, stream, a); }
#else
    a.ph_lo = 0; a.ph_hi = N_PHASES;
    hipLaunchKernelGGL(hymba_fwd, dim3(grid), dim3(NTHREADS), LDS_BYTES, stream, a);
#endif
}
```

```cpp
#include <hip/hip_runtime.h>
#include <cstdio>
#include <cstdint>
#include <cmath>
namespace pg8 {
#define PG8_LAS __attribute__((address_space(3)))
typedef unsigned short bf16_t;
typedef short bf16x8 __attribute__((ext_vector_type(8)));
typedef float f32x4 __attribute__((ext_vector_type(4)));
typedef unsigned u32x4 __attribute__((ext_vector_type(4)));
constexpr int BM = 256, BK = 64, HALF = 128, HTB = HALF * BK * 2  , STAGE_BYTES = 8 * HTB, NXCD = 8, WGM = 8;

__host__ __device__ __forceinline__ int lds_byte(int r, int c) { const int st = (r >> 4) * 2 + (c >> 5), rr = r & 15, cc = c & 31, ob = rr * 64 + cc * 2; return st * 1024 + (ob ^ (((ob >> 9) & 1) << 5)); }
__host__ __device__ __forceinline__ void stage_rc(int b, int& R, int& C) { const int st = b / 1024, sb = b % 1024, swz = sb ^ (((sb >> 9) & 1) << 5); R = (st >> 1) * 16 + swz / 64; C = (st & 1) * 32 + (swz % 64) / 2; }
__host__ __device__ __forceinline__ int perm32(int rho) { const int n = rho >> 4, i = rho & 15; return 8 * (i >> 2) + 4 * n + (i & 3); }

struct Unit { int pm, pn; };
struct Gemm { const bf16_t* A; const bf16_t* Bt; int M, N, K; };

struct StaticOrder {
    static constexpr bool HALF_PM = false;
    int nM, nN, nwg, G, c;
    __host__ __device__ void init(int M, int N, int G_, int c_) { nM = M / BM; nN = N / BM; nwg = nM * nN; G = G_; c = c_; }
    __host__ __device__ __forceinline__ bool next(int i, Unit& u) const {
        const long L = (long)i * G + c; if (L >= nwg) return false;
        int wgid = (int)L; { const int q = nwg / NXCD, r = nwg % NXCD, xcd = wgid % NXCD, off = wgid / NXCD; wgid = (xcd < r ? xcd * (q + 1) : r * (q + 1) + (xcd - r) * q) + off; }
        const int nig = WGM * nN, gid = wgid / nig, fm = gid * WGM, gsz = (nM - fm) < WGM ? (nM - fm) : WGM;
        u.pm = fm + ((wgid % nig) % gsz); u.pn = (wgid % nig) / gsz; return true;
    }
    __device__ __forceinline__ void a_ready(const Unit&) const {}
    __device__ __forceinline__ void done(const Unit&) const {}
};

struct OrderPF {
    static constexpr bool HALF_PM = false;
    int nMp, nMs, nN, G, c, r0, r1;
    __device__ bool next(int i, Unit& u) const {
        const int ii = r0 + i; if (ii >= r1) return false;
        const int nP = nMp * nN, nT = (nMp + nMs) * nN; const int e = ii * G + c; if (e >= nT) return false;
        if (e < nP) { int wgid = e; { const int q = nP / NXCD, r = nP % NXCD, xcd = wgid % NXCD, off = wgid / NXCD; wgid = (xcd < r ? xcd * (q + 1) : r * (q + 1) + (xcd - r) * q) + off; }
            const int nig = WGM * nN, gid = wgid / nig, fm = gid * WGM, gsz = (nMp - fm) < WGM ? (nMp - fm) : WGM; u.pm = fm + ((wgid % nig) % gsz); u.pn = (wgid % nig) / gsz; }
        else { const int q = e - nP; u.pm = nMp + q % nMs; u.pn = q / nMs; }
        return true;
    }
    __device__ __forceinline__ void a_ready(const Unit&) const {}
    __device__ __forceinline__ void done(const Unit&) const {}
};

struct OrderG2 {
    static constexpr bool HALF_PM = true;
    StaticOrder so;
    __device__ __forceinline__ bool next(int i, Unit& u) const { if (!so.next(i, u)) return false; const int b = u.pm >> 4, j = u.pm & 15; u.pm = 33 * b + 1 + 2 * j; return true; }
    __device__ __forceinline__ void a_ready(const Unit&) const {}
    __device__ __forceinline__ void done(const Unit&) const {}
};

__device__ __forceinline__ unsigned cvt_pk_bf16(float lo, float hi) { unsigned r; asm volatile("v_cvt_pk_bf16_f32 %0, %1, %2" : "=v"(r) : "v"(lo), "v"(hi)); return r; }
typedef float f32x2 __attribute__((ext_vector_type(2)));
__device__ __forceinline__ f32x2 gelu_pk(f32x2 v) {
    const f32x2 av = __builtin_elementwise_abs(v), d = av * 0.2316418882f + 1.0f;
    f32x2 t; t.x = __builtin_amdgcn_rcpf(d.x); t.y = __builtin_amdgcn_rcpf(d.y);
    f32x2 q = t * 0.5307027145f + (-0.7265760135f); q = q * t + 0.7107068705f; q = q * t + (-0.142248368f); q = q * t + 0.127414796f; q = q * t;
    const f32x2 s = (v * v) * (-0.72134752044f);
    f32x2 e; e.x = __builtin_amdgcn_exp2f(s.x); e.y = __builtin_amdgcn_exp2f(s.y);
    const f32x2 m = v * (q * e), r = v - m;
    f32x2 o; o.x = v.x < 0.f ? m.x : r.x; o.y = v.y < 0.f ? m.y : r.y; return o;
}

template <int ACT  > struct EpiBf16 {
    static constexpr bool PERM = true, AFTER_DRAIN = false; static_assert(ACT == 0 || ACT == 1, "EpiBf16: ACT is 0 (none) or 1 (gelu_pk)");
    bf16_t* O; int ldc; const float* bias; int split_cols; size_t split_stride; float scale0;
    __device__ __forceinline__ void operator()(const f32x4 (&acc)[2][2][4][2], const Unit& u, int wr, int wc, int fr, int fq) const {
        const int row0 = u.pm * BM + wr * 64 + fr; int colt = u.pn * BM; bf16_t* base = O;
        float sc = 1.f; if (split_cols) { const int t = colt / split_cols; base += (size_t)t * split_stride; colt -= t * split_cols; if (t == 0) sc = scale0; }
        const int col0 = colt + wc * 32 + 8 * fq, bcol0 = u.pn * BM + wc * 32 + 8 * fq;
        f32x4 bv[2][2];
#pragma unroll
        for (int bj = 0; bj < 2; ++bj)
#pragma unroll
            for (int n = 0; n < 2; ++n) bv[bj][n] = bias ? *(const f32x4*)(bias + bcol0 + bj * HALF + 4 * n) : (f32x4){0.f, 0.f, 0.f, 0.f};
#pragma unroll
        for (int ai = 0; ai < 2; ++ai)
#pragma unroll
            for (int m = 0; m < 4; ++m) { bf16_t* rowp = base + (size_t)(row0 + ai * HALF + m * 16) * ldc + col0;
#pragma unroll
                for (int bj = 0; bj < 2; ++bj) { f32x4 v0 = acc[ai][bj][m][0] + bv[bj][0], v1 = acc[ai][bj][m][1] + bv[bj][1];
                    if (ACT == 1) { f32x2 a = gelu_pk((f32x2){v0[0], v0[1]}), b = gelu_pk((f32x2){v0[2], v0[3]}), c = gelu_pk((f32x2){v1[0], v1[1]}), d = gelu_pk((f32x2){v1[2], v1[3]});
                        v0 = (f32x4){a.x, a.y, b.x, b.y}; v1 = (f32x4){c.x, c.y, d.x, d.y}; }
                    v0 = v0 * sc; v1 = v1 * sc; u32x4 w; w.x = cvt_pk_bf16(v0[0], v0[1]); w.y = cvt_pk_bf16(v0[2], v0[3]); w.z = cvt_pk_bf16(v1[0], v1[1]); w.w = cvt_pk_bf16(v1[2], v1[3]);
                    *(u32x4*)(rowp + bj * HALF) = w; } }
    }
};

struct EpiF32 {
    static constexpr bool PERM = false, AFTER_DRAIN = false;
    float* O; int ldc;
    __device__ __forceinline__ void operator()(const f32x4 (&acc)[2][2][4][2], const Unit& u, int wr, int wc, int fr, int fq) const {
        const int row0 = u.pm * BM + wr * 64 + fr, col0 = u.pn * BM + wc * 32 + 4 * fq;
#pragma unroll
        for (int ai = 0; ai < 2; ++ai)
#pragma unroll
            for (int m = 0; m < 4; ++m) { float* rowp = O + (size_t)(row0 + ai * HALF + m * 16) * ldc + col0;
#pragma unroll
                for (int bj = 0; bj < 2; ++bj)
#pragma unroll
                    for (int n = 0; n < 2; ++n) *(f32x4*)(rowp + bj * HALF + n * 16) = acc[ai][bj][m][n]; }
    }
};
struct EpiY {
    static constexpr bool PERM = false, AFTER_DRAIN = false;
    float* yp; float* ys; int lp, seq, rows_p;
    __device__ __forceinline__ void operator()(const f32x4 (&acc)[2][2][4][2], const Unit& u, int wr, int wc, int fr, int fq) const {
        const int row0 = u.pm * BM + wr * 64 + fr, col0 = u.pn * BM + wc * 32 + 4 * fq;
#pragma unroll
        for (int ai = 0; ai < 2; ++ai)
#pragma unroll
            for (int m = 0; m < 4; ++m) { const int row = row0 + ai * HALF + m * 16; float* rowp;
                if (row < rows_p) { const int b = row / lp, i = row - b * lp; if (i < 128) continue; rowp = yp + ((size_t)b * seq + (i - 128)) * 2048 + col0; }
                else rowp = ys + (size_t)(row - rows_p) * 2048 + col0;
#pragma unroll
                for (int bj = 0; bj < 2; ++bj)
#pragma unroll
                    for (int n = 0; n < 2; ++n) *(f32x4*)(rowp + bj * HALF + n * 16) = acc[ai][bj][m][n]; }
    }
};
template <int PM_ROWS  > struct EpiY16 {
    static constexpr bool PERM = true, AFTER_DRAIN = false;
    float* yp; float* ys; int lp, seq, rows_p;
    __device__ __forceinline__ void operator()(const f32x4 (&acc)[2][2][4][2], const Unit& u, int wr, int wc, int fr, int fq) const {
        const int row0 = u.pm * PM_ROWS + wr * 64 + fr, col0 = u.pn * BM + wc * 32 + 8 * fq;
#pragma unroll
        for (int ai = 0; ai < 2; ++ai)
#pragma unroll
            for (int m = 0; m < 4; ++m) { const int row = row0 + ai * HALF + m * 16; bf16_t* rowp;
                if (row < rows_p) { const int b = row / lp, i = row - b * lp; if (i < 128) continue; rowp = (bf16_t*)(yp + ((size_t)b * seq + (i - 128)) * 2048) + col0; }
                else rowp = (bf16_t*)(ys + (size_t)(row - rows_p) * 2048) + col0;
#pragma unroll
                for (int bj = 0; bj < 2; ++bj) { const f32x4 v0 = acc[ai][bj][m][0], v1 = acc[ai][bj][m][1];
                    u32x4 w; w.x = cvt_pk_bf16(v0[0], v0[1]); w.y = cvt_pk_bf16(v0[2], v0[3]); w.z = cvt_pk_bf16(v1[0], v1[1]); w.w = cvt_pk_bf16(v1[2], v1[3]);
                    *(u32x4*)(rowp + bj * HALF) = w; } }
    }
};
template <class Epi, class Sched, bool ALIGN_EPI = false, bool SP2 = false>
__device__ __forceinline__ void gemm_phase(PG8_LAS unsigned char* lds, const Gemm g, const Sched& S, const Epi& E) {
    const int tid = threadIdx.x, wid = __builtin_amdgcn_readfirstlane(tid >> 6), lane = tid & 63, wr = wid >> 2, wc = wid & 3, fr = lane & 15, fq = lane >> 4;
    const int K = g.K, nt = K / BK;
    unsigned voffA[2], voffB[2];
#pragma unroll
    for (int i = 0; i < 2; ++i) { int R, C; stage_rc(tid * 16 + i * 8192, R, C); const int Rb = Epi::PERM ? ((R & ~31) + perm32(R & 31)) : R;
        voffA[i] = (unsigned)(R * K + C) * 2u; voffB[i] = (unsigned)(Rb * K + C) * 2u; }
    const size_t kstep = (size_t)(BK * 2);
    const size_t hstep = (size_t)HALF * K * 2;
    const size_t tstep = 2 * hstep;
    const unsigned ldsw = (unsigned)wid * 1024u;
    const int aoff = lds_byte(wr * 64 + fr, fq * 8), boff = lds_byte(wc * 32 + fr, fq * 8);
#define PG8_SA(b, h) (((b) * 2 + (h)) * HTB)
#define PG8_SB(b, h) ((4 + (b) * 2 + (h)) * HTB)
#define PG8_STAGE(bufoff, gbase, voff) do { _Pragma("unroll") for (int _i = 0; _i < 2; ++_i) \
        __builtin_amdgcn_global_load_lds((const unsigned*)((const char*)(gbase) + (voff)[_i]), (PG8_LAS unsigned*)(lds + (bufoff) + ldsw + _i * 8192), 16, 0, 0); } while (0)
#define PG8_LDA(dst, b, h) do { _Pragma("unroll") for (int m = 0; m < 4; ++m) _Pragma("unroll") for (int k = 0; k < 2; ++k) dst[m][k] = *(const PG8_LAS bf16x8*)(lds + PG8_SA(b, h) + aoff + m * 2048 + k * 1024); } while (0)
#define PG8_LDB(dst, b, h) do { _Pragma("unroll") for (int n = 0; n < 2; ++n) _Pragma("unroll") for (int k = 0; k < 2; ++k) dst[n][k] = *(const PG8_LAS bf16x8*)(lds + PG8_SB(b, h) + boff + n * 2048 + k * 1024); } while (0)
#define PG8_MMA(ai, bj, At, Bt) do { __builtin_amdgcn_s_setprio(1); _Pragma("unroll") for (int m = 0; m < 4; ++m) _Pragma("unroll") for (int n = 0; n < 2; ++n) _Pragma("unroll") for (int k = 0; k < 2; ++k) \
        acc[ai][bj][m][n] = __builtin_amdgcn_mfma_f32_16x16x32_bf16(Bt[n][k], At[m][k], acc[ai][bj][m][n], 0, 0, 0); __builtin_amdgcn_s_setprio(0); } while (0)
#define PG8_WAIT_V(n) asm volatile("s_waitcnt vmcnt(" #n ")" ::: "memory")
#define PG8_WAIT_L(n) asm volatile("s_waitcnt lgkmcnt(" #n ")" ::: "memory")
#define PG8_BAR __builtin_amdgcn_s_barrier()
#define PG8_SCHED __builtin_amdgcn_sched_barrier(0)
    Unit cur, nxt; int ui = 0;
    if (!S.next(0, cur)) return;
    f32x4 acc[2][2][4][2];
#pragma unroll
    for (int a = 0; a < 2; ++a)
#pragma unroll
        for (int b = 0; b < 2; ++b)
#pragma unroll
            for (int m = 0; m < 4; ++m)
#pragma unroll
                for (int n = 0; n < 2; ++n) acc[a][b][m][n] = (f32x4){0.f, 0.f, 0.f, 0.f};
    bf16x8 At[4][2], B0[2][2], B1[2][2];
    const size_t astep = Sched::HALF_PM ? hstep : tstep;
    const char* cA = (const char*)g.A + (size_t)cur.pm * astep; const char* cB = (const char*)g.Bt + (size_t)cur.pn * tstep;
    S.a_ready(cur);
    if constexpr (SP2) {
        PG8_STAGE(PG8_SB(0, 0), cB, voffB); PG8_STAGE(PG8_SB(0, 1), cB + hstep, voffB); PG8_STAGE(PG8_SA(0, 0), cA, voffA); PG8_STAGE(PG8_SA(0, 1), cA + hstep, voffA);
        if (wr == 1) PG8_BAR;
        PG8_WAIT_V(2); PG8_BAR;
        PG8_STAGE(PG8_SB(1, 0), cB + kstep, voffB); PG8_STAGE(PG8_SA(1, 0), cA + kstep, voffA); PG8_STAGE(PG8_SB(1, 1), cB + hstep + kstep, voffB);
        PG8_WAIT_V(6); PG8_BAR;
    } else {
        PG8_STAGE(PG8_SB(0, 0), cB, voffB); PG8_STAGE(PG8_SA(0, 0), cA, voffA); PG8_STAGE(PG8_SB(0, 1), cB + hstep, voffB); PG8_STAGE(PG8_SA(0, 1), cA + hstep, voffA);
        if (wr == 1) PG8_BAR;
        PG8_WAIT_V(4); PG8_BAR;
        PG8_STAGE(PG8_SB(1, 0), cB + kstep, voffB); PG8_STAGE(PG8_SA(1, 0), cA + kstep, voffA); PG8_STAGE(PG8_SB(1, 1), cB + hstep + kstep, voffB);
        PG8_WAIT_V(6); PG8_BAR;
    }
    for (;;) {
        const bool has_next = S.next(ui + 1, nxt);
        const char* nA = has_next ? (const char*)g.A + (size_t)nxt.pm * astep : cA; const char* nB = has_next ? (const char*)g.Bt + (size_t)nxt.pn * tstep : cB;
        for (int t = 0; t < nt; t += 2) {
            const bool last = (t == nt - 2);
            const char* a1 = cA + (size_t)(t + 1) * kstep;
            const char* a2 = last ? nA : cA + (size_t)(t + 2) * kstep; const char* b2 = last ? nB : cB + (size_t)(t + 2) * kstep;
            const char* a3 = a2 + kstep; const char* b3 = b2 + kstep;
            if (last && has_next) S.a_ready(nxt);
            if constexpr (SP2) {
            PG8_LDB(B0, 0, 0); PG8_LDB(B1, 0, 1); PG8_SCHED; PG8_LDA(At, 0, 0); PG8_STAGE(PG8_SA(1, 1), a1 + hstep, voffA);
            PG8_WAIT_V(8); PG8_WAIT_L(0); PG8_BAR; PG8_MMA(0, 0, At, B0); PG8_MMA(0, 1, At, B1); PG8_BAR; PG8_SCHED;
            PG8_LDA(At, 0, 1); PG8_STAGE(PG8_SB(0, 0), b2, voffB); PG8_STAGE(PG8_SB(0, 1), b2 + hstep, voffB); PG8_STAGE(PG8_SA(0, 0), a2, voffA);
            PG8_WAIT_V(8); PG8_WAIT_L(0); PG8_BAR; PG8_MMA(1, 0, At, B0); PG8_MMA(1, 1, At, B1); PG8_BAR; PG8_SCHED;
            PG8_LDB(B0, 1, 0); PG8_LDB(B1, 1, 1); PG8_SCHED; PG8_LDA(At, 1, 0); PG8_STAGE(PG8_SA(0, 1), a2 + hstep, voffA);
            PG8_WAIT_V(8); PG8_WAIT_L(0); PG8_BAR; PG8_MMA(0, 0, At, B0); PG8_MMA(0, 1, At, B1); PG8_BAR; PG8_SCHED;
            PG8_LDA(At, 1, 1); PG8_STAGE(PG8_SB(1, 0), b3, voffB); PG8_STAGE(PG8_SB(1, 1), b3 + hstep, voffB); PG8_STAGE(PG8_SA(1, 0), a3, voffA);
            PG8_WAIT_V(8); PG8_WAIT_L(0); PG8_BAR; PG8_MMA(1, 0, At, B0); PG8_MMA(1, 1, At, B1); PG8_BAR; PG8_SCHED;
            } else {
            PG8_LDB(B0, 0, 0); PG8_SCHED; PG8_LDA(At, 0, 0); PG8_STAGE(PG8_SA(1, 1), a1 + hstep, voffA);
            PG8_WAIT_L(8); PG8_BAR; PG8_WAIT_L(0); PG8_MMA(0, 0, At, B0); PG8_BAR; PG8_SCHED;
            PG8_LDB(B1, 0, 1); PG8_STAGE(PG8_SB(0, 0), b2, voffB);
            PG8_BAR; PG8_WAIT_L(0); PG8_MMA(0, 1, At, B1); PG8_BAR;
            PG8_LDA(At, 0, 1); PG8_STAGE(PG8_SA(0, 0), a2, voffA);
            PG8_BAR; PG8_WAIT_L(0); PG8_MMA(1, 0, At, B0); PG8_BAR; PG8_SCHED;
            PG8_STAGE(PG8_SB(0, 1), b2 + hstep, voffB);
            PG8_WAIT_V(6); PG8_BAR; PG8_MMA(1, 1, At, B1); PG8_BAR;
            PG8_LDB(B0, 1, 0); PG8_SCHED; PG8_LDA(At, 1, 0); PG8_STAGE(PG8_SA(0, 1), a2 + hstep, voffA);
            PG8_WAIT_L(8); PG8_BAR; PG8_WAIT_L(0); PG8_MMA(0, 0, At, B0); PG8_BAR; PG8_SCHED;
            PG8_LDB(B1, 1, 1); PG8_STAGE(PG8_SB(1, 0), b3, voffB);
            PG8_BAR; PG8_WAIT_L(0); PG8_MMA(0, 1, At, B1); PG8_BAR;
            PG8_LDA(At, 1, 1); PG8_STAGE(PG8_SA(1, 0), a3, voffA);
            PG8_BAR; PG8_WAIT_L(0); PG8_MMA(1, 0, At, B0); PG8_BAR; PG8_SCHED;
            PG8_STAGE(PG8_SB(1, 1), b3 + hstep, voffB);
            PG8_WAIT_V(6); PG8_BAR; PG8_MMA(1, 1, At, B1); PG8_BAR;
            }
        }
        if constexpr (ALIGN_EPI) { if (wr == 0) PG8_BAR; }
        if constexpr (!Epi::AFTER_DRAIN) { E(acc, cur, wr, wc, fr, fq); S.done(cur); }
        if (!has_next) break;
#pragma unroll
        for (int a = 0; a < 2; ++a)
#pragma unroll
            for (int b = 0; b < 2; ++b)
#pragma unroll
                for (int m = 0; m < 4; ++m)
#pragma unroll
                    for (int n = 0; n < 2; ++n) acc[a][b][m][n] = (f32x4){0.f, 0.f, 0.f, 0.f};
        cur = nxt; cA = nA; cB = nB; ++ui;
        if constexpr (ALIGN_EPI) { if (wr == 1) PG8_BAR; }
    }
    PG8_WAIT_V(0);
    if constexpr (!ALIGN_EPI) { if (wr == 0) PG8_BAR; }
    PG8_BAR;
    if constexpr (Epi::AFTER_DRAIN) { E.fused(acc, cur, wr, wc, fr, fq, lds, wid, lane); S.done(cur); }
#undef PG8_SA
#undef PG8_SB
#undef PG8_STAGE
#undef PG8_LDA
#undef PG8_LDB
#undef PG8_MMA
#undef PG8_WAIT_V
#undef PG8_WAIT_L
#undef PG8_BAR
#undef PG8_SCHED
}
}

#define GAS __attribute__((address_space(1)))
#define LAS __attribute__((address_space(3)))
typedef unsigned short bf16;
typedef unsigned v4u __attribute__((ext_vector_type(4)));
typedef float f32x4 __attribute__((ext_vector_type(4)));
typedef short bf16x8 __attribute__((ext_vector_type(8)));
typedef GAS unsigned gu32;
typedef GAS unsigned long long gu64;
#define RLX_AGENT __ATOMIC_RELAXED, __HIP_MEMORY_SCOPE_AGENT
#define LDS_WAIT() asm volatile("s_waitcnt lgkmcnt(0)" ::: "memory")
#define VM_WAIT() asm volatile("s_waitcnt vmcnt(0)" ::: "memory")
__device__ __forceinline__ unsigned long long rt() { return __builtin_amdgcn_s_memrealtime(); }
__device__ __forceinline__ unsigned f2bf(float f) { unsigned u = __builtin_bit_cast(unsigned, f); return (u + 0x7fffu + ((u >> 16) & 1u)) >> 16; }
__device__ __forceinline__ unsigned pk2(float lo, float hi) { return f2bf(lo) | (f2bf(hi) << 16); }
#define XB_TMO      128
#define XB_XCNT(j)  (256  + 64 * (j))
#define XB_XSUB(j)  (1280 + 64 * (j))
#define XB_XGEN(j)  (2304 + 64 * (j))
#define XB_TOP      3328
#define XB_TOPGEN   3392
#define XCD_BAR_WORDS 3456
#define XB_SPIN_CAP (1u << 18)

__device__ __forceinline__ unsigned xb_ld(unsigned* p)              { return __hip_atomic_load(p, __ATOMIC_RELAXED, __HIP_MEMORY_SCOPE_AGENT); }
__device__ __forceinline__ unsigned xb_add(unsigned* p, unsigned v) { return __hip_atomic_fetch_add(p, v, __ATOMIC_RELAXED, __HIP_MEMORY_SCOPE_AGENT); }
__device__ __forceinline__ unsigned xb_xcc_id() { return (unsigned)__builtin_amdgcn_s_getreg((3 << 11) | 20) & 0xFu; }
#define XB_SPIN(cond, bar) do { unsigned _sp = 0; while (cond) { __builtin_amdgcn_s_sleep(1); \
    if ((++_sp & 255u) == 0u) { if (xb_ld(&(bar)[XB_TMO])) break; if (_sp > XB_SPIN_CAP) { atomicAdd(&(bar)[XB_TMO], 1u); break; } } } } while (0)

struct XcdBarrier {
    unsigned* bar; unsigned x;
    volatile LAS unsigned* st;
};

__device__ __forceinline__ XcdBarrier xcd_barrier_post(unsigned* bar, volatile LAS unsigned* st) {
    XcdBarrier b; b.bar = bar; b.x = xb_xcc_id(); b.st = st;
    if (threadIdx.x == 0) (void)xb_add(&bar[XB_XCNT(b.x)], 1u);
    return b;
}
__device__ __forceinline__ void xcd_barrier_complete(unsigned* bar, unsigned x, unsigned& nloc, unsigned& nx) {
    const unsigned G = gridDim.x * gridDim.y * gridDim.z;
    unsigned sum, cnt, mine, sp = 0u;
    for (;;) {
        sum = 0u; cnt = 0u; mine = 0u;
#pragma unroll
        for (unsigned j = 0; j < 16; ++j) { const unsigned c = xb_ld(&bar[XB_XCNT(j)]); sum += c; cnt += (c > 0u) ? 1u : 0u; mine = (j == x) ? c : mine; }
        if (sum == G) break;
        __builtin_amdgcn_s_sleep(1);
        if ((++sp & 255u) == 0u) { if (xb_ld(&bar[XB_TMO])) break; if (sp > XB_SPIN_CAP) { atomicAdd(&bar[XB_TMO], 1u); break; } }
    }
    nloc = mine > 0u ? mine : 1u; nx = cnt > 0u ? cnt : 1u;
}

__device__ __forceinline__ void xcd_barrier(const XcdBarrier& b) {
    asm volatile("s_waitcnt vmcnt(0)" ::: "memory");
    __syncthreads();
    if (threadIdx.x == 0) {
        unsigned* bar = b.bar;
        __builtin_amdgcn_s_waitcnt(0);
        unsigned nloc = b.st[0], nx = b.st[1];
        if (nloc == 0u) { xcd_barrier_complete(bar, b.x, nloc, nx); b.st[0] = nloc; b.st[1] = nx; }
        const unsigned old = xb_add(&bar[XB_XSUB(b.x)], 1u);
        const unsigned gen = old / nloc;
        if (old + 1u == (gen + 1u) * nloc) {
            __builtin_amdgcn_fence(__ATOMIC_RELEASE, "agent");
            asm volatile("s_waitcnt vmcnt(0)" ::: "memory");
            const unsigned og = xb_add(&bar[XB_TOP], 1u);
            const unsigned tg = og / nx;
            if (og + 1u == (tg + 1u) * nx) xb_add(&bar[XB_TOPGEN], 1u);
            else XB_SPIN(xb_ld(&bar[XB_TOPGEN]) == tg, bar);
            __builtin_amdgcn_fence(__ATOMIC_ACQUIRE, "agent");
            xb_add(&bar[XB_XGEN(b.x)], 1u);
            asm volatile("s_waitcnt vmcnt(0)" ::: "memory");
        } else {
            XB_SPIN(xb_ld(&bar[XB_XGEN(b.x)]) == gen, bar);
            __builtin_amdgcn_fence(__ATOMIC_ACQUIRE, "agent");
            asm volatile("s_waitcnt vmcnt(0)" ::: "memory");
        }
    }
    __syncthreads();
}


constexpr int NWAVES = 8, NTHREADS = 512;
constexpr int DM = 2048, NBATCH = 2, SEQ = 4096, NMETA = 16, FPAD = 112, LP = 4224, NBLK = 33;
constexpr int DBATCH = 128, DSEQ = 8, WIN = 128;
constexpr int ROWS_P = NBATCH * LP, ROWS_S = DBATCH * DSEQ, MROWS = ROWS_P + ROWS_S;
constexpr int NIN = 5648, NPAD = 5888;
constexpr int C_QA = 0, C_KA = 1024, C_VA = 1280, C_GA = 1536, C_QG = 2560, C_KG = 3072, C_VG = 3584, C_GG = 4608, C_ZG = 5632;
constexpr float EPSN = 1e-6f;
static_assert(MROWS % 256 == 0 && NPAD % 256 == 0, "tiles");

constexpr size_t O_YP = 0, O_YS = 16777216, O_KWP = 18874368, O_VWP = 18939904, O_GP = 19005440, O_KWS = 19267584, O_VWS = 23461888, O_GS = 27656192, O_END = 44433408;

constexpr size_t MiB = 1u << 20;
constexpr size_t WS_CTL = 0, CTL_ZERO_BYTES = 64 * 1024;
constexpr size_t WS_WIN = 1 * MiB;
constexpr size_t WS_WOUT = 24 * MiB;
constexpr size_t WS_XN = 32 * MiB;
constexpr size_t WS_P = 69 * MiB;
constexpr size_t WS_DST = 176 * MiB;
constexpr size_t WS_ST = 209 * MiB;
constexpr size_t WS_DEC = 226 * MiB;
constexpr size_t WS_QT = 227 * MiB, WS_KT = 236 * MiB;
constexpr size_t WS_END = 245 * MiB;
constexpr int CW_BAR = 1024;

constexpr int LDS_CTL_BYTES = 1024;
constexpr int SCR_OFF = 1024;
constexpr int LDS_BYTES = 156 * 1024;

typedef short bf16x4 __attribute__((ext_vector_type(4)));
typedef short v4i16_t __attribute__((ext_vector_type(4)));
typedef float f32x2 __attribute__((ext_vector_type(2)));

__device__ __forceinline__ float bf2f(unsigned short b) { return __uint_as_float(((unsigned)b) << 16); }
__device__ __forceinline__ unsigned short f2bf16(float f) { return (unsigned short)f2bf(f); }
__device__ __forceinline__ float wave_sum(float v) {
#pragma unroll
    for (int o = 1; o < 64; o <<= 1) v += __shfl_xor(v, o);
    return v;
}
__device__ __forceinline__ float silu_f(float x) { return x / (1.f + __expf(-x)); }
__device__ __forceinline__ float logsig_f(float x) { return fminf(x, 0.f) - __logf(1.f + __expf(-fabsf(x))); }

#ifndef USE_TR
#define USE_TR 1
#endif
__device__ __forceinline__ bf16x8 tr_frag(const LAS unsigned short* M, int row0, int col0, int pitch, int lane) {
#if USE_TR
    const int q = (lane & 15) >> 2, p = lane & 3;
    const LAS unsigned short* a0 = M + (row0 + q) * pitch + col0 + 4 * p;
    const v4i16_t lo = __builtin_amdgcn_ds_read_tr16_b64_v4i16((LAS v4i16_t*)a0);
    const v4i16_t hi = __builtin_amdgcn_ds_read_tr16_b64_v4i16((LAS v4i16_t*)(a0 + 4 * pitch));
    return (bf16x8){lo[0], lo[1], lo[2], lo[3], hi[0], hi[1], hi[2], hi[3]};
#else
    bf16x8 r; const LAS unsigned short* a0 = M + row0 * pitch + col0 + (lane & 15);
#pragma unroll
    for (int j = 0; j < 8; ++j) r[j] = (short)a0[j * pitch];
    return r;
#endif
}
#define MFMA16(a, b, c) __builtin_amdgcn_mfma_f32_16x16x32_bf16((a), (b), (c), 0, 0, 0)

struct Frame {
    LAS unsigned char* lds;
    int tid, lane, wave, G;
    unsigned char* ws; float* out;
    __device__ __forceinline__ bf16* WinT() const { return (bf16*)(ws + WS_WIN); }
    __device__ __forceinline__ bf16* WoutT() const { return (bf16*)(ws + WS_WOUT); }
    __device__ __forceinline__ bf16* XN() const { return (bf16*)(out + O_GS); }
    __device__ __forceinline__ bf16* MIX() const { return (bf16*)(ws + WS_XN); }
    __device__ __forceinline__ bf16* P() const { return (bf16*)(ws + WS_P); }
    __device__ __forceinline__ float* O2() const { return (float*)(ws + WS_P); }
    __device__ __forceinline__ float* dST() const { return (float*)(ws + WS_DST); }
    __device__ __forceinline__ bf16* St() const { return (bf16*)(ws + WS_ST); }
    __device__ __forceinline__ float* dec() const { return (float*)(ws + WS_DEC); }
    __device__ __forceinline__ bf16* QT() const { return (bf16*)(ws + WS_QT); }
    __device__ __forceinline__ bf16* KT() const { return (bf16*)(ws + WS_KT); }
};
enum { A_XP = 0, A_XS, A_CK, A_CV, A_STATE, A_META, A_RELB, A_NPRE, A_NPOST, A_WIN, A_WA2, A_BA, A_SINK, A_GNORM, A_WOUT, A_OUT, A_WS };
typedef const GAS float* gcf;
template <int IDX> __device__ __forceinline__ gcf ldarg() {
    const unsigned long long ka = (unsigned long long)__builtin_amdgcn_kernarg_segment_ptr();
    unsigned long long v;
    asm volatile("s_load_dwordx2 %0, %1, %2\n\ts_waitcnt lgkmcnt(0)" : "=s"(v) : "s"(ka), "i"(IDX * 8) : "memory");
    return (gcf)v;
}

struct P0Item { gcf W; bf16* WT; int N, kb, nb; bool on; };
__device__ __forceinline__ void p0_item_load(const P0Item& it, int K, int lane, f32x4 (&v)[16]) {
    const int k0 = 64 * it.kb, n0 = 64 * it.nb; const int nq = 4 * (lane & 15), kr = lane >> 4; const bool ok = it.on && (n0 + nq) < it.N;
#pragma unroll
    for (int i = 0; i < 16; ++i) v[i] = ok ? *(const GAS f32x4*)(it.W + (size_t)(k0 + 4 * i + kr) * it.N + n0 + nq) : (f32x4){0.f, 0.f, 0.f, 0.f};
}
__device__ __forceinline__ void p0_item_store(const P0Item& it, int K, int lane, const f32x4 (&v)[16], LAS float* scr) {
    if (!it.on) return;
    const int k0 = 64 * it.kb, n0 = 64 * it.nb; const int nq = 4 * (lane & 15), kr = lane >> 4;
#pragma unroll
    for (int i = 0; i < 16; ++i) { LAS float* d = scr + (4 * i + kr) * 65 + nq; d[0] = v[i].x; d[1] = v[i].y; d[2] = v[i].z; d[3] = v[i].w; }
    LDS_WAIT(); asm volatile("" ::: "memory");
    const int c = lane & 7;
#pragma unroll
    for (int j = 0; j < 8; ++j) { const int nn = (lane >> 3) + 8 * j; const LAS float* s = scr + (8 * c) * 65 + nn;
        v4u o; o.x = pk2(s[0 * 65], s[1 * 65]); o.y = pk2(s[2 * 65], s[3 * 65]); o.z = pk2(s[4 * 65], s[5 * 65]); o.w = pk2(s[6 * 65], s[7 * 65]);
        *(GAS v4u*)(it.WT + (size_t)(n0 + nn) * K + k0 + 8 * c) = o; }
    LDS_WAIT(); asm volatile("" ::: "memory");
}
__device__ __forceinline__ gcf p0_row_src(int m, gcf meta, gcf x_prompt, gcf x_sample) {
    if (m < ROWS_P) { const int b = m / LP, i = m - b * LP;
        if (i < FPAD) return nullptr;
        return (i < 128) ? meta + (size_t)(i - FPAD) * DM : x_prompt + ((size_t)b * SEQ + (i - 128)) * DM; }
    return x_sample + (size_t)(m - ROWS_P) * DM;
}
constexpr int P0R = 4;
__device__ __forceinline__ void p0_rows2(Frame& F, int m0, int mstep, gcf meta, gcf x_prompt, gcf x_sample, gcf norm_pre) {
    gcf src[P0R]; int mm[P0R];
#pragma unroll
    for (int q = 0; q < P0R; ++q) { mm[q] = m0 + q * mstep; src[q] = (mm[q] < MROWS) ? p0_row_src(mm[q], meta, x_prompt, x_sample) : nullptr; }
    f32x4 v[P0R][8];
#pragma unroll
    for (int q = 0; q < P0R; ++q)
#pragma unroll
        for (int j = 0; j < 8; ++j) v[q][j] = src[q] ? ((const GAS f32x4*)src[q])[F.lane + 64 * j] : (f32x4){0.f, 0.f, 0.f, 0.f};
#pragma unroll
    for (int q = 0; q < P0R; ++q) { if (mm[q] >= MROWS) continue;
        float s = 0.f;
#pragma unroll
        for (int j = 0; j < 8; ++j) s += (v[q][j].x * v[q][j].x + v[q][j].y * v[q][j].y) + (v[q][j].z * v[q][j].z + v[q][j].w * v[q][j].w);
        const float rstd = rsqrtf(wave_sum(s) * (1.f / DM) + EPSN);
        GAS unsigned long long* o8 = (GAS unsigned long long*)(F.XN() + (size_t)mm[q] * DM) + F.lane;
        if (src[q] == nullptr) { GAS unsigned long long* z8 = (GAS unsigned long long*)(F.MIX() + (size_t)mm[q] * DM) + F.lane;
#pragma unroll
            for (int j = 0; j < 8; ++j) z8[64 * j] = 0ull; }
#pragma unroll
        for (int j = 0; j < 8; ++j) { const f32x4 w = ((const GAS f32x4*)norm_pre)[F.lane + 64 * j];
            o8[64 * j] = (unsigned long long)pk2(v[q][j].x * rstd * w.x, v[q][j].y * rstd * w.y) | ((unsigned long long)pk2(v[q][j].z * rstd * w.z, v[q][j].w * rstd * w.w) << 32); } }
}
__device__ __forceinline__ void p0_prologue(Frame& F, int it_lo, int it_hi, int b_lo, int nb, bool with_rows) { gcf const w_in = ldarg<A_WIN>(); gcf const w_out = ldarg<A_WOUT>();
    LAS float* scr = (LAS float*)(F.lds + SCR_OFF + F.wave * 16640);
    const int gw = ((int)blockIdx.x - b_lo) * NWAVES + F.wave, NGW = nb * NWAVES;
    constexpr int I_IN = (DM / 64) * (NPAD / 64), I_OUT = (DM / 64) * (DM / 64);
    auto mk = [&](int it) { P0Item r; r.on = it < it_hi;
        if (it < I_IN) { r.W = w_in; r.WT = F.WinT(); r.N = NIN; r.kb = it / (NPAD / 64); r.nb = it % (NPAD / 64); }
        else { const int q = r.on ? it - I_IN : 0; r.W = w_out; r.WT = F.WoutT(); r.N = DM; r.kb = q / (DM / 64); r.nb = q % (DM / 64); }
        return r; };
    for (int it = it_lo + gw; it < it_hi; it += 2 * NGW) {
        const P0Item a = mk(it), b = mk(it + NGW);
        f32x4 va[16], vb[16];
        p0_item_load(a, DM, F.lane, va); p0_item_load(b, DM, F.lane, vb);
        p0_item_store(a, DM, F.lane, va, scr); p0_item_store(b, DM, F.lane, vb, scr);
    }
    if (with_rows) {
        gcf const meta = ldarg<A_META>(); gcf const x_prompt = ldarg<A_XP>(); gcf const x_sample = ldarg<A_XS>(); gcf const norm_pre = ldarg<A_NPRE>();
        for (int m = gw; m < MROWS; m += P0R * NGW) p0_rows2(F, m, NGW, meta, x_prompt, x_sample, norm_pre);
    }
}

constexpr int AKP = 72, APP = 168;
constexpr int A_K = 0, A_V = 272 * AKP * 2, A_BIAS = 2 * A_V, A_P = A_BIAS + 2048, A_END = A_P + NWAVES * 16 * APP * 2;
static_assert(A_END <= LDS_BYTES - SCR_OFF, "attention LDS");

struct AttnLds { const LAS unsigned short* AK; const LAS unsigned short* AV; const LAS float* AB; LAS unsigned short* AP; };
template <bool SAMPLE>
__device__ __forceinline__ void attn_tile(Frame& F, const AttnLds& L, const bf16x8 (&qa)[2], int s0, int kmin  ,
                                          int tb, int gb, size_t rowb, gcf sinks, int kvh) {
    int lane = F.lane; asm volatile("" : "+v"(lane));
    const int gq = lane >> 4, i = lane & 15;
    const LAS unsigned short* AK = L.AK; const LAS unsigned short* AV = L.AV; const LAS float* AB = L.AB; LAS unsigned short* AP = L.AP;
    size_t prow[2]; int pcol[2]; v4u gpre[2];
#pragma unroll
    for (int jj = 0; jj < 2; ++jj) { const int q = lane + 64 * jj, rr = q >> 3, ch = q & 7;
        prow[jj] = SAMPLE ? rowb + (rr & 7) : rowb + rr; pcol[jj] = kvh * 256 + (SAMPLE ? gb + (rr >> 3) : gb) * 64 + 8 * ch;
        gpre[jj] = *(const GAS v4u*)(F.P() + prow[jj] * NPAD + C_GA + pcol[jj]); }
    int trow[4], grow[4]; float sinkr[4];
#pragma unroll
    for (int r = 0; r < 4; ++r) { const int rr = 4 * gq + r; trow[r] = SAMPLE ? (rr & 7) : tb + rr; grow[r] = SAMPLE ? gb + (rr >> 3) : gb; sinkr[r] = sinks[kvh * 4 + grow[r]]; }
    f32x4 acc[10];
#pragma unroll
    for (int cb = 0; cb < 10; ++cb) { acc[cb] = (f32x4){0.f, 0.f, 0.f, 0.f};
#pragma unroll
        for (int ks = 0; ks < 2; ++ks) { const bf16x8 kb = *(const LAS bf16x8*)(AK + (s0 + 16 * cb + i) * AKP + 32 * ks + 8 * gq); acc[cb] = MFMA16(qa[ks], kb, acc[cb]); } }
    float mx[4] = {-INFINITY, -INFINITY, -INFINITY, -INFINITY};
#pragma unroll
    for (int cb = 0; cb < 10; ++cb) { const int s = s0 + 16 * cb + i;
#pragma unroll
        for (int r = 0; r < 4; ++r) { const int dist = 128 + trow[r] - s; const bool valid = (dist >= 0) && (dist < 128) && (s >= kmin);
            const int dc = dist < 0 ? 0 : (dist > 127 ? 127 : dist);
            const float v = valid ? acc[cb][r] * 0.125f + AB[grow[r] * 128 + dc] : -INFINITY; acc[cb][r] = v; mx[r] = fmaxf(mx[r], v); } }
    float inv[4];
#pragma unroll
    for (int r = 0; r < 4; ++r) { float m = mx[r];
        m = fmaxf(m, __shfl_xor(m, 1)); m = fmaxf(m, __shfl_xor(m, 2)); m = fmaxf(m, __shfl_xor(m, 4)); m = fmaxf(m, __shfl_xor(m, 8));
        m = fmaxf(m, sinkr[r]); float sum = 0.f;
#pragma unroll
        for (int cb = 0; cb < 10; ++cb) { const float e = __expf(acc[cb][r] - m); acc[cb][r] = e; sum += e; }
        sum += __shfl_xor(sum, 1); sum += __shfl_xor(sum, 2); sum += __shfl_xor(sum, 4); sum += __shfl_xor(sum, 8);
        inv[r] = 1.f / (sum + __expf(sinkr[r] - m)); }
#pragma unroll
    for (int cb = 0; cb < 10; ++cb)
#pragma unroll
        for (int r = 0; r < 4; ++r) AP[(4 * gq + r) * APP + 16 * cb + i] = f2bf16(acc[cb][r]);
    LDS_WAIT(); asm volatile("" ::: "memory");
    f32x4 o[4];
#pragma unroll
    for (int db = 0; db < 4; ++db) o[db] = (f32x4){0.f, 0.f, 0.f, 0.f};
#pragma unroll
    for (int kk = 0; kk < 5; ++kk) { const bf16x8 pa = *(const LAS bf16x8*)(AP + i * APP + 32 * kk + 8 * gq);
#pragma unroll
        for (int db = 0; db < 4; ++db) { const bf16x8 vb = tr_frag(AV, s0 + 32 * kk + 8 * gq, 16 * db, AKP, lane); o[db] = MFMA16(pa, vb, o[db]); } }
    LDS_WAIT(); asm volatile("" ::: "memory");
#pragma unroll
    for (int r = 0; r < 4; ++r)
#pragma unroll
        for (int db = 0; db < 4; ++db) AP[(4 * gq + r) * APP + 16 * db + i] = f2bf16(o[db][r] * inv[r]);
    LDS_WAIT(); asm volatile("" ::: "memory");
#pragma unroll
    for (int jj = 0; jj < 2; ++jj) { const int q = lane + 64 * jj, rr = q >> 3, ch = q & 7;
        const v4u ov = *(const LAS v4u*)(AP + rr * APP + 8 * ch); const v4u gv = gpre[jj];
        v4u res;
        res.x = pk2(bf2f(ov.x & 0xffff) * silu_f(bf2f(gv.x & 0xffff)), bf2f(ov.x >> 16) * silu_f(bf2f(gv.x >> 16)));
        res.y = pk2(bf2f(ov.y & 0xffff) * silu_f(bf2f(gv.y & 0xffff)), bf2f(ov.y >> 16) * silu_f(bf2f(gv.y >> 16)));
        res.z = pk2(bf2f(ov.z & 0xffff) * silu_f(bf2f(gv.z & 0xffff)), bf2f(ov.z >> 16) * silu_f(bf2f(gv.z >> 16)));
        res.w = pk2(bf2f(ov.w & 0xffff) * silu_f(bf2f(gv.w & 0xffff)), bf2f(ov.w >> 16) * silu_f(bf2f(gv.w >> 16)));
        *(GAS v4u*)(F.MIX() + prow[jj] * DM + pcol[jj]) = res; }
    LDS_WAIT(); asm volatile("" ::: "memory");
}

__device__ __forceinline__ void attn_bias_table(Frame& F, LAS float* AB, int kvh) { gcf const rel_bias = ldarg<A_RELB>();
    const int g = F.tid >> 7, d = F.tid & 127;
    int bk = d;
    if (d >= 16) { bk = 16 + (int)(__logf((float)d * (1.f / 16.f)) * (16.f / 2.0794415416798357f)); bk = bk > 31 ? 31 : bk; }
    AB[g * 128 + d] = rel_bias[bk * 16 + kvh * 4 + g];
}

__device__ __forceinline__ void attn_prompt_unit(Frame& F0, LAS unsigned char* scr, int b, int n, int kvh) { Frame F = F0; asm volatile("" : "+v"(F.tid), "+v"(F.lane));     gcf const sinks = ldarg<A_SINK>();
    LAS unsigned short* AK = (LAS unsigned short*)(scr + A_K); LAS unsigned short* AV = (LAS unsigned short*)(scr + A_V);
    __syncthreads();
    const long wrow0 = (long)b * LP + 128 * (n - 1);
#pragma unroll
    for (int j = 0; j < 4; ++j) { const int c = F.tid + 512 * j, row = c >> 3, ch = c & 7; const long gr = wrow0 + row;
        v4u kv = (v4u){0u, 0u, 0u, 0u}, vv = kv;
        if (gr >= 0) { const bf16* p = F.P() + (size_t)gr * NPAD + kvh * 64 + 8 * ch; kv = *(const GAS v4u*)(p + C_KA); vv = *(const GAS v4u*)(p + C_VA); }
        *(LAS v4u*)(AK + row * AKP + 8 * ch) = kv; *(LAS v4u*)(AV + row * AKP + 8 * ch) = vv; }
    if (F.tid < 128) { const int row = 256 + (F.tid >> 3), ch = F.tid & 7; *(LAS v4u*)(AK + row * AKP + 8 * ch) = (v4u){0u, 0u, 0u, 0u}; *(LAS v4u*)(AV + row * AKP + 8 * ch) = (v4u){0u, 0u, 0u, 0u}; }
    attn_bias_table(F, (LAS float*)(scr + A_BIAS), kvh);
    __syncthreads();
    const AttnLds L{AK, AV, (const LAS float*)(scr + A_BIAS), (LAS unsigned short*)(scr + A_P) + F.wave * 16 * APP};
    const int gq = F.lane >> 4, i = F.lane & 15, t0 = (n == 0) ? 112 : 16 * F.wave;
    const int kmin = FPAD - 128 * (n - 1);
    const size_t rbase = (size_t)b * LP + 128 * n;
    const int g_lo = (n == 0) ? F.wave : 0, g_hi = (n == 0) ? (F.wave < 4 ? F.wave + 1 : 0) : 4;
    bf16x8 qn[2] = {(bf16x8){0, 0, 0, 0, 0, 0, 0, 0}, (bf16x8){0, 0, 0, 0, 0, 0, 0, 0}};
    if (g_lo < g_hi) { const bf16* qp = F.P() + (rbase + t0 + i) * NPAD + C_QA + (kvh * 4 + g_lo) * 64; qn[0] = *(const GAS bf16x8*)(qp + 8 * gq); qn[1] = *(const GAS bf16x8*)(qp + 32 + 8 * gq); }
#pragma unroll 1
    for (int g = g_lo; g < g_hi; ++g) {
        const bf16x8 qa[2] = {qn[0], qn[1]};
        if (g + 1 < g_hi) { const bf16* qp = F.P() + (rbase + t0 + i) * NPAD + C_QA + (kvh * 4 + g + 1) * 64; qn[0] = *(const GAS bf16x8*)(qp + 8 * gq); qn[1] = *(const GAS bf16x8*)(qp + 32 + 8 * gq); }
        attn_tile<false>(F, L, qa, t0, kmin, t0, g, rbase + t0, sinks, kvh);
    }
    if (n == NBLK - 1) {
#pragma unroll
        for (int j = 0; j < 16; ++j) { const int e = F.tid + 512 * j, row = e >> 6, d = e & 63;
            const size_t oidx = (((size_t)b * WIN + row) * 4 + kvh) * 64 + d;
            F.out[O_KWP + oidx] = bf2f(AK[(128 + row) * AKP + d]); F.out[O_VWP + oidx] = bf2f(AV[(128 + row) * AKP + d]); }
    }
}

__device__ __forceinline__ void attn_sample_stage(Frame& F, LAS unsigned short* AK, LAS unsigned short* AV, int db, int kvh, gcf cache_k, gcf cache_v) {
#pragma unroll
    for (int j = 0; j < 4; ++j) { const int c = F.tid + 512 * j, row = c >> 4, ch = c & 15;
        const size_t src = (((size_t)db * WIN + row) * 4 + kvh) * 64 + 4 * ch;
        const f32x4 kv = *(const GAS f32x4*)(cache_k + src), vv = *(const GAS f32x4*)(cache_v + src);
        *(LAS unsigned long long*)(AK + row * AKP + 4 * ch) = (unsigned long long)pk2(kv.x, kv.y) | ((unsigned long long)pk2(kv.z, kv.w) << 32);
        *(LAS unsigned long long*)(AV + row * AKP + 4 * ch) = (unsigned long long)pk2(vv.x, vv.y) | ((unsigned long long)pk2(vv.z, vv.w) << 32);
        if (row >= DSEQ) { const size_t dst = (((size_t)db * WIN + row - DSEQ) * 4 + kvh) * 64 + 4 * ch; *(GAS f32x4*)(F.out + O_KWS + dst) = kv; *(GAS f32x4*)(F.out + O_VWS + dst) = vv; } }
    const size_t srow0 = (size_t)ROWS_P + (size_t)db * DSEQ;
    if (F.tid < 64) { const int t = F.tid >> 3, ch = F.tid & 7; const bf16* p = F.P() + (srow0 + t) * NPAD + kvh * 64 + 8 * ch;
        const v4u kv = *(const GAS v4u*)(p + C_KA), vv = *(const GAS v4u*)(p + C_VA);
        *(LAS v4u*)(AK + (128 + t) * AKP + 8 * ch) = kv; *(LAS v4u*)(AV + (128 + t) * AKP + 8 * ch) = vv;
        const size_t dst = (((size_t)db * WIN + (WIN - DSEQ) + t) * 4 + kvh) * 64 + 8 * ch;
        f32x4 a, c2; a.x = bf2f(kv.x & 0xffff); a.y = bf2f(kv.x >> 16); a.z = bf2f(kv.y & 0xffff); a.w = bf2f(kv.y >> 16); c2.x = bf2f(kv.z & 0xffff); c2.y = bf2f(kv.z >> 16); c2.z = bf2f(kv.w & 0xffff); c2.w = bf2f(kv.w >> 16);
        *(GAS f32x4*)(F.out + O_KWS + dst) = a; *(GAS f32x4*)(F.out + O_KWS + dst + 4) = c2;
        a.x = bf2f(vv.x & 0xffff); a.y = bf2f(vv.x >> 16); a.z = bf2f(vv.y & 0xffff); a.w = bf2f(vv.y >> 16); c2.x = bf2f(vv.z & 0xffff); c2.y = bf2f(vv.z >> 16); c2.z = bf2f(vv.w & 0xffff); c2.w = bf2f(vv.w >> 16);
        *(GAS f32x4*)(F.out + O_VWS + dst) = a; *(GAS f32x4*)(F.out + O_VWS + dst + 4) = c2; }
    if (F.tid >= 64 && F.tid < 64 + 192) { const int c = F.tid - 64, row = 136 + (c >> 3), ch = c & 7; *(LAS v4u*)(AK + row * AKP + 8 * ch) = (v4u){0u, 0u, 0u, 0u}; *(LAS v4u*)(AV + row * AKP + 8 * ch) = (v4u){0u, 0u, 0u, 0u}; }
}
__device__ __forceinline__ void attn_sample_tiles(Frame& F, const AttnLds& L, int db, int kvh, int wl, gcf sinks) {
    const int gq = F.lane >> 4, i = F.lane & 15; const size_t srow0 = (size_t)ROWS_P + (size_t)db * DSEQ;
    const bf16* qptr = F.P() + (srow0 + (i & 7)) * NPAD + C_QA + (kvh * 4 + 2 * wl + (i >> 3)) * 64;
    const bf16x8 qa[2] = {*(const GAS bf16x8*)(qptr + 8 * gq), *(const GAS bf16x8*)(qptr + 32 + 8 * gq)};
    attn_tile<true>(F, L, qa, 0, 0, 0, 2 * wl, srow0, sinks, kvh);
}
__device__ __forceinline__ void attn_sample_unit(Frame& F0, LAS unsigned char* scr, int u) { Frame F = F0; asm volatile("" : "+v"(F.tid), "+v"(F.lane));
    gcf const cache_k = ldarg<A_CK>(); gcf const cache_v = ldarg<A_CV>(); gcf const sinks = ldarg<A_SINK>();
    const int kvh = u & 3, db = u >> 2;
    LAS unsigned short* AK = (LAS unsigned short*)(scr + A_K); LAS unsigned short* AV = (LAS unsigned short*)(scr + A_V);
    __syncthreads();
    attn_sample_stage(F, AK, AV, db, kvh, cache_k, cache_v);
    attn_bias_table(F, (LAS float*)(scr + A_BIAS), kvh);
    __syncthreads();
    if (F.wave < 2) { const AttnLds L{AK, AV, (const LAS float*)(scr + A_BIAS), (LAS unsigned short*)(scr + A_P) + F.wave * 16 * APP}; attn_sample_tiles(F, L, db, kvh, F.wave, sinks); }
}
constexpr int SP_SLOT = 160 * AKP * 2, SP_BIAS = 4 * SP_SLOT, SP_P = SP_BIAS + 2048, SP_END = SP_P + 4 * 16 * APP * 2;
static_assert(SP_END <= LDS_BYTES - SCR_OFF, "sample pair LDS");
__device__ __forceinline__ void attn_sample_pair(Frame& F0, LAS unsigned char* scr, int u0, int u1) { Frame F = F0; asm volatile("" : "+v"(F.tid), "+v"(F.lane));
    gcf const cache_k = ldarg<A_CK>(); gcf const cache_v = ldarg<A_CV>(); gcf const sinks = ldarg<A_SINK>();
    const int kvh = u0 & 3;
    LAS unsigned short* K0 = (LAS unsigned short*)(scr); LAS unsigned short* V0 = (LAS unsigned short*)(scr + SP_SLOT);
    LAS unsigned short* K1 = (LAS unsigned short*)(scr + 2 * SP_SLOT); LAS unsigned short* V1 = (LAS unsigned short*)(scr + 3 * SP_SLOT);
    __syncthreads();
    attn_sample_stage(F, K0, V0, u0 >> 2, kvh, cache_k, cache_v);
    attn_sample_stage(F, K1, V1, u1 >> 2, kvh, cache_k, cache_v);
    attn_bias_table(F, (LAS float*)(scr + SP_BIAS), kvh);
    __syncthreads();
    if (F.wave < 4) { const int sl = F.wave >> 1;
        const AttnLds L{sl ? K1 : K0, sl ? V1 : V0, (const LAS float*)(scr + SP_BIAS), (LAS unsigned short*)(scr + SP_P) + F.wave * 16 * APP};
        attn_sample_tiles(F, L, (sl ? u1 : u0) >> 2, kvh, F.wave & 1, sinks); }
}

constexpr int GQP = 136, GVP = 264;
constexpr int G_Q = 0, G_K = 128 * GQP * 2, G_V = 2 * G_K, G_Z = G_V + 128 * GVP * 2, G_TOT = G_Z + 8192, G_D = G_TOT + 2048, G_END = G_D + 512;
static_assert(G_END <= LDS_BYTES - SCR_OFF, "GLA LDS");

template <bool NEED_Q>
__device__ __forceinline__ void gla_gate(Frame& F, LAS unsigned char* scr, int b, int c, int h) { gcf const w_a2 = ldarg<A_WA2>(); gcf const b_a = ldarg<A_BA>();
    LAS unsigned short* GQ = (LAS unsigned short*)(scr + G_Q); LAS unsigned short* GK = (LAS unsigned short*)(scr + G_K); LAS unsigned short* GV = (LAS unsigned short*)(scr + G_V);
    LAS float* GD = (LAS float*)(scr + G_D);
    const size_t R0 = (size_t)b * LP + 128 * c;
    const int lane = F.lane, gq = lane >> 4, i = lane & 15, w = F.wave;
    __syncthreads();
    bf16x8 za[8]; bf16x8 wh, wl; float ba;
    {
        v4u vv[8], kk[4], qq[4];
#pragma unroll
        for (int j = 0; j < 8; ++j) { const int cc = F.tid + 512 * j, row = cc >> 5, ch = cc & 31; vv[j] = *(const GAS v4u*)(F.P() + (R0 + row) * NPAD + C_VG + h * 256 + 8 * ch); }
#pragma unroll
        for (int j = 0; j < 4; ++j) { const int cc = F.tid + 512 * j, row = cc >> 4, ch = cc & 15; const bf16* p = F.P() + (R0 + row) * NPAD + h * 128 + 8 * ch;
            kk[j] = *(const GAS v4u*)(p + C_KG); if (NEED_Q) qq[j] = *(const GAS v4u*)(p + C_QG); }
#pragma unroll
        for (int tb = 0; tb < 8; ++tb) za[tb] = (gq < 2) ? *(const GAS bf16x8*)(F.P() + (R0 + 16 * tb + i) * NPAD + C_ZG + 8 * gq) : (bf16x8){0, 0, 0, 0, 0, 0, 0, 0};
#pragma unroll
        for (int j = 0; j < 8; ++j) { const float wv = (gq < 2) ? w_a2[(8 * gq + j) * 512 + h * 128 + 16 * w + i] : 0.f; const unsigned short hi = f2bf16(wv); wh[j] = (short)hi; wl[j] = (short)f2bf16(wv - bf2f(hi)); }
        ba = b_a[h * 128 + 16 * w + i];
#pragma unroll
        for (int j = 0; j < 8; ++j) { const int cc = F.tid + 512 * j, row = cc >> 5, ch = cc & 31; *(LAS v4u*)(GV + row * GVP + 8 * ch) = vv[j]; }
#pragma unroll
        for (int j = 0; j < 4; ++j) { const int cc = F.tid + 512 * j, row = cc >> 4, ch = cc & 15; *(LAS v4u*)(GK + row * GQP + 8 * ch) = kk[j]; if (NEED_Q) *(LAS v4u*)(GQ + row * GQP + 8 * ch) = qq[j]; }
    }
    f32x4 bc[8]; float run = 0.f;
#pragma unroll
    for (int tb = 0; tb < 8; ++tb) { f32x4 x = (f32x4){ba, ba, ba, ba}; x = MFMA16(za[tb], wh, x); x = MFMA16(za[tb], wl, x);
        float l0 = logsig_f(x[0]) * (1.f / 16.f), l1 = logsig_f(x[1]) * (1.f / 16.f), l2 = logsig_f(x[2]) * (1.f / 16.f), l3 = logsig_f(x[3]) * (1.f / 16.f);
        if (c == 0) { const int t0 = 16 * tb + 4 * gq; if (t0 + 0 < FPAD) l0 = 0.f; if (t0 + 1 < FPAD) l1 = 0.f; if (t0 + 2 < FPAD) l2 = 0.f; if (t0 + 3 < FPAD) l3 = 0.f; }
        const float p0 = l0, p1 = p0 + l1, p2 = p1 + l2, p3 = p2 + l3;
        float a = p3; const float u1 = __shfl_up(a, 16); if (gq >= 1) a += u1; const float u2 = __shfl_up(a, 32); if (gq >= 2) a += u2;
        const float excl = a - p3, tot = __shfl(a, 48 + i);
        bc[tb] = (f32x4){run + excl + p0, run + excl + p1, run + excl + p2, run + excl + p3}; run += tot; }
    __syncthreads();
#pragma unroll
    for (int tb = 0; tb < 8; ++tb)
#pragma unroll
        for (int r = 0; r < 4; ++r) { const int t = 16 * tb + 4 * gq + r, k = 16 * w + i; const float bt = bc[tb][r];
            GK[t * GQP + k] = f2bf16(bf2f(GK[t * GQP + k]) * __expf(-bt));
            if (NEED_Q) GQ[t * GQP + k] = f2bf16(bf2f(GQ[t * GQP + k]) * __expf(bt) * 0.08838834764831845f); }
    if (gq == 0) GD[16 * w + i] = __expf(run);
    __syncthreads();
}

__device__ __forceinline__ void gla_ds_unit(Frame& F0, LAS unsigned char* scr, int b, int c, int h) { Frame F = F0; asm volatile("" : "+v"(F.tid), "+v"(F.lane));
    const int u = (b * NBLK + c) * 4 + h;
    gla_gate<true>(F, scr, b, c, h);
    if (c != 0) {
        const LAS unsigned short* GQs = (const LAS unsigned short*)(scr + G_Q); const LAS unsigned short* GKs = (const LAS unsigned short*)(scr + G_K);
        bf16* qt = F.QT() + (size_t)u * 16384; bf16* kt = F.KT() + (size_t)u * 16384;
#pragma unroll
        for (int j = 0; j < 4; ++j) { const int cc = F.tid + 512 * j, row = cc >> 4, ch = cc & 15;
            *(GAS v4u*)(qt + row * 128 + 8 * ch) = *(const LAS v4u*)(GQs + row * GQP + 8 * ch); *(GAS v4u*)(kt + row * 128 + 8 * ch) = *(const LAS v4u*)(GKs + row * GQP + 8 * ch); } }
    const LAS unsigned short* GK = (const LAS unsigned short*)(scr + G_K); const LAS unsigned short* GV = (const LAS unsigned short*)(scr + G_V); const LAS float* GD = (const LAS float*)(scr + G_D);
    int lane = F.lane; asm volatile("" : "+v"(lane));
    const int gq = lane >> 4, i = lane & 15, w = F.wave;
    f32x4 acc[8][2];
#pragma unroll
    for (int rb = 0; rb < 8; ++rb) { acc[rb][0] = (f32x4){0.f, 0.f, 0.f, 0.f}; acc[rb][1] = (f32x4){0.f, 0.f, 0.f, 0.f}; }
#pragma unroll
    for (int ks = 0; ks < 4; ++ks) {
        if (c == 0 && ks < 3) continue;
        const bf16x8 vb0 = tr_frag(GV, 32 * ks + 8 * gq, 32 * w, GVP, lane), vb1 = tr_frag(GV, 32 * ks + 8 * gq, 32 * w + 16, GVP, lane);
#pragma unroll
        for (int rb = 0; rb < 8; ++rb) { const bf16x8 ka = tr_frag(GK, 32 * ks + 8 * gq, 16 * rb, GQP, lane); acc[rb][0] = MFMA16(ka, vb0, acc[rb][0]); acc[rb][1] = MFMA16(ka, vb1, acc[rb][1]); } }
    bf16* dst = (bf16*)F.dST() + (size_t)u * 32768;
#pragma unroll
    for (int rb = 0; rb < 8; ++rb) { const f32x4 d4 = *(const LAS f32x4*)(GD + 16 * rb + 4 * gq);
#pragma unroll
        for (int cb = 0; cb < 2; ++cb) { const f32x4 o = acc[rb][cb] * d4; *(GAS unsigned long long*)(dst + (size_t)(32 * w + 16 * cb + i) * 128 + 16 * rb + 4 * gq) = (unsigned long long)pk2(o[0], o[1]) | ((unsigned long long)pk2(o[2], o[3]) << 32); } }
    if (F.tid < 128) F.dec()[(size_t)u * 128 + F.tid] = GD[F.tid];
}

__device__ __forceinline__ void gla_scan(Frame& F) {
    for (int e = blockIdx.x * NTHREADS + F.tid; e < NBATCH * 4 * 256 * 64; e += F.G * NTHREADS) {
        const int k2 = e & 63, v = (e >> 6) & 255, bh = e >> 14, b = bh >> 2, h = bh & 3;
        float s0 = 0.f, s1 = 0.f;
#pragma unroll 1
        for (int c0 = 0; c0 < NBLK; c0 += 11) {
            f32x2 d[11], ds[11];
#pragma unroll
            for (int q = 0; q < 11; ++q) { const size_t u = ((size_t)b * NBLK + c0 + q) * 4 + h;
                d[q] = *(const GAS f32x2*)(F.dec() + u * 128 + 2 * k2); { const unsigned dv = *(const GAS unsigned*)((const bf16*)F.dST() + u * 32768 + (size_t)v * 128 + 2 * k2); ds[q] = (f32x2){bf2f((unsigned short)dv), bf2f((unsigned short)(dv >> 16))}; } }
#pragma unroll
            for (int q = 0; q < 11; ++q) { const size_t u = ((size_t)b * NBLK + c0 + q) * 4 + h;
                *(GAS unsigned*)(F.St() + u * 32768 + (size_t)v * 128 + 2 * k2) = pk2(s0, s1);
                s0 = d[q].x * s0 + ds[q].x; s1 = d[q].y * s1 + ds[q].y; }
        }
        float* gp = F.out + O_GP + ((size_t)bh * 128 + 2 * k2) * 256 + v; gp[0] = s0; gp[256] = s1;
    }
}

__device__ __forceinline__ void gla_out_unit(Frame& F0, LAS unsigned char* scr, int b, int c, int h) { Frame F = F0; asm volatile("" : "+v"(F.tid), "+v"(F.lane)); gcf const gla_norm = ldarg<A_GNORM>();
    const int u = (b * NBLK + c) * 4 + h;
    const bf16* St = F.St() + (size_t)u * 32768; const size_t R0 = (size_t)b * LP + 128 * c;
    v4u stp[8], gvp[8];
#pragma unroll
    for (int j = 0; j < 8; ++j) { const int cc = F.tid + 512 * j; stp[j] = (c != 0) ? *(const GAS v4u*)(St + (size_t)(cc >> 4) * 128 + 8 * (cc & 15)) : (v4u){0u, 0u, 0u, 0u}; }
#pragma unroll
    for (int j = 0; j < 8; ++j) { const int q = F.lane + 64 * j, row = 16 * F.wave + (q >> 5), ch = q & 31; gvp[j] = *(const GAS v4u*)(F.P() + (R0 + row) * NPAD + C_GG + h * 256 + 8 * ch); }
    if (c == 0) gla_gate<true>(F, scr, b, c, h);
    else {
        LAS unsigned short* GQs = (LAS unsigned short*)(scr + G_Q); LAS unsigned short* GKs = (LAS unsigned short*)(scr + G_K); LAS unsigned short* GVs = (LAS unsigned short*)(scr + G_V);
        const bf16* qt = F.QT() + (size_t)u * 16384; const bf16* kt = F.KT() + (size_t)u * 16384;
        __syncthreads();
        v4u vv[8], qq[4], kk[4];
#pragma unroll
        for (int j = 0; j < 8; ++j) { const int cc = F.tid + 512 * j, row = cc >> 5, ch = cc & 31; vv[j] = *(const GAS v4u*)(F.P() + (R0 + row) * NPAD + C_VG + h * 256 + 8 * ch); }
#pragma unroll
        for (int j = 0; j < 4; ++j) { const int cc = F.tid + 512 * j, row = cc >> 4, ch = cc & 15; qq[j] = *(const GAS v4u*)(qt + row * 128 + 8 * ch); kk[j] = *(const GAS v4u*)(kt + row * 128 + 8 * ch); }
#pragma unroll
        for (int j = 0; j < 8; ++j) { const int cc = F.tid + 512 * j, row = cc >> 5, ch = cc & 31; *(LAS v4u*)(GVs + row * GVP + 8 * ch) = vv[j]; }
#pragma unroll
        for (int j = 0; j < 4; ++j) { const int cc = F.tid + 512 * j, row = cc >> 4, ch = cc & 15; *(LAS v4u*)(GQs + row * GQP + 8 * ch) = qq[j]; *(LAS v4u*)(GKs + row * GQP + 8 * ch) = kk[j]; }
        __syncthreads();
    }
    const LAS unsigned short* GQ = (const LAS unsigned short*)(scr + G_Q); LAS unsigned short* GK = (LAS unsigned short*)(scr + G_K); const LAS unsigned short* GV = (const LAS unsigned short*)(scr + G_V);
    int lane = F.lane; asm volatile("" : "+v"(lane));
    const int gq = lane >> 4, i = lane & 15, w = F.wave;
    const bool active = true;
    bf16x8 qa[4];
#pragma unroll
    for (int ks = 0; ks < 4; ++ks) qa[ks] = *(const LAS bf16x8*)(GQ + (16 * w + i) * GQP + 32 * ks + 8 * gq);
    f32x4 aa[8];
#pragma unroll
    for (int sb = 0; sb < 8; ++sb) { aa[sb] = (f32x4){0.f, 0.f, 0.f, 0.f};
        if (active && sb <= w) {
#pragma unroll
            for (int ks = 0; ks < 4; ++ks) { const bf16x8 kb = *(const LAS bf16x8*)(GK + (16 * sb + i) * GQP + 32 * ks + 8 * gq); aa[sb] = MFMA16(qa[ks], kb, aa[sb]); } } }
    __syncthreads();
    f32x4 acc[16];
#pragma unroll
    for (int cb = 0; cb < 16; ++cb) acc[cb] = (f32x4){0.f, 0.f, 0.f, 0.f};
    if (active) {
#pragma unroll
    for (int sb = 0; sb < 8; ++sb)
#pragma unroll
        for (int r = 0; r < 4; ++r) { const int t = 16 * w + 4 * gq + r, s = 16 * sb + i; GK[t * GQP + s] = f2bf16(s <= t ? aa[sb][r] : 0.f); }
    LDS_WAIT(); asm volatile("" ::: "memory");
#pragma unroll
    for (int ks = 0; ks < 4; ++ks) {
        if (2 * ks <= w) {
            const bf16x8 af = *(const LAS bf16x8*)(GK + (16 * w + i) * GQP + 32 * ks + 8 * gq);
#pragma unroll
            for (int cb = 0; cb < 16; ++cb) { const bf16x8 vb = tr_frag(GV, 32 * ks + 8 * gq, 16 * cb, GVP, lane); acc[cb] = MFMA16(af, vb, acc[cb]); } } }
    }
    __syncthreads();
    { LAS unsigned char* GS = scr + G_V;
#pragma unroll
      for (int j = 0; j < 8; ++j) { const int cc = F.tid + 512 * j, v = cc >> 4, ch = cc & 15; *(LAS v4u*)(GS + v * 256 + ((ch ^ (v & 15)) << 4)) = stp[j]; } }
    __syncthreads();
    if (active) {
    if (c != 0) {
        const LAS unsigned char* GS = scr + G_V;
#pragma unroll
    for (int ks = 0; ks < 4; ++ks)
#pragma unroll
        for (int cb = 0; cb < 16; ++cb) { const bf16x8 sb = *(const LAS bf16x8*)(GS + (16 * cb + i) * 256 + (((4 * ks + gq) ^ i) << 4)); acc[cb] = MFMA16(qa[ks], sb, acc[cb]); }
    }
    LDS_WAIT(); asm volatile("" ::: "memory");
    { LAS unsigned short* GQw = (LAS unsigned short*)(scr + G_Q);
#pragma unroll
    for (int r = 0; r < 4; ++r) { float ss = 0.f;
#pragma unroll
        for (int cb = 0; cb < 16; ++cb) ss += acc[cb][r] * acc[cb][r];
        ss += __shfl_xor(ss, 1); ss += __shfl_xor(ss, 2); ss += __shfl_xor(ss, 4); ss += __shfl_xor(ss, 8);
        const float rstd = rsqrtf(ss * (1.f / 256.f) + EPSN); const int row = 16 * w + 4 * gq + r;
#pragma unroll
        for (int cb = 0; cb < 8; ++cb) { GQw[row * GQP + 16 * cb + i] = f2bf16(acc[cb][r] * rstd); GK[row * GQP + 16 * cb + i] = f2bf16(acc[cb + 8][r] * rstd); } }
    LDS_WAIT(); asm volatile("" ::: "memory");
#pragma unroll
    for (int j = 0; j < 8; ++j) { const int q = lane + 64 * j, row = 16 * w + (q >> 5), ch = q & 31;
        const v4u ov = *(const LAS v4u*)((ch < 16 ? GQw : GK) + row * GQP + 8 * (ch & 15));
        const v4u gv = gvp[j];
        const f32x4 n0 = *(const GAS f32x4*)(gla_norm + 8 * ch), n1 = *(const GAS f32x4*)(gla_norm + 8 * ch + 4);
        v4u res;
        res.x = pk2(bf2f(ov.x & 0xffff) * n0.x * silu_f(bf2f(gv.x & 0xffff)), bf2f(ov.x >> 16) * n0.y * silu_f(bf2f(gv.x >> 16)));
        res.y = pk2(bf2f(ov.y & 0xffff) * n0.z * silu_f(bf2f(gv.y & 0xffff)), bf2f(ov.y >> 16) * n0.w * silu_f(bf2f(gv.y >> 16)));
        res.z = pk2(bf2f(ov.z & 0xffff) * n1.x * silu_f(bf2f(gv.z & 0xffff)), bf2f(ov.z >> 16) * n1.y * silu_f(bf2f(gv.z >> 16)));
        res.w = pk2(bf2f(ov.w & 0xffff) * n1.z * silu_f(bf2f(gv.w & 0xffff)), bf2f(ov.w >> 16) * n1.w * silu_f(bf2f(gv.w >> 16)));
        *(GAS v4u*)(F.MIX() + (R0 + row) * DM + 1024 + h * 256 + 8 * ch) = res; } }
    }
}

constexpr int S_Q = 0, S_KH = 4096, S_KT = 8192, S_LG = 12288, S_D = 16384, S_A = 16896, S_Z = 17152, S_OP = 17664, S_END = S_OP + 65536;
static_assert(S_END <= LDS_BYTES - SCR_OFF, "sample GLA LDS");
__device__ __forceinline__ void gla_sample_unit(Frame& F0, LAS unsigned char* scr, int u) { Frame F = F0; asm volatile("" : "+v"(F.tid), "+v"(F.lane));
    gcf const w_a2 = ldarg<A_WA2>(); gcf const b_a = ldarg<A_BA>(); gcf const state = ldarg<A_STATE>(); gcf const gla_norm = ldarg<A_GNORM>();
    const int h = u & 3, db = u >> 2;
    LAS float* SQ = (LAS float*)(scr + S_Q); LAS float* SKH = (LAS float*)(scr + S_KH); LAS float* SKT = (LAS float*)(scr + S_KT); LAS float* SLG = (LAS float*)(scr + S_LG); LAS float* SD = (LAS float*)(scr + S_D);
    LAS float* SA = (LAS float*)(scr + S_A); LAS float* SZ = (LAS float*)(scr + S_Z); LAS float* SOP = (LAS float*)(scr + S_OP);
    const size_t R0 = (size_t)ROWS_P + (size_t)db * DSEQ;
    const int w = F.wave, lane = F.lane;
    const int k = F.tid & 127, tp = F.tid >> 7;
    const bf16 zraw = F.P()[(R0 + ((F.tid & 127) >> 4)) * NPAD + C_ZG + (F.tid & 15)];
    float qv[2], kv[2], wv[16];
#pragma unroll
    for (int q = 0; q < 2; ++q) { const bf16* p = F.P() + (R0 + 2 * tp + q) * NPAD + h * 128 + k; qv[q] = bf2f(p[C_QG]); kv[q] = bf2f(p[C_KG]); }
#pragma unroll
    for (int r = 0; r < 16; ++r) wv[r] = w_a2[r * 512 + h * 128 + k];
    const float ba = b_a[h * 128 + k];
    f32x4 st[16];
    { const GAS f32x4* sp = (const GAS f32x4*)(state + ((size_t)u * 128 + 16 * w) * 256) + lane;
#pragma unroll
      for (int kk = 0; kk < 16; ++kk) st[kk] = sp[64 * kk]; }
    unsigned long long pvr[8];
#pragma unroll
    for (int t = 0; t < 8; ++t) pvr[t] = *(const GAS unsigned long long*)(F.P() + (R0 + t) * NPAD + C_VG + h * 256 + 4 * lane);
    const unsigned long long gv = *(const GAS unsigned long long*)(F.P() + (R0 + w) * NPAD + C_GG + h * 256 + 4 * lane); const f32x4 gn = *(const GAS f32x4*)(gla_norm + 4 * lane);
    __syncthreads();
    if (F.tid < 128) SZ[F.tid] = bf2f(zraw);
    __syncthreads();
#pragma unroll
    for (int q = 0; q < 2; ++q) { const int t = 2 * tp + q; float x = ba;
#pragma unroll
        for (int r = 0; r < 16; ++r) x += SZ[t * 16 + r] * wv[r];
        SLG[t * 128 + k] = logsig_f(x) * (1.f / 16.f); }
    __syncthreads();
    { float run = 0.f, bt[2] = {0.f, 0.f};
#pragma unroll
      for (int t = 0; t < 8; ++t) { run += SLG[t * 128 + k]; if (t == 2 * tp) bt[0] = run; if (t == 2 * tp + 1) bt[1] = run; }
#pragma unroll
      for (int q = 0; q < 2; ++q) { const int t = 2 * tp + q;
          SQ[k * 8 + t] = qv[q] * __expf(bt[q]) * 0.08838834764831845f; SKT[k * 8 + t] = kv[q] * __expf(-bt[q]); SKH[k * 8 + t] = kv[q] * __expf(run - bt[q]); }
      if (tp == 0) SD[k] = __expf(run); }
    __syncthreads();
    if (F.tid < 64) { const int t = F.tid >> 3, s2 = F.tid & 7; float a = 0.f;
        if (s2 <= t) { for (int kk = 0; kk < 128; ++kk) a += SQ[kk * 8 + t] * SKT[kk * 8 + s2]; }
        SA[t * 8 + s2] = a; }
    f32x4 vv[8];
    {   f32x4 op[8];
#pragma unroll
        for (int t = 0; t < 8; ++t) { const unsigned long long pv = pvr[t];
            vv[t] = (f32x4){bf2f((unsigned short)pv), bf2f((unsigned short)(pv >> 16)), bf2f((unsigned short)(pv >> 32)), bf2f((unsigned short)(pv >> 48))}; op[t] = (f32x4){0.f, 0.f, 0.f, 0.f}; }
        GAS f32x4* np = (GAS f32x4*)(F.out + O_GS + ((size_t)u * 128 + 16 * w) * 256) + lane;
#pragma unroll
        for (int kk = 0; kk < 16; ++kk) { const int kc = 16 * w + kk; const f32x4 s0 = st[kk];
            const f32x4 q0 = *(const LAS f32x4*)(SQ + kc * 8), q1 = *(const LAS f32x4*)(SQ + kc * 8 + 4), h0 = *(const LAS f32x4*)(SKH + kc * 8), h1 = *(const LAS f32x4*)(SKH + kc * 8 + 4);
            f32x4 sn = s0 * SD[kc];
            sn += vv[0] * h0.x + vv[1] * h0.y + vv[2] * h0.z + vv[3] * h0.w + vv[4] * h1.x + vv[5] * h1.y + vv[6] * h1.z + vv[7] * h1.w;
            np[64 * kk] = sn;
            op[0] += s0 * q0.x; op[1] += s0 * q0.y; op[2] += s0 * q0.z; op[3] += s0 * q0.w; op[4] += s0 * q1.x; op[5] += s0 * q1.y; op[6] += s0 * q1.z; op[7] += s0 * q1.w; }
#pragma unroll
        for (int t = 0; t < 8; ++t) *(LAS f32x4*)(SOP + (w * 8 + t) * 256 + 4 * lane) = op[t];
    }
    __syncthreads();
    {   const int t = w; f32x4 a = (f32x4){0.f, 0.f, 0.f, 0.f};
#pragma unroll
        for (int w2 = 0; w2 < 8; ++w2) a += *(const LAS f32x4*)(SOP + (w2 * 8 + t) * 256 + 4 * lane);
#pragma unroll
        for (int s2 = 0; s2 < 8; ++s2) a += vv[s2] * SA[t * 8 + s2];
        const float ss = (a.x * a.x + a.y * a.y) + (a.z * a.z + a.w * a.w);
        const float rstd = rsqrtf(wave_sum(ss) * (1.f / 256.f) + EPSN);
        const float g0 = bf2f((unsigned short)gv), g1 = bf2f((unsigned short)(gv >> 16)), g2 = bf2f((unsigned short)(gv >> 32)), g3 = bf2f((unsigned short)(gv >> 48));
        *(GAS unsigned long long*)(F.MIX() + (R0 + t) * DM + 1024 + h * 256 + 4 * lane) =
            (unsigned long long)pk2(a.x * rstd * gn.x * silu_f(g0), a.y * rstd * gn.y * silu_f(g1)) | ((unsigned long long)pk2(a.z * rstd * gn.z * silu_f(g2), a.w * rstd * gn.w * silu_f(g3)) << 32);
    }
}

__device__ __forceinline__ void final_rows(Frame& F) { gcf const x_prompt = ldarg<A_XP>(); gcf const x_sample = ldarg<A_XS>(); gcf const norm_post = ldarg<A_NPOST>();
    const int gw = blockIdx.x * NWAVES + F.wave, NGW = F.G * NWAVES; constexpr int NR = NBATCH * SEQ + ROWS_S;
    for (int idx0 = gw; idx0 < NR; idx0 += 2 * NGW) {
        f32x4 v[2][8], xx[2][8]; float* yp[2]; bool on[2];
#pragma unroll
        for (int q = 0; q < 2; ++q) { const int idx = idx0 + q * NGW; on[q] = idx < NR; const int id2 = on[q] ? idx : idx0;
            size_t grow; gcf x;
            if (id2 < NBATCH * SEQ) { const int b = id2 / SEQ, s2 = id2 - b * SEQ; grow = (size_t)b * LP + 128 + s2; x = x_prompt + (size_t)id2 * DM; yp[q] = F.out + O_YP + (size_t)id2 * DM; }
            else { const int j = id2 - NBATCH * SEQ; grow = (size_t)ROWS_P + j; x = x_sample + (size_t)j * DM; yp[q] = F.out + O_YS + (size_t)j * DM; }
            const GAS unsigned long long* o4 = (const GAS unsigned long long*)yp[q] + F.lane;   const GAS f32x4* x4 = (const GAS f32x4*)x + F.lane;
#pragma unroll
            for (int j = 0; j < 8; ++j) { const unsigned long long ov = o4[64 * j]; v[q][j] = (f32x4){bf2f((unsigned short)ov), bf2f((unsigned short)(ov >> 16)), bf2f((unsigned short)(ov >> 32)), bf2f((unsigned short)(ov >> 48))}; xx[q][j] = x4[64 * j]; } }
#pragma unroll
        for (int q = 0; q < 2; ++q) { float s2 = 0.f;
#pragma unroll
            for (int j = 0; j < 8; ++j) s2 += (v[q][j].x * v[q][j].x + v[q][j].y * v[q][j].y) + (v[q][j].z * v[q][j].z + v[q][j].w * v[q][j].w);
            const float rstd = rsqrtf(wave_sum(s2) * (1.f / DM) + EPSN);
            if (on[q]) { GAS f32x4* y4 = (GAS f32x4*)yp[q] + F.lane;
#pragma unroll
                for (int j = 0; j < 8; ++j) { const f32x4 w = ((const GAS f32x4*)norm_post)[F.lane + 64 * j]; y4[64 * j] = xx[q][j] + v[q][j] * rstd * w; } } }
    }
}

constexpr int PS_ROWB = (DM / 2) * 2 + 16;
static_assert(64 * PS_ROWB <= LDS_BYTES - SCR_OFF, "sample projection LDS");
__device__ __forceinline__ void proj_sample_rows(Frame& F0, LAS unsigned char* scr, int rgrp, int cgrp) { Frame F = F0; asm volatile("" : "+v"(F.tid), "+v"(F.lane));
    const int lane = F.lane, gq = lane >> 4, i = lane & 15, w = F.wave;
    const bf16* ap = F.MIX() + ((size_t)ROWS_P + 128 * rgrp + 16 * w + i) * DM + 16 * gq;
    const bf16* wp = F.WoutT() + (size_t)(64 * cgrp) * DM;
    v4u a0[8], a1[8];
#define PS_LOADA(dst, ch) do { _Pragma("unroll") for (int ks = 0; ks < 8; ++ks) dst[ks] = *(const GAS v4u*)(ap + 256 * (ch) + 64 * (ks >> 1) + 8 * (ks & 1)); } while (0)
    v4u t_[16];
#define PS_LOADW(half) do { _Pragma("unroll") for (int j = 0; j < 16; ++j) { const int pc = F.tid + 512 * j, row = pc >> 7, c16 = pc & 127; t_[j] = *(const GAS v4u*)(wp + (size_t)row * DM + (DM / 2) * (half) + 8 * c16); } } while (0)
#define PS_STOREW() do { _Pragma("unroll") for (int j = 0; j < 16; ++j) { const int pc = F.tid + 512 * j, row = pc >> 7, c16 = pc & 127; *(LAS v4u*)(scr + row * PS_ROWB + 16 * c16) = t_[j]; } } while (0)
#define PS_BAR() do { asm volatile("s_waitcnt lgkmcnt(0)" ::: "memory"); __builtin_amdgcn_s_barrier(); } while (0)
#define PS_MMA(src, chl) do { _Pragma("unroll") for (int ks = 0; ks < 8; ++ks) { const int off = (256 * (chl) + 64 * (ks >> 1) + 8 * (ks & 1)) * 2; \
        bf16x8 aa; { const v4u t2_ = src[ks]; __builtin_memcpy(&aa, &t2_, 16); } \
        _Pragma("unroll") for (int n = 0; n < 4; ++n) acc[n] = MFMA16(*(const LAS bf16x8*)(bl + n * 16 * PS_ROWB + off), aa, acc[n]); } } while (0)
    PS_LOADW(0);
    PS_LOADA(a0, 0); PS_LOADA(a1, 1);
    f32x4 acc[4];
#pragma unroll
    for (int n = 0; n < 4; ++n) acc[n] = (f32x4){0.f, 0.f, 0.f, 0.f};
    const LAS unsigned char* bl = scr + i * PS_ROWB + 32 * gq;
    PS_BAR();
    PS_STOREW();
    PS_LOADW(1);
    PS_BAR();
    PS_MMA(a0, 0); PS_LOADA(a0, 2); PS_MMA(a1, 1); PS_LOADA(a1, 3); PS_MMA(a0, 2); PS_LOADA(a0, 4); PS_MMA(a1, 3); PS_LOADA(a1, 5);
    PS_BAR();
    PS_STOREW();
    PS_BAR();
    PS_MMA(a0, 0); PS_LOADA(a0, 6); PS_MMA(a1, 1); PS_LOADA(a1, 7); PS_MMA(a0, 2); PS_MMA(a1, 3);
#undef PS_LOADA
#undef PS_LOADW
#undef PS_STOREW
#undef PS_BAR
#undef PS_MMA
#pragma unroll
    for (int n = 0; n < 4; ++n) { const f32x4 v = acc[n];
        bf16* rowp = (bf16*)(F.out + O_YS + (size_t)(128 * rgrp + 16 * w + i) * DM) + 64 * cgrp + 16 * n + 4 * gq;
        *(GAS unsigned long long*)rowp = (unsigned long long)pk2(v[0], v[1]) | ((unsigned long long)pk2(v[2], v[3]) << 32); }
}

#ifndef MK_PER_PHASE
#define MK_PER_PHASE 0
#endif
constexpr int N_PHASES = 7;
struct Args { const float* in[15]; float* out; unsigned char* ws; int ph_lo, ph_hi; };
__global__ void __launch_bounds__(NTHREADS, 2) hymba_fwd(Args args) {
    extern __shared__ __attribute__((aligned(16))) unsigned char lds_raw[];
    Frame F;
    F.lds = (LAS unsigned char*)lds_raw;
    F.tid = threadIdx.x; F.lane = F.tid & 63; F.wave = __builtin_amdgcn_readfirstlane(F.tid >> 6); F.G = gridDim.x;
    F.out = args.out; F.ws = args.ws;
    unsigned char* ws = args.ws;
    for (int u = F.tid; u < LDS_CTL_BYTES / 4; u += NTHREADS) ((LAS unsigned*)F.lds)[u] = 0u;
    __syncthreads();
    volatile LAS unsigned* MISC = (volatile LAS unsigned*)(F.lds + 512);
    XcdBarrier bar; bar.bar = (unsigned*)(ws + WS_CTL) + CW_BAR; bar.x = 0; bar.st = nullptr;
    if (!MK_PER_PHASE) bar = xcd_barrier_post((unsigned*)(ws + WS_CTL) + CW_BAR, MISC + 8);
    LAS unsigned char* scr = F.lds + SCR_OFF;
    const int lo = args.ph_lo, hi = args.ph_hi;
#define IN(k) (lo <= (k) && (k) < hi)
#define SEAM(k) do { if (IN(k) && IN((k) + 1)) xcd_barrier(bar); } while (0)

#ifndef PROBE_PHASE
#define PROBE_PHASE -1
#endif
#ifndef PROBE_REP
#define PROBE_REP 1
#endif
#define REPS(k) for (int rep_ = 0; rep_ < ((k) == PROBE_PHASE ? PROBE_REP : 1); ++rep_)
    constexpr int P0_I_IN = (DM / 64) * (NPAD / 64), P0_I_ALL = P0_I_IN + (DM / 64) * (DM / 64);
    constexpr int G1_TAIL = (MROWS / 256) * (NPAD / 256) % 256;
    const bool wout_late = (F.G == 256) && !MK_PER_PHASE && IN(0) && IN(1) && IN(2) && PROBE_PHASE < 0;
    REPS(0) if (IN(0)) { p0_prologue(F, 0, wout_late ? P0_I_IN : P0_I_ALL, 0, F.G, true); if (PROBE_PHASE == 0) xcd_barrier(bar); }
    SEAM(0);
#define UNIT_BCH(idx, b_, c_, h_) const int b_ = (idx) < 256 ? (idx) >> 7 : ((idx) - 256) >> 2, c_ = (idx) < 256 ? 1 + (((idx) >> 2) & 31) : 0, h_ = (idx) & 3
    const bool split12 = (F.G == 256) && !MK_PER_PHASE && IN(0) && IN(1) && IN(2) && PROBE_PHASE < 0;
    if (split12) {
        constexpr int G1_MP = ROWS_P / 256, G1_MS = ROWS_S / 256, G1_N = NPAD / 256, G1_FULL = (G1_MP + G1_MS) * G1_N / 256;
        const int cb_ = (int)blockIdx.x;
        { pg8::Gemm g{F.XN(), F.WinT(), MROWS, NPAD, DM}; pg8::OrderPF S{G1_MP, G1_MS, G1_N, F.G, cb_, 0, G1_FULL};
          pg8::EpiBf16<0> E{F.P(), NPAD, nullptr, 0, 0, 1.f}; pg8::gemm_phase<pg8::EpiBf16<0>, pg8::OrderPF, true, true>(scr, g, S, E); }
        xcd_barrier(bar);
        if (cb_ < G1_TAIL) {
            { pg8::Gemm g{F.XN(), F.WinT(), MROWS, NPAD, DM}; pg8::OrderPF S{G1_MP, G1_MS, G1_N, F.G, cb_, G1_FULL, G1_FULL + 1};
              pg8::EpiBf16<0> E{F.P(), NPAD, nullptr, 0, 0, 1.f}; pg8::gemm_phase<pg8::EpiBf16<0>, pg8::OrderPF, true, true>(scr, g, S, E); }
        } else { UNIT_BCH(cb_, b_, c_, h_); attn_prompt_unit(F, scr, b_, c_, h_); gla_ds_unit(F, scr, b_, c_, h_); }
        xcd_barrier(bar);
        if (cb_ < G1_TAIL) { { UNIT_BCH(cb_, b_, c_, h_); attn_prompt_unit(F, scr, b_, c_, h_); gla_ds_unit(F, scr, b_, c_, h_); } gla_sample_unit(F, scr, cb_); }
        else if (cb_ < G1_TAIL + 8) { UNIT_BCH(256 + (cb_ - G1_TAIL), b_, c_, h_); attn_prompt_unit(F, scr, b_, c_, h_); gla_ds_unit(F, scr, b_, c_, h_); gla_out_unit(F, scr, b_, c_, h_); }
        else { const int v = cb_ - (G1_TAIL + 8), nb = 256 - (G1_TAIL + 8);
            attn_sample_pair(F, scr, v, 256 + v); if (nb + v < 256) attn_sample_pair(F, scr, nb + v, 256 + nb + v);
            gla_sample_unit(F, scr, G1_TAIL + v); gla_sample_unit(F, scr, G1_TAIL + nb + v);
            { constexpr int N1 = 2 * (256 - (G1_TAIL + 8)) - 256;
              const int n3 = DBATCH * 4 - (G1_TAIL + 2 * nb), v1 = v - (nb - N1);
              if (v1 >= 0) { gla_sample_unit(F, scr, G1_TAIL + 2 * nb + v1); const int v4 = v1 - (2 * N1 - n3); if (v4 >= 0) gla_sample_unit(F, scr, G1_TAIL + 2 * nb + N1 + v4);
                             else { __syncthreads(); p0_prologue(F, P0_I_IN, P0_I_ALL, G1_TAIL + 8 + (nb - N1), 2 * N1 - n3, false); } } } }
    } else {
    REPS(1) if (IN(1)) {
        pg8::Gemm g{F.XN(), F.WinT(), MROWS, NPAD, DM}; pg8::StaticOrder S; S.init(MROWS, NPAD, F.G, (int)blockIdx.x);
        pg8::EpiBf16<0> E{F.P(), NPAD, nullptr, 0, 0, 1.f};
        pg8::gemm_phase<pg8::EpiBf16<0>, pg8::StaticOrder, true, true>(scr, g, S, E);
        if (wout_late && (int)blockIdx.x >= G1_TAIL) { __syncthreads(); p0_prologue(F, P0_I_IN, P0_I_ALL, G1_TAIL, F.G - G1_TAIL, false); }
        if (PROBE_PHASE == 1) xcd_barrier(bar);
    }
    SEAM(1);
    REPS(2) if (IN(2)) {
        REPS(20) for (int u = blockIdx.x; u < NBATCH * NBLK * 4; u += F.G) { UNIT_BCH(u, b_, c_, h_); attn_prompt_unit(F, scr, b_, c_, h_); }
        REPS(21) for (int u = blockIdx.x; u < NBATCH * NBLK * 4; u += F.G) { UNIT_BCH(u, b_, c_, h_); gla_ds_unit(F, scr, b_, c_, h_); }
        if (F.G == 256) {
            if (blockIdx.x < 8) { UNIT_BCH(256 + (int)blockIdx.x, b_, c_, h_); gla_out_unit(F, scr, b_, c_, h_); }
            else { const int v = (int)blockIdx.x - 8;
                attn_sample_pair(F, scr, v, 248 + v); if (v < 16) attn_sample_unit(F, scr, 496 + v);
                gla_sample_unit(F, scr, v); gla_sample_unit(F, scr, 248 + v); if (v >= 16 && v < 32) gla_sample_unit(F, scr, 496 + v - 16); }
        } else {
            for (int u = 256 + blockIdx.x; u < NBATCH * NBLK * 4; u += F.G) { UNIT_BCH(u, b_, c_, h_); gla_out_unit(F, scr, b_, c_, h_); }
            REPS(22) for (int u = blockIdx.x; u < DBATCH * 4; u += F.G) attn_sample_unit(F, scr, u);
            REPS(23) for (int u = blockIdx.x; u < DBATCH * 4; u += F.G) gla_sample_unit(F, scr, u);
        }
        if (PROBE_PHASE == 2) xcd_barrier(bar);
    }
    }
    SEAM(2);
    REPS(3) if (IN(3)) { gla_scan(F); if (PROBE_PHASE == 3) xcd_barrier(bar); }
    SEAM(3);
    REPS(4) if (IN(4)) {
        for (int u = blockIdx.x; u < 256; u += F.G) { UNIT_BCH(u, b_, c_, h_); gla_out_unit(F, scr, b_, c_, h_); }
        __syncthreads();
        if (PROBE_PHASE == 4) xcd_barrier(bar);
    }
    SEAM(4);
    REPS(5) if (IN(5)) {
        if (F.G == 256) {
            pg8::Gemm g{F.MIX(), F.WoutT(), MROWS, DM, DM}; pg8::OrderG2 S; S.so.init(NBATCH * SEQ, DM, F.G, (int)blockIdx.x);
            pg8::EpiY16<128> E{F.out + O_YP, F.out + O_YS, LP, SEQ, ROWS_P};
            pg8::gemm_phase<pg8::EpiY16<128>, pg8::OrderG2, true, true>(scr, g, S, E);
            { const int xc = (int)blockIdx.x & 7, lc = (int)blockIdx.x >> 3;
              proj_sample_rows(F, scr, 4 * (xc & 1) + (lc & 3), 8 * (xc >> 1) + (lc >> 2)); }
        } else {
        pg8::Gemm g{F.MIX(), F.WoutT(), MROWS, DM, DM}; pg8::StaticOrder S; S.init(MROWS, DM, F.G, (int)blockIdx.x);
        pg8::EpiY16<256> E{F.out + O_YP, F.out + O_YS, LP, SEQ, ROWS_P};
        pg8::gemm_phase<pg8::EpiY16<256>, pg8::StaticOrder, true, true>(scr, g, S, E);
        }
        if (PROBE_PHASE == 5) xcd_barrier(bar);
    }
    SEAM(5);
    REPS(6) if (IN(6)) { final_rows(F); if (PROBE_PHASE == 6) xcd_barrier(bar); }
#undef IN
#undef SEAM
}

extern "C" void kernel_launch(void* const* d_in, const int* in_sizes, int n_in, void* d_out, int out_size, void* d_ws, size_t ws_size, hipStream_t stream) {
    static int grid = 0;
    if (grid == 0) {
        if (n_in != 15 || out_size != (int)O_END || ws_size < WS_END) { fprintf(stderr, "kernel_launch: unexpected problem: n_in %d out %d ws %zu\n", n_in, out_size, ws_size); grid = -1; return; }
        int dev = 0, cus = 0, per_cu = 0;
        if (hipGetDevice(&dev) != hipSuccess || hipDeviceGetAttribute(&cus, hipDeviceAttributeMultiprocessorCount, dev) != hipSuccess) { grid = -1; return; }
        if (hipFuncSetAttribute((const void*)hymba_fwd, hipFuncAttributeMaxDynamicSharedMemorySize, LDS_BYTES) != hipSuccess) { fprintf(stderr, "kernel_launch: hipFuncSetAttribute failed\n"); grid = -1; return; }
        if (hipOccupancyMaxActiveBlocksPerMultiprocessor(&per_cu, (const void*)hymba_fwd, NTHREADS, LDS_BYTES) != hipSuccess || per_cu < 1) fprintf(stderr, "kernel_launch: note: occupancy query reports %d\n", per_cu);
        (void)hipGetLastError();
        grid = cus;
    }
    if (grid < 0) return;
    (void)hipMemsetAsync((char*)d_ws + WS_CTL, 0, CTL_ZERO_BYTES, stream);
    Args a{};
    for (int i = 0; i < 15; ++i) a.in[i] = (const float*)d_in[i];
    a.out = (float*)d_out; a.ws = (unsigned char*)d_ws;
#if MK_PER_PHASE
    for (int p = 0; p < N_PHASES; ++p) { a.ph_lo = p; a.ph_hi = p + 1; hipLaunchKernelGGL(hymba_fwd, dim3(grid), dim3(NTHREADS), LDS_BYTES, stream, a); }
#else
    a.ph_lo = 0; a.ph_hi = N_PHASES;
    hipLaunchKernelGGL(hymba_fwd, dim3(grid), dim3(NTHREADS), LDS_BYTES, stream, a);
#endif
}
```
